# Optimizing an MI355X kernel written in HIP

```python
import math
import jax, jax.numpy as jnp
from jax import lax
import numpy as np

D_MODEL = 1024
BATCH = 8
SEQ = 2048
DEPTH = 2

POOL_WINDOWS = (2, 4, 8, 16)
N_POOL_GROUPS = len(POOL_WINDOWS)
POOL_GROUP_DIM = D_MODEL // N_POOL_GROUPS
HEAD_DIM = 64
N_HEADS = D_MODEL // HEAD_DIM
Q_BLOCK = 128
N_EXPERTS = 32
TOP_K = 4
D_FF = D_MODEL
SWIGLU_LIMIT = 7.0
SWIGLU_ALPHA = 1.702
RMS_EPS = 1e-6
N_MIXERS = 2
N_POOL_LAYERS = (DEPTH + 1) // 2
N_SB_LAYERS = DEPTH // 2

kernel_name = "hybrid_pool_stickbreak_moe"


def rmsnorm(x, g):
    xf = x.astype(jnp.float32)
    y = xf * lax.rsqrt(jnp.mean(xf * xf, axis=-1, keepdims=True) + RMS_EPS)
    return (y * g.astype(jnp.float32)).astype(x.dtype)


def pool_mixer(h, w_groups, scale):
    B, S, D = h.shape
    hf = h.astype(jnp.float32)
    c = jnp.cumsum(hf, axis=1)
    pos = jnp.arange(S)
    outs = []
    for g, w in enumerate(POOL_WINDOWS):
        cg = c[..., g * POOL_GROUP_DIM:(g + 1) * POOL_GROUP_DIM]
        lag = jnp.pad(cg, ((0, 0), (w, 0), (0, 0)))[:, :S]
        cnt = jnp.minimum(pos + 1, w).astype(jnp.float32)[None, :, None]
        outs.append((cg - lag) / cnt)
    pooled = jnp.concatenate(outs, axis=-1) - hf
    pooled = pooled.reshape(B, S, N_POOL_GROUPS, POOL_GROUP_DIM).astype(h.dtype)
    y = jnp.einsum('bsgc,gcd->bsgd', pooled, w_groups).reshape(B, S, D)
    return y * scale


def stick_breaking_attention(h, w_qkv, q_gain, k_gain, w_o):
    B, S, D = h.shape
    qkv = h @ w_qkv
    q, k, v = jnp.split(qkv, 3, axis=-1)
    q = rmsnorm(q.reshape(B, S, N_HEADS, HEAD_DIM), q_gain).transpose(0, 2, 1, 3)
    k = rmsnorm(k.reshape(B, S, N_HEADS, HEAD_DIM), k_gain).transpose(0, 2, 1, 3)
    v = v.reshape(B, S, N_HEADS, HEAD_DIM).transpose(0, 2, 1, 3)
    kf = k.astype(jnp.float32)
    n_blk = S // Q_BLOCK
    q_blocks = jnp.moveaxis(q.reshape(B, N_HEADS, n_blk, Q_BLOCK, HEAD_DIM), 2, 0)
    starts = jnp.arange(n_blk, dtype=jnp.int32) * Q_BLOCK
    inv_sqrt_d = 1.0 / math.sqrt(HEAD_DIM)
    kpos = jnp.arange(S, dtype=jnp.int32)

    def block(args):
        qb, q0 = args
        z = jnp.einsum('bhqd,bhkd->bhqk', qb.astype(jnp.float32), kf) * inv_sqrt_d
        qpos = q0 + jnp.arange(Q_BLOCK, dtype=jnp.int32)
        causal = kpos[None, :] < qpos[:, None]
        log_beta = jax.nn.log_sigmoid(z)
        log_keep = jnp.where(causal, jax.nn.log_sigmoid(-z), 0.0)
        suffix = lax.cumsum(log_keep, axis=3, reverse=True) - log_keep
        a = jnp.where(causal, jnp.exp(log_beta + suffix), 0.0)
        return jnp.einsum('bhqk,bhkd->bhqd', a.astype(v.dtype), v)

    o = lax.map(block, (q_blocks, starts))
    o = jnp.moveaxis(o, 0, 2).reshape(B, N_HEADS, S, HEAD_DIM)
    o = o.transpose(0, 2, 1, 3).reshape(B, S, D)
    return o @ w_o


def moe(h, router_w, router_b, w_gate_up, b_gate_up, w_down, b_down):
    B, S, D = h.shape
    t = h.reshape(B * S, D)
    logits = (t @ router_w).astype(jnp.float32) + router_b.astype(jnp.float32)
    top_val, top_idx = lax.top_k(logits, TOP_K)
    top_w = jax.nn.softmax(top_val, axis=-1)
    gates = jnp.sum(jax.nn.one_hot(top_idx, N_EXPERTS, dtype=jnp.float32) * top_w[..., None], axis=1)
    y = jnp.zeros((B * S, D), jnp.float32)
    for e in range(N_EXPERTS):
        gu = t @ w_gate_up[e] + b_gate_up[e]
        gate, up = gu[:, :D_FF], gu[:, D_FF:]
        gate = jnp.minimum(gate, SWIGLU_LIMIT)
        up = jnp.clip(up, -SWIGLU_LIMIT, SWIGLU_LIMIT)
        act = (up + 1) * (gate * jax.nn.sigmoid(SWIGLU_ALPHA * gate))
        out = act @ w_down[e] + b_down[e]
        y = y + gates[:, e:e + 1] * out.astype(jnp.float32)
    return y.astype(h.dtype).reshape(B, S, D)


def setup_inputs(seed: int = 0) -> dict:
    key = jax.random.key(seed)
    ks = jax.random.split(key, 16)
    f32 = jnp.float32
    D, F, E = D_MODEL, D_FF, N_EXPERTS
    nrm = lambda k, shape, s: jax.random.normal(k, shape, f32) * s
    return {
        "x": nrm(ks[0], (BATCH, SEQ, D), 1.0),
        "mix_norm": 1.0 + nrm(ks[1], (DEPTH, D), 0.02),
        "pool_w": nrm(ks[2], (N_POOL_LAYERS, N_POOL_GROUPS, POOL_GROUP_DIM, POOL_GROUP_DIM), POOL_GROUP_DIM ** -0.5),
        "pool_scale": 1.0 + nrm(ks[3], (N_POOL_LAYERS, D), 0.02),
        "w_qkv": nrm(ks[4], (N_SB_LAYERS, D, 3 * D), D ** -0.5),
        "q_norm": 1.0 + nrm(ks[5], (N_SB_LAYERS, HEAD_DIM), 0.02),
        "k_norm": 1.0 + nrm(ks[6], (N_SB_LAYERS, HEAD_DIM), 0.02),
        "w_o": nrm(ks[7], (N_SB_LAYERS, D, D), D ** -0.5),
        "ffn_norm": 1.0 + nrm(ks[8], (DEPTH, D), 0.02),
        "router_w": nrm(ks[9], (DEPTH, D, E), D ** -0.5),
        "router_b": nrm(ks[10], (DEPTH, E), 0.01),
        "w_gate_up": nrm(ks[11], (DEPTH, E, D, 2 * F), D ** -0.5),
        "b_gate_up": nrm(ks[12], (DEPTH, E, 2 * F), 0.01),
        "w_down": nrm(ks[13], (DEPTH, E, F, D), F ** -0.5),
        "b_down": nrm(ks[14], (DEPTH, E, D), 0.01),
    }


def reference(x, mix_norm, pool_w, pool_scale, w_qkv, q_norm, k_norm, w_o,
              ffn_norm, router_w, router_b, w_gate_up, b_gate_up, w_down, b_down):
    for i in range(DEPTH):
        h = rmsnorm(x, mix_norm[i])
        j = i // N_MIXERS
        if i % N_MIXERS == 0:
            x = x + pool_mixer(h, pool_w[j], pool_scale[j])
        else:
            x = x + stick_breaking_attention(h, w_qkv[j], q_norm[j], k_norm[j], w_o[j])
        h = rmsnorm(x, ffn_norm[i])
        x = x + moe(h, router_w[i], router_b[i], w_gate_up[i], b_gate_up[i], w_down[i], b_down[i])
    return x
```

```cpp
#include <hip/hip_runtime.h>
#include <cstdio>
#include <cstdint>

#define GAS __attribute__((address_space(1)))
#define LAS __attribute__((address_space(3)))
typedef unsigned short bf16;
typedef unsigned u32x4 __attribute__((ext_vector_type(4)));
typedef unsigned u32x2 __attribute__((ext_vector_type(2)));
typedef float f32x4 __attribute__((ext_vector_type(4)));
typedef float f32x2 __attribute__((ext_vector_type(2)));
typedef float f32x16 __attribute__((ext_vector_type(16)));
typedef short bf16x8 __attribute__((ext_vector_type(8)));
typedef short s16x4 __attribute__((ext_vector_type(4)));
typedef short v4i16_t __attribute__((ext_vector_type(4)));
typedef __bf16 bf16x2_t __attribute__((ext_vector_type(2)));
typedef GAS unsigned gu32;

constexpr int BATCH = 8, SEQ = 2048, D = 1024, M = BATCH * SEQ, NH = 16, HD = 64, NE = 32, TOPK = 4, FF = 1024;
constexpr float RMS_EPS = 1e-6f, SW_LIMIT = 7.0f, SW_ALPHA = 1.702f;
constexpr int MT_MAX = M * TOPK / 256 + NE;
constexpr int NSLOT = MT_MAX * 256;
constexpr float C2 = 0.125f * 1.4426950408889634f;

constexpr size_t MiB = 1u << 20;
constexpr size_t WS_CTL = 0, CTL_ZERO_BYTES = 1 * MiB;
constexpr size_t WS_POOLW = 1 * MiB;
constexpr size_t WS_WQKV = 2 * MiB;
constexpr size_t WS_WO = 8 * MiB;
constexpr size_t WS_TOPE = 10 * MiB, WS_TOPP = WS_TOPE + 256 * 1024, WS_TOPW = WS_TOPP + 256 * 1024;
constexpr size_t WS_LIST = 12 * MiB;
constexpr size_t WS_WGU = 16 * MiB;
constexpr size_t WS_WDN = 272 * MiB;
constexpr size_t WS_X1 = 400 * MiB, WS_X2 = 464 * MiB, WS_X3 = 528 * MiB;
constexpr size_t WS_POOLED = 592 * MiB, WS_H2 = 624 * MiB, WS_HQ = 656 * MiB, WS_Q = 688 * MiB, WS_K = 720 * MiB, WS_V = 752 * MiB, WS_O = 784 * MiB;
constexpr size_t WS_ACT = 816 * MiB, WS_OUTS = 960 * MiB;
constexpr size_t WS_END = 1104 * MiB;
static_assert(WS_ACT + (size_t)NSLOT * 1024 * 2 <= WS_OUTS && WS_OUTS + (size_t)NSLOT * 1024 * 2 <= WS_END, "ws map");
constexpr int CW_TMO = 0, CW_CODE = 1;
constexpr int CW_BAR = 4096;
constexpr int CW_ECNT = 16384;

constexpr int RING_BYTES = 131072;
constexpr int LDSCTL_OFF = RING_BYTES, MISC_OFF = LDSCTL_OFF + 320;
constexpr int TAB_OFF = 131584;
constexpr int TAB_ECNT = TAB_OFF, TAB_TBASE = TAB_OFF + 128, TAB_TEXP = TAB_OFF + 384, TAB_ROW = TAB_OFF + 1024;
constexpr int MAXU = 12;
constexpr int LDS_BYTES = 147456;
static_assert(TAB_ROW + MAXU * 1024 <= LDS_BYTES, "LDS map");

constexpr int NWAVES = 8;
#ifndef MK_PER_PHASE
#define MK_PER_PHASE 0
#endif
#ifndef MK_LAST_PHASE
#define MK_LAST_PHASE 12
#endif

#define RLX_AGENT __ATOMIC_RELAXED, __HIP_MEMORY_SCOPE_AGENT
#define LDS_WAIT() asm volatile("s_waitcnt lgkmcnt(0)" ::: "memory")
#define VM_WAIT() asm volatile("s_waitcnt vmcnt(0)" ::: "memory")
__device__ __forceinline__ unsigned cvtpk(float lo, float hi) { f32x2 v = {lo, hi}; bf16x2_t b = __builtin_convertvector(v, bf16x2_t); return __builtin_bit_cast(unsigned, b); }
__device__ __forceinline__ float bf_lo(unsigned u) { return __uint_as_float(u << 16); }
__device__ __forceinline__ float bf_hi(unsigned u) { return __uint_as_float(u & 0xffff0000u); }
__device__ __forceinline__ float wave_sum(float v) {
#pragma unroll
    for (int o = 1; o < 64; o <<= 1) v += __shfl_xor(v, o);
    return v;
}

#define XB_TMO      128
#define XB_XCNT(j)  (256  + 64 * (j))
#define XB_XSUB(j)  (1280 + 64 * (j))
#define XB_XGEN(j)  (2304 + 64 * (j))
#define XB_TOP      3328
#define XB_TOPGEN   3392
#define XCD_BAR_WORDS 3456
#define XB_SPIN_CAP (1u << 18)
__device__ __forceinline__ unsigned xb_ld(unsigned* p)              { return __hip_atomic_load(p, __ATOMIC_RELAXED, __HIP_MEMORY_SCOPE_AGENT); }
__device__ __forceinline__ unsigned xb_add(unsigned* p, unsigned v) { return __hip_atomic_fetch_add(p, v, __ATOMIC_RELAXED, __HIP_MEMORY_SCOPE_AGENT); }
__device__ __forceinline__ unsigned xb_xcc_id() { return (unsigned)__builtin_amdgcn_s_getreg((3 << 11) | 20) & 0xFu; }
#define XB_SPIN(cond, bar) do { unsigned _sp = 0; while (cond) { __builtin_amdgcn_s_sleep(1); \
    if ((++_sp & 255u) == 0u) { if (xb_ld(&(bar)[XB_TMO])) break; if (_sp > XB_SPIN_CAP) { atomicAdd(&(bar)[XB_TMO], 1u); break; } } } } while (0)
struct XcdBarrier { unsigned* bar; unsigned x; volatile LAS unsigned* st; };
__device__ __forceinline__ XcdBarrier xcd_barrier_post(unsigned* bar, volatile LAS unsigned* st) {
    XcdBarrier b; b.bar = bar; b.x = xb_xcc_id(); b.st = st;
    if (threadIdx.x == 0) (void)xb_add(&bar[XB_XCNT(b.x)], 1u);
    return b;
}
__device__ __forceinline__ void xcd_barrier_complete(unsigned* bar, unsigned x, unsigned& nloc, unsigned& nx) {
    const unsigned G = gridDim.x * gridDim.y * gridDim.z;
    unsigned sum, cnt, mine, sp = 0u;
    for (;;) {
        sum = 0u; cnt = 0u; mine = 0u;
#pragma unroll
        for (unsigned j = 0; j < 16; ++j) { const unsigned c = xb_ld(&bar[XB_XCNT(j)]); sum += c; cnt += (c > 0u) ? 1u : 0u; mine = (j == x) ? c : mine; }
        if (sum == G) break;
        __builtin_amdgcn_s_sleep(1);
        if ((++sp & 255u) == 0u) { if (xb_ld(&bar[XB_TMO])) break; if (sp > XB_SPIN_CAP) { atomicAdd(&bar[XB_TMO], 1u); break; } }
    }
    nloc = mine > 0u ? mine : 1u; nx = cnt > 0u ? cnt : 1u;
}
__device__ __forceinline__ void xcd_barrier(const XcdBarrier& b) {
    asm volatile("s_waitcnt vmcnt(0)" ::: "memory");
    __syncthreads();
    if (threadIdx.x == 0) {
        unsigned* bar = b.bar;
        __builtin_amdgcn_s_waitcnt(0);
        unsigned nloc = b.st[0], nx = b.st[1];
        if (nloc == 0u) { xcd_barrier_complete(bar, b.x, nloc, nx); b.st[0] = nloc; b.st[1] = nx; }
        const unsigned old = xb_add(&bar[XB_XSUB(b.x)], 1u);
        const unsigned gen = old / nloc;
        if (old + 1u == (gen + 1u) * nloc) {
            __builtin_amdgcn_fence(__ATOMIC_RELEASE, "agent");
            asm volatile("s_waitcnt vmcnt(0)" ::: "memory");
            const unsigned og = xb_add(&bar[XB_TOP], 1u);
            const unsigned tg = og / nx;
            if (og + 1u == (tg + 1u) * nx) xb_add(&bar[XB_TOPGEN], 1u);
            else XB_SPIN(xb_ld(&bar[XB_TOPGEN]) == tg, bar);
            __builtin_amdgcn_fence(__ATOMIC_ACQUIRE, "agent");
            xb_add(&bar[XB_XGEN(b.x)], 1u);
            asm volatile("s_waitcnt vmcnt(0)" ::: "memory");
        } else {
            XB_SPIN(xb_ld(&bar[XB_XGEN(b.x)]) == gen, bar);
            __builtin_amdgcn_fence(__ATOMIC_ACQUIRE, "agent");
            asm volatile("s_waitcnt vmcnt(0)" ::: "memory");
        }
    }
    __syncthreads();
}

namespace pg8 {
constexpr int BM = 256, BK = 64, HALF = 128, HTB = HALF * BK * 2, STAGE_BYTES = 8 * HTB, NXCD = 8, WGM = 8;
__host__ __device__ __forceinline__ int lds_byte(int r, int c) { const int st = (r >> 4) * 2 + (c >> 5), rr = r & 15, cc = c & 31, ob = rr * 64 + cc * 2; return st * 1024 + (ob ^ (((ob >> 9) & 1) << 5)); }
__host__ __device__ __forceinline__ void stage_rc(int b, int& R, int& C) { const int st = b / 1024, sb = b % 1024, swz = sb ^ (((sb >> 9) & 1) << 5); R = (st >> 1) * 16 + swz / 64; C = (st & 1) * 32 + (swz % 64) / 2; }
__host__ __device__ __forceinline__ int perm32(int rho) { const int n = rho >> 4, i = rho & 15; return 8 * (i >> 2) + 4 * n + (i & 3); }

struct Unit { int pm, pn, e; };
struct UD { const char* a; const char* b0; const char* b1; };

__device__ __forceinline__ bool order_next(int i, int G, int c, int nM, int nN, int& pm, int& pn) {
    const long L = (long)i * G + c; const int nwg = nM * nN; if (L >= nwg) return false;
    int wgid = (int)L; { const int q = nwg / NXCD, r = nwg % NXCD, xcd = wgid % NXCD, off = wgid / NXCD; wgid = (xcd < r ? xcd * (q + 1) : r * (q + 1) + (xcd - r) * q) + off; }
    const int nig = WGM * nN, gid = wgid / nig, fm = gid * WGM, gsz = (nM - fm) < WGM ? (nM - fm) : WGM;
    pm = fm + ((wgid % nig) % gsz); pn = (wgid % nig) / gsz; return true;
}

template <class Prob, class Epi>
__device__ __forceinline__ void gemm_phase(LAS unsigned char* lds, const Prob& S, const Epi& E) {
    const int tid = threadIdx.x, wid = __builtin_amdgcn_readfirstlane(tid >> 6), lane = tid & 63, wr = wid >> 2, wc = wid & 3, fr = lane & 15, fq = lane >> 4;
    const int nt = S.K / BK;
    int sR[2], sC[2]; unsigned voffB[2];
#pragma unroll
    for (int i = 0; i < 2; ++i) { int R, C; stage_rc(tid * 16 + i * 8192, R, C); sR[i] = R; sC[i] = C; const int Rb = Epi::PERM ? ((R & ~31) + perm32(R & 31)) : R; voffB[i] = (unsigned)(Rb * S.ldb + C) * 2u; }
    const size_t kstep = (size_t)(BK * 2);
    const unsigned ldsw = (unsigned)wid * 1024u;
    const int aoff = lds_byte(wr * 64 + fr, fq * 8), boff = lds_byte(wc * 32 + fr, fq * 8);
#define PG8_SA(b, h) (((b) * 2 + (h)) * HTB)
#define PG8_SB(b, h) ((4 + (b) * 2 + (h)) * HTB)
#define PG8_STA(bufoff, gbase, va, h) do { _Pragma("unroll") for (int _i = 0; _i < 2; ++_i) \
        __builtin_amdgcn_global_load_lds((const unsigned*)((const char*)(gbase) + (va)[(h) * 2 + _i]), (LAS unsigned*)(lds + (bufoff) + ldsw + _i * 8192), 16, 0, 0); } while (0)
#define PG8_STB(bufoff, gbase) do { _Pragma("unroll") for (int _i = 0; _i < 2; ++_i) \
        __builtin_amdgcn_global_load_lds((const unsigned*)((const char*)(gbase) + voffB[_i]), (LAS unsigned*)(lds + (bufoff) + ldsw + _i * 8192), 16, 0, 0); } while (0)
#define PG8_LDA(dst, b, h) do { _Pragma("unroll") for (int m = 0; m < 4; ++m) _Pragma("unroll") for (int k = 0; k < 2; ++k) dst[m][k] = *(const LAS bf16x8*)(lds + PG8_SA(b, h) + aoff + m * 2048 + k * 1024); } while (0)
#define PG8_LDB(dst, b, h) do { _Pragma("unroll") for (int n = 0; n < 2; ++n) _Pragma("unroll") for (int k = 0; k < 2; ++k) dst[n][k] = *(const LAS bf16x8*)(lds + PG8_SB(b, h) + boff + n * 2048 + k * 1024); } while (0)
#define PG8_MMA(ai, bj, At, Bt) do { __builtin_amdgcn_s_setprio(1); _Pragma("unroll") for (int m = 0; m < 4; ++m) _Pragma("unroll") for (int n = 0; n < 2; ++n) _Pragma("unroll") for (int k = 0; k < 2; ++k) \
        acc[ai][bj][m][n] = __builtin_amdgcn_mfma_f32_16x16x32_bf16(Bt[n][k], At[m][k], acc[ai][bj][m][n], 0, 0, 0); __builtin_amdgcn_s_setprio(0); } while (0)
#define PG8_WAIT_V(n) asm volatile("s_waitcnt vmcnt(" #n ")" ::: "memory")
#define PG8_WAIT_L(n) asm volatile("s_waitcnt lgkmcnt(" #n ")" ::: "memory")
#define PG8_BAR __builtin_amdgcn_s_barrier()
#define PG8_SCHED __builtin_amdgcn_sched_barrier(0)
    Unit cur, nxt; UD cd, nd; unsigned cva[4], nva[4]; int ui = 0;
    if (!S.next(0, cur)) return;
    S.desc(0, cur, cd, cva, sR, sC);
    f32x4 acc[2][2][4][2];
#pragma unroll
    for (int a = 0; a < 2; ++a)
#pragma unroll
        for (int b = 0; b < 2; ++b)
#pragma unroll
            for (int m = 0; m < 4; ++m)
#pragma unroll
                for (int n = 0; n < 2; ++n) acc[a][b][m][n] = (f32x4){0.f, 0.f, 0.f, 0.f};
    bf16x8 At[4][2], B0[2][2], B1[2][2];
    PG8_STB(PG8_SB(0, 0), cd.b0); PG8_STB(PG8_SB(0, 1), cd.b1); PG8_STA(PG8_SA(0, 0), cd.a, cva, 0); PG8_STA(PG8_SA(0, 1), cd.a, cva, 1);
    if (wr == 1) PG8_BAR;
    PG8_WAIT_V(2); PG8_BAR;
    PG8_STB(PG8_SB(1, 0), cd.b0 + kstep); PG8_STA(PG8_SA(1, 0), cd.a + kstep, cva, 0); PG8_STB(PG8_SB(1, 1), cd.b1 + kstep);
    PG8_WAIT_V(6); PG8_BAR;
    for (;;) {
        const bool has_next = S.next(ui + 1, nxt);
        if (has_next) S.desc(ui + 1, nxt, nd, nva, sR, sC);
        else { nd = cd;
#pragma unroll
            for (int q = 0; q < 4; ++q) nva[q] = cva[q]; }
        for (int t = 0; t < nt; t += 2) {
            const bool last = (t == nt - 2);
            const char* a1 = cd.a + (size_t)(t + 1) * kstep;
            const char* a2 = last ? nd.a : cd.a + (size_t)(t + 2) * kstep;
            const char* b20 = last ? nd.b0 : cd.b0 + (size_t)(t + 2) * kstep; const char* b21 = last ? nd.b1 : cd.b1 + (size_t)(t + 2) * kstep;
            const char* a3 = a2 + kstep; const char* b30 = b20 + kstep; const char* b31 = b21 + kstep;
            unsigned va2[4];
#pragma unroll
            for (int q = 0; q < 4; ++q) va2[q] = last ? nva[q] : cva[q];
            PG8_LDB(B0, 0, 0); PG8_LDB(B1, 0, 1); PG8_SCHED; PG8_LDA(At, 0, 0); PG8_STA(PG8_SA(1, 1), a1, cva, 1);
            PG8_WAIT_V(8); PG8_WAIT_L(0); PG8_BAR; PG8_MMA(0, 0, At, B0); PG8_MMA(0, 1, At, B1); PG8_BAR; PG8_SCHED;
            PG8_LDA(At, 0, 1); PG8_STB(PG8_SB(0, 0), b20); PG8_STB(PG8_SB(0, 1), b21); PG8_STA(PG8_SA(0, 0), a2, va2, 0);
            PG8_WAIT_V(8); PG8_WAIT_L(0); PG8_BAR; PG8_MMA(1, 0, At, B0); PG8_MMA(1, 1, At, B1); PG8_BAR; PG8_SCHED;
            PG8_LDB(B0, 1, 0); PG8_LDB(B1, 1, 1); PG8_SCHED; PG8_LDA(At, 1, 0); PG8_STA(PG8_SA(0, 1), a2, va2, 1);
            PG8_WAIT_V(8); PG8_WAIT_L(0); PG8_BAR; PG8_MMA(0, 0, At, B0); PG8_MMA(0, 1, At, B1); PG8_BAR; PG8_SCHED;
            PG8_LDA(At, 1, 1); PG8_STB(PG8_SB(1, 0), b30); PG8_STB(PG8_SB(1, 1), b31); PG8_STA(PG8_SA(1, 0), a3, va2, 0);
            PG8_WAIT_V(8); PG8_WAIT_L(0); PG8_BAR; PG8_MMA(1, 0, At, B0); PG8_MMA(1, 1, At, B1); PG8_BAR; PG8_SCHED;
        }
        if (wr == 0) PG8_BAR;
        E(acc, cur, wr, wc, fr, fq);
        if (!has_next) break;
#pragma unroll
        for (int a = 0; a < 2; ++a)
#pragma unroll
            for (int b = 0; b < 2; ++b)
#pragma unroll
                for (int m = 0; m < 4; ++m)
#pragma unroll
                    for (int n = 0; n < 2; ++n) acc[a][b][m][n] = (f32x4){0.f, 0.f, 0.f, 0.f};
        cur = nxt; cd = nd;
#pragma unroll
        for (int q = 0; q < 4; ++q) cva[q] = nva[q];
        ++ui;
        if (wr == 1) PG8_BAR;
    }
    PG8_WAIT_V(0);
    PG8_BAR;
#undef PG8_SA
#undef PG8_SB
#undef PG8_STA
#undef PG8_STB
#undef PG8_LDA
#undef PG8_LDB
#undef PG8_MMA
#undef PG8_WAIT_V
#undef PG8_WAIT_L
#undef PG8_BAR
#undef PG8_SCHED
}
}

struct Frame {
    LAS unsigned char* lds;
    volatile LAS unsigned* MISC;
    gu32* ctl;
    int tid, lane, wave, G;
    unsigned char* ws;
    const float *x, *mix_norm, *pool_w, *pool_scale, *w_qkv, *q_norm, *k_norm, *w_o, *ffn_norm, *router_w, *router_b, *w_gu, *b_gu, *w_dn, *b_dn;
    float* out;
};

struct ProbDense {
    const char* A; const char* Bt; int lda, ldb, K, nM, nN, G, c;
    __device__ __forceinline__ bool next(int i, pg8::Unit& u) const { u.e = 0; return pg8::order_next(i, G, c, nM, nN, u.pm, u.pn); }
    __device__ __forceinline__ void desc(int, const pg8::Unit& u, pg8::UD& d, unsigned (&va)[4], const int (&sR)[2], const int (&sC)[2]) const {
        d.a = A + (size_t)u.pm * 256 * lda * 2; d.b0 = Bt + (size_t)u.pn * 256 * ldb * 2; d.b1 = d.b0 + (size_t)128 * ldb * 2;
#pragma unroll
        for (int h = 0; h < 2; ++h)
#pragma unroll
            for (int i = 0; i < 2; ++i) va[h * 2 + i] = (unsigned)((h * 128 + sR[i]) * lda + sC[i]) * 2u;
    }
};
struct ProbPool {
    const char* A; const char* Bt; int ldb, K, G, c;
    __device__ __forceinline__ bool next(int i, pg8::Unit& u) const { u.e = 0; return pg8::order_next(i, G, c, M / 256, 4, u.pm, u.pn); }
    __device__ __forceinline__ void desc(int, const pg8::Unit& u, pg8::UD& d, unsigned (&va)[4], const int (&sR)[2], const int (&sC)[2]) const {
        d.a = A + (size_t)u.pm * 256 * D * 2 + (size_t)u.pn * 256 * 2; d.b0 = Bt + (size_t)u.pn * 65536 * 2; d.b1 = d.b0 + (size_t)128 * 256 * 2;
#pragma unroll
        for (int h = 0; h < 2; ++h)
#pragma unroll
            for (int i = 0; i < 2; ++i) va[h * 2 + i] = (unsigned)((h * 128 + sR[i]) * D + sC[i]) * 2u;
    }
};
struct ProbMoeUp {
    const char* A; const char* Bt; LAS unsigned char* lds; int ldb, K, nM, G, c;
    __device__ __forceinline__ bool next(int i, pg8::Unit& u) const { if (!pg8::order_next(i, G, c, nM, 8, u.pm, u.pn)) return false; u.e = (int)((const LAS unsigned char*)(lds + TAB_TEXP))[u.pm]; return true; }
    __device__ __forceinline__ void desc(int ord, const pg8::Unit& u, pg8::UD& d, unsigned (&va)[4], const int (&sR)[2], const int (&sC)[2]) const {
        d.a = A; d.b0 = Bt + ((size_t)u.e * 2048 + (size_t)u.pn * 128) * 1024 * 2; d.b1 = d.b0 + (size_t)1024 * 1024 * 2;
        const LAS unsigned* rt = (const LAS unsigned*)(lds + TAB_ROW) + ord * 256;
#pragma unroll
        for (int h = 0; h < 2; ++h)
#pragma unroll
            for (int i = 0; i < 2; ++i) va[h * 2 + i] = rt[h * 128 + sR[i]] + (unsigned)sC[i] * 2u;
    }
};
struct ProbMoeDown {
    const char* A; const char* Bt; LAS unsigned char* lds; int ldb, K, nM, G, c;
    __device__ __forceinline__ bool next(int i, pg8::Unit& u) const { if (!pg8::order_next(i, G, c, nM, 4, u.pm, u.pn)) return false; u.e = (int)((const LAS unsigned char*)(lds + TAB_TEXP))[u.pm]; return true; }
    __device__ __forceinline__ void desc(int, const pg8::Unit& u, pg8::UD& d, unsigned (&va)[4], const int (&sR)[2], const int (&sC)[2]) const {
        d.a = A + (size_t)u.pm * 256 * 1024 * 2; d.b0 = Bt + ((size_t)u.e * 1024 + (size_t)u.pn * 256) * 1024 * 2; d.b1 = d.b0 + (size_t)128 * 1024 * 2;
#pragma unroll
        for (int h = 0; h < 2; ++h)
#pragma unroll
            for (int i = 0; i < 2; ++i) va[h * 2 + i] = (unsigned)((h * 128 + sR[i]) * 1024 + sC[i]) * 2u;
    }
};

struct EpiPool {
    static constexpr bool PERM = false;
    const float* x; float* X1; const float* scale;
    __device__ __forceinline__ void operator()(const f32x4 (&acc)[2][2][4][2], const pg8::Unit& u, int wr, int wc, int fr, int fq) const {
        const int row0 = u.pm * 256 + wr * 64 + fr, col0 = u.pn * 256 + wc * 32 + 4 * fq;
        f32x4 sv[2][2];
#pragma unroll
        for (int bj = 0; bj < 2; ++bj)
#pragma unroll
            for (int n = 0; n < 2; ++n) sv[bj][n] = *(const f32x4*)(scale + col0 + bj * 128 + n * 16);
#pragma unroll
        for (int ai = 0; ai < 2; ++ai)
#pragma unroll
            for (int m = 0; m < 4; ++m) { const size_t off = (size_t)(row0 + ai * 128 + m * 16) * D + col0;
#pragma unroll
                for (int bj = 0; bj < 2; ++bj)
#pragma unroll
                    for (int n = 0; n < 2; ++n) { const f32x4 xv = *(const f32x4*)(x + off + bj * 128 + n * 16); *(f32x4*)(X1 + off + bj * 128 + n * 16) = xv + acc[ai][bj][m][n] * sv[bj][n]; }
                if (m & 1) asm volatile("" ::: "memory"); }
    }
};
struct EpiRes {
    static constexpr bool PERM = false;
    const float* Xi; float* Xo;
    __device__ __forceinline__ void operator()(const f32x4 (&acc)[2][2][4][2], const pg8::Unit& u, int wr, int wc, int fr, int fq) const {
        const int row0 = u.pm * 256 + wr * 64 + fr, col0 = u.pn * 256 + wc * 32 + 4 * fq;
#pragma unroll
        for (int ai = 0; ai < 2; ++ai)
#pragma unroll
            for (int m = 0; m < 4; ++m) { const size_t off = (size_t)(row0 + ai * 128 + m * 16) * D + col0;
#pragma unroll
                for (int bj = 0; bj < 2; ++bj)
#pragma unroll
                    for (int n = 0; n < 2; ++n) { const f32x4 xv = *(const f32x4*)(Xi + off + bj * 128 + n * 16); *(f32x4*)(Xo + off + bj * 128 + n * 16) = xv + acc[ai][bj][m][n]; }
                if (m & 1) asm volatile("" ::: "memory"); }
    }
};
struct EpiQKV {
    static constexpr bool PERM = true;
    bf16* QKV; const float* qg; const float* kg;
    __device__ __forceinline__ void operator()(const f32x4 (&acc)[2][2][4][2], const pg8::Unit& u, int wr, int wc, int fr, int fq) const {
        const int seg = u.pn >> 2, head = (u.pn & 3) * 4 + wc;
        f32x4 gv[2][2];
#pragma unroll
        for (int bj = 0; bj < 2; ++bj)
#pragma unroll
            for (int n = 0; n < 2; ++n) {
                if (seg == 2) gv[bj][n] = (f32x4){1.f, 1.f, 1.f, 1.f};
                else { const float* g = (seg == 0 ? qg : kg) + bj * 32 + 8 * fq + 4 * n; gv[bj][n] = *(const f32x4*)g; if (seg == 0) gv[bj][n] = gv[bj][n] * C2; } }
        bf16* base = QKV + (size_t)seg * M * D;
#pragma unroll
        for (int ai = 0; ai < 2; ++ai)
#pragma unroll
            for (int m = 0; m < 4; ++m) {
                const int t = u.pm * 256 + ai * 128 + wr * 64 + m * 16 + fr, b = t >> 11, s = t & (SEQ - 1);
                float rstd = 1.f;
                if (seg < 2) { float ss = 0.f;
#pragma unroll
                    for (int bj = 0; bj < 2; ++bj)
#pragma unroll
                        for (int n = 0; n < 2; ++n) { const f32x4 v = acc[ai][bj][m][n]; ss += (v[0] * v[0] + v[1] * v[1]) + (v[2] * v[2] + v[3] * v[3]); }
                    ss += __shfl_xor(ss, 16); ss += __shfl_xor(ss, 32);
                    rstd = 1.0f / sqrtf(ss * (1.0f / 64.0f) + RMS_EPS); }
                bf16* rowp = base + ((size_t)(b * NH + head) * SEQ + s) * HD + 8 * fq;
#pragma unroll
                for (int bj = 0; bj < 2; ++bj) { const f32x4 v0 = acc[ai][bj][m][0] * rstd * gv[bj][0], v1 = acc[ai][bj][m][1] * rstd * gv[bj][1];
                    u32x4 w; w.x = cvtpk(v0[0], v0[1]); w.y = cvtpk(v0[2], v0[3]); w.z = cvtpk(v1[0], v1[1]); w.w = cvtpk(v1[2], v1[3]);
                    *(u32x4*)(rowp + bj * 32) = w; }
            }
    }
};
struct EpiGateUp {
    static constexpr bool PERM = true;
    bf16* ACT; const float* bias;
    __device__ __forceinline__ void operator()(const f32x4 (&acc)[2][2][4][2], const pg8::Unit& u, int wr, int wc, int fr, int fq) const {
        const int lc = u.pn * 128 + wc * 32 + 8 * fq;
        const float* bg = bias + (size_t)u.e * 2048 + lc;
        f32x4 bv[2][2];
#pragma unroll
        for (int bj = 0; bj < 2; ++bj)
#pragma unroll
            for (int n = 0; n < 2; ++n) bv[bj][n] = *(const f32x4*)(bg + bj * 1024 + 4 * n);
#pragma unroll
        for (int ai = 0; ai < 2; ++ai)
#pragma unroll
            for (int m = 0; m < 4; ++m) {
                bf16* rowp = ACT + (size_t)(u.pm * 256 + ai * 128 + wr * 64 + m * 16 + fr) * FF + lc;
                float o[8];
#pragma unroll
                for (int n = 0; n < 2; ++n) { const f32x4 g4 = acc[ai][0][m][n] + bv[0][n], u4 = acc[ai][1][m][n] + bv[1][n];
#pragma unroll
                    for (int i = 0; i < 4; ++i) { const float g = fminf(g4[i], SW_LIMIT), up = fminf(fmaxf(u4[i], -SW_LIMIT), SW_LIMIT);
                        const float sg = __builtin_amdgcn_rcpf(1.0f + __builtin_amdgcn_exp2f(g * (-SW_ALPHA * 1.4426950408889634f)));
                        o[n * 4 + i] = (up + 1.0f) * (g * sg); } }
                u32x4 w; w.x = cvtpk(o[0], o[1]); w.y = cvtpk(o[2], o[3]); w.z = cvtpk(o[4], o[5]); w.w = cvtpk(o[6], o[7]);
                *(u32x4*)rowp = w;
            }
    }
};
struct EpiDown {
    static constexpr bool PERM = true;
    bf16* OUTS; const float* bias;
    __device__ __forceinline__ void operator()(const f32x4 (&acc)[2][2][4][2], const pg8::Unit& u, int wr, int wc, int fr, int fq) const {
        const int col0 = u.pn * 256 + wc * 32 + 8 * fq;
        const float* bd = bias + (size_t)u.e * 1024 + col0;
        f32x4 bv[2][2];
#pragma unroll
        for (int bj = 0; bj < 2; ++bj)
#pragma unroll
            for (int n = 0; n < 2; ++n) bv[bj][n] = *(const f32x4*)(bd + bj * 128 + 4 * n);
#pragma unroll
        for (int ai = 0; ai < 2; ++ai)
#pragma unroll
            for (int m = 0; m < 4; ++m) { bf16* rowp = OUTS + (size_t)(u.pm * 256 + ai * 128 + wr * 64 + m * 16 + fr) * D + col0;
#pragma unroll
                for (int bj = 0; bj < 2; ++bj) { const f32x4 v0 = acc[ai][bj][m][0] + bv[bj][0], v1 = acc[ai][bj][m][1] + bv[bj][1];
                    u32x4 w; w.x = cvtpk(v0[0], v0[1]); w.y = cvtpk(v0[2], v0[3]); w.z = cvtpk(v1[0], v1[1]); w.w = cvtpk(v1[2], v1[3]);
                    *(u32x4*)(rowp + bj * 128) = w; } }
    }
};

__device__ __forceinline__ void cvt_item(const float* W, int N, int k0, int n0, bf16* dst  , int dpitch, LAS float* scr, int lane) {
    float v[32];
#pragma unroll
    for (int i = 0; i < 32; ++i) { const int kk = 2 * i + (lane >> 5); v[i] = W[(size_t)(k0 + kk) * N + n0 + (lane & 31)]; }
#pragma unroll
    for (int i = 0; i < 32; ++i) { const int kk = 2 * i + (lane >> 5); scr[kk * 33 + (lane & 31)] = v[i]; }
    LDS_WAIT(); asm volatile("" ::: "memory");
    const int c = lane & 7;
#pragma unroll
    for (int j = 0; j < 4; ++j) { const int n = (lane >> 3) + 8 * j; const LAS float* s = scr + (8 * c) * 33 + n;
        u32x4 o; o.x = cvtpk(s[0 * 33], s[1 * 33]); o.y = cvtpk(s[2 * 33], s[3 * 33]); o.z = cvtpk(s[4 * 33], s[5 * 33]); o.w = cvtpk(s[6 * 33], s[7 * 33]);
        *(u32x4*)(dst + (size_t)n * dpitch + 8 * c) = o; }
    LDS_WAIT(); asm volatile("" ::: "memory");
}
__device__ __forceinline__ void phase_convert(Frame& F) {
    LAS float* scr = (LAS float*)(F.lds + F.wave * 8448);
    const int gw = blockIdx.x * NWAVES + F.wave, NGW = F.G * NWAVES;
    constexpr int I_POOL = 4 * 4 * 8, I_QKV = 16 * 96, I_WO = 16 * 32, I_GU = 64 * 16 * 64, I_DN = 64 * 16 * 32;
    constexpr int NITEMS = I_POOL + I_QKV + I_WO + I_GU + I_DN;
    for (int it = gw; it < NITEMS; it += NGW) {
        int r = it;
        if (r < I_POOL) { const int g = r >> 5, q = r & 31, kb = q >> 3, nb = q & 7;
            cvt_item(F.pool_w + (size_t)g * 65536, 256, kb * 64, nb * 32, (bf16*)(F.ws + WS_POOLW) + (size_t)g * 65536 + (size_t)(nb * 32) * 256 + kb * 64, 256, scr, F.lane); continue; }
        r -= I_POOL;
        if (r < I_QKV) { const int kb = r / 96, nb = r % 96, n0 = nb * 32, pn = n0 >> 8, cc = n0 & 255, drow = 256 * pn + 128 * ((cc >> 5) & 1) + 32 * (cc >> 6);
            cvt_item(F.w_qkv, 3 * D, kb * 64, n0, (bf16*)(F.ws + WS_WQKV) + (size_t)drow * D + kb * 64, D, scr, F.lane); continue; }
        r -= I_QKV;
        if (r < I_WO) { const int kb = r >> 5, nb = r & 31;
            cvt_item(F.w_o, D, kb * 64, nb * 32, (bf16*)(F.ws + WS_WO) + (size_t)(nb * 32) * D + kb * 64, D, scr, F.lane); continue; }
        r -= I_WO;
        if (r < I_GU) { const int mat = r >> 10, q = r & 1023, kb = q >> 6, nb = q & 63;
            cvt_item(F.w_gu + (size_t)mat * D * 2 * FF, 2 * FF, kb * 64, nb * 32, (bf16*)(F.ws + WS_WGU) + (size_t)mat * 2 * FF * D + (size_t)(nb * 32) * D + kb * 64, D, scr, F.lane); continue; }
        r -= I_GU;
        { const int mat = r >> 9, q = r & 511, kb = q >> 5, nb = q & 31;
            cvt_item(F.w_dn + (size_t)mat * FF * D, D, kb * 64, nb * 32, (bf16*)(F.ws + WS_WDN) + (size_t)mat * D * FF + (size_t)(nb * 32) * FF + kb * 64, FF, scr, F.lane); }
    }
}
__device__ __forceinline__ void phase_pooled(Frame& F) {
    LAS float* H = (LAS float*)F.lds;
    LAS float* RS = (LAS float*)(F.lds + 81920);
    bf16* P = (bf16*)(F.ws + WS_POOLED);
    for (int tile = blockIdx.x; tile < M / 64; tile += F.G) {
        const int t0 = tile * 64, s0 = t0 & (SEQ - 1);
        for (int i = F.wave; i < 79; i += NWAVES) {
            const int s = s0 - 15 + i; float r = 0.f;
            if (s >= 0) { const f32x4* xr = (const f32x4*)(F.x + (size_t)(t0 - 15 + i) * D) + F.lane; float ss = 0.f;
#pragma unroll
                for (int j = 0; j < 4; ++j) { const f32x4 v = xr[64 * j]; ss += (v[0] * v[0] + v[1] * v[1]) + (v[2] * v[2] + v[3] * v[3]); }
                ss = wave_sum(ss); r = 1.0f / sqrtf(ss * (1.0f / D) + RMS_EPS); }
            if (F.lane == 0) RS[i] = r;
        }
        __syncthreads();
        for (int g = 0; g < 4; ++g) {
            const f32x4 gn = *((const f32x4*)(F.mix_norm + g * 256) + F.lane);
            for (int i = F.wave; i < 79; i += NWAVES) {
                const int s = s0 - 15 + i; f32x4 v = (f32x4){0.f, 0.f, 0.f, 0.f};
                if (s >= 0) { v = *((const f32x4*)(F.x + (size_t)(t0 - 15 + i) * D + g * 256) + F.lane); v = v * RS[i] * gn; }
                *((LAS f32x4*)(H + i * 256) + F.lane) = v;
            }
            __syncthreads();
            const int w = 2 << g, cp = F.tid & 127, rq = F.tid >> 7, i0 = 15 + rq * 16;
            const LAS f32x2* H2p = (const LAS f32x2*)H + cp;
            f32x2 S = (f32x2){0.f, 0.f};
            for (int j = i0 - w + 1; j <= i0; ++j) S += H2p[j * 128];
            for (int r = 0; r < 16; ++r) {
                const int i = i0 + r;
                if (r > 0) S += H2p[i * 128] - H2p[(i - w) * 128];
                const int s = s0 + rq * 16 + r; const int cnt = (s + 1 < w) ? (s + 1) : w;
                const f32x2 h = H2p[i * 128]; const float inv = 1.0f / (float)cnt;
                const f32x2 pv = S * inv - h;
                *(unsigned*)(P + (size_t)(t0 + rq * 16 + r) * D + g * 256 + 2 * cp) = cvtpk(pv[0], pv[1]);
            }
            __syncthreads();
        }
    }
}

__device__ __forceinline__ void moe_tables(Frame& F, int layer) {
    LAS int* ecnt = (LAS int*)(F.lds + TAB_ECNT); LAS int* tbase = (LAS int*)(F.lds + TAB_TBASE); LAS unsigned char* texp = (LAS unsigned char*)(F.lds + TAB_TEXP);
    if (F.tid < NE) ecnt[F.tid] = (int)__hip_atomic_load(F.ctl + CW_ECNT + layer * 2048 + F.tid * 64, RLX_AGENT);
    __syncthreads();
    if (F.tid == 0) { int a = 0; for (int e = 0; e < NE; ++e) { tbase[e] = a; a += (ecnt[e] + 255) >> 8; } tbase[NE] = a; }
    __syncthreads();
    if (F.tid < MT_MAX) { int e = 0; for (int q = 1; q < NE; ++q) if (F.tid >= tbase[q]) e = q; texp[F.tid] = (unsigned char)e; }
    __syncthreads();
}
template <bool COMBINE, bool WRITE_X, bool NORM, bool ROUTER>
__device__ __forceinline__ void phase_rows(Frame& F, const float* src, float* dstX, const float* gain, bf16* dstH, int layer  ) {
    const int* tope = (const int*)(F.ws + WS_TOPE); const int* topp = (const int*)(F.ws + WS_TOPP); const float* topw = (const float*)(F.ws + WS_TOPW);
    const bf16* OUTS = (const bf16*)(F.ws + WS_OUTS);
    if (COMBINE) moe_tables(F, layer);
    const LAS int* tbase = (const LAS int*)(F.lds + TAB_TBASE);
    f32x4 gn[4];
    if (NORM) {
#pragma unroll
        for (int j = 0; j < 4; ++j) gn[j] = *((const f32x4*)gain + F.lane + 64 * j); }
    for (int tile = blockIdx.x; tile < M / 64; tile += F.G) {
        f32x4 v[8][4];
#pragma unroll
        for (int rr = 0; rr < 8; ++rr) {
            const int t = tile * 64 + F.wave * 8 + rr;
            const f32x4* xr = (const f32x4*)(src + (size_t)t * D) + F.lane;
#pragma unroll
            for (int j = 0; j < 4; ++j) v[rr][j] = xr[64 * j];
            if (COMBINE) {
#pragma unroll
                for (int k = 0; k < TOPK; ++k) {
                    const int e = tope[t * 4 + k], pos = topp[t * 4 + k]; const float wk = topw[t * 4 + k];
                    const u32x2* orow = (const u32x2*)(OUTS + (size_t)(tbase[e] * 256 + pos) * D) + F.lane;
#pragma unroll
                    for (int j = 0; j < 4; ++j) { const u32x2 o = orow[64 * j]; v[rr][j] += (f32x4){bf_lo(o.x), bf_hi(o.x), bf_lo(o.y), bf_hi(o.y)} * wk; }
                }
            }
            if (WRITE_X) { f32x4* xo = (f32x4*)(dstX + (size_t)t * D) + F.lane;
#pragma unroll
                for (int j = 0; j < 4; ++j) xo[64 * j] = v[rr][j]; }
            if (NORM) {
                float ss = 0.f;
#pragma unroll
                for (int j = 0; j < 4; ++j) ss += (v[rr][j][0] * v[rr][j][0] + v[rr][j][1] * v[rr][j][1]) + (v[rr][j][2] * v[rr][j][2] + v[rr][j][3] * v[rr][j][3]);
                ss = wave_sum(ss); const float rstd = 1.0f / sqrtf(ss * (1.0f / D) + RMS_EPS);
                u32x2* ho = (u32x2*)(dstH + (size_t)t * D) + F.lane;
#pragma unroll
                for (int j = 0; j < 4; ++j) { v[rr][j] = v[rr][j] * rstd * gn[j]; u32x2 o; o.x = cvtpk(v[rr][j][0], v[rr][j][1]); o.y = cvtpk(v[rr][j][2], v[rr][j][3]); ho[64 * j] = o; }
            }
        }
        if (ROUTER) {
            LAS float* HT = (LAS float*)F.lds;
            LAS float* WC = (LAS float*)(F.lds + 66560);
            LAS float* PART = (LAS float*)F.lds;
            LAS float* LG = (LAS float*)(F.lds + 66560);
            LAS int* lcnt = (LAS int*)(F.lds + 99328);
            LAS int* gbase = (LAS int*)(F.lds + 99328 + 128);
            const float* RW = F.router_w + (size_t)layer * D * NE; const float* RB = F.router_b + layer * NE;
            const int th = F.wave & 1, kq = F.wave >> 1, r32 = F.lane & 31, hi = F.lane >> 5;
            f32x16 acc = {};
            for (int j = 0; j < 4; ++j) {
                __syncthreads();
#pragma unroll
                for (int rr = 0; rr < 8; ++rr)
#pragma unroll
                    for (int i = 0; i < 4; ++i) HT[(4 * F.lane + i) * 65 + F.wave * 8 + rr] = v[rr][j][i];
                { const f32x4* wsrc = (const f32x4*)(RW + (size_t)j * 256 * NE); LAS f32x4* wdst = (LAS f32x4*)WC;
#pragma unroll
                    for (int q = 0; q < 4; ++q) wdst[F.tid + 512 * q] = wsrc[F.tid + 512 * q]; }
                __syncthreads();
                const LAS float* ap = HT + (kq * 64 + hi) * 65 + th * 32 + r32; const LAS float* bp = WC + (kq * 64 + hi) * 32 + r32;
#pragma unroll 8
                for (int s = 0; s < 32; ++s) acc = __builtin_amdgcn_mfma_f32_32x32x2f32(ap[s * 2 * 65], bp[s * 2 * 32], acc, 0, 0, 0);
            }
            __syncthreads();
#pragma unroll
            for (int r = 0; r < 16; ++r) { const int tok = th * 32 + (r & 3) + 8 * (r >> 2) + 4 * hi; PART[(kq * 64 + tok) * 33 + r32] = acc[r]; }
            if (F.tid < NE) lcnt[F.tid] = 0;
            __syncthreads();
            for (int q = F.tid; q < 64 * NE; q += 512) { const int tok = q >> 5, e = q & 31;
                LG[tok * 33 + e] = ((PART[tok * 33 + e] + PART[(64 + tok) * 33 + e]) + (PART[(128 + tok) * 33 + e] + PART[(192 + tok) * 33 + e])) + RB[e]; }
            __syncthreads();
            int te[4], lp[4]; float tw[4];
            if (F.wave == 0) {
                const int tok = F.lane; unsigned used = 0u; float tv[4];
#pragma unroll
                for (int k = 0; k < 4; ++k) { float best = -INFINITY; int bi = 0;
                    for (int e = 0; e < NE; ++e) { const float xv = LG[tok * 33 + e]; if (!((used >> e) & 1u) && xv > best) { best = xv; bi = e; } }
                    used |= 1u << bi; tv[k] = best; te[k] = bi; }
                float sum = 0.f;
#pragma unroll
                for (int k = 0; k < 4; ++k) { tw[k] = __expf(tv[k] - tv[0]); sum += tw[k]; }
                const float inv = 1.0f / sum;
#pragma unroll
                for (int k = 0; k < 4; ++k) { tw[k] *= inv; lp[k] = atomicAdd((int*)(lcnt + te[k]), 1); }
            }
            __syncthreads();
            if (F.tid < NE) { const int c = lcnt[F.tid]; gbase[F.tid] = c > 0 ? (int)__hip_atomic_fetch_add(F.ctl + CW_ECNT + layer * 2048 + F.tid * 64, (unsigned)c, RLX_AGENT) : 0; }
            __syncthreads();
            if (F.wave == 0) {
                const int t = tile * 64 + F.lane;
                int* list = (int*)(F.ws + WS_LIST); int* tope_w = (int*)(F.ws + WS_TOPE); int* topp_w = (int*)(F.ws + WS_TOPP); float* topw_w = (float*)(F.ws + WS_TOPW);
#pragma unroll
                for (int k = 0; k < 4; ++k) { const int pos = gbase[te[k]] + lp[k]; list[te[k] * M + pos] = t; tope_w[t * 4 + k] = te[k]; topp_w[t * 4 + k] = pos; topw_w[t * 4 + k] = tw[k]; }
            }
            __syncthreads();
        }
    }
}

__device__ __forceinline__ void phase_moe_up(Frame& F, int layer) {
    moe_tables(F, layer);
    const LAS int* ecnt = (const LAS int*)(F.lds + TAB_ECNT); const LAS int* tbase = (const LAS int*)(F.lds + TAB_TBASE);
    ProbMoeUp S{(const char*)(F.ws + WS_H2), (const char*)(F.ws + WS_WGU) + (size_t)layer * NE * 2048 * 1024 * 2, F.lds, 1024, 1024, tbase[NE], F.G, (int)blockIdx.x};
    {
        const int* list = (const int*)(F.ws + WS_LIST); LAS unsigned* rt = (LAS unsigned*)(F.lds + TAB_ROW);
        pg8::Unit u;
        for (int ord = 0; ord < MAXU && S.next(ord, u); ++ord) {
            if (F.tid < 256) { const int p = (u.pm - tbase[u.e]) * 256 + F.tid; const int tok = (p < ecnt[u.e]) ? list[u.e * M + p] : 0; rt[ord * 256 + F.tid] = (unsigned)tok * (unsigned)(D * 2); }
        }
        __syncthreads();
    }
    EpiGateUp E{(bf16*)(F.ws + WS_ACT), F.b_gu + (size_t)layer * NE * 2048};
    pg8::gemm_phase<ProbMoeUp, EpiGateUp>(F.lds, S, E);
}
__device__ __forceinline__ void phase_moe_down(Frame& F, int layer) {
    moe_tables(F, layer);
    const LAS int* tbase = (const LAS int*)(F.lds + TAB_TBASE);
    ProbMoeDown S{(const char*)(F.ws + WS_ACT), (const char*)(F.ws + WS_WDN) + (size_t)layer * NE * 1024 * 1024 * 2, F.lds, 1024, 1024, tbase[NE], F.G, (int)blockIdx.x};
    EpiDown E{(bf16*)(F.ws + WS_OUTS), F.b_dn + (size_t)layer * NE * 1024};
    pg8::gemm_phase<ProbMoeDown, EpiDown>(F.lds, S, E);
}

__device__ __forceinline__ int crow(int r, int hi) { return (r & 3) + 8 * (r >> 2) + 4 * hi; }
typedef LAS const char* lds_cptr;
__device__ __forceinline__ s16x4 vtr(lds_cptr p) { return __builtin_bit_cast(s16x4, __builtin_amdgcn_ds_read_tr16_b64_v4i16((LAS v4i16_t*)p)); }
__device__ __forceinline__ void attn_unit(Frame& F, int bh, int qb) {
    const int lane = F.lane, r32 = lane & 31, hi = lane >> 5, wid = F.wave, tid = F.tid;
    const bf16* Qh = (const bf16*)(F.ws + WS_Q) + (size_t)bh * SEQ * HD; const bf16* Kh = (const bf16*)(F.ws + WS_K) + (size_t)bh * SEQ * HD; const bf16* Vh = (const bf16*)(F.ws + WS_V) + (size_t)bh * SEQ * HD;
    const int q0 = qb * 256, qw = q0 + 32 * wid, qpos = qw + r32, jd = qw >> 6, jtop = (q0 >> 6) + 3;
    LAS unsigned char* KB = F.lds; LAS unsigned char* VB = F.lds + 16384; LAS unsigned char* OST = F.lds + 32768 + wid * 4096;
    const bf16* ksrc = Kh + (size_t)lane * HD + wid * 8;
    const bf16* vsrc = Vh + (size_t)(16 * (wid & 3) + (lane >> 2)) * HD + (wid >> 2) * 32 + (lane & 3) * 8;
    bf16x8 qr[4];
#pragma unroll
    for (int d0 = 0; d0 < 4; ++d0) qr[d0] = *(const bf16x8*)(Qh + (size_t)qpos * HD + d0 * 16 + hi * 8);
    f32x16 o0 = {}, o1 = {};
    float C = 0.f;
    int cur = 0;
    { const u32x4 kk = *(const u32x4*)(ksrc + (size_t)jtop * 64 * HD), vv = *(const u32x4*)(vsrc + (size_t)jtop * 64 * HD);
      *(LAS u32x4*)(KB + tid * 16) = kk; *(LAS u32x4*)(VB + tid * 16) = vv; }
    __syncthreads();
    for (int j = jtop; j >= 0; --j) {
        u32x4 kn, vn;
        if (j > 0) { kn = *(const u32x4*)(ksrc + (size_t)(j - 1) * 64 * HD); vn = *(const u32x4*)(vsrc + (size_t)(j - 1) * 64 * HD); }
        if (j <= jd) {
            const lds_cptr kb = (lds_cptr)(KB + cur * 8192) + hi * 1024 + r32 * 16;
            f32x16 p0 = {}, p1 = {};
#pragma unroll
            for (int d0 = 0; d0 < 4; ++d0) { const bf16x8 b0 = *(const LAS bf16x8*)(kb + d0 * 2048), b1 = *(const LAS bf16x8*)(kb + d0 * 2048 + 512);
                p0 = __builtin_amdgcn_mfma_f32_32x32x16_bf16(b0, qr[d0], p0, 0, 0, 0); p1 = __builtin_amdgcn_mfma_f32_32x32x16_bf16(b1, qr[d0], p1, 0, 0, 0); }
            float L0[16], L1[16];
#pragma unroll
            for (int r = 0; r < 16; ++r) { L0[r] = __builtin_amdgcn_logf(1.0f + __builtin_amdgcn_exp2f(p0[r])); L1[r] = __builtin_amdgcn_logf(1.0f + __builtin_amdgcn_exp2f(p1[r])); }
            if (j == jd) {
                const int kb0 = 64 * j + 4 * hi;
#pragma unroll
                for (int r = 0; r < 16; ++r) { const int kv = kb0 + (r & 3) + 8 * (r >> 2);
                    if (kv >= qpos) { L0[r] = 0.f; p0[r] = -INFINITY; } if (kv + 32 >= qpos) { L1[r] = 0.f; p1[r] = -INFINITY; } }
            }
            float tg[8];
#pragma unroll
            for (int g = 0; g < 4; ++g) {
                L0[4 * g + 2] += L0[4 * g + 3]; L0[4 * g + 1] += L0[4 * g + 2]; L0[4 * g] += L0[4 * g + 1]; tg[g] = L0[4 * g];
                L1[4 * g + 2] += L1[4 * g + 3]; L1[4 * g + 1] += L1[4 * g + 2]; L1[4 * g] += L1[4 * g + 1]; tg[4 + g] = L1[4 * g]; }
            float off[8]; float R = C;
#pragma unroll
            for (int g = 7; g >= 0; --g) {
                const auto rr = __builtin_amdgcn_permlane32_swap(__float_as_uint(tg[g]), __float_as_uint(tg[g]), false, false);
                const float tlo = __uint_as_float(rr[0]), thi = __uint_as_float(rr[1]);
                off[g] = R + (hi ? 0.f : thi);
                R += tlo + thi; }
            C = R;
#pragma unroll
            for (int g = 0; g < 4; ++g)
#pragma unroll
                for (int i = 0; i < 4; ++i) { p0[4 * g + i] = __builtin_amdgcn_exp2f(p0[4 * g + i] - (L0[4 * g + i] + off[g])); p1[4 * g + i] = __builtin_amdgcn_exp2f(p1[4 * g + i] - (L1[4 * g + i] + off[4 + g])); }
            u32x4 pw0, pw1, pw2, pw3;
            pw0 = (u32x4){cvtpk(p0[0], p0[1]), cvtpk(p0[2], p0[3]), cvtpk(p0[4], p0[5]), cvtpk(p0[6], p0[7])};
            pw1 = (u32x4){cvtpk(p0[8], p0[9]), cvtpk(p0[10], p0[11]), cvtpk(p0[12], p0[13]), cvtpk(p0[14], p0[15])};
            pw2 = (u32x4){cvtpk(p1[0], p1[1]), cvtpk(p1[2], p1[3]), cvtpk(p1[4], p1[5]), cvtpk(p1[6], p1[7])};
            pw3 = (u32x4){cvtpk(p1[8], p1[9]), cvtpk(p1[10], p1[11]), cvtpk(p1[12], p1[13]), cvtpk(p1[14], p1[15])};
            const lds_cptr vp = (lds_cptr)(VB + cur * 8192) + ((lane >> 4) & 1) * 32 + (lane & 3) * 8 + (4 * hi + ((lane & 15) >> 2)) * 64;
#define PVSTEP(OACC, D0, KS, PW) do { const s16x4 lo_ = vtr(vp + (D0) * 4096 + (KS) * 1024), hi_ = vtr(vp + (D0) * 4096 + (KS) * 1024 + 512); \
                const bf16x8 vf_ = (bf16x8){lo_[0], lo_[1], lo_[2], lo_[3], hi_[0], hi_[1], hi_[2], hi_[3]}; \
                OACC = __builtin_amdgcn_mfma_f32_32x32x16_bf16(__builtin_bit_cast(bf16x8, PW), vf_, OACC, 0, 0, 0); } while (0)
            PVSTEP(o0, 0, 0, pw0); PVSTEP(o1, 1, 0, pw0); PVSTEP(o0, 0, 1, pw1); PVSTEP(o1, 1, 1, pw1);
            PVSTEP(o0, 0, 2, pw2); PVSTEP(o1, 1, 2, pw2); PVSTEP(o0, 0, 3, pw3); PVSTEP(o1, 1, 3, pw3);
#undef PVSTEP
        }
        if (j > 0) { *(LAS u32x4*)(KB + (cur ^ 1) * 8192 + tid * 16) = kn; *(LAS u32x4*)(VB + (cur ^ 1) * 8192 + tid * 16) = vn; }
        __syncthreads();
        cur ^= 1;
    }
    { LAS bf16* stg = (LAS bf16*)OST;
#pragma unroll
      for (int r = 0; r < 16; ++r) { const int orow = crow(r, hi); stg[orow * 64 + r32] = (bf16)(cvtpk(o0[r], 0.f) & 0xffffu); stg[orow * 64 + 32 + r32] = (bf16)(cvtpk(o1[r], 0.f) & 0xffffu); }
      LDS_WAIT(); asm volatile("" ::: "memory");
      const int b = bh >> 4, h = bh & 15;
      bf16* Ow = (bf16*)(F.ws + WS_O) + ((size_t)b * SEQ + qw) * D + h * HD;
#pragma unroll
      for (int i = 0; i < 4; ++i) { const int row = i * 8 + (lane >> 3), ch = lane & 7; const u32x4 vv = *(const LAS u32x4*)(stg + row * 64 + ch * 8); *(u32x4*)(Ow + (size_t)row * D + ch * 8) = vv; } }
    __syncthreads();
}
__device__ __forceinline__ void phase_attn(Frame& F) {
    for (int v = blockIdx.x; v < BATCH * NH * 2; v += F.G) {
        const int bh = v >> 1, odd = v & 1;
        for (int i = 0; i < 4; ++i) { const int qb = (i == 0) ? (odd ? 6 : 7) : (i == 1) ? (odd ? 5 : 4) : (i == 2) ? (odd ? 2 : 3) : (odd ? 1 : 0); attn_unit(F, bh, qb); }
    }
}

constexpr int NPHASE = 14;
struct Args { const float* in[15]; float* out; unsigned char* ws; int ph_lo, ph_hi; };
__global__ void __launch_bounds__(NWAVES * 64, 2) fwd_kernel(Args args) {
    extern __shared__ __attribute__((aligned(16))) unsigned char lds[];
    Frame F;
    F.lds = (LAS unsigned char*)lds; F.MISC = (volatile LAS unsigned*)(F.lds + MISC_OFF);
    F.tid = threadIdx.x; F.lane = F.tid & 63; F.wave = __builtin_amdgcn_readfirstlane(F.tid >> 6); F.G = gridDim.x;
    F.ws = args.ws; F.ctl = (gu32*)(args.ws + WS_CTL);
    F.x = args.in[0]; F.mix_norm = args.in[1]; F.pool_w = args.in[2]; F.pool_scale = args.in[3]; F.w_qkv = args.in[4]; F.q_norm = args.in[5]; F.k_norm = args.in[6]; F.w_o = args.in[7];
    F.ffn_norm = args.in[8]; F.router_w = args.in[9]; F.router_b = args.in[10]; F.w_gu = args.in[11]; F.b_gu = args.in[12]; F.w_dn = args.in[13]; F.b_dn = args.in[14]; F.out = args.out;
    for (int u = F.tid; u < (LDS_BYTES - LDSCTL_OFF) / 4; u += NWAVES * 64) ((LAS unsigned*)(F.lds + LDSCTL_OFF))[u] = 0u;
    __syncthreads();
    XcdBarrier bar; bar.bar = (unsigned*)(F.ctl + CW_BAR); bar.x = 0; bar.st = nullptr;
    if (!MK_PER_PHASE) bar = xcd_barrier_post((unsigned*)(F.ctl + CW_BAR), F.MISC + 8);
    const int lo = args.ph_lo, hi = args.ph_hi;
#define IN(k) (lo <= (k) && (k) < hi)
#define SEAM(k) do { if (IN(k) && IN((k) + 1)) xcd_barrier(bar); } while (0)
    float* X1 = (float*)(F.ws + WS_X1); float* X2 = (float*)(F.ws + WS_X2); float* X3 = (float*)(F.ws + WS_X3);

    if (IN(0)) { phase_convert(F); __syncthreads(); phase_pooled(F); }
    SEAM(0);
    if (IN(1)) { ProbPool S{(const char*)(F.ws + WS_POOLED), (const char*)(F.ws + WS_POOLW), 256, 256, F.G, (int)blockIdx.x}; EpiPool E{F.x, X1, F.pool_scale};
        pg8::gemm_phase<ProbPool, EpiPool>(F.lds, S, E); }
    SEAM(1);
    if (IN(2)) phase_rows<false, false, true, true>(F, X1, nullptr, F.ffn_norm, (bf16*)(F.ws + WS_H2), 0);
    SEAM(2);
    if (IN(3)) phase_moe_up(F, 0);
    SEAM(3);
    if (IN(4)) phase_moe_down(F, 0);
    SEAM(4);
    if (IN(5)) phase_rows<true, true, true, false>(F, X1, X2, F.mix_norm + D, (bf16*)(F.ws + WS_HQ), 0);
    SEAM(5);
    if (IN(6)) { ProbDense S{(const char*)(F.ws + WS_HQ), (const char*)(F.ws + WS_WQKV), D, D, D, M / 256, 12, F.G, (int)blockIdx.x}; EpiQKV E{(bf16*)(F.ws + WS_Q), F.q_norm, F.k_norm};
        pg8::gemm_phase<ProbDense, EpiQKV>(F.lds, S, E); }
    SEAM(6);
    if (IN(7)) phase_attn(F);
    SEAM(7);
    if (IN(8)) { ProbDense S{(const char*)(F.ws + WS_O), (const char*)(F.ws + WS_WO), D, D, D, M / 256, 4, F.G, (int)blockIdx.x}; EpiRes E{X2, X3};
        pg8::gemm_phase<ProbDense, EpiRes>(F.lds, S, E); }
    SEAM(8);
    if (IN(9)) phase_rows<false, false, true, true>(F, X3, nullptr, F.ffn_norm + D, (bf16*)(F.ws + WS_H2), 1);
    SEAM(9);
    if (IN(10)) phase_moe_up(F, 1);
    SEAM(10);
    if (IN(11)) phase_moe_down(F, 1);
    SEAM(11);
    if (IN(12)) phase_rows<true, true, false, false>(F, X3, F.out, nullptr, nullptr, 1);
    if (IN(13)) {
        const float* src = (MK_LAST_PHASE >= 8) ? X3 : (MK_LAST_PHASE >= 5) ? X2 : X1;
        for (size_t i = (size_t)blockIdx.x * 512 + F.tid; i < (size_t)M * D / 4; i += (size_t)F.G * 512) ((f32x4*)F.out)[i] = ((const f32x4*)src)[i];
    }
#undef IN
#undef SEAM
}

extern "C" void kernel_launch(void* const* d_in, const int* in_sizes, int n_in, void* d_out, int out_size, void* d_ws, size_t ws_size, hipStream_t stream) {
    static int grid = 0;
    if (grid == 0) {
        if (n_in != 15 || in_sizes[0] != M * D || out_size != M * D || ws_size < WS_END) { fprintf(stderr, "kernel_launch: unexpected shapes (n_in %d, in0 %d, out %d, ws %zu, need %zu)\n", n_in, n_in > 0 ? in_sizes[0] : -1, out_size, ws_size, (size_t)WS_END); grid = -1; return; }
        int dev = 0, cus = 0, per_cu = 0;
        if (hipGetDevice(&dev) != hipSuccess || hipDeviceGetAttribute(&cus, hipDeviceAttributeMultiprocessorCount, dev) != hipSuccess) { grid = -1; return; }
        if (hipFuncSetAttribute((const void*)fwd_kernel, hipFuncAttributeMaxDynamicSharedMemorySize, LDS_BYTES) != hipSuccess) { fprintf(stderr, "kernel_launch: hipFuncSetAttribute failed\n"); grid = -1; return; }
        if (hipOccupancyMaxActiveBlocksPerMultiprocessor(&per_cu, (const void*)fwd_kernel, NWAVES * 64, LDS_BYTES) != hipSuccess || per_cu < 1) fprintf(stderr, "kernel_launch: occupancy query says %d\n", per_cu);
        (void)hipGetLastError();
        grid = cus;
    }
    if (grid < 0) return;
    (void)hipMemsetAsync((char*)d_ws + WS_CTL, 0, CTL_ZERO_BYTES, stream);
    Args a{};
    for (int i = 0; i < 15; ++i) a.in[i] = (const float*)d_in[i];
    a.out = (float*)d_out; a.ws = (unsigned char*)d_ws;
    const int last = MK_LAST_PHASE;
    if (MK_PER_PHASE) {
        for (int p = 0; p <= last; ++p) { a.ph_lo = p; a.ph_hi = p + 1; hipLaunchKernelGGL(fwd_kernel, dim3(grid), dim3(NWAVES * 64), LDS_BYTES, stream, a); }
        if (last < 12) { a.ph_lo = 13; a.ph_hi = 14; hipLaunchKernelGGL(fwd_kernel, dim3(grid), dim3(NWAVES * 64), LDS_BYTES, stream, a); }
    } else {
        a.ph_lo = 0; a.ph_hi = 13; hipLaunchKernelGGL(fwd_kernel, dim3(grid), dim3(NWAVES * 64), LDS_BYTES, stream, a);
    }
    const hipError_t le = hipPeekAtLastError();
    if (le != hipSuccess) fprintf(stderr, "kernel_launch: launch failed: %s\n", hipGetErrorName(le));
}
```

```cpp
#include <hip/hip_runtime.h>
#include <cstdio>
#include <cstdint>

#define GAS __attribute__((address_space(1)))
#define LAS __attribute__((address_space(3)))
typedef unsigned short bf16;
typedef unsigned u32x4 __attribute__((ext_vector_type(4)));
typedef unsigned u32x2 __attribute__((ext_vector_type(2)));
typedef float f32x4 __attribute__((ext_vector_type(4)));
typedef float f32x2 __attribute__((ext_vector_type(2)));
typedef float f32x16 __attribute__((ext_vector_type(16)));
typedef short bf16x8 __attribute__((ext_vector_type(8)));
typedef short s16x4 __attribute__((ext_vector_type(4)));
typedef short v4i16_t __attribute__((ext_vector_type(4)));
typedef __bf16 bf16x2_t __attribute__((ext_vector_type(2)));
typedef GAS unsigned gu32;

constexpr int BATCH = 8, SEQ = 2048, D = 1024, M = BATCH * SEQ, NH = 16, HD = 64, NE = 32, TOPK = 4, FF = 1024;
constexpr float RMS_EPS = 1e-6f, SW_LIMIT = 7.0f, SW_ALPHA = 1.702f;
constexpr int MT_MAX = M * TOPK / 256 + NE;
constexpr int NSLOT = MT_MAX * 256;
constexpr float C2 = 0.125f * 1.4426950408889634f;

constexpr size_t MiB = 1u << 20;
constexpr size_t WS_CTL = 0, CTL_ZERO_BYTES = 1 * MiB;
constexpr size_t WS_POOLW = 1 * MiB;
constexpr size_t WS_WQKV = 2 * MiB;
constexpr size_t WS_WO = 8 * MiB;
constexpr size_t WS_TOPE = 10 * MiB, WS_TOPP = WS_TOPE + 256 * 1024, WS_TOPW = WS_TOPP + 256 * 1024;
constexpr size_t WS_LIST = 12 * MiB;
constexpr size_t WS_WGU = 16 * MiB;
constexpr size_t WS_WDN = 272 * MiB;
constexpr size_t WS_X1 = 400 * MiB, WS_X2 = 464 * MiB, WS_X3 = 528 * MiB;
constexpr size_t WS_POOLED = 592 * MiB, WS_H2 = 624 * MiB, WS_HQ = 656 * MiB, WS_Q = 688 * MiB, WS_K = 720 * MiB, WS_V = 752 * MiB, WS_O = 784 * MiB;
constexpr size_t WS_ACT = 816 * MiB, WS_OUTS = 960 * MiB;
constexpr size_t WS_END = 1104 * MiB;
static_assert(WS_ACT + (size_t)NSLOT * 1024 * 2 <= WS_OUTS && WS_OUTS + (size_t)NSLOT * 1024 * 2 <= WS_END, "ws map");
constexpr int CW_TMO = 0, CW_CODE = 1;
constexpr int CW_BAR = 4096;
constexpr int CW_ECNT = 16384;

constexpr int RING_BYTES = 131072;
constexpr int LDSCTL_OFF = RING_BYTES, MISC_OFF = LDSCTL_OFF + 320;
constexpr int TAB_OFF = 131584;
constexpr int TAB_ECNT = TAB_OFF, TAB_TBASE = TAB_OFF + 128, TAB_TEXP = TAB_OFF + 384, TAB_ROW = TAB_OFF + 1024;
constexpr int MAXU = 12;
constexpr int LDS_BYTES = 147456;
static_assert(TAB_ROW + MAXU * 1024 <= LDS_BYTES, "LDS map");

constexpr int NWAVES = 8;
#ifndef MK_PER_PHASE
#define MK_PER_PHASE 0
#endif
#ifndef MK_REP
#define MK_REP -1
#endif
#define REPS(k) ((MK_REP == (k)) ? 2 : 1)
#ifndef MK_LAST_PHASE
#define MK_LAST_PHASE 12
#endif

#define RLX_AGENT __ATOMIC_RELAXED, __HIP_MEMORY_SCOPE_AGENT
#define LDS_WAIT() asm volatile("s_waitcnt lgkmcnt(0)" ::: "memory")
#define VM_WAIT() asm volatile("s_waitcnt vmcnt(0)" ::: "memory")
__device__ __forceinline__ unsigned cvtpk(float lo, float hi) { f32x2 v = {lo, hi}; bf16x2_t b = __builtin_convertvector(v, bf16x2_t); return __builtin_bit_cast(unsigned, b); }
__device__ __forceinline__ float bf_lo(unsigned u) { return __uint_as_float(u << 16); }
__device__ __forceinline__ float bf_hi(unsigned u) { return __uint_as_float(u & 0xffff0000u); }
__device__ __forceinline__ float wave_sum(float v) {
#pragma unroll
    for (int o = 1; o < 64; o <<= 1) v += __shfl_xor(v, o);
    return v;
}

#define XB_TMO      128
#define XB_XCNT(j)  (256  + 64 * (j))
#define XB_XSUB(j)  (1280 + 64 * (j))
#define XB_XGEN(j)  (2304 + 64 * (j))
#define XB_TOP      3328
#define XB_TOPGEN   3392
#define XCD_BAR_WORDS 3456
#define XB_SPIN_CAP (1u << 18)
__device__ __forceinline__ unsigned xb_ld(unsigned* p)              { return __hip_atomic_load(p, __ATOMIC_RELAXED, __HIP_MEMORY_SCOPE_AGENT); }
__device__ __forceinline__ unsigned xb_add(unsigned* p, unsigned v) { return __hip_atomic_fetch_add(p, v, __ATOMIC_RELAXED, __HIP_MEMORY_SCOPE_AGENT); }
__device__ __forceinline__ unsigned xb_xcc_id() { return (unsigned)__builtin_amdgcn_s_getreg((3 << 11) | 20) & 0xFu; }
#define XB_SPIN(cond, bar) do { unsigned _sp = 0; while (cond) { __builtin_amdgcn_s_sleep(1); \
    if ((++_sp & 255u) == 0u) { if (xb_ld(&(bar)[XB_TMO])) break; if (_sp > XB_SPIN_CAP) { atomicAdd(&(bar)[XB_TMO], 1u); break; } } } } while (0)
struct XcdBarrier { unsigned* bar; unsigned x; volatile LAS unsigned* st; };
__device__ __forceinline__ XcdBarrier xcd_barrier_post(unsigned* bar, volatile LAS unsigned* st) {
    XcdBarrier b; b.bar = bar; b.x = xb_xcc_id(); b.st = st;
    if (threadIdx.x == 0) (void)xb_add(&bar[XB_XCNT(b.x)], 1u);
    return b;
}
__device__ __forceinline__ void xcd_barrier_complete(unsigned* bar, unsigned x, unsigned& nloc, unsigned& nx) {
    const unsigned G = gridDim.x * gridDim.y * gridDim.z;
    unsigned sum, cnt, mine, sp = 0u;
    for (;;) {
        sum = 0u; cnt = 0u; mine = 0u;
#pragma unroll
        for (unsigned j = 0; j < 16; ++j) { const unsigned c = xb_ld(&bar[XB_XCNT(j)]); sum += c; cnt += (c > 0u) ? 1u : 0u; mine = (j == x) ? c : mine; }
        if (sum == G) break;
        __builtin_amdgcn_s_sleep(1);
        if ((++sp & 255u) == 0u) { if (xb_ld(&bar[XB_TMO])) break; if (sp > XB_SPIN_CAP) { atomicAdd(&bar[XB_TMO], 1u); break; } }
    }
    nloc = mine > 0u ? mine : 1u; nx = cnt > 0u ? cnt : 1u;
}
__device__ __forceinline__ void xcd_barrier(const XcdBarrier& b) {
    asm volatile("s_waitcnt vmcnt(0)" ::: "memory");
    __syncthreads();
    if (threadIdx.x == 0) {
        unsigned* bar = b.bar;
        __builtin_amdgcn_s_waitcnt(0);
        unsigned nloc = b.st[0], nx = b.st[1];
        if (nloc == 0u) { xcd_barrier_complete(bar, b.x, nloc, nx); b.st[0] = nloc; b.st[1] = nx; }
        const unsigned old = xb_add(&bar[XB_XSUB(b.x)], 1u);
        const unsigned gen = old / nloc;
        if (old + 1u == (gen + 1u) * nloc) {
            __builtin_amdgcn_fence(__ATOMIC_RELEASE, "agent");
            asm volatile("s_waitcnt vmcnt(0)" ::: "memory");
            const unsigned og = xb_add(&bar[XB_TOP], 1u);
            const unsigned tg = og / nx;
            if (og + 1u == (tg + 1u) * nx) xb_add(&bar[XB_TOPGEN], 1u);
            else XB_SPIN(xb_ld(&bar[XB_TOPGEN]) == tg, bar);
            __builtin_amdgcn_fence(__ATOMIC_ACQUIRE, "agent");
            xb_add(&bar[XB_XGEN(b.x)], 1u);
            asm volatile("s_waitcnt vmcnt(0)" ::: "memory");
        } else {
            XB_SPIN(xb_ld(&bar[XB_XGEN(b.x)]) == gen, bar);
            __builtin_amdgcn_fence(__ATOMIC_ACQUIRE, "agent");
            asm volatile("s_waitcnt vmcnt(0)" ::: "memory");
        }
    }
    __syncthreads();
}

namespace pg8 {
constexpr int BM = 256, BK = 64, HALF = 128, HTB = HALF * BK * 2, STAGE_BYTES = 8 * HTB, NXCD = 8, WGM = 8;
__host__ __device__ __forceinline__ int lds_byte(int r, int c) { const int st = (r >> 4) * 2 + (c >> 5), rr = r & 15, cc = c & 31, ob = rr * 64 + cc * 2; return st * 1024 + (ob ^ (((ob >> 9) & 1) << 5)); }
__host__ __device__ __forceinline__ void stage_rc(int b, int& R, int& C) { const int st = b / 1024, sb = b % 1024, swz = sb ^ (((sb >> 9) & 1) << 5); R = (st >> 1) * 16 + swz / 64; C = (st & 1) * 32 + (swz % 64) / 2; }
__host__ __device__ __forceinline__ int perm32(int rho) { const int n = rho >> 4, i = rho & 15; return 8 * (i >> 2) + 4 * n + (i & 3); }

struct Unit { int pm, pn, e; };
struct UD { const char* a; const char* b0; const char* b1; };

__device__ __forceinline__ bool order_next(int i, int G, int c, int nM, int nN, int& pm, int& pn) {
    const long L = (long)i * G + c; const int nwg = nM * nN; if (L >= nwg) return false;
    int wgid = (int)L; { const int q = nwg / NXCD, r = nwg % NXCD, xcd = wgid % NXCD, off = wgid / NXCD; wgid = (xcd < r ? xcd * (q + 1) : r * (q + 1) + (xcd - r) * q) + off; }
    const int nig = WGM * nN, gid = wgid / nig, fm = gid * WGM, gsz = (nM - fm) < WGM ? (nM - fm) : WGM;
    pm = fm + ((wgid % nig) % gsz); pn = (wgid % nig) / gsz; return true;
}

template <class Prob, class Epi>
__device__ __forceinline__ void gemm_phase(LAS unsigned char* lds, const Prob& S, const Epi& E) {
    const int tid = threadIdx.x, wid = __builtin_amdgcn_readfirstlane(tid >> 6), lane = tid & 63, wr = wid >> 2, wc = wid & 3, fr = lane & 15, fq = lane >> 4;
    const int nt = S.K / BK;
    int sR[2], sC[2]; unsigned voffB[2];
#pragma unroll
    for (int i = 0; i < 2; ++i) { int R, C; stage_rc(tid * 16 + i * 8192, R, C); sR[i] = R; sC[i] = C; const int Rb = Epi::PERM ? ((R & ~31) + perm32(R & 31)) : R; voffB[i] = (unsigned)(Rb * S.ldb + C) * 2u; }
    const size_t kstep = (size_t)(BK * 2);
    const unsigned ldsw = (unsigned)wid * 1024u;
    const int aoff = lds_byte(wr * 64 + fr, fq * 8), boff = lds_byte(wc * 32 + fr, fq * 8);
#define PG8_SA(b, h) (((b) * 2 + (h)) * HTB)
#define PG8_SB(b, h) ((4 + (b) * 2 + (h)) * HTB)
#define PG8_STA(bufoff, gbase, va, h) do { _Pragma("unroll") for (int _i = 0; _i < 2; ++_i) \
        __builtin_amdgcn_global_load_lds((const unsigned*)((const char*)(gbase) + (va)[(h) * 2 + _i]), (LAS unsigned*)(lds + (bufoff) + ldsw + _i * 8192), 16, 0, 0); } while (0)
#define PG8_STB(bufoff, gbase) do { _Pragma("unroll") for (int _i = 0; _i < 2; ++_i) \
        __builtin_amdgcn_global_load_lds((const unsigned*)((const char*)(gbase) + voffB[_i]), (LAS unsigned*)(lds + (bufoff) + ldsw + _i * 8192), 16, 0, 0); } while (0)
#define PG8_LDA(dst, b, h) do { _Pragma("unroll") for (int m = 0; m < 4; ++m) _Pragma("unroll") for (int k = 0; k < 2; ++k) dst[m][k] = *(const LAS bf16x8*)(lds + PG8_SA(b, h) + aoff + m * 2048 + k * 1024); } while (0)
#define PG8_LDB(dst, b, h) do { _Pragma("unroll") for (int n = 0; n < 2; ++n) _Pragma("unroll") for (int k = 0; k < 2; ++k) dst[n][k] = *(const LAS bf16x8*)(lds + PG8_SB(b, h) + boff + n * 2048 + k * 1024); } while (0)
#define PG8_MMA(ai, bj, At, Bt) do { __builtin_amdgcn_s_setprio(1); _Pragma("unroll") for (int m = 0; m < 4; ++m) _Pragma("unroll") for (int n = 0; n < 2; ++n) _Pragma("unroll") for (int k = 0; k < 2; ++k) \
        acc[ai][bj][m][n] = __builtin_amdgcn_mfma_f32_16x16x32_bf16(Bt[n][k], At[m][k], acc[ai][bj][m][n], 0, 0, 0); __builtin_amdgcn_s_setprio(0); } while (0)
#define PG8_WAIT_V(n) asm volatile("s_waitcnt vmcnt(" #n ")" ::: "memory")
#define PG8_WAIT_L(n) asm volatile("s_waitcnt lgkmcnt(" #n ")" ::: "memory")
#define PG8_BAR __builtin_amdgcn_s_barrier()
#define PG8_SCHED __builtin_amdgcn_sched_barrier(0)
    Unit cur, nxt; UD cd, nd; unsigned cva[4], nva[4]; int ui = 0;
    if (!S.next(0, cur)) return;
    S.desc(0, cur, cd, cva, sR, sC);
    f32x4 acc[2][2][4][2];
#pragma unroll
    for (int a = 0; a < 2; ++a)
#pragma unroll
        for (int b = 0; b < 2; ++b)
#pragma unroll
            for (int m = 0; m < 4; ++m)
#pragma unroll
                for (int n = 0; n < 2; ++n) acc[a][b][m][n] = (f32x4){0.f, 0.f, 0.f, 0.f};
    bf16x8 At[4][2], B0[2][2], B1[2][2];
    PG8_STB(PG8_SB(0, 0), cd.b0); PG8_STB(PG8_SB(0, 1), cd.b1); PG8_STA(PG8_SA(0, 0), cd.a, cva, 0); PG8_STA(PG8_SA(0, 1), cd.a, cva, 1);
    if (wr == 1) PG8_BAR;
    PG8_WAIT_V(2); PG8_BAR;
    PG8_STB(PG8_SB(1, 0), cd.b0 + kstep); PG8_STA(PG8_SA(1, 0), cd.a + kstep, cva, 0); PG8_STB(PG8_SB(1, 1), cd.b1 + kstep);
    PG8_WAIT_V(6); PG8_BAR;
    for (;;) {
        const bool has_next = S.next(ui + 1, nxt);
        if (has_next) S.desc(ui + 1, nxt, nd, nva, sR, sC);
        else { nd = cd;
#pragma unroll
            for (int q = 0; q < 4; ++q) nva[q] = cva[q]; }
        for (int t = 0; t < nt; t += 2) {
            const bool last = (t == nt - 2);
            const char* a1 = cd.a + (size_t)(t + 1) * kstep;
            const char* a2 = last ? nd.a : cd.a + (size_t)(t + 2) * kstep;
            const char* b20 = last ? nd.b0 : cd.b0 + (size_t)(t + 2) * kstep; const char* b21 = last ? nd.b1 : cd.b1 + (size_t)(t + 2) * kstep;
            const char* a3 = a2 + kstep; const char* b30 = b20 + kstep; const char* b31 = b21 + kstep;
            unsigned va2[4];
#pragma unroll
            for (int q = 0; q < 4; ++q) va2[q] = last ? nva[q] : cva[q];
            PG8_LDB(B0, 0, 0); PG8_LDB(B1, 0, 1); PG8_SCHED; PG8_LDA(At, 0, 0); PG8_STA(PG8_SA(1, 1), a1, cva, 1);
            PG8_WAIT_V(8); PG8_WAIT_L(0); PG8_BAR; PG8_MMA(0, 0, At, B0); PG8_MMA(0, 1, At, B1); PG8_BAR; PG8_SCHED;
            PG8_LDA(At, 0, 1); PG8_STB(PG8_SB(0, 0), b20); PG8_STB(PG8_SB(0, 1), b21); PG8_STA(PG8_SA(0, 0), a2, va2, 0);
            PG8_WAIT_V(8); PG8_WAIT_L(0); PG8_BAR; PG8_MMA(1, 0, At, B0); PG8_MMA(1, 1, At, B1); PG8_BAR; PG8_SCHED;
            PG8_LDB(B0, 1, 0); PG8_LDB(B1, 1, 1); PG8_SCHED; PG8_LDA(At, 1, 0); PG8_STA(PG8_SA(0, 1), a2, va2, 1);
            PG8_WAIT_V(8); PG8_WAIT_L(0); PG8_BAR; PG8_MMA(0, 0, At, B0); PG8_MMA(0, 1, At, B1); PG8_BAR; PG8_SCHED;
            PG8_LDA(At, 1, 1); PG8_STB(PG8_SB(1, 0), b30); PG8_STB(PG8_SB(1, 1), b31); PG8_STA(PG8_SA(1, 0), a3, va2, 0);
            PG8_WAIT_V(8); PG8_WAIT_L(0); PG8_BAR; PG8_MMA(1, 0, At, B0); PG8_MMA(1, 1, At, B1); PG8_BAR; PG8_SCHED;
        }
        if (wr == 0) PG8_BAR;
        E(acc, cur, wr, wc, fr, fq);
        if (!has_next) break;
#pragma unroll
        for (int a = 0; a < 2; ++a)
#pragma unroll
            for (int b = 0; b < 2; ++b)
#pragma unroll
                for (int m = 0; m < 4; ++m)
#pragma unroll
                    for (int n = 0; n < 2; ++n) acc[a][b][m][n] = (f32x4){0.f, 0.f, 0.f, 0.f};
        cur = nxt; cd = nd;
#pragma unroll
        for (int q = 0; q < 4; ++q) cva[q] = nva[q];
        ++ui;
        if (wr == 1) PG8_BAR;
    }
    PG8_WAIT_V(0);
    PG8_BAR;
#undef PG8_SA
#undef PG8_SB
#undef PG8_STA
#undef PG8_STB
#undef PG8_LDA
#undef PG8_LDB
#undef PG8_MMA
#undef PG8_WAIT_V
#undef PG8_WAIT_L
#undef PG8_BAR
#undef PG8_SCHED
}
}

struct Frame {
    LAS unsigned char* lds;
    volatile LAS unsigned* MISC;
    gu32* ctl;
    int tid, lane, wave, G;
    unsigned char* ws;
    const float *x, *mix_norm, *pool_w, *pool_scale, *w_qkv, *q_norm, *k_norm, *w_o, *ffn_norm, *router_w, *router_b, *w_gu, *b_gu, *w_dn, *b_dn;
    float* out;
};

struct ProbDense {
    const char* A; const char* Bt; int lda, ldb, K, nM, nN, G, c;
    __device__ __forceinline__ bool next(int i, pg8::Unit& u) const { u.e = 0; return pg8::order_next(i, G, c, nM, nN, u.pm, u.pn); }
    __device__ __forceinline__ void desc(int, const pg8::Unit& u, pg8::UD& d, unsigned (&va)[4], const int (&sR)[2], const int (&sC)[2]) const {
        d.a = A + (size_t)u.pm * 256 * lda * 2; d.b0 = Bt + (size_t)u.pn * 256 * ldb * 2; d.b1 = d.b0 + (size_t)128 * ldb * 2;
#pragma unroll
        for (int h = 0; h < 2; ++h)
#pragma unroll
            for (int i = 0; i < 2; ++i) va[h * 2 + i] = (unsigned)((h * 128 + sR[i]) * lda + sC[i]) * 2u;
    }
};
struct ProbPool {
    const char* A; const char* Bt; int ldb, K, G, c;
    __device__ __forceinline__ bool next(int i, pg8::Unit& u) const { u.e = 0; return pg8::order_next(i, G, c, M / 256, 4, u.pm, u.pn); }
    __device__ __forceinline__ void desc(int, const pg8::Unit& u, pg8::UD& d, unsigned (&va)[4], const int (&sR)[2], const int (&sC)[2]) const {
        d.a = A + (size_t)u.pm * 256 * D * 2 + (size_t)u.pn * 256 * 2; d.b0 = Bt + (size_t)u.pn * 65536 * 2; d.b1 = d.b0 + (size_t)128 * 256 * 2;
#pragma unroll
        for (int h = 0; h < 2; ++h)
#pragma unroll
            for (int i = 0; i < 2; ++i) va[h * 2 + i] = (unsigned)((h * 128 + sR[i]) * D + sC[i]) * 2u;
    }
};
struct ProbMoeUp {
    const char* A; const char* Bt; LAS unsigned char* lds; int ldb, K, nM, G, c;
    __device__ __forceinline__ bool next(int i, pg8::Unit& u) const { if (!pg8::order_next(i, G, c, nM, 8, u.pm, u.pn)) return false; u.e = (int)((const LAS unsigned char*)(lds + TAB_TEXP))[u.pm]; return true; }
    __device__ __forceinline__ void desc(int ord, const pg8::Unit& u, pg8::UD& d, unsigned (&va)[4], const int (&sR)[2], const int (&sC)[2]) const {
        d.a = A; d.b0 = Bt + ((size_t)u.e * 2048 + (size_t)u.pn * 128) * 1024 * 2; d.b1 = d.b0 + (size_t)1024 * 1024 * 2;
        const LAS unsigned* rt = (const LAS unsigned*)(lds + TAB_ROW) + ord * 256;
#pragma unroll
        for (int h = 0; h < 2; ++h)
#pragma unroll
            for (int i = 0; i < 2; ++i) va[h * 2 + i] = rt[h * 128 + sR[i]] + (unsigned)sC[i] * 2u;
    }
};
struct ProbMoeDown {
    const char* A; const char* Bt; LAS unsigned char* lds; int ldb, K, nM, G, c;
    __device__ __forceinline__ bool next(int i, pg8::Unit& u) const { if (!pg8::order_next(i, G, c, nM, 4, u.pm, u.pn)) return false; u.e = (int)((const LAS unsigned char*)(lds + TAB_TEXP))[u.pm]; return true; }
    __device__ __forceinline__ void desc(int, const pg8::Unit& u, pg8::UD& d, unsigned (&va)[4], const int (&sR)[2], const int (&sC)[2]) const {
        d.a = A + (size_t)u.pm * 256 * 1024 * 2; d.b0 = Bt + ((size_t)u.e * 1024 + (size_t)u.pn * 256) * 1024 * 2; d.b1 = d.b0 + (size_t)128 * 1024 * 2;
#pragma unroll
        for (int h = 0; h < 2; ++h)
#pragma unroll
            for (int i = 0; i < 2; ++i) va[h * 2 + i] = (unsigned)((h * 128 + sR[i]) * 1024 + sC[i]) * 2u;
    }
};

struct EpiPool {
    static constexpr bool PERM = false;
    const float* x; float* X1; const float* scale;
    __device__ __forceinline__ void operator()(const f32x4 (&acc)[2][2][4][2], const pg8::Unit& u, int wr, int wc, int fr, int fq) const {
        const int row0 = u.pm * 256 + wr * 64 + fr, col0 = u.pn * 256 + wc * 32 + 4 * fq;
        f32x4 sv[2][2];
#pragma unroll
        for (int bj = 0; bj < 2; ++bj)
#pragma unroll
            for (int n = 0; n < 2; ++n) sv[bj][n] = *(const f32x4*)(scale + col0 + bj * 128 + n * 16);
#pragma unroll
        for (int ai = 0; ai < 2; ++ai)
#pragma unroll
            for (int m = 0; m < 4; ++m) { const size_t off = (size_t)(row0 + ai * 128 + m * 16) * D + col0;
#pragma unroll
                for (int bj = 0; bj < 2; ++bj)
#pragma unroll
                    for (int n = 0; n < 2; ++n) { const f32x4 xv = *(const f32x4*)(x + off + bj * 128 + n * 16); *(f32x4*)(X1 + off + bj * 128 + n * 16) = xv + acc[ai][bj][m][n] * sv[bj][n]; }
                if (m & 1) asm volatile("" ::: "memory"); }
    }
};
struct EpiRes {
    static constexpr bool PERM = false;
    const float* Xi; float* Xo;
    __device__ __forceinline__ void operator()(const f32x4 (&acc)[2][2][4][2], const pg8::Unit& u, int wr, int wc, int fr, int fq) const {
        const int row0 = u.pm * 256 + wr * 64 + fr, col0 = u.pn * 256 + wc * 32 + 4 * fq;
#pragma unroll
        for (int ai = 0; ai < 2; ++ai)
#pragma unroll
            for (int m = 0; m < 4; ++m) { const size_t off = (size_t)(row0 + ai * 128 + m * 16) * D + col0;
#pragma unroll
                for (int bj = 0; bj < 2; ++bj)
#pragma unroll
                    for (int n = 0; n < 2; ++n) { const f32x4 xv = *(const f32x4*)(Xi + off + bj * 128 + n * 16); *(f32x4*)(Xo + off + bj * 128 + n * 16) = xv + acc[ai][bj][m][n]; }
                if (m & 1) asm volatile("" ::: "memory"); }
    }
};
struct EpiQKV {
    static constexpr bool PERM = true;
    bf16* QKV; const float* qg; const float* kg;
    __device__ __forceinline__ void operator()(const f32x4 (&acc)[2][2][4][2], const pg8::Unit& u, int wr, int wc, int fr, int fq) const {
        const int seg = u.pn >> 2, head = (u.pn & 3) * 4 + wc;
        f32x4 gv[2][2];
#pragma unroll
        for (int bj = 0; bj < 2; ++bj)
#pragma unroll
            for (int n = 0; n < 2; ++n) {
                if (seg == 2) gv[bj][n] = (f32x4){1.f, 1.f, 1.f, 1.f};
                else { const float* g = (seg == 0 ? qg : kg) + bj * 32 + 8 * fq + 4 * n; gv[bj][n] = *(const f32x4*)g; if (seg == 0) gv[bj][n] = gv[bj][n] * C2; } }
        bf16* base = QKV + (size_t)seg * M * D;
#pragma unroll
        for (int ai = 0; ai < 2; ++ai)
#pragma unroll
            for (int m = 0; m < 4; ++m) {
                const int t = u.pm * 256 + ai * 128 + wr * 64 + m * 16 + fr, b = t >> 11, s = t & (SEQ - 1);
                float rstd = 1.f;
                if (seg < 2) { float ss = 0.f;
#pragma unroll
                    for (int bj = 0; bj < 2; ++bj)
#pragma unroll
                        for (int n = 0; n < 2; ++n) { const f32x4 v = acc[ai][bj][m][n]; ss += (v[0] * v[0] + v[1] * v[1]) + (v[2] * v[2] + v[3] * v[3]); }
                    ss += __shfl_xor(ss, 16); ss += __shfl_xor(ss, 32);
                    rstd = 1.0f / sqrtf(ss * (1.0f / 64.0f) + RMS_EPS); }
                bf16* rowp = base + ((size_t)(b * NH + head) * SEQ + s) * HD + 8 * fq;
#pragma unroll
                for (int bj = 0; bj < 2; ++bj) { const f32x4 v0 = acc[ai][bj][m][0] * rstd * gv[bj][0], v1 = acc[ai][bj][m][1] * rstd * gv[bj][1];
                    u32x4 w; w.x = cvtpk(v0[0], v0[1]); w.y = cvtpk(v0[2], v0[3]); w.z = cvtpk(v1[0], v1[1]); w.w = cvtpk(v1[2], v1[3]);
                    *(u32x4*)(rowp + bj * 32) = w; }
            }
    }
};
struct EpiGateUp {
    static constexpr bool PERM = true;
    bf16* ACT; const float* bias;
    __device__ __forceinline__ void operator()(const f32x4 (&acc)[2][2][4][2], const pg8::Unit& u, int wr, int wc, int fr, int fq) const {
        const int lc = u.pn * 128 + wc * 32 + 8 * fq;
        const float* bg = bias + (size_t)u.e * 2048 + lc;
        f32x4 bv[2][2];
#pragma unroll
        for (int bj = 0; bj < 2; ++bj)
#pragma unroll
            for (int n = 0; n < 2; ++n) bv[bj][n] = *(const f32x4*)(bg + bj * 1024 + 4 * n);
#pragma unroll
        for (int ai = 0; ai < 2; ++ai)
#pragma unroll
            for (int m = 0; m < 4; ++m) {
                bf16* rowp = ACT + (size_t)(u.pm * 256 + ai * 128 + wr * 64 + m * 16 + fr) * FF + lc;
                float o[8];
#pragma unroll
                for (int n = 0; n < 2; ++n) { const f32x4 g4 = acc[ai][0][m][n] + bv[0][n], u4 = acc[ai][1][m][n] + bv[1][n];
#pragma unroll
                    for (int i = 0; i < 4; ++i) { const float g = fminf(g4[i], SW_LIMIT), up = fminf(fmaxf(u4[i], -SW_LIMIT), SW_LIMIT);
                        const float sg = __builtin_amdgcn_rcpf(1.0f + __builtin_amdgcn_exp2f(g * (-SW_ALPHA * 1.4426950408889634f)));
                        o[n * 4 + i] = (up + 1.0f) * (g * sg); } }
                u32x4 w; w.x = cvtpk(o[0], o[1]); w.y = cvtpk(o[2], o[3]); w.z = cvtpk(o[4], o[5]); w.w = cvtpk(o[6], o[7]);
                *(u32x4*)rowp = w;
            }
    }
};
struct EpiDown {
    static constexpr bool PERM = true;
    bf16* OUTS; const float* bias;
    __device__ __forceinline__ void operator()(const f32x4 (&acc)[2][2][4][2], const pg8::Unit& u, int wr, int wc, int fr, int fq) const {
        const int col0 = u.pn * 256 + wc * 32 + 8 * fq;
        const float* bd = bias + (size_t)u.e * 1024 + col0;
        f32x4 bv[2][2];
#pragma unroll
        for (int bj = 0; bj < 2; ++bj)
#pragma unroll
            for (int n = 0; n < 2; ++n) bv[bj][n] = *(const f32x4*)(bd + bj * 128 + 4 * n);
#pragma unroll
        for (int ai = 0; ai < 2; ++ai)
#pragma unroll
            for (int m = 0; m < 4; ++m) { bf16* rowp = OUTS + (size_t)(u.pm * 256 + ai * 128 + wr * 64 + m * 16 + fr) * D + col0;
#pragma unroll
                for (int bj = 0; bj < 2; ++bj) { const f32x4 v0 = acc[ai][bj][m][0] + bv[bj][0], v1 = acc[ai][bj][m][1] + bv[bj][1];
                    u32x4 w; w.x = cvtpk(v0[0], v0[1]); w.y = cvtpk(v0[2], v0[3]); w.z = cvtpk(v1[0], v1[1]); w.w = cvtpk(v1[2], v1[3]);
                    *(u32x4*)(rowp + bj * 128) = w; } }
    }
};

__device__ __forceinline__ void cvt_item(const float* W, int N, int k0, int n0, bf16* dst  , int dpitch, LAS float* scr, int lane) {
    float v[32];
#pragma unroll
    for (int i = 0; i < 32; ++i) { const int kk = 2 * i + (lane >> 5); v[i] = W[(size_t)(k0 + kk) * N + n0 + (lane & 31)]; }
#pragma unroll
    for (int i = 0; i < 32; ++i) { const int kk = 2 * i + (lane >> 5); scr[kk * 33 + (lane & 31)] = v[i]; }
    LDS_WAIT(); asm volatile("" ::: "memory");
    const int c = lane & 7;
#pragma unroll
    for (int j = 0; j < 4; ++j) { const int n = (lane >> 3) + 8 * j; const LAS float* s = scr + (8 * c) * 33 + n;
        u32x4 o; o.x = cvtpk(s[0 * 33], s[1 * 33]); o.y = cvtpk(s[2 * 33], s[3 * 33]); o.z = cvtpk(s[4 * 33], s[5 * 33]); o.w = cvtpk(s[6 * 33], s[7 * 33]);
        *(u32x4*)(dst + (size_t)n * dpitch + 8 * c) = o; }
    LDS_WAIT(); asm volatile("" ::: "memory");
}
__device__ __forceinline__ void phase_convert(Frame& F) {
    LAS float* scr = (LAS float*)(F.lds + F.wave * 8448);
    const int gw = blockIdx.x * NWAVES + F.wave, NGW = F.G * NWAVES;
    constexpr int I_POOL = 4 * 4 * 8, I_QKV = 16 * 96, I_WO = 16 * 32, I_GU = 64 * 16 * 64, I_DN = 64 * 16 * 32;
    constexpr int NITEMS = I_POOL + I_QKV + I_WO + I_GU + I_DN;
    for (int it = gw; it < NITEMS; it += NGW) {
        int r = it;
        if (r < I_POOL) { const int g = r >> 5, q = r & 31, kb = q >> 3, nb = q & 7;
            cvt_item(F.pool_w + (size_t)g * 65536, 256, kb * 64, nb * 32, (bf16*)(F.ws + WS_POOLW) + (size_t)g * 65536 + (size_t)(nb * 32) * 256 + kb * 64, 256, scr, F.lane); continue; }
        r -= I_POOL;
        if (r < I_QKV) { const int kb = r / 96, nb = r % 96, n0 = nb * 32, pn = n0 >> 8, cc = n0 & 255, drow = 256 * pn + 128 * ((cc >> 5) & 1) + 32 * (cc >> 6);
            cvt_item(F.w_qkv, 3 * D, kb * 64, n0, (bf16*)(F.ws + WS_WQKV) + (size_t)drow * D + kb * 64, D, scr, F.lane); continue; }
        r -= I_QKV;
        if (r < I_WO) { const int kb = r >> 5, nb = r & 31;
            cvt_item(F.w_o, D, kb * 64, nb * 32, (bf16*)(F.ws + WS_WO) + (size_t)(nb * 32) * D + kb * 64, D, scr, F.lane); continue; }
        r -= I_WO;
        if (r < I_GU) { const int mat = r >> 10, q = r & 1023, kb = q >> 6, nb = q & 63;
            cvt_item(F.w_gu + (size_t)mat * D * 2 * FF, 2 * FF, kb * 64, nb * 32, (bf16*)(F.ws + WS_WGU) + (size_t)mat * 2 * FF * D + (size_t)(nb * 32) * D + kb * 64, D, scr, F.lane); continue; }
        r -= I_GU;
        { const int mat = r >> 9, q = r & 511, kb = q >> 5, nb = q & 31;
            cvt_item(F.w_dn + (size_t)mat * FF * D, D, kb * 64, nb * 32, (bf16*)(F.ws + WS_WDN) + (size_t)mat * D * FF + (size_t)(nb * 32) * FF + kb * 64, FF, scr, F.lane); }
    }
}
__device__ __forceinline__ void phase_pooled(Frame& F) {
    LAS float* H = (LAS float*)F.lds;
    LAS float* RS = (LAS float*)(F.lds + 81920);
    bf16* P = (bf16*)(F.ws + WS_POOLED);
    for (int tile = blockIdx.x; tile < M / 64; tile += F.G) {
        const int t0 = tile * 64, s0 = t0 & (SEQ - 1);
        for (int i = F.wave; i < 79; i += NWAVES) {
            const int s = s0 - 15 + i; float r = 0.f;
            if (s >= 0) { const f32x4* xr = (const f32x4*)(F.x + (size_t)(t0 - 15 + i) * D) + F.lane; float ss = 0.f;
#pragma unroll
                for (int j = 0; j < 4; ++j) { const f32x4 v = xr[64 * j]; ss += (v[0] * v[0] + v[1] * v[1]) + (v[2] * v[2] + v[3] * v[3]); }
                ss = wave_sum(ss); r = 1.0f / sqrtf(ss * (1.0f / D) + RMS_EPS); }
            if (F.lane == 0) RS[i] = r;
        }
        __syncthreads();
        for (int g = 0; g < 4; ++g) {
            const f32x4 gn = *((const f32x4*)(F.mix_norm + g * 256) + F.lane);
            for (int i = F.wave; i < 79; i += NWAVES) {
                const int s = s0 - 15 + i; f32x4 v = (f32x4){0.f, 0.f, 0.f, 0.f};
                if (s >= 0) { v = *((const f32x4*)(F.x + (size_t)(t0 - 15 + i) * D + g * 256) + F.lane); v = v * RS[i] * gn; }
                *((LAS f32x4*)(H + i * 256) + F.lane) = v;
            }
            __syncthreads();
            const int w = 2 << g, cp = F.tid & 127, rq = F.tid >> 7, i0 = 15 + rq * 16;
            const LAS f32x2* H2p = (const LAS f32x2*)H + cp;
            f32x2 S = (f32x2){0.f, 0.f};
            for (int j = i0 - w + 1; j <= i0; ++j) S += H2p[j * 128];
            for (int r = 0; r < 16; ++r) {
                const int i = i0 + r;
                if (r > 0) S += H2p[i * 128] - H2p[(i - w) * 128];
                const int s = s0 + rq * 16 + r; const int cnt = (s + 1 < w) ? (s + 1) : w;
                const f32x2 h = H2p[i * 128]; const float inv = 1.0f / (float)cnt;
                const f32x2 pv = S * inv - h;
                *(unsigned*)(P + (size_t)(t0 + rq * 16 + r) * D + g * 256 + 2 * cp) = cvtpk(pv[0], pv[1]);
            }
            __syncthreads();
        }
    }
}

__device__ __forceinline__ void moe_tables(Frame& F, int layer) {
    LAS int* ecnt = (LAS int*)(F.lds + TAB_ECNT); LAS int* tbase = (LAS int*)(F.lds + TAB_TBASE); LAS unsigned char* texp = (LAS unsigned char*)(F.lds + TAB_TEXP);
    if (F.tid < NE) ecnt[F.tid] = (int)__hip_atomic_load(F.ctl + CW_ECNT + layer * 2048 + F.tid * 64, RLX_AGENT);
    __syncthreads();
    if (F.tid == 0) { int a = 0; for (int e = 0; e < NE; ++e) { tbase[e] = a; a += (ecnt[e] + 255) >> 8; } tbase[NE] = a; }
    __syncthreads();
    if (F.tid < MT_MAX) { int e = 0; for (int q = 1; q < NE; ++q) if (F.tid >= tbase[q]) e = q; texp[F.tid] = (unsigned char)e; }
    __syncthreads();
}
template <bool COMBINE, bool WRITE_X, bool NORM, bool ROUTER>
__device__ __forceinline__ void phase_rows(Frame& F, const float* src, float* dstX, const float* gain, bf16* dstH, int layer  ) {
    const int* tope = (const int*)(F.ws + WS_TOPE); const int* topp = (const int*)(F.ws + WS_TOPP); const float* topw = (const float*)(F.ws + WS_TOPW);
    const bf16* OUTS = (const bf16*)(F.ws + WS_OUTS);
    if (COMBINE) moe_tables(F, layer);
    const LAS int* tbase = (const LAS int*)(F.lds + TAB_TBASE);
    f32x4 gn[4];
    if (NORM) {
#pragma unroll
        for (int j = 0; j < 4; ++j) gn[j] = *((const f32x4*)gain + F.lane + 64 * j); }
    for (int tile = blockIdx.x; tile < M / 64; tile += F.G) {
        f32x4 v[8][4];
#pragma unroll
        for (int rr = 0; rr < 8; ++rr) {
            const int t = tile * 64 + F.wave * 8 + rr;
            const f32x4* xr = (const f32x4*)(src + (size_t)t * D) + F.lane;
#pragma unroll
            for (int j = 0; j < 4; ++j) v[rr][j] = xr[64 * j];
            if (COMBINE) {
#pragma unroll
                for (int k = 0; k < TOPK; ++k) {
                    const int e = tope[t * 4 + k], pos = topp[t * 4 + k]; const float wk = topw[t * 4 + k];
                    const u32x2* orow = (const u32x2*)(OUTS + (size_t)(tbase[e] * 256 + pos) * D) + F.lane;
#pragma unroll
                    for (int j = 0; j < 4; ++j) { const u32x2 o = orow[64 * j]; v[rr][j] += (f32x4){bf_lo(o.x), bf_hi(o.x), bf_lo(o.y), bf_hi(o.y)} * wk; }
                }
            }
            if (WRITE_X) { f32x4* xo = (f32x4*)(dstX + (size_t)t * D) + F.lane;
#pragma unroll
                for (int j = 0; j < 4; ++j) xo[64 * j] = v[rr][j]; }
            if (NORM) {
                float ss = 0.f;
#pragma unroll
                for (int j = 0; j < 4; ++j) ss += (v[rr][j][0] * v[rr][j][0] + v[rr][j][1] * v[rr][j][1]) + (v[rr][j][2] * v[rr][j][2] + v[rr][j][3] * v[rr][j][3]);
                ss = wave_sum(ss); const float rstd = 1.0f / sqrtf(ss * (1.0f / D) + RMS_EPS);
                u32x2* ho = (u32x2*)(dstH + (size_t)t * D) + F.lane;
#pragma unroll
                for (int j = 0; j < 4; ++j) { v[rr][j] = v[rr][j] * rstd * gn[j]; u32x2 o; o.x = cvtpk(v[rr][j][0], v[rr][j][1]); o.y = cvtpk(v[rr][j][2], v[rr][j][3]); ho[64 * j] = o; }
            }
        }
        if (ROUTER) {
            LAS float* HT = (LAS float*)F.lds;
            LAS float* WC = (LAS float*)(F.lds + 66560);
            LAS float* PART = (LAS float*)F.lds;
            LAS float* LG = (LAS float*)(F.lds + 66560);
            LAS int* lcnt = (LAS int*)(F.lds + 99328);
            LAS int* gbase = (LAS int*)(F.lds + 99328 + 128);
            const float* RW = F.router_w + (size_t)layer * D * NE; const float* RB = F.router_b + layer * NE;
            const int th = F.wave & 1, kq = F.wave >> 1, r32 = F.lane & 31, hi = F.lane >> 5;
            f32x16 acc = {};
            for (int j = 0; j < 4; ++j) {
                __syncthreads();
#pragma unroll
                for (int rr = 0; rr < 8; ++rr)
#pragma unroll
                    for (int i = 0; i < 4; ++i) HT[(4 * F.lane + i) * 65 + F.wave * 8 + rr] = v[rr][j][i];
                { const f32x4* wsrc = (const f32x4*)(RW + (size_t)j * 256 * NE); LAS f32x4* wdst = (LAS f32x4*)WC;
#pragma unroll
                    for (int q = 0; q < 4; ++q) wdst[F.tid + 512 * q] = wsrc[F.tid + 512 * q]; }
                __syncthreads();
                const LAS float* ap = HT + (kq * 64 + hi) * 65 + th * 32 + r32; const LAS float* bp = WC + (kq * 64 + hi) * 32 + r32;
#pragma unroll 8
                for (int s = 0; s < 32; ++s) acc = __builtin_amdgcn_mfma_f32_32x32x2f32(ap[s * 2 * 65], bp[s * 2 * 32], acc, 0, 0, 0);
            }
            __syncthreads();
#pragma unroll
            for (int r = 0; r < 16; ++r) { const int tok = th * 32 + (r & 3) + 8 * (r >> 2) + 4 * hi; PART[(kq * 64 + tok) * 33 + r32] = acc[r]; }
            if (F.tid < NE) lcnt[F.tid] = 0;
            __syncthreads();
            for (int q = F.tid; q < 64 * NE; q += 512) { const int tok = q >> 5, e = q & 31;
                LG[tok * 33 + e] = ((PART[tok * 33 + e] + PART[(64 + tok) * 33 + e]) + (PART[(128 + tok) * 33 + e] + PART[(192 + tok) * 33 + e])) + RB[e]; }
            __syncthreads();
            int te[4], lp[4]; float tw[4];
            if (F.wave == 0) {
                const int tok = F.lane; unsigned used = 0u; float tv[4];
#pragma unroll
                for (int k = 0; k < 4; ++k) { float best = -INFINITY; int bi = 0;
                    for (int e = 0; e < NE; ++e) { const float xv = LG[tok * 33 + e]; if (!((used >> e) & 1u) && xv > best) { best = xv; bi = e; } }
                    used |= 1u << bi; tv[k] = best; te[k] = bi; }
                float sum = 0.f;
#pragma unroll
                for (int k = 0; k < 4; ++k) { tw[k] = __expf(tv[k] - tv[0]); sum += tw[k]; }
                const float inv = 1.0f / sum;
#pragma unroll
                for (int k = 0; k < 4; ++k) { tw[k] *= inv; lp[k] = atomicAdd((int*)(lcnt + te[k]), 1); }
            }
            __syncthreads();
            if (F.tid < NE) { const int c = lcnt[F.tid]; gbase[F.tid] = c > 0 ? (int)__hip_atomic_fetch_add(F.ctl + CW_ECNT + layer * 2048 + F.tid * 64, (unsigned)c, RLX_AGENT) : 0; }
            __syncthreads();
            if (F.wave == 0) {
                const int t = tile * 64 + F.lane;
                int* list = (int*)(F.ws + WS_LIST); int* tope_w = (int*)(F.ws + WS_TOPE); int* topp_w = (int*)(F.ws + WS_TOPP); float* topw_w = (float*)(F.ws + WS_TOPW);
#pragma unroll
                for (int k = 0; k < 4; ++k) { const int pos = gbase[te[k]] + lp[k]; list[te[k] * M + pos] = t; tope_w[t * 4 + k] = te[k]; topp_w[t * 4 + k] = pos; topw_w[t * 4 + k] = tw[k]; }
            }
            __syncthreads();
        }
    }
}

__device__ __forceinline__ void phase_moe_up(Frame& F, int layer) {
    moe_tables(F, layer);
    const LAS int* ecnt = (const LAS int*)(F.lds + TAB_ECNT); const LAS int* tbase = (const LAS int*)(F.lds + TAB_TBASE);
    ProbMoeUp S{(const char*)(F.ws + WS_H2), (const char*)(F.ws + WS_WGU) + (size_t)layer * NE * 2048 * 1024 * 2, F.lds, 1024, 1024, tbase[NE], F.G, (int)blockIdx.x};
    {
        const int* list = (const int*)(F.ws + WS_LIST); LAS unsigned* rt = (LAS unsigned*)(F.lds + TAB_ROW);
        pg8::Unit u;
        for (int ord = 0; ord < MAXU && S.next(ord, u); ++ord) {
            if (F.tid < 256) { const int p = (u.pm - tbase[u.e]) * 256 + F.tid; const int tok = (p < ecnt[u.e]) ? list[u.e * M + p] : 0; rt[ord * 256 + F.tid] = (unsigned)tok * (unsigned)(D * 2); }
        }
        __syncthreads();
    }
    EpiGateUp E{(bf16*)(F.ws + WS_ACT), F.b_gu + (size_t)layer * NE * 2048};
    pg8::gemm_phase<ProbMoeUp, EpiGateUp>(F.lds, S, E);
}
__device__ __forceinline__ void phase_moe_down(Frame& F, int layer) {
    moe_tables(F, layer);
    const LAS int* tbase = (const LAS int*)(F.lds + TAB_TBASE);
    ProbMoeDown S{(const char*)(F.ws + WS_ACT), (const char*)(F.ws + WS_WDN) + (size_t)layer * NE * 1024 * 1024 * 2, F.lds, 1024, 1024, tbase[NE], F.G, (int)blockIdx.x};
    EpiDown E{(bf16*)(F.ws + WS_OUTS), F.b_dn + (size_t)layer * NE * 1024};
    pg8::gemm_phase<ProbMoeDown, EpiDown>(F.lds, S, E);
}

__device__ __forceinline__ int crow(int r, int hi) { return (r & 3) + 8 * (r >> 2) + 4 * hi; }
typedef LAS const char* lds_cptr;
__device__ __forceinline__ s16x4 vtr(lds_cptr p) { return __builtin_bit_cast(s16x4, __builtin_amdgcn_ds_read_tr16_b64_v4i16((LAS v4i16_t*)p)); }
__device__ __forceinline__ void attn_unit(Frame& F, int bh, int qb) {
    const int lane = F.lane, r32 = lane & 31, hi = lane >> 5, wid = F.wave, tid = F.tid;
    const bf16* Qh = (const bf16*)(F.ws + WS_Q) + (size_t)bh * SEQ * HD; const bf16* Kh = (const bf16*)(F.ws + WS_K) + (size_t)bh * SEQ * HD; const bf16* Vh = (const bf16*)(F.ws + WS_V) + (size_t)bh * SEQ * HD;
    const int q0 = qb * 256, qw = q0 + 32 * wid, qpos = qw + r32, jd = qw >> 6, jtop = (q0 >> 6) + 3;
    LAS unsigned char* KB = F.lds; LAS unsigned char* VB = F.lds + 16384; LAS unsigned char* OST = F.lds + 32768 + wid * 4096;
    const bf16* ksrc = Kh + (size_t)lane * HD + wid * 8;
    const bf16* vsrc = Vh + (size_t)(16 * (wid & 3) + (lane >> 2)) * HD + (wid >> 2) * 32 + (lane & 3) * 8;
    bf16x8 qr[4];
#pragma unroll
    for (int d0 = 0; d0 < 4; ++d0) qr[d0] = *(const bf16x8*)(Qh + (size_t)qpos * HD + d0 * 16 + hi * 8);
    f32x16 o0 = {}, o1 = {};
    float C = 0.f;
    int cur = 0;
    bool done = false;
    LAS int* flags = (LAS int*)(F.lds + 65536);
    { const u32x4 kk = *(const u32x4*)(ksrc + (size_t)jtop * 64 * HD), vv = *(const u32x4*)(vsrc + (size_t)jtop * 64 * HD);
      *(LAS u32x4*)(KB + tid * 16) = kk; *(LAS u32x4*)(VB + tid * 16) = vv; }
    __syncthreads();
    for (int j = jtop; j >= 0; --j) {
        u32x4 kn, vn;
        if (j > 0) { kn = *(const u32x4*)(ksrc + (size_t)(j - 1) * 64 * HD); vn = *(const u32x4*)(vsrc + (size_t)(j - 1) * 64 * HD); }
        if (j <= jd && !done) {
            const lds_cptr kb = (lds_cptr)(KB + cur * 8192) + hi * 1024 + r32 * 16;
            f32x16 p0 = {}, p1 = {};
#pragma unroll
            for (int d0 = 0; d0 < 4; ++d0) { const bf16x8 b0 = *(const LAS bf16x8*)(kb + d0 * 2048), b1 = *(const LAS bf16x8*)(kb + d0 * 2048 + 512);
                p0 = __builtin_amdgcn_mfma_f32_32x32x16_bf16(b0, qr[d0], p0, 0, 0, 0); p1 = __builtin_amdgcn_mfma_f32_32x32x16_bf16(b1, qr[d0], p1, 0, 0, 0); }
            float L0[16], L1[16];
#pragma unroll
            for (int r = 0; r < 16; ++r) { L0[r] = __builtin_amdgcn_logf(1.0f + __builtin_amdgcn_exp2f(p0[r])); L1[r] = __builtin_amdgcn_logf(1.0f + __builtin_amdgcn_exp2f(p1[r])); }
            if (j == jd) {
                const int kb0 = 64 * j + 4 * hi;
#pragma unroll
                for (int r = 0; r < 16; ++r) { const int kv = kb0 + (r & 3) + 8 * (r >> 2);
                    if (kv >= qpos) { L0[r] = 0.f; p0[r] = -INFINITY; } if (kv + 32 >= qpos) { L1[r] = 0.f; p1[r] = -INFINITY; } }
            }
            float tg[8];
#pragma unroll
            for (int g = 0; g < 4; ++g) {
                L0[4 * g + 2] += L0[4 * g + 3]; L0[4 * g + 1] += L0[4 * g + 2]; L0[4 * g] += L0[4 * g + 1]; tg[g] = L0[4 * g];
                L1[4 * g + 2] += L1[4 * g + 3]; L1[4 * g + 1] += L1[4 * g + 2]; L1[4 * g] += L1[4 * g + 1]; tg[4 + g] = L1[4 * g]; }
            float off[8]; float R = C;
#pragma unroll
            for (int g = 7; g >= 0; --g) {
                const auto rr = __builtin_amdgcn_permlane32_swap(__float_as_uint(tg[g]), __float_as_uint(tg[g]), false, false);
                const float tlo = __uint_as_float(rr[0]), thi = __uint_as_float(rr[1]);
                off[g] = R + (hi ? 0.f : thi);
                R += tlo + thi; }
            C = R;
#pragma unroll
            for (int g = 0; g < 4; ++g)
#pragma unroll
                for (int i = 0; i < 4; ++i) { p0[4 * g + i] = __builtin_amdgcn_exp2f(p0[4 * g + i] - (L0[4 * g + i] + off[g])); p1[4 * g + i] = __builtin_amdgcn_exp2f(p1[4 * g + i] - (L1[4 * g + i] + off[4 + g])); }
            u32x4 pw0, pw1, pw2, pw3;
            pw0 = (u32x4){cvtpk(p0[0], p0[1]), cvtpk(p0[2], p0[3]), cvtpk(p0[4], p0[5]), cvtpk(p0[6], p0[7])};
            pw1 = (u32x4){cvtpk(p0[8], p0[9]), cvtpk(p0[10], p0[11]), cvtpk(p0[12], p0[13]), cvtpk(p0[14], p0[15])};
            pw2 = (u32x4){cvtpk(p1[0], p1[1]), cvtpk(p1[2], p1[3]), cvtpk(p1[4], p1[5]), cvtpk(p1[6], p1[7])};
            pw3 = (u32x4){cvtpk(p1[8], p1[9]), cvtpk(p1[10], p1[11]), cvtpk(p1[12], p1[13]), cvtpk(p1[14], p1[15])};
            const lds_cptr vp = (lds_cptr)(VB + cur * 8192) + ((lane >> 4) & 1) * 32 + (lane & 3) * 8 + (4 * hi + ((lane & 15) >> 2)) * 64;
#define PVSTEP(OACC, D0, KS, PW) do { const s16x4 lo_ = vtr(vp + (D0) * 4096 + (KS) * 1024), hi_ = vtr(vp + (D0) * 4096 + (KS) * 1024 + 512); \
                const bf16x8 vf_ = (bf16x8){lo_[0], lo_[1], lo_[2], lo_[3], hi_[0], hi_[1], hi_[2], hi_[3]}; \
                OACC = __builtin_amdgcn_mfma_f32_32x32x16_bf16(__builtin_bit_cast(bf16x8, PW), vf_, OACC, 0, 0, 0); } while (0)
            PVSTEP(o0, 0, 0, pw0); PVSTEP(o1, 1, 0, pw0); PVSTEP(o0, 0, 1, pw1); PVSTEP(o1, 1, 1, pw1);
            PVSTEP(o0, 0, 2, pw2); PVSTEP(o1, 1, 2, pw2); PVSTEP(o0, 0, 3, pw3); PVSTEP(o1, 1, 3, pw3);
#undef PVSTEP
            done = __all(C > 150.0f);
        }
        if (j > 0) { *(LAS u32x4*)(KB + (cur ^ 1) * 8192 + tid * 16) = kn; *(LAS u32x4*)(VB + (cur ^ 1) * 8192 + tid * 16) = vn; }
        if (lane == 0) flags[(j & 1) * 8 + wid] = done ? 1 : 0;
        __syncthreads();
        if (__all(flags[(j & 1) * 8 + (lane & 7)] != 0)) break;
        cur ^= 1;
    }
    { LAS bf16* stg = (LAS bf16*)OST;
#pragma unroll
      for (int r = 0; r < 16; ++r) { const int orow = crow(r, hi); stg[orow * 64 + r32] = (bf16)(cvtpk(o0[r], 0.f) & 0xffffu); stg[orow * 64 + 32 + r32] = (bf16)(cvtpk(o1[r], 0.f) & 0xffffu); }
      LDS_WAIT(); asm volatile("" ::: "memory");
      const int b = bh >> 4, h = bh & 15;
      bf16* Ow = (bf16*)(F.ws + WS_O) + ((size_t)b * SEQ + qw) * D + h * HD;
#pragma unroll
      for (int i = 0; i < 4; ++i) { const int row = i * 8 + (lane >> 3), ch = lane & 7; const u32x4 vv = *(const LAS u32x4*)(stg + row * 64 + ch * 8); *(u32x4*)(Ow + (size_t)row * D + ch * 8) = vv; } }
    __syncthreads();
}
__device__ __forceinline__ void phase_attn(Frame& F) {
    for (int v = blockIdx.x; v < BATCH * NH * 2; v += F.G) {
        const int bh = v >> 1, odd = v & 1;
        for (int i = 0; i < 4; ++i) { const int qb = (i == 0) ? (odd ? 6 : 7) : (i == 1) ? (odd ? 5 : 4) : (i == 2) ? (odd ? 2 : 3) : (odd ? 1 : 0); attn_unit(F, bh, qb); }
    }
}

constexpr int NPHASE = 14;
struct Args { const float* in[15]; float* out; unsigned char* ws; int ph_lo, ph_hi; };
__global__ void __launch_bounds__(NWAVES * 64, 2) fwd_kernel(Args args) {
    extern __shared__ __attribute__((aligned(16))) unsigned char lds[];
    Frame F;
    F.lds = (LAS unsigned char*)lds; F.MISC = (volatile LAS unsigned*)(F.lds + MISC_OFF);
    F.tid = threadIdx.x; F.lane = F.tid & 63; F.wave = __builtin_amdgcn_readfirstlane(F.tid >> 6); F.G = gridDim.x;
    F.ws = args.ws; F.ctl = (gu32*)(args.ws + WS_CTL);
    F.x = args.in[0]; F.mix_norm = args.in[1]; F.pool_w = args.in[2]; F.pool_scale = args.in[3]; F.w_qkv = args.in[4]; F.q_norm = args.in[5]; F.k_norm = args.in[6]; F.w_o = args.in[7];
    F.ffn_norm = args.in[8]; F.router_w = args.in[9]; F.router_b = args.in[10]; F.w_gu = args.in[11]; F.b_gu = args.in[12]; F.w_dn = args.in[13]; F.b_dn = args.in[14]; F.out = args.out;
    for (int u = F.tid; u < (LDS_BYTES - LDSCTL_OFF) / 4; u += NWAVES * 64) ((LAS unsigned*)(F.lds + LDSCTL_OFF))[u] = 0u;
    __syncthreads();
    XcdBarrier bar; bar.bar = (unsigned*)(F.ctl + CW_BAR); bar.x = 0; bar.st = nullptr;
    if (!MK_PER_PHASE) bar = xcd_barrier_post((unsigned*)(F.ctl + CW_BAR), F.MISC + 8);
    const int lo = args.ph_lo, hi = args.ph_hi;
#define IN(k) (lo <= (k) && (k) < hi)
#define SEAM(k) do { if (IN(k) && IN((k) + 1)) xcd_barrier(bar); } while (0)
    float* X1 = (float*)(F.ws + WS_X1); float* X2 = (float*)(F.ws + WS_X2); float* X3 = (float*)(F.ws + WS_X3);

    if (IN(0)) { for (int rep = 0; rep < REPS(0); ++rep) { phase_convert(F); __syncthreads(); } for (int rep = 0; rep < REPS(20); ++rep) phase_pooled(F); }
    SEAM(0);
    if (IN(1)) for (int rep = 0; rep < REPS(1); ++rep) { ProbPool S{(const char*)(F.ws + WS_POOLED), (const char*)(F.ws + WS_POOLW), 256, 256, F.G, (int)blockIdx.x}; EpiPool E{F.x, X1, F.pool_scale};
        pg8::gemm_phase<ProbPool, EpiPool>(F.lds, S, E); }
    SEAM(1);
    if (IN(2)) phase_rows<false, false, true, true>(F, X1, nullptr, F.ffn_norm, (bf16*)(F.ws + WS_H2), 0);
    SEAM(2);
    if (IN(3)) for (int rep = 0; rep < REPS(3); ++rep) phase_moe_up(F, 0);
    SEAM(3);
    if (IN(4)) for (int rep = 0; rep < REPS(4); ++rep) phase_moe_down(F, 0);
    SEAM(4);
    if (IN(5)) for (int rep = 0; rep < REPS(5); ++rep) phase_rows<true, true, true, false>(F, X1, X2, F.mix_norm + D, (bf16*)(F.ws + WS_HQ), 0);
    SEAM(5);
    if (IN(6)) for (int rep = 0; rep < REPS(6); ++rep) { ProbDense S{(const char*)(F.ws + WS_HQ), (const char*)(F.ws + WS_WQKV), D, D, D, M / 256, 12, F.G, (int)blockIdx.x}; EpiQKV E{(bf16*)(F.ws + WS_Q), F.q_norm, F.k_norm};
        pg8::gemm_phase<ProbDense, EpiQKV>(F.lds, S, E); }
    SEAM(6);
    if (IN(7)) for (int rep = 0; rep < REPS(7); ++rep) phase_attn(F);
    SEAM(7);
    if (IN(8)) for (int rep = 0; rep < REPS(8); ++rep) { ProbDense S{(const char*)(F.ws + WS_O), (const char*)(F.ws + WS_WO), D, D, D, M / 256, 4, F.G, (int)blockIdx.x}; EpiRes E{X2, X3};
        pg8::gemm_phase<ProbDense, EpiRes>(F.lds, S, E); }
    SEAM(8);
    if (IN(9)) phase_rows<false, false, true, true>(F, X3, nullptr, F.ffn_norm + D, (bf16*)(F.ws + WS_H2), 1);
    SEAM(9);
    if (IN(10)) for (int rep = 0; rep < REPS(10); ++rep) phase_moe_up(F, 1);
    SEAM(10);
    if (IN(11)) for (int rep = 0; rep < REPS(11); ++rep) phase_moe_down(F, 1);
    SEAM(11);
    if (IN(12)) for (int rep = 0; rep < REPS(12); ++rep) phase_rows<true, true, false, false>(F, X3, F.out, nullptr, nullptr, 1);
    if (IN(13)) {
        const float* src = (MK_LAST_PHASE >= 8) ? X3 : (MK_LAST_PHASE >= 5) ? X2 : X1;
        for (size_t i = (size_t)blockIdx.x * 512 + F.tid; i < (size_t)M * D / 4; i += (size_t)F.G * 512) ((f32x4*)F.out)[i] = ((const f32x4*)src)[i];
    }
#undef IN
#undef SEAM
}

extern "C" void kernel_launch(void* const* d_in, const int* in_sizes, int n_in, void* d_out, int out_size, void* d_ws, size_t ws_size, hipStream_t stream) {
    static int grid = 0;
    if (grid == 0) {
        if (n_in != 15 || in_sizes[0] != M * D || out_size != M * D || ws_size < WS_END) { fprintf(stderr, "kernel_launch: unexpected shapes (n_in %d, in0 %d, out %d, ws %zu, need %zu)\n", n_in, n_in > 0 ? in_sizes[0] : -1, out_size, ws_size, (size_t)WS_END); grid = -1; return; }
        int dev = 0, cus = 0, per_cu = 0;
        if (hipGetDevice(&dev) != hipSuccess || hipDeviceGetAttribute(&cus, hipDeviceAttributeMultiprocessorCount, dev) != hipSuccess) { grid = -1; return; }
        if (hipFuncSetAttribute((const void*)fwd_kernel, hipFuncAttributeMaxDynamicSharedMemorySize, LDS_BYTES) != hipSuccess) { fprintf(stderr, "kernel_launch: hipFuncSetAttribute failed\n"); grid = -1; return; }
        if (hipOccupancyMaxActiveBlocksPerMultiprocessor(&per_cu, (const void*)fwd_kernel, NWAVES * 64, LDS_BYTES) != hipSuccess || per_cu < 1) fprintf(stderr, "kernel_launch: occupancy query says %d\n", per_cu);
        (void)hipGetLastError();
        grid = cus;
    }
    if (grid < 0) return;
    (void)hipMemsetAsync((char*)d_ws + WS_CTL, 0, CTL_ZERO_BYTES, stream);
    Args a{};
    for (int i = 0; i < 15; ++i) a.in[i] = (const float*)d_in[i];
    a.out = (float*)d_out; a.ws = (unsigned char*)d_ws;
    const int last = MK_LAST_PHASE;
    if (MK_PER_PHASE) {
        for (int p = 0; p <= last; ++p) { a.ph_lo = p; a.ph_hi = p + 1; hipLaunchKernelGGL(fwd_kernel, dim3(grid), dim3(NWAVES * 64), LDS_BYTES, stream, a); }
        if (last < 12) { a.ph_lo = 13; a.ph_hi = 14; hipLaunchKernelGGL(fwd_kernel, dim3(grid), dim3(NWAVES * 64), LDS_BYTES, stream, a); }
    } else {
        a.ph_lo = 0; a.ph_hi = 13; hipLaunchKernelGGL(fwd_kernel, dim3(grid), dim3(NWAVES * 64), LDS_BYTES, stream, a);
    }
    const hipError_t le = hipPeekAtLastError();
    if (le != hipSuccess) fprintf(stderr, "kernel_launch: launch failed: %s\n", hipGetErrorName(le));
}
```

```cpp
#include <hip/hip_runtime.h>
#include <cstdio>
#include <cstdint>

#define GAS __attribute__((address_space(1)))
#define LAS __attribute__((address_space(3)))
typedef unsigned short bf16;
typedef unsigned u32x4 __attribute__((ext_vector_type(4)));
typedef unsigned u32x2 __attribute__((ext_vector_type(2)));
typedef float f32x4 __attribute__((ext_vector_type(4)));
typedef float f32x2 __attribute__((ext_vector_type(2)));
typedef float f32x16 __attribute__((ext_vector_type(16)));
typedef short bf16x8 __attribute__((ext_vector_type(8)));
typedef short s16x4 __attribute__((ext_vector_type(4)));
typedef short v4i16_t __attribute__((ext_vector_type(4)));
typedef __bf16 bf16x2_t __attribute__((ext_vector_type(2)));
typedef int i32x8 __attribute__((ext_vector_type(8)));
typedef GAS unsigned gu32;

constexpr int BATCH = 8, SEQ = 2048, D = 1024, M = BATCH * SEQ, NH = 16, HD = 64, NE = 32, TOPK = 4, FF = 1024;
constexpr float RMS_EPS = 1e-6f, SW_LIMIT = 7.0f, SW_ALPHA = 1.702f;
constexpr int MT_MAX = M * TOPK / 256 + NE;
constexpr int NSLOT = MT_MAX * 256;
constexpr float C2 = 0.125f * 1.4426950408889634f;
constexpr float S8_W = 64.0f, S8_H = 8.0f, S8_ACT = 4.0f;
constexpr int E8_UP = 127 - 9, E8_DOWN = 127 - 8;

constexpr size_t MiB = 1u << 20;
constexpr size_t WS_CTL = 0, CTL_ZERO_BYTES = 1 * MiB;
constexpr size_t WS_POOLW = 1 * MiB;
constexpr size_t WS_WQKV = 2 * MiB;
constexpr size_t WS_WO = 8 * MiB;
constexpr size_t WS_TOPE = 10 * MiB, WS_TOPP = WS_TOPE + 256 * 1024, WS_TOPW = WS_TOPP + 256 * 1024;
constexpr size_t WS_LIST = 12 * MiB;
constexpr size_t WS_WGU = 16 * MiB;
constexpr size_t WS_WDN = 272 * MiB;
constexpr size_t WS_WGU8 = WS_WGU + 128 * MiB;
constexpr size_t WS_WDN8 = WS_WDN + 64 * MiB;
constexpr size_t WS_X1 = 400 * MiB, WS_X2 = 464 * MiB, WS_X3 = 528 * MiB;
constexpr size_t WS_POOLED = 592 * MiB, WS_H2 = 624 * MiB, WS_HQ = 656 * MiB, WS_Q = 688 * MiB, WS_K = 720 * MiB, WS_V = 752 * MiB, WS_O = 784 * MiB;
constexpr size_t WS_ACT = 816 * MiB, WS_OUTS = 960 * MiB;
constexpr size_t WS_END = 1104 * MiB;
static_assert(WS_ACT + (size_t)NSLOT * 1024 * 2 <= WS_OUTS && WS_OUTS + (size_t)NSLOT * 1024 * 2 <= WS_END, "ws map");
constexpr int CW_TMO = 0, CW_CODE = 1;
constexpr int CW_BAR = 4096;
constexpr int CW_ECNT = 16384;

constexpr int RING_BYTES = 131072;
constexpr int LDSCTL_OFF = RING_BYTES, MISC_OFF = LDSCTL_OFF + 320;
constexpr int TAB_OFF = 131584;
constexpr int TAB_ECNT = TAB_OFF, TAB_TBASE = TAB_OFF + 128, TAB_TEXP = TAB_OFF + 384, TAB_ROW = TAB_OFF + 1024;
constexpr int MAXU = 12;
constexpr int LDS_BYTES = 147456;
static_assert(TAB_ROW + MAXU * 1024 <= LDS_BYTES, "LDS map");

constexpr int NWAVES = 8;
#ifndef MK_PER_PHASE
#define MK_PER_PHASE 0
#endif
#ifndef MK_REP
#define MK_REP -1
#endif
#define REPS(k) ((MK_REP == (k)) ? 2 : 1)
#ifndef MK_LAST_PHASE
#define MK_LAST_PHASE 12
#endif

#define RLX_AGENT __ATOMIC_RELAXED, __HIP_MEMORY_SCOPE_AGENT
#define LDS_WAIT() asm volatile("s_waitcnt lgkmcnt(0)" ::: "memory")
#define VM_WAIT() asm volatile("s_waitcnt vmcnt(0)" ::: "memory")
__device__ __forceinline__ unsigned cvtpk(float lo, float hi) { f32x2 v = {lo, hi}; bf16x2_t b = __builtin_convertvector(v, bf16x2_t); return __builtin_bit_cast(unsigned, b); }
__device__ __forceinline__ unsigned cvtfp8x4(float a, float b, float c, float d) { int w = __builtin_amdgcn_cvt_pk_fp8_f32(a, b, 0, false); w = __builtin_amdgcn_cvt_pk_fp8_f32(c, d, w, true); return (unsigned)w; }
__device__ __forceinline__ float bf_lo(unsigned u) { return __uint_as_float(u << 16); }
__device__ __forceinline__ float bf_hi(unsigned u) { return __uint_as_float(u & 0xffff0000u); }
__device__ __forceinline__ int lane_id() { int r; asm volatile("v_mbcnt_lo_u32_b32 %0, -1, 0\n\tv_mbcnt_hi_u32_b32 %0, -1, %0" : "=v"(r)); return r; }
__device__ __forceinline__ float wave_sum(float v) {
#pragma unroll
    for (int o = 1; o < 64; o <<= 1) v += __shfl_xor(v, o);
    return v;
}

#define XB_TMO      128
#define XB_XCNT(j)  (256  + 64 * (j))
#define XB_XSUB(j)  (1280 + 64 * (j))
#define XB_XGEN(j)  (2304 + 64 * (j))
#define XB_TOP      3328
#define XB_TOPGEN   3392
#define XCD_BAR_WORDS 3456
#define XB_SPIN_CAP (1u << 18)
__device__ __forceinline__ unsigned xb_ld(unsigned* p)              { return __hip_atomic_load(p, __ATOMIC_RELAXED, __HIP_MEMORY_SCOPE_AGENT); }
__device__ __forceinline__ unsigned xb_add(unsigned* p, unsigned v) { return __hip_atomic_fetch_add(p, v, __ATOMIC_RELAXED, __HIP_MEMORY_SCOPE_AGENT); }
__device__ __forceinline__ unsigned xb_xcc_id() { return (unsigned)__builtin_amdgcn_s_getreg((3 << 11) | 20) & 0xFu; }
#define XB_SPIN(cond, bar) do { unsigned _sp = 0; while (cond) { __builtin_amdgcn_s_sleep(1); \
    if ((++_sp & 255u) == 0u) { if (xb_ld(&(bar)[XB_TMO])) break; if (_sp > XB_SPIN_CAP) { atomicAdd(&(bar)[XB_TMO], 1u); break; } } } } while (0)
struct XcdBarrier { unsigned* bar; unsigned x; volatile LAS unsigned* st; };
__device__ __forceinline__ XcdBarrier xcd_barrier_post(unsigned* bar, volatile LAS unsigned* st) {
    XcdBarrier b; b.bar = bar; b.x = xb_xcc_id(); b.st = st;
    if (threadIdx.x == 0) (void)xb_add(&bar[XB_XCNT(b.x)], 1u);
    return b;
}
__device__ __forceinline__ void xcd_barrier_complete(unsigned* bar, unsigned x, unsigned& nloc, unsigned& nx) {
    const unsigned G = gridDim.x * gridDim.y * gridDim.z;
    unsigned sum, cnt, mine, sp = 0u;
    for (;;) {
        sum = 0u; cnt = 0u; mine = 0u;
#pragma unroll
        for (unsigned j = 0; j < 16; ++j) { const unsigned c = xb_ld(&bar[XB_XCNT(j)]); sum += c; cnt += (c > 0u) ? 1u : 0u; mine = (j == x) ? c : mine; }
        if (sum == G) break;
        __builtin_amdgcn_s_sleep(1);
        if ((++sp & 255u) == 0u) { if (xb_ld(&bar[XB_TMO])) break; if (sp > XB_SPIN_CAP) { atomicAdd(&bar[XB_TMO], 1u); break; } }
    }
    nloc = mine > 0u ? mine : 1u; nx = cnt > 0u ? cnt : 1u;
}
__device__ __forceinline__ void xcd_barrier(const XcdBarrier& b) {
    asm volatile("s_waitcnt vmcnt(0)" ::: "memory");
    __syncthreads();
    if (threadIdx.x == 0) {
        unsigned* bar = b.bar;
        __builtin_amdgcn_s_waitcnt(0);
        unsigned nloc = b.st[0], nx = b.st[1];
        if (nloc == 0u) { xcd_barrier_complete(bar, b.x, nloc, nx); b.st[0] = nloc; b.st[1] = nx; }
        const unsigned old = xb_add(&bar[XB_XSUB(b.x)], 1u);
        const unsigned gen = old / nloc;
        if (old + 1u == (gen + 1u) * nloc) {
            __builtin_amdgcn_fence(__ATOMIC_RELEASE, "agent");
            asm volatile("s_waitcnt vmcnt(0)" ::: "memory");
            const unsigned og = xb_add(&bar[XB_TOP], 1u);
            const unsigned tg = og / nx;
            if (og + 1u == (tg + 1u) * nx) xb_add(&bar[XB_TOPGEN], 1u);
            else XB_SPIN(xb_ld(&bar[XB_TOPGEN]) == tg, bar);
            __builtin_amdgcn_fence(__ATOMIC_ACQUIRE, "agent");
            xb_add(&bar[XB_XGEN(b.x)], 1u);
            asm volatile("s_waitcnt vmcnt(0)" ::: "memory");
        } else {
            XB_SPIN(xb_ld(&bar[XB_XGEN(b.x)]) == gen, bar);
            __builtin_amdgcn_fence(__ATOMIC_ACQUIRE, "agent");
            asm volatile("s_waitcnt vmcnt(0)" ::: "memory");
        }
    }
    __syncthreads();
}

namespace pg8 {
constexpr int BM = 256, BK = 64, HALF = 128, HTB = HALF * BK * 2, STAGE_BYTES = 8 * HTB, NXCD = 8, WGM = 8;
__host__ __device__ __forceinline__ int lds_byte(int r, int c) { const int st = (r >> 4) * 2 + (c >> 5), rr = r & 15, cc = c & 31, ob = rr * 64 + cc * 2; return st * 1024 + (ob ^ (((ob >> 9) & 1) << 5)); }
__host__ __device__ __forceinline__ void stage_rc(int b, int& R, int& C) { const int st = b / 1024, sb = b % 1024, swz = sb ^ (((sb >> 9) & 1) << 5); R = (st >> 1) * 16 + swz / 64; C = (st & 1) * 32 + (swz % 64) / 2; }
__host__ __device__ __forceinline__ int perm32(int rho) { const int n = rho >> 4, i = rho & 15; return 8 * (i >> 2) + 4 * n + (i & 3); }

struct Unit { int pm, pn, e; };
__device__ __forceinline__ void glds_sv(const char* base, unsigned voff, unsigned lds_dst) {
    unsigned keep;
    asm volatile("s_mov_b32 %0, m0\n\ts_mov_b32 m0, %3\n\ts_nop 0\n\tglobal_load_lds_dwordx4 %1, %2\n\ts_mov_b32 m0, %0" : "=&s"(keep) : "v"(voff), "s"(base), "s"(lds_dst) : "memory");
}
__device__ __forceinline__ const char* uni_ptr(const char* p) { const unsigned long long u = (unsigned long long)p; const unsigned lo = __builtin_amdgcn_readfirstlane((unsigned)u), hi = __builtin_amdgcn_readfirstlane((unsigned)(u >> 32)); return (const char*)(((unsigned long long)hi << 32) | lo); }
struct UD { const char* a; const char* b0; const char* b1; };

__device__ __forceinline__ bool order_next(int i, int G, int c, int nM, int nN, int& pm, int& pn) {
    const long L = (long)i * G + c; const int nwg = nM * nN; if (L >= nwg) return false;
    int wgid = (int)L; { const int q = nwg / NXCD, r = nwg % NXCD, xcd = wgid % NXCD, off = wgid / NXCD; wgid = (xcd < r ? xcd * (q + 1) : r * (q + 1) + (xcd - r) * q) + off; }
    const int nig = WGM * nN, gid = wgid / nig, fm = gid * WGM, gsz = (nM - fm) < WGM ? (nM - fm) : WGM;
    pm = fm + ((wgid % nig) % gsz); pn = (wgid % nig) / gsz; return true;
}

template <class Prob, class Epi, bool FP8 = false, int E8 = 127>
__device__ __forceinline__ void gemm_phase(LAS unsigned char* lds, const Prob& S, const Epi& E) {
    const int wid = S.wave, lane = lane_id(), tid = wid * 64 + lane, wr = wid >> 2, wc = wid & 3, fr = lane & 15, fq = lane >> 4;
    const int nt = S.Kb / 128;
    unsigned voffB[2];
#pragma unroll
    for (int i = 0; i < 2; ++i) { int R, C; stage_rc(tid * 16 + i * 8192, R, C); const int Rb = Epi::PERM ? ((R & ~31) + perm32(R & 31)) : R; voffB[i] = (unsigned)(Rb * S.ldb + C * 2); }
    const size_t kstep = (size_t)(BK * 2);
    const unsigned ldsb = (unsigned)__builtin_amdgcn_readfirstlane((int)(unsigned)(uintptr_t)lds + wid * 1024);
    const int aoff = lds_byte(wr * 64 + fr, fq * 8), boff = lds_byte(wc * 32 + fr, fq * 8);
#define PG8_SA(b, h) (((b) * 2 + (h)) * HTB)
#define PG8_SB(b, h) ((4 + (b) * 2 + (h)) * HTB)
#define PG8_STA(bufoff, gbase, va, h) do { _Pragma("unroll") for (int _i = 0; _i < 2; ++_i) glds_sv((const char*)(gbase), (va)[(h) * 2 + _i], ldsb + (unsigned)((bufoff) + _i * 8192)); } while (0)
#define PG8_STB(bufoff, gbase) do { _Pragma("unroll") for (int _i = 0; _i < 2; ++_i) glds_sv((const char*)(gbase), voffB[_i], ldsb + (unsigned)((bufoff) + _i * 8192)); } while (0)
#define PG8_LDA(dst, b, h) do { _Pragma("unroll") for (int m = 0; m < 4; ++m) _Pragma("unroll") for (int k = 0; k < 2; ++k) dst[m][k] = *(const LAS bf16x8*)(lds + PG8_SA(b, h) + aoff + m * 2048 + k * 1024); } while (0)
#define PG8_LDB(dst, b, h) do { _Pragma("unroll") for (int n = 0; n < 2; ++n) _Pragma("unroll") for (int k = 0; k < 2; ++k) dst[n][k] = *(const LAS bf16x8*)(lds + PG8_SB(b, h) + boff + n * 2048 + k * 1024); } while (0)
#define PG8_CAT(x) __builtin_bit_cast(i32x8, __builtin_shufflevector(x[0], x[1], 0, 1, 2, 3, 4, 5, 6, 7, 8, 9, 10, 11, 12, 13, 14, 15))
#define PG8_MMA(ai, bj, At, Bt) do { __builtin_amdgcn_s_setprio(1); _Pragma("unroll") for (int m = 0; m < 4; ++m) _Pragma("unroll") for (int n = 0; n < 2; ++n) { \
        if constexpr (FP8) acc[ai][bj][m][n] = __builtin_amdgcn_mfma_scale_f32_16x16x128_f8f6f4(PG8_CAT(Bt[n]), PG8_CAT(At[m]), acc[ai][bj][m][n], 0, 0, 0, E8, 0, 127); \
        else { _Pragma("unroll") for (int k = 0; k < 2; ++k) acc[ai][bj][m][n] = __builtin_amdgcn_mfma_f32_16x16x32_bf16(Bt[n][k], At[m][k], acc[ai][bj][m][n], 0, 0, 0); } } \
        __builtin_amdgcn_s_setprio(0); } while (0)
#define PG8_WAIT_V(n) asm volatile("s_waitcnt vmcnt(" #n ")" ::: "memory")
#define PG8_WAIT_L(n) asm volatile("s_waitcnt lgkmcnt(" #n ")" ::: "memory")
#define PG8_BAR __builtin_amdgcn_s_barrier()
#define PG8_SCHED __builtin_amdgcn_sched_barrier(0)
    Unit cur, nxt; UD cd, nd; unsigned cva[4]; int ui = 0;
    if (!S.next(0, cur)) return;
    S.desc(cur, cd); S.desc_va(0, cur, cva);
    f32x4 acc[2][2][4][2];
#pragma unroll
    for (int a = 0; a < 2; ++a)
#pragma unroll
        for (int b = 0; b < 2; ++b)
#pragma unroll
            for (int m = 0; m < 4; ++m)
#pragma unroll
                for (int n = 0; n < 2; ++n) acc[a][b][m][n] = (f32x4){0.f, 0.f, 0.f, 0.f};
    bf16x8 At[4][2], B0[2][2], B1[2][2];
    PG8_STB(PG8_SB(0, 0), cd.b0); PG8_STB(PG8_SB(0, 1), cd.b1); PG8_STA(PG8_SA(0, 0), cd.a, cva, 0); PG8_STA(PG8_SA(0, 1), cd.a, cva, 1);
    if (wr == 1) PG8_BAR;
    PG8_WAIT_V(2); PG8_BAR;
    PG8_STB(PG8_SB(1, 0), cd.b0 + kstep); PG8_STA(PG8_SA(1, 0), cd.a + kstep, cva, 0); PG8_STB(PG8_SB(1, 1), cd.b1 + kstep);
    PG8_WAIT_V(6); PG8_BAR;
    for (;;) {
        const bool has_next = S.next(ui + 1, nxt);
        if (has_next) S.desc(nxt, nd); else nd = cd;
        for (int t = 0; t < nt; t += 2) {
            const bool last = (t == nt - 2);
            const char* a1 = cd.a + (size_t)(t + 1) * kstep;
            const char* a2 = last ? nd.a : cd.a + (size_t)(t + 2) * kstep;
            const char* b20 = last ? nd.b0 : cd.b0 + (size_t)(t + 2) * kstep; const char* b21 = last ? nd.b1 : cd.b1 + (size_t)(t + 2) * kstep;
            const char* a3 = a2 + kstep; const char* b30 = b20 + kstep; const char* b31 = b21 + kstep;
            PG8_LDB(B0, 0, 0); PG8_LDB(B1, 0, 1); PG8_SCHED; PG8_LDA(At, 0, 0); PG8_STA(PG8_SA(1, 1), a1, cva, 1);
            PG8_WAIT_V(8); PG8_WAIT_L(0); PG8_BAR; PG8_MMA(0, 0, At, B0); PG8_MMA(0, 1, At, B1); PG8_BAR; PG8_SCHED;
            if (last && has_next) S.desc_va(ui + 1, nxt, cva);
            PG8_LDA(At, 0, 1); PG8_STB(PG8_SB(0, 0), b20); PG8_STB(PG8_SB(0, 1), b21); PG8_STA(PG8_SA(0, 0), a2, cva, 0);
            PG8_WAIT_V(8); PG8_WAIT_L(0); PG8_BAR; PG8_MMA(1, 0, At, B0); PG8_MMA(1, 1, At, B1); PG8_BAR; PG8_SCHED;
            PG8_LDB(B0, 1, 0); PG8_LDB(B1, 1, 1); PG8_SCHED; PG8_LDA(At, 1, 0); PG8_STA(PG8_SA(0, 1), a2, cva, 1);
            PG8_WAIT_V(8); PG8_WAIT_L(0); PG8_BAR; PG8_MMA(0, 0, At, B0); PG8_MMA(0, 1, At, B1); PG8_BAR; PG8_SCHED;
            PG8_LDA(At, 1, 1); PG8_STB(PG8_SB(1, 0), b30); PG8_STB(PG8_SB(1, 1), b31); PG8_STA(PG8_SA(1, 0), a3, cva, 0);
            PG8_WAIT_V(8); PG8_WAIT_L(0); PG8_BAR; PG8_MMA(1, 0, At, B0); PG8_MMA(1, 1, At, B1); PG8_BAR; PG8_SCHED;
        }
        if (wr == 0) PG8_BAR;
        E(acc, cur, wr, wc, fr, fq);
        if (!has_next) break;
#pragma unroll
        for (int a = 0; a < 2; ++a)
#pragma unroll
            for (int b = 0; b < 2; ++b)
#pragma unroll
                for (int m = 0; m < 4; ++m)
#pragma unroll
                    for (int n = 0; n < 2; ++n) acc[a][b][m][n] = (f32x4){0.f, 0.f, 0.f, 0.f};
        cur = nxt; cd = nd;
        ++ui;
        if (wr == 1) PG8_BAR;
    }
    PG8_WAIT_V(0);
    PG8_BAR;
#undef PG8_SA
#undef PG8_SB
#undef PG8_STA
#undef PG8_STB
#undef PG8_LDA
#undef PG8_LDB
#undef PG8_MMA
#undef PG8_CAT
#undef PG8_WAIT_V
#undef PG8_WAIT_L
#undef PG8_BAR
#undef PG8_SCHED
}
}

struct Frame {
    LAS unsigned char* lds;
    volatile LAS unsigned* MISC;
    gu32* ctl;
    int wave, G;
    unsigned char* ws;
    const float *x, *mix_norm, *pool_w, *pool_scale, *w_qkv, *q_norm, *k_norm, *w_o, *ffn_norm, *router_w, *router_b, *w_gu, *b_gu, *w_dn, *b_dn;
    float* out;
};

struct ProbDense {
    const char* A; const char* Bt; int lda, ldb, Kb, nM, nN, G, c, wave;
    __device__ __forceinline__ bool next(int i, pg8::Unit& u) const { u.e = 0; return pg8::order_next(i, G, c, nM, nN, u.pm, u.pn); }
    __device__ __forceinline__ void desc(const pg8::Unit& u, pg8::UD& d) const { d.a = pg8::uni_ptr(A + (size_t)u.pm * 256 * lda); d.b0 = pg8::uni_ptr(Bt + (size_t)u.pn * 256 * ldb); d.b1 = d.b0 + (size_t)128 * ldb; }
    __device__ __forceinline__ void desc_va(int, const pg8::Unit&, unsigned (&va)[4]) const {
#pragma unroll
        for (int i = 0; i < 2; ++i) { int R, C; pg8::stage_rc((wave * 64 + lane_id()) * 16 + i * 8192, R, C); va[i] = (unsigned)(R * lda + C * 2); va[2 + i] = va[i] + (unsigned)(128 * lda); }
    }
};
struct ProbPool {
    const char* A; const char* Bt; int ldb, Kb, G, c, wave;
    __device__ __forceinline__ bool next(int i, pg8::Unit& u) const { u.e = 0; return pg8::order_next(i, G, c, M / 256, 4, u.pm, u.pn); }
    __device__ __forceinline__ void desc(const pg8::Unit& u, pg8::UD& d) const { d.a = pg8::uni_ptr(A + (size_t)u.pm * 256 * D * 2 + (size_t)u.pn * 256 * 2); d.b0 = pg8::uni_ptr(Bt + (size_t)u.pn * 65536 * 2); d.b1 = d.b0 + (size_t)128 * 256 * 2; }
    __device__ __forceinline__ void desc_va(int, const pg8::Unit&, unsigned (&va)[4]) const {
#pragma unroll
        for (int i = 0; i < 2; ++i) { int R, C; pg8::stage_rc((wave * 64 + lane_id()) * 16 + i * 8192, R, C); va[i] = (unsigned)(R * D * 2 + C * 2); va[2 + i] = va[i] + (unsigned)(128 * D * 2); }
    }
};
struct ProbMoeUp {
    const char* A; const char* Bt; LAS unsigned char* lds; int ldb, Kb, nM, G, c, wave;
    __device__ __forceinline__ bool next(int i, pg8::Unit& u) const { if (!pg8::order_next(i, G, c, nM, 8, u.pm, u.pn)) return false; u.e = __builtin_amdgcn_readfirstlane((int)((const LAS unsigned char*)(lds + TAB_TEXP))[u.pm]); return true; }
    __device__ __forceinline__ void desc(const pg8::Unit& u, pg8::UD& d) const { d.a = pg8::uni_ptr(A); d.b0 = pg8::uni_ptr(Bt + ((size_t)u.e * 2048 + (size_t)u.pn * 128) * ldb); d.b1 = d.b0 + (size_t)1024 * ldb; }
    __device__ __forceinline__ void desc_va(int ord, const pg8::Unit&, unsigned (&va)[4]) const {
        const LAS unsigned* rt = (const LAS unsigned*)(lds + TAB_ROW) + ord * 256;
#pragma unroll
        for (int i = 0; i < 2; ++i) { int R, C; pg8::stage_rc((wave * 64 + lane_id()) * 16 + i * 8192, R, C); va[i] = rt[R] + (unsigned)(C * 2); va[2 + i] = rt[128 + R] + (unsigned)(C * 2); }
    }
};
struct ProbMoeDown {
    const char* A; const char* Bt; LAS unsigned char* lds; int ldb, Kb, nM, G, c, wave;
    __device__ __forceinline__ bool next(int i, pg8::Unit& u) const { if (!pg8::order_next(i, G, c, nM, 4, u.pm, u.pn)) return false; u.e = __builtin_amdgcn_readfirstlane((int)((const LAS unsigned char*)(lds + TAB_TEXP))[u.pm]); return true; }
    __device__ __forceinline__ void desc(const pg8::Unit& u, pg8::UD& d) const { d.a = pg8::uni_ptr(A + (size_t)u.pm * 256 * ldb); d.b0 = pg8::uni_ptr(Bt + ((size_t)u.e * 1024 + (size_t)u.pn * 256) * ldb); d.b1 = d.b0 + (size_t)128 * ldb; }
    __device__ __forceinline__ void desc_va(int, const pg8::Unit&, unsigned (&va)[4]) const {
#pragma unroll
        for (int i = 0; i < 2; ++i) { int R, C; pg8::stage_rc((wave * 64 + lane_id()) * 16 + i * 8192, R, C); va[i] = (unsigned)(R * ldb + C * 2); va[2 + i] = va[i] + (unsigned)(128 * ldb); }
    }
};

struct EpiPool {
    static constexpr bool PERM = false;
    const float* x; float* X1; const float* scale;
    __device__ __forceinline__ void operator()(const f32x4 (&acc)[2][2][4][2], const pg8::Unit& u, int wr, int wc, int fr, int fq) const {
        const int row0 = u.pm * 256 + wr * 64 + fr, col0 = u.pn * 256 + wc * 32 + 4 * fq;
        f32x4 sv[2][2];
#pragma unroll
        for (int bj = 0; bj < 2; ++bj)
#pragma unroll
            for (int n = 0; n < 2; ++n) sv[bj][n] = *(const f32x4*)(scale + col0 + bj * 128 + n * 16);
#pragma unroll
        for (int ai = 0; ai < 2; ++ai)
#pragma unroll
            for (int m = 0; m < 4; ++m) { const size_t off = (size_t)(row0 + ai * 128 + m * 16) * D + col0;
#pragma unroll
                for (int bj = 0; bj < 2; ++bj)
#pragma unroll
                    for (int n = 0; n < 2; ++n) { const f32x4 xv = *(const f32x4*)(x + off + bj * 128 + n * 16); *(f32x4*)(X1 + off + bj * 128 + n * 16) = xv + acc[ai][bj][m][n] * sv[bj][n]; }
                if (m & 1) asm volatile("" ::: "memory"); }
    }
};
struct EpiRes {
    static constexpr bool PERM = false;
    const float* Xi; float* Xo;
    __device__ __forceinline__ void operator()(const f32x4 (&acc)[2][2][4][2], const pg8::Unit& u, int wr, int wc, int fr, int fq) const {
        const int row0 = u.pm * 256 + wr * 64 + fr, col0 = u.pn * 256 + wc * 32 + 4 * fq;
#pragma unroll
        for (int ai = 0; ai < 2; ++ai)
#pragma unroll
            for (int m = 0; m < 4; ++m) { const size_t off = (size_t)(row0 + ai * 128 + m * 16) * D + col0;
#pragma unroll
                for (int bj = 0; bj < 2; ++bj)
#pragma unroll
                    for (int n = 0; n < 2; ++n) { const f32x4 xv = *(const f32x4*)(Xi + off + bj * 128 + n * 16); *(f32x4*)(Xo + off + bj * 128 + n * 16) = xv + acc[ai][bj][m][n]; }
                if (m & 1) asm volatile("" ::: "memory"); }
    }
};
struct EpiQKV {
    static constexpr bool PERM = true;
    bf16* QKV; const float* qg; const float* kg;
    __device__ __forceinline__ void operator()(const f32x4 (&acc)[2][2][4][2], const pg8::Unit& u, int wr, int wc, int fr, int fq) const {
        const int seg = u.pn >> 2, head = (u.pn & 3) * 4 + wc;
        f32x4 gv[2][2];
#pragma unroll
        for (int bj = 0; bj < 2; ++bj)
#pragma unroll
            for (int n = 0; n < 2; ++n) {
                if (seg == 2) gv[bj][n] = (f32x4){1.f, 1.f, 1.f, 1.f};
                else { const float* g = (seg == 0 ? qg : kg) + bj * 32 + 8 * fq + 4 * n; gv[bj][n] = *(const f32x4*)g; if (seg == 0) gv[bj][n] = gv[bj][n] * C2; } }
        bf16* base = QKV + (size_t)seg * M * D;
#pragma unroll
        for (int ai = 0; ai < 2; ++ai)
#pragma unroll
            for (int m = 0; m < 4; ++m) {
                const int t = u.pm * 256 + ai * 128 + wr * 64 + m * 16 + fr, b = t >> 11, s = t & (SEQ - 1);
                float rstd = 1.f;
                if (seg < 2) { float ss = 0.f;
#pragma unroll
                    for (int bj = 0; bj < 2; ++bj)
#pragma unroll
                        for (int n = 0; n < 2; ++n) { const f32x4 v = acc[ai][bj][m][n]; ss += (v[0] * v[0] + v[1] * v[1]) + (v[2] * v[2] + v[3] * v[3]); }
                    ss += __shfl_xor(ss, 16); ss += __shfl_xor(ss, 32);
                    rstd = 1.0f / sqrtf(ss * (1.0f / 64.0f) + RMS_EPS); }
                bf16* rowp = base + ((size_t)(b * NH + head) * SEQ + s) * HD + 8 * fq;
#pragma unroll
                for (int bj = 0; bj < 2; ++bj) { const f32x4 v0 = acc[ai][bj][m][0] * rstd * gv[bj][0], v1 = acc[ai][bj][m][1] * rstd * gv[bj][1];
                    u32x4 w; w.x = cvtpk(v0[0], v0[1]); w.y = cvtpk(v0[2], v0[3]); w.z = cvtpk(v1[0], v1[1]); w.w = cvtpk(v1[2], v1[3]);
                    *(u32x4*)(rowp + bj * 32) = w; }
            }
    }
};
template <bool OUT8> struct EpiGateUp {
    static constexpr bool PERM = true;
    bf16* ACT; const float* bias;
    __device__ __forceinline__ void operator()(const f32x4 (&acc)[2][2][4][2], const pg8::Unit& u, int wr, int wc, int fr, int fq) const {
        const int lc = u.pn * 128 + wc * 32 + 8 * fq;
        const float* bg = bias + (size_t)u.e * 2048 + lc;
        f32x4 bv[2][2];
#pragma unroll
        for (int bj = 0; bj < 2; ++bj)
#pragma unroll
            for (int n = 0; n < 2; ++n) bv[bj][n] = *(const f32x4*)(bg + bj * 1024 + 4 * n);
#pragma unroll
        for (int ai = 0; ai < 2; ++ai)
#pragma unroll
            for (int m = 0; m < 4; ++m) {
                const size_t eoff = (size_t)(u.pm * 256 + ai * 128 + wr * 64 + m * 16 + fr) * FF + lc;
                float o[8];
#pragma unroll
                for (int n = 0; n < 2; ++n) { const f32x4 g4 = acc[ai][0][m][n] + bv[0][n], u4 = acc[ai][1][m][n] + bv[1][n];
#pragma unroll
                    for (int i = 0; i < 4; ++i) { const float g = fminf(g4[i], SW_LIMIT), up = fminf(fmaxf(u4[i], -SW_LIMIT), SW_LIMIT);
                        const float sg = __builtin_amdgcn_rcpf(1.0f + __builtin_amdgcn_exp2f(g * (-SW_ALPHA * 1.4426950408889634f)));
                        o[n * 4 + i] = (up + 1.0f) * (g * sg); } }
                if constexpr (OUT8) { u32x2 w; w.x = cvtfp8x4(o[0] * S8_ACT, o[1] * S8_ACT, o[2] * S8_ACT, o[3] * S8_ACT); w.y = cvtfp8x4(o[4] * S8_ACT, o[5] * S8_ACT, o[6] * S8_ACT, o[7] * S8_ACT);
                    *(u32x2*)((unsigned char*)ACT + eoff) = w; }
                else { u32x4 w; w.x = cvtpk(o[0], o[1]); w.y = cvtpk(o[2], o[3]); w.z = cvtpk(o[4], o[5]); w.w = cvtpk(o[6], o[7]);
                    *(u32x4*)(ACT + eoff) = w; }
            }
    }
};
struct EpiDown {
    static constexpr bool PERM = true;
    bf16* OUTS; const float* bias;
    __device__ __forceinline__ void operator()(const f32x4 (&acc)[2][2][4][2], const pg8::Unit& u, int wr, int wc, int fr, int fq) const {
        const int col0 = u.pn * 256 + wc * 32 + 8 * fq;
        const float* bd = bias + (size_t)u.e * 1024 + col0;
        f32x4 bv[2][2];
#pragma unroll
        for (int bj = 0; bj < 2; ++bj)
#pragma unroll
            for (int n = 0; n < 2; ++n) bv[bj][n] = *(const f32x4*)(bd + bj * 128 + 4 * n);
#pragma unroll
        for (int ai = 0; ai < 2; ++ai)
#pragma unroll
            for (int m = 0; m < 4; ++m) { bf16* rowp = OUTS + (size_t)(u.pm * 256 + ai * 128 + wr * 64 + m * 16 + fr) * D + col0;
#pragma unroll
                for (int bj = 0; bj < 2; ++bj) { const f32x4 v0 = acc[ai][bj][m][0] + bv[bj][0], v1 = acc[ai][bj][m][1] + bv[bj][1];
                    u32x4 w; w.x = cvtpk(v0[0], v0[1]); w.y = cvtpk(v0[2], v0[3]); w.z = cvtpk(v1[0], v1[1]); w.w = cvtpk(v1[2], v1[3]);
                    *(u32x4*)(rowp + bj * 128) = w; } }
    }
};

struct CvtItem { const float* src; unsigned char* dst; int N, dpitch, fp8; };
__device__ __forceinline__ CvtItem cvt_decode(Frame& F, int it) {
    constexpr int I_POOL = 4 * 4 * 8, I_QKV = 16 * 96, I_WO = 16 * 32, I_GU = 64 * 16 * 64;
    CvtItem c; int r = it; c.fp8 = 0;
    if (r < I_POOL) { const int g = r >> 5, q = r & 31, kb = q >> 3, nb = q & 7; c.N = 256; c.dpitch = 512;
        c.src = F.pool_w + (size_t)g * 65536 + (size_t)(kb * 64) * 256 + nb * 32; c.dst = F.ws + WS_POOLW + ((size_t)g * 65536 + (size_t)(nb * 32) * 256 + kb * 64) * 2; return c; }
    r -= I_POOL;
    if (r < I_QKV) { const int kb = r / 96, nb = r % 96, n0 = nb * 32, pn = n0 >> 8, cc = n0 & 255, drow = 256 * pn + 128 * ((cc >> 5) & 1) + 32 * (cc >> 6); c.N = 3 * D; c.dpitch = 2 * D;
        c.src = F.w_qkv + (size_t)(kb * 64) * (3 * D) + n0; c.dst = F.ws + WS_WQKV + ((size_t)drow * D + kb * 64) * 2; return c; }
    r -= I_QKV;
    if (r < I_WO) { const int kb = r >> 5, nb = r & 31; c.N = D; c.dpitch = 2 * D;
        c.src = F.w_o + (size_t)(kb * 64) * D + nb * 32; c.dst = F.ws + WS_WO + ((size_t)(nb * 32) * D + kb * 64) * 2; return c; }
    r -= I_WO;
    if (r < I_GU) { const int mat = r >> 10, q = r & 1023, kb = q >> 6, nb = q & 63; c.N = 2 * FF; c.fp8 = (mat >= NE); c.dpitch = c.fp8 ? D : 2 * D;
        c.src = F.w_gu + (size_t)mat * D * 2 * FF + (size_t)(kb * 64) * (2 * FF) + nb * 32;
        c.dst = c.fp8 ? F.ws + WS_WGU8 + (size_t)(mat - NE) * 2 * FF * D + (size_t)(nb * 32) * D + kb * 64 : F.ws + WS_WGU + ((size_t)mat * 2 * FF * D + (size_t)(nb * 32) * D + kb * 64) * 2; return c; }
    r -= I_GU;
    { const int mat = r >> 9, q = r & 511, kb = q >> 5, nb = q & 31; c.N = D; c.fp8 = (mat >= NE); c.dpitch = c.fp8 ? FF : 2 * FF;
        c.src = F.w_dn + (size_t)mat * FF * D + (size_t)(kb * 64) * D + nb * 32;
        c.dst = c.fp8 ? F.ws + WS_WDN8 + (size_t)(mat - NE) * D * FF + (size_t)(nb * 32) * FF + kb * 64 : F.ws + WS_WDN + ((size_t)mat * D * FF + (size_t)(nb * 32) * FF + kb * 64) * 2; return c; }
}
__device__ __forceinline__ void cvt_load(const CvtItem& c, float (&v)[32], int lane) {
#pragma unroll
    for (int i = 0; i < 32; ++i) v[i] = c.src[(size_t)(2 * i + (lane >> 5)) * c.N + (lane & 31)];
}
__device__ __forceinline__ void cvt_store(const CvtItem& c, const float (&v)[32], LAS float* scr, int lane) {
#pragma unroll
    for (int i = 0; i < 32; ++i) scr[(2 * i + (lane >> 5)) * 33 + (lane & 31)] = v[i];
    LDS_WAIT(); asm volatile("" ::: "memory");
    if (c.fp8) {
        const int cq = lane & 3;
#pragma unroll
        for (int j = 0; j < 2; ++j) { const int n = (lane >> 2) + 16 * j; const LAS float* s = scr + (16 * cq) * 33 + n;
            u32x4 o;
            o.x = cvtfp8x4(s[0 * 33] * S8_W, s[1 * 33] * S8_W, s[2 * 33] * S8_W, s[3 * 33] * S8_W); o.y = cvtfp8x4(s[4 * 33] * S8_W, s[5 * 33] * S8_W, s[6 * 33] * S8_W, s[7 * 33] * S8_W);
            o.z = cvtfp8x4(s[8 * 33] * S8_W, s[9 * 33] * S8_W, s[10 * 33] * S8_W, s[11 * 33] * S8_W); o.w = cvtfp8x4(s[12 * 33] * S8_W, s[13 * 33] * S8_W, s[14 * 33] * S8_W, s[15 * 33] * S8_W);
            *(u32x4*)(c.dst + (size_t)n * c.dpitch + 16 * cq) = o; }
    } else {
        const int cc = lane & 7;
#pragma unroll
        for (int j = 0; j < 4; ++j) { const int n = (lane >> 3) + 8 * j; const LAS float* s = scr + (8 * cc) * 33 + n;
            u32x4 o; o.x = cvtpk(s[0 * 33], s[1 * 33]); o.y = cvtpk(s[2 * 33], s[3 * 33]); o.z = cvtpk(s[4 * 33], s[5 * 33]); o.w = cvtpk(s[6 * 33], s[7 * 33]);
            *(u32x4*)(c.dst + (size_t)n * c.dpitch + 16 * cc) = o; }
    }
    LDS_WAIT(); asm volatile("" ::: "memory");
}
__device__ __forceinline__ void phase_convert(Frame& F) {
    const int lane = lane_id(), tid = F.wave * 64 + lane; (void)tid;
    LAS float* scr = (LAS float*)(F.lds + F.wave * 8448);
    const int gw = blockIdx.x * NWAVES + F.wave, NGW = F.G * NWAVES;
    constexpr int NITEMS = 4 * 4 * 8 + 16 * 96 + 16 * 32 + 64 * 16 * 64 + 64 * 16 * 32;
    int it = gw; if (it >= NITEMS) return;
    CvtItem c = cvt_decode(F, it); float v[32]; cvt_load(c, v, lane);
    for (;;) {
        const int itn = it + NGW; const bool more = itn < NITEMS;
        CvtItem cn = c; float vn[32];
        if (more) { cn = cvt_decode(F, itn); cvt_load(cn, vn, lane); }
        cvt_store(c, v, scr, lane);
        if (!more) break;
        c = cn; it = itn;
#pragma unroll
        for (int i = 0; i < 32; ++i) v[i] = vn[i];
    }
}
__device__ __forceinline__ void phase_pooled(Frame& F) {
    const int lane = lane_id(), tid = F.wave * 64 + lane; (void)tid;
    LAS float* H = (LAS float*)F.lds;
    LAS float* RS = (LAS float*)(F.lds + 81920);
    bf16* P = (bf16*)(F.ws + WS_POOLED);
    for (int tile = blockIdx.x; tile < M / 64; tile += F.G) {
        const int t0 = tile * 64, s0 = t0 & (SEQ - 1);
        for (int i = F.wave; i < 79; i += NWAVES) {
            const int s = s0 - 15 + i; float r = 0.f;
            if (s >= 0) { const f32x4* xr = (const f32x4*)(F.x + (size_t)(t0 - 15 + i) * D) + lane; float ss = 0.f;
#pragma unroll
                for (int j = 0; j < 4; ++j) { const f32x4 v = xr[64 * j]; ss += (v[0] * v[0] + v[1] * v[1]) + (v[2] * v[2] + v[3] * v[3]); }
                ss = wave_sum(ss); r = 1.0f / sqrtf(ss * (1.0f / D) + RMS_EPS); }
            if (lane == 0) RS[i] = r;
        }
        __syncthreads();
        for (int g = 0; g < 4; ++g) {
            const f32x4 gn = *((const f32x4*)(F.mix_norm + g * 256) + lane);
            for (int i = F.wave; i < 79; i += NWAVES) {
                const int s = s0 - 15 + i; f32x4 v = (f32x4){0.f, 0.f, 0.f, 0.f};
                if (s >= 0) { v = *((const f32x4*)(F.x + (size_t)(t0 - 15 + i) * D + g * 256) + lane); v = v * RS[i] * gn; }
                *((LAS f32x4*)(H + i * 256) + lane) = v;
            }
            __syncthreads();
            const int w = 2 << g, cp = tid & 127, rq = tid >> 7, i0 = 15 + rq * 16;
            const LAS f32x2* H2p = (const LAS f32x2*)H + cp;
            f32x2 S = (f32x2){0.f, 0.f};
            for (int j = i0 - w + 1; j <= i0; ++j) S += H2p[j * 128];
            for (int r = 0; r < 16; ++r) {
                const int i = i0 + r;
                if (r > 0) S += H2p[i * 128] - H2p[(i - w) * 128];
                const int s = s0 + rq * 16 + r; const int cnt = (s + 1 < w) ? (s + 1) : w;
                const f32x2 h = H2p[i * 128]; const float inv = 1.0f / (float)cnt;
                const f32x2 pv = S * inv - h;
                *(unsigned*)(P + (size_t)(t0 + rq * 16 + r) * D + g * 256 + 2 * cp) = cvtpk(pv[0], pv[1]);
            }
            __syncthreads();
        }
    }
}

__device__ __forceinline__ void moe_tables(Frame& F, int layer) {
    const int lane = lane_id(), tid = F.wave * 64 + lane; (void)tid;
    LAS int* ecnt = (LAS int*)(F.lds + TAB_ECNT); LAS int* tbase = (LAS int*)(F.lds + TAB_TBASE); LAS unsigned char* texp = (LAS unsigned char*)(F.lds + TAB_TEXP);
    if (tid < NE) ecnt[tid] = (int)__hip_atomic_load(F.ctl + CW_ECNT + layer * 2048 + tid * 64, RLX_AGENT);
    __syncthreads();
    if (tid == 0) { int a = 0; for (int e = 0; e < NE; ++e) { tbase[e] = a; a += (ecnt[e] + 255) >> 8; } tbase[NE] = a; }
    __syncthreads();
    if (tid < MT_MAX) { int e = 0; for (int q = 1; q < NE; ++q) if (tid >= tbase[q]) e = q; texp[tid] = (unsigned char)e; }
    __syncthreads();
}
template <bool COMBINE, bool WRITE_X, bool NORM, bool ROUTER, bool H8 = false>
__device__ __forceinline__ void phase_rows(Frame& F, const float* src, float* dstX, const float* gain, bf16* dstH, int layer  ) {
    const int lane = lane_id(), tid = F.wave * 64 + lane; (void)tid;
    const int* tope = (const int*)(F.ws + WS_TOPE); const int* topp = (const int*)(F.ws + WS_TOPP); const float* topw = (const float*)(F.ws + WS_TOPW);
    const bf16* OUTS = (const bf16*)(F.ws + WS_OUTS);
    if (COMBINE) moe_tables(F, layer);
    const LAS int* tbase = (const LAS int*)(F.lds + TAB_TBASE);
    f32x4 gn[4];
    if (NORM) {
#pragma unroll
        for (int j = 0; j < 4; ++j) gn[j] = *((const f32x4*)gain + lane + 64 * j); }
    for (int tile = blockIdx.x; tile < M / 64; tile += F.G) {
        f32x4 v[8][4];
#pragma unroll
        for (int rr = 0; rr < 8; ++rr) {
            const int t = tile * 64 + F.wave * 8 + rr;
            const f32x4* xr = (const f32x4*)(src + (size_t)t * D) + lane;
#pragma unroll
            for (int j = 0; j < 4; ++j) v[rr][j] = xr[64 * j];
            if (COMBINE) {
#pragma unroll
                for (int k = 0; k < TOPK; ++k) {
                    const int e = tope[t * 4 + k], pos = topp[t * 4 + k]; const float wk = topw[t * 4 + k];
                    const u32x2* orow = (const u32x2*)(OUTS + (size_t)(tbase[e] * 256 + pos) * D) + lane;
#pragma unroll
                    for (int j = 0; j < 4; ++j) { const u32x2 o = orow[64 * j]; v[rr][j] += (f32x4){bf_lo(o.x), bf_hi(o.x), bf_lo(o.y), bf_hi(o.y)} * wk; }
                }
            }
            if (WRITE_X) { f32x4* xo = (f32x4*)(dstX + (size_t)t * D) + lane;
#pragma unroll
                for (int j = 0; j < 4; ++j) xo[64 * j] = v[rr][j]; }
            if (NORM) {
                float ss = 0.f;
#pragma unroll
                for (int j = 0; j < 4; ++j) ss += (v[rr][j][0] * v[rr][j][0] + v[rr][j][1] * v[rr][j][1]) + (v[rr][j][2] * v[rr][j][2] + v[rr][j][3] * v[rr][j][3]);
                ss = wave_sum(ss); const float rstd = 1.0f / sqrtf(ss * (1.0f / D) + RMS_EPS);
                if constexpr (H8) { unsigned* ho = (unsigned*)((unsigned char*)dstH + (size_t)t * D) + lane;
#pragma unroll
                    for (int j = 0; j < 4; ++j) { v[rr][j] = v[rr][j] * rstd * gn[j]; ho[64 * j] = cvtfp8x4(v[rr][j][0] * S8_H, v[rr][j][1] * S8_H, v[rr][j][2] * S8_H, v[rr][j][3] * S8_H); } }
                else { u32x2* ho = (u32x2*)(dstH + (size_t)t * D) + lane;
#pragma unroll
                    for (int j = 0; j < 4; ++j) { v[rr][j] = v[rr][j] * rstd * gn[j]; u32x2 o; o.x = cvtpk(v[rr][j][0], v[rr][j][1]); o.y = cvtpk(v[rr][j][2], v[rr][j][3]); ho[64 * j] = o; } }
            }
        }
        if (ROUTER) {
            LAS float* HT = (LAS float*)F.lds;
            LAS float* WC = (LAS float*)(F.lds + 66560);
            LAS float* PART = (LAS float*)F.lds;
            LAS float* LG = (LAS float*)(F.lds + 66560);
            LAS int* lcnt = (LAS int*)(F.lds + 99328);
            LAS int* gbase = (LAS int*)(F.lds + 99328 + 128);
            const float* RW = F.router_w + (size_t)layer * D * NE; const float* RB = F.router_b + layer * NE;
            const int th = F.wave & 1, kq = F.wave >> 1, r32 = lane & 31, hi = lane >> 5;
            f32x16 acc = {};
            for (int j = 0; j < 4; ++j) {
                __syncthreads();
#pragma unroll
                for (int rr = 0; rr < 8; ++rr)
#pragma unroll
                    for (int i = 0; i < 4; ++i) HT[(4 * lane + i) * 65 + F.wave * 8 + rr] = v[rr][j][i];
                { const f32x4* wsrc = (const f32x4*)(RW + (size_t)j * 256 * NE); LAS f32x4* wdst = (LAS f32x4*)WC;
#pragma unroll
                    for (int q = 0; q < 4; ++q) wdst[tid + 512 * q] = wsrc[tid + 512 * q]; }
                __syncthreads();
                const LAS float* ap = HT + (kq * 64 + hi) * 65 + th * 32 + r32; const LAS float* bp = WC + (kq * 64 + hi) * 32 + r32;
#pragma unroll 8
                for (int s = 0; s < 32; ++s) acc = __builtin_amdgcn_mfma_f32_32x32x2f32(ap[s * 2 * 65], bp[s * 2 * 32], acc, 0, 0, 0);
            }
            __syncthreads();
#pragma unroll
            for (int r = 0; r < 16; ++r) { const int tok = th * 32 + (r & 3) + 8 * (r >> 2) + 4 * hi; PART[(kq * 64 + tok) * 33 + r32] = acc[r]; }
            if (tid < NE) lcnt[tid] = 0;
            __syncthreads();
            for (int q = tid; q < 64 * NE; q += 512) { const int tok = q >> 5, e = q & 31;
                LG[tok * 33 + e] = ((PART[tok * 33 + e] + PART[(64 + tok) * 33 + e]) + (PART[(128 + tok) * 33 + e] + PART[(192 + tok) * 33 + e])) + RB[e]; }
            __syncthreads();
            int te[4], lp[4]; float tw[4];
            if (F.wave == 0) {
                const int tok = lane; unsigned used = 0u; float tv[4];
#pragma unroll
                for (int k = 0; k < 4; ++k) { float best = -INFINITY; int bi = 0;
                    for (int e = 0; e < NE; ++e) { const float xv = LG[tok * 33 + e]; if (!((used >> e) & 1u) && xv > best) { best = xv; bi = e; } }
                    used |= 1u << bi; tv[k] = best; te[k] = bi; }
                float sum = 0.f;
#pragma unroll
                for (int k = 0; k < 4; ++k) { tw[k] = __expf(tv[k] - tv[0]); sum += tw[k]; }
                const float inv = 1.0f / sum;
#pragma unroll
                for (int k = 0; k < 4; ++k) { tw[k] *= inv; lp[k] = atomicAdd((int*)(lcnt + te[k]), 1); }
            }
            __syncthreads();
            if (tid < NE) { const int c = lcnt[tid]; gbase[tid] = c > 0 ? (int)__hip_atomic_fetch_add(F.ctl + CW_ECNT + layer * 2048 + tid * 64, (unsigned)c, RLX_AGENT) : 0; }
            __syncthreads();
            if (F.wave == 0) {
                const int t = tile * 64 + lane;
                int* list = (int*)(F.ws + WS_LIST); int* tope_w = (int*)(F.ws + WS_TOPE); int* topp_w = (int*)(F.ws + WS_TOPP); float* topw_w = (float*)(F.ws + WS_TOPW);
#pragma unroll
                for (int k = 0; k < 4; ++k) { const int pos = gbase[te[k]] + lp[k]; list[te[k] * M + pos] = t; tope_w[t * 4 + k] = te[k]; topp_w[t * 4 + k] = pos; topw_w[t * 4 + k] = tw[k]; }
            }
            __syncthreads();
        }
    }
}

template <bool FP8>
__device__ __forceinline__ void phase_moe_up(Frame& F, int layer) {
    const int lane = lane_id(), tid = F.wave * 64 + lane; (void)tid;
    moe_tables(F, layer);
    const LAS int* ecnt = (const LAS int*)(F.lds + TAB_ECNT); const LAS int* tbase = (const LAS int*)(F.lds + TAB_TBASE);
    const int rowb = FP8 ? D : 2 * D;
    ProbMoeUp S{(const char*)(F.ws + WS_H2), FP8 ? (const char*)(F.ws + WS_WGU8) : (const char*)(F.ws + WS_WGU) + (size_t)layer * NE * 2048 * 1024 * 2, F.lds, rowb, rowb, __builtin_amdgcn_readfirstlane(tbase[NE]), F.G, (int)blockIdx.x, F.wave};
    {
        const int* list = (const int*)(F.ws + WS_LIST); LAS unsigned* rt = (LAS unsigned*)(F.lds + TAB_ROW);
        pg8::Unit u;
#pragma nounroll
        for (int ord = 0; ord < MAXU && S.next(ord, u); ++ord) {
            if (tid < 256) { const int p = (u.pm - tbase[u.e]) * 256 + tid; const int tok = (p < ecnt[u.e]) ? list[u.e * M + p] : 0; rt[ord * 256 + tid] = (unsigned)tok * (unsigned)rowb; }
        }
        __syncthreads();
    }
    EpiGateUp<FP8> E{(bf16*)(F.ws + WS_ACT), F.b_gu + (size_t)layer * NE * 2048};
    pg8::gemm_phase<ProbMoeUp, EpiGateUp<FP8>, FP8, E8_UP>(F.lds, S, E);
}
template <bool FP8>
__device__ __forceinline__ void phase_moe_down(Frame& F, int layer) {
    moe_tables(F, layer);
    const LAS int* tbase = (const LAS int*)(F.lds + TAB_TBASE);
    const int rowb = FP8 ? FF : 2 * FF;
    ProbMoeDown S{(const char*)(F.ws + WS_ACT), FP8 ? (const char*)(F.ws + WS_WDN8) : (const char*)(F.ws + WS_WDN) + (size_t)layer * NE * 1024 * 1024 * 2, F.lds, rowb, rowb, __builtin_amdgcn_readfirstlane(tbase[NE]), F.G, (int)blockIdx.x, F.wave};
    EpiDown E{(bf16*)(F.ws + WS_OUTS), F.b_dn + (size_t)layer * NE * 1024};
    pg8::gemm_phase<ProbMoeDown, EpiDown, FP8, E8_DOWN>(F.lds, S, E);
}

__device__ __forceinline__ int crow(int r, int hi) { return (r & 3) + 8 * (r >> 2) + 4 * hi; }
typedef LAS const char* lds_cptr;
__device__ __forceinline__ s16x4 vtr(lds_cptr p) { return __builtin_bit_cast(s16x4, __builtin_amdgcn_ds_read_tr16_b64_v4i16((LAS v4i16_t*)p)); }
__device__ __forceinline__ void attn_unit(Frame& F, int bh, int qb) {
    const int lane = lane_id(), r32 = lane & 31, hi = lane >> 5, wid = F.wave, tid = wid * 64 + lane;
    const bf16* Qh = (const bf16*)(F.ws + WS_Q) + (size_t)bh * SEQ * HD; const bf16* Kh = (const bf16*)(F.ws + WS_K) + (size_t)bh * SEQ * HD; const bf16* Vh = (const bf16*)(F.ws + WS_V) + (size_t)bh * SEQ * HD;
    const int q0 = qb * 256, qw = q0 + 32 * wid, qpos = qw + r32, jd = qw >> 6, jtop = (q0 >> 6) + 3;
    LAS unsigned char* KB = F.lds; LAS unsigned char* VB = F.lds + 16384; LAS unsigned char* OST = F.lds + 32768 + wid * 4096;
    const bf16* ksrc = Kh + (size_t)lane * HD + wid * 8;
    const bf16* vsrc = Vh + (size_t)(16 * (wid & 3) + (lane >> 2)) * HD + (wid >> 2) * 32 + (lane & 3) * 8;
    bf16x8 qr[4];
#pragma unroll
    for (int d0 = 0; d0 < 4; ++d0) qr[d0] = *(const bf16x8*)(Qh + (size_t)qpos * HD + d0 * 16 + hi * 8);
    f32x16 o0 = {}, o1 = {};
    float C = 0.f;
    int cur = 0;
    bool done = false;
    LAS int* flags = (LAS int*)(F.lds + 65536);
    { const u32x4 kk = *(const u32x4*)(ksrc + (size_t)jtop * 64 * HD), vv = *(const u32x4*)(vsrc + (size_t)jtop * 64 * HD);
      *(LAS u32x4*)(KB + tid * 16) = kk; *(LAS u32x4*)(VB + tid * 16) = vv; }
    __syncthreads();
    for (int j = jtop; j >= 0; --j) {
        u32x4 kn, vn;
        if (j > 0) { kn = *(const u32x4*)(ksrc + (size_t)(j - 1) * 64 * HD); vn = *(const u32x4*)(vsrc + (size_t)(j - 1) * 64 * HD); }
        if (j <= jd && !done) {
            const lds_cptr kb = (lds_cptr)(KB + cur * 8192) + hi * 1024 + r32 * 16;
            f32x16 p0 = {}, p1 = {};
#pragma unroll
            for (int d0 = 0; d0 < 4; ++d0) { const bf16x8 b0 = *(const LAS bf16x8*)(kb + d0 * 2048), b1 = *(const LAS bf16x8*)(kb + d0 * 2048 + 512);
                p0 = __builtin_amdgcn_mfma_f32_32x32x16_bf16(b0, qr[d0], p0, 0, 0, 0); p1 = __builtin_amdgcn_mfma_f32_32x32x16_bf16(b1, qr[d0], p1, 0, 0, 0); }
            float L0[16], L1[16];
#pragma unroll
            for (int r = 0; r < 16; ++r) { L0[r] = __builtin_amdgcn_logf(1.0f + __builtin_amdgcn_exp2f(p0[r])); L1[r] = __builtin_amdgcn_logf(1.0f + __builtin_amdgcn_exp2f(p1[r])); }
            if (j == jd) {
                const int kb0 = 64 * j + 4 * hi;
#pragma unroll
                for (int r = 0; r < 16; ++r) { const int kv = kb0 + (r & 3) + 8 * (r >> 2);
                    if (kv >= qpos) { L0[r] = 0.f; p0[r] = -INFINITY; } if (kv + 32 >= qpos) { L1[r] = 0.f; p1[r] = -INFINITY; } }
            }
            float tg[8];
#pragma unroll
            for (int g = 0; g < 4; ++g) {
                L0[4 * g + 2] += L0[4 * g + 3]; L0[4 * g + 1] += L0[4 * g + 2]; L0[4 * g] += L0[4 * g + 1]; tg[g] = L0[4 * g];
                L1[4 * g + 2] += L1[4 * g + 3]; L1[4 * g + 1] += L1[4 * g + 2]; L1[4 * g] += L1[4 * g + 1]; tg[4 + g] = L1[4 * g]; }
            float off[8]; float R = C;
#pragma unroll
            for (int g = 7; g >= 0; --g) {
                const auto rr = __builtin_amdgcn_permlane32_swap(__float_as_uint(tg[g]), __float_as_uint(tg[g]), false, false);
                const float tlo = __uint_as_float(rr[0]), thi = __uint_as_float(rr[1]);
                off[g] = R + (hi ? 0.f : thi);
                R += tlo + thi; }
            C = R;
#pragma unroll
            for (int g = 0; g < 4; ++g)
#pragma unroll
                for (int i = 0; i < 4; ++i) { p0[4 * g + i] = __builtin_amdgcn_exp2f(p0[4 * g + i] - (L0[4 * g + i] + off[g])); p1[4 * g + i] = __builtin_amdgcn_exp2f(p1[4 * g + i] - (L1[4 * g + i] + off[4 + g])); }
            u32x4 pw0, pw1, pw2, pw3;
            pw0 = (u32x4){cvtpk(p0[0], p0[1]), cvtpk(p0[2], p0[3]), cvtpk(p0[4], p0[5]), cvtpk(p0[6], p0[7])};
            pw1 = (u32x4){cvtpk(p0[8], p0[9]), cvtpk(p0[10], p0[11]), cvtpk(p0[12], p0[13]), cvtpk(p0[14], p0[15])};
            pw2 = (u32x4){cvtpk(p1[0], p1[1]), cvtpk(p1[2], p1[3]), cvtpk(p1[4], p1[5]), cvtpk(p1[6], p1[7])};
            pw3 = (u32x4){cvtpk(p1[8], p1[9]), cvtpk(p1[10], p1[11]), cvtpk(p1[12], p1[13]), cvtpk(p1[14], p1[15])};
            const lds_cptr vp = (lds_cptr)(VB + cur * 8192) + ((lane >> 4) & 1) * 32 + (lane & 3) * 8 + (4 * hi + ((lane & 15) >> 2)) * 64;
#define PVSTEP(OACC, D0, KS, PW) do { const s16x4 lo_ = vtr(vp + (D0) * 4096 + (KS) * 1024), hi_ = vtr(vp + (D0) * 4096 + (KS) * 1024 + 512); \
                const bf16x8 vf_ = (bf16x8){lo_[0], lo_[1], lo_[2], lo_[3], hi_[0], hi_[1], hi_[2], hi_[3]}; \
                OACC = __builtin_amdgcn_mfma_f32_32x32x16_bf16(__builtin_bit_cast(bf16x8, PW), vf_, OACC, 0, 0, 0); } while (0)
            PVSTEP(o0, 0, 0, pw0); PVSTEP(o1, 1, 0, pw0); PVSTEP(o0, 0, 1, pw1); PVSTEP(o1, 1, 1, pw1);
            PVSTEP(o0, 0, 2, pw2); PVSTEP(o1, 1, 2, pw2); PVSTEP(o0, 0, 3, pw3); PVSTEP(o1, 1, 3, pw3);
#undef PVSTEP
            done = __all(C > 150.0f);
        }
        if (j > 0) { *(LAS u32x4*)(KB + (cur ^ 1) * 8192 + tid * 16) = kn; *(LAS u32x4*)(VB + (cur ^ 1) * 8192 + tid * 16) = vn; }
        if (lane == 0) flags[(j & 1) * 8 + wid] = done ? 1 : 0;
        __syncthreads();
        if (__all(flags[(j & 1) * 8 + (lane & 7)] != 0)) break;
        cur ^= 1;
    }
    { LAS bf16* stg = (LAS bf16*)OST;
#pragma unroll
      for (int r = 0; r < 16; ++r) { const int orow = crow(r, hi); stg[orow * 64 + r32] = (bf16)(cvtpk(o0[r], 0.f) & 0xffffu); stg[orow * 64 + 32 + r32] = (bf16)(cvtpk(o1[r], 0.f) & 0xffffu); }
      LDS_WAIT(); asm volatile("" ::: "memory");
      const int b = bh >> 4, h = bh & 15;
      bf16* Ow = (bf16*)(F.ws + WS_O) + ((size_t)b * SEQ + qw) * D + h * HD;
#pragma unroll
      for (int i = 0; i < 4; ++i) { const int row = i * 8 + (lane >> 3), ch = lane & 7; const u32x4 vv = *(const LAS u32x4*)(stg + row * 64 + ch * 8); *(u32x4*)(Ow + (size_t)row * D + ch * 8) = vv; } }
    __syncthreads();
}
__device__ __forceinline__ void phase_attn(Frame& F) {
    for (int v = blockIdx.x; v < BATCH * NH * 2; v += F.G) {
        const int bh = v >> 1, odd = v & 1;
        for (int i = 0; i < 4; ++i) { const int qb = (i == 0) ? (odd ? 6 : 7) : (i == 1) ? (odd ? 5 : 4) : (i == 2) ? (odd ? 2 : 3) : (odd ? 1 : 0); attn_unit(F, bh, qb); }
    }
}

constexpr int NPHASE = 14;
struct Args { const float* in[15]; float* out; unsigned char* ws; int ph_lo, ph_hi; };
__global__ void __launch_bounds__(NWAVES * 64, 2) fwd_kernel(Args args) {
    extern __shared__ __attribute__((aligned(16))) unsigned char lds[];
    Frame F;
    F.lds = (LAS unsigned char*)lds; F.MISC = (volatile LAS unsigned*)(F.lds + MISC_OFF);
    F.wave = __builtin_amdgcn_readfirstlane((int)threadIdx.x >> 6); F.G = gridDim.x;
    F.ws = args.ws; F.ctl = (gu32*)(args.ws + WS_CTL);
    F.x = args.in[0]; F.mix_norm = args.in[1]; F.pool_w = args.in[2]; F.pool_scale = args.in[3]; F.w_qkv = args.in[4]; F.q_norm = args.in[5]; F.k_norm = args.in[6]; F.w_o = args.in[7];
    F.ffn_norm = args.in[8]; F.router_w = args.in[9]; F.router_b = args.in[10]; F.w_gu = args.in[11]; F.b_gu = args.in[12]; F.w_dn = args.in[13]; F.b_dn = args.in[14]; F.out = args.out;
    for (int u = (int)threadIdx.x; u < (LDS_BYTES - LDSCTL_OFF) / 4; u += NWAVES * 64) ((LAS unsigned*)(F.lds + LDSCTL_OFF))[u] = 0u;
    __syncthreads();
    XcdBarrier bar; bar.bar = (unsigned*)(F.ctl + CW_BAR); bar.x = 0; bar.st = nullptr;
    if (!MK_PER_PHASE) bar = xcd_barrier_post((unsigned*)(F.ctl + CW_BAR), F.MISC + 8);
    const int lo = args.ph_lo, hi = args.ph_hi;
#define IN(k) (lo <= (k) && (k) < hi)
#define SEAM(k) do { if (IN(k) && IN((k) + 1)) xcd_barrier(bar); } while (0)
    float* X1 = (float*)(F.ws + WS_X1); float* X2 = (float*)(F.ws + WS_X2); float* X3 = (float*)(F.ws + WS_X3);

    if (IN(0)) { for (int rep = 0; rep < REPS(0); ++rep) { phase_convert(F); __syncthreads(); } for (int rep = 0; rep < REPS(20); ++rep) phase_pooled(F); }
    SEAM(0);
    if (IN(1)) for (int rep = 0; rep < REPS(1); ++rep) { ProbPool S{(const char*)(F.ws + WS_POOLED), (const char*)(F.ws + WS_POOLW), 512, 512, F.G, (int)blockIdx.x, F.wave}; EpiPool E{F.x, X1, F.pool_scale};
        pg8::gemm_phase<ProbPool, EpiPool>(F.lds, S, E); }
    SEAM(1);
    if (IN(2)) phase_rows<false, false, true, true>(F, X1, nullptr, F.ffn_norm, (bf16*)(F.ws + WS_H2), 0);
    SEAM(2);
    if (IN(3)) for (int rep = 0; rep < REPS(3); ++rep) phase_moe_up<false>(F, 0);
    SEAM(3);
    if (IN(4)) for (int rep = 0; rep < REPS(4); ++rep) phase_moe_down<false>(F, 0);
    SEAM(4);
    if (IN(5)) for (int rep = 0; rep < REPS(5); ++rep) phase_rows<true, true, true, false>(F, X1, X2, F.mix_norm + D, (bf16*)(F.ws + WS_HQ), 0);
    SEAM(5);
    if (IN(6)) for (int rep = 0; rep < REPS(6); ++rep) { ProbDense S{(const char*)(F.ws + WS_HQ), (const char*)(F.ws + WS_WQKV), 2 * D, 2 * D, 2 * D, M / 256, 12, F.G, (int)blockIdx.x, F.wave}; EpiQKV E{(bf16*)(F.ws + WS_Q), F.q_norm, F.k_norm};
        pg8::gemm_phase<ProbDense, EpiQKV>(F.lds, S, E); }
    SEAM(6);
    if (IN(7)) for (int rep = 0; rep < REPS(7); ++rep) phase_attn(F);
    SEAM(7);
    if (IN(8)) for (int rep = 0; rep < REPS(8); ++rep) { ProbDense S{(const char*)(F.ws + WS_O), (const char*)(F.ws + WS_WO), 2 * D, 2 * D, 2 * D, M / 256, 4, F.G, (int)blockIdx.x, F.wave}; EpiRes E{X2, X3};
        pg8::gemm_phase<ProbDense, EpiRes>(F.lds, S, E); }
    SEAM(8);
    if (IN(9)) phase_rows<false, false, true, true, true>(F, X3, nullptr, F.ffn_norm + D, (bf16*)(F.ws + WS_H2), 1);
    SEAM(9);
    if (IN(10)) for (int rep = 0; rep < REPS(10); ++rep) phase_moe_up<true>(F, 1);
    SEAM(10);
    if (IN(11)) for (int rep = 0; rep < REPS(11); ++rep) phase_moe_down<true>(F, 1);
    SEAM(11);
    if (IN(12)) for (int rep = 0; rep < REPS(12); ++rep) phase_rows<true, true, false, false>(F, X3, F.out, nullptr, nullptr, 1);
    if (IN(13)) {
        const float* src = (MK_LAST_PHASE >= 8) ? X3 : (MK_LAST_PHASE >= 5) ? X2 : X1;
        for (size_t i = (size_t)blockIdx.x * 512 + F.wave * 64 + lane_id(); i < (size_t)M * D / 4; i += (size_t)F.G * 512) ((f32x4*)F.out)[i] = ((const f32x4*)src)[i];
    }
#undef IN
#undef SEAM
}

extern "C" void kernel_launch(void* const* d_in, const int* in_sizes, int n_in, void* d_out, int out_size, void* d_ws, size_t ws_size, hipStream_t stream) {
    static int grid = 0;
    if (grid == 0) {
        if (n_in != 15 || in_sizes[0] != M * D || out_size != M * D || ws_size < WS_END) { fprintf(stderr, "kernel_launch: unexpected shapes (n_in %d, in0 %d, out %d, ws %zu, need %zu)\n", n_in, n_in > 0 ? in_sizes[0] : -1, out_size, ws_size, (size_t)WS_END); grid = -1; return; }
        int dev = 0, cus = 0, per_cu = 0;
        if (hipGetDevice(&dev) != hipSuccess || hipDeviceGetAttribute(&cus, hipDeviceAttributeMultiprocessorCount, dev) != hipSuccess) { grid = -1; return; }
        if (hipFuncSetAttribute((const void*)fwd_kernel, hipFuncAttributeMaxDynamicSharedMemorySize, LDS_BYTES) != hipSuccess) { fprintf(stderr, "kernel_launch: hipFuncSetAttribute failed\n"); grid = -1; return; }
        if (hipOccupancyMaxActiveBlocksPerMultiprocessor(&per_cu, (const void*)fwd_kernel, NWAVES * 64, LDS_BYTES) != hipSuccess || per_cu < 1) fprintf(stderr, "kernel_launch: occupancy query says %d\n", per_cu);
        (void)hipGetLastError();
        grid = cus;
    }
    if (grid < 0) return;
    (void)hipMemsetAsync((char*)d_ws + WS_CTL, 0, CTL_ZERO_BYTES, stream);
    Args a{};
    for (int i = 0; i < 15; ++i) a.in[i] = (const float*)d_in[i];
    a.out = (float*)d_out; a.ws = (unsigned char*)d_ws;
    const int last = MK_LAST_PHASE;
    if (MK_PER_PHASE) {
        for (int p = 0; p <= last; ++p) { a.ph_lo = p; a.ph_hi = p + 1; hipLaunchKernelGGL(fwd_kernel, dim3(grid), dim3(NWAVES * 64), LDS_BYTES, stream, a); }
        if (last < 12) { a.ph_lo = 13; a.ph_hi = 14; hipLaunchKernelGGL(fwd_kernel, dim3(grid), dim3(NWAVES * 64), LDS_BYTES, stream, a); }
    } else {
        a.ph_lo = 0; a.ph_hi = 13; hipLaunchKernelGGL(fwd_kernel, dim3(grid), dim3(NWAVES * 64), LDS_BYTES, stream, a);
    }
    const hipError_t le = hipPeekAtLastError();
    if (le != hipSuccess) fprintf(stderr, "kernel_launch: launch failed: %s\n", hipGetErrorName(le));
}
```

```cpp
#include <hip/hip_runtime.h>
#include <cstdio>
#include <cstdint>

#define GAS __attribute__((address_space(1)))
#define LAS __attribute__((address_space(3)))
typedef unsigned short bf16;
typedef unsigned u32x4 __attribute__((ext_vector_type(4)));
typedef unsigned u32x2 __attribute__((ext_vector_type(2)));
typedef float f32x4 __attribute__((ext_vector_type(4)));
typedef float f32x2 __attribute__((ext_vector_type(2)));
typedef float f32x16 __attribute__((ext_vector_type(16)));
typedef short bf16x8 __attribute__((ext_vector_type(8)));
typedef short s16x4 __attribute__((ext_vector_type(4)));
typedef short v4i16_t __attribute__((ext_vector_type(4)));
typedef __bf16 bf16x2_t __attribute__((ext_vector_type(2)));
typedef int i32x8 __attribute__((ext_vector_type(8)));
typedef int i32x4 __attribute__((ext_vector_type(4)));
typedef GAS unsigned gu32;

constexpr int BATCH = 8, SEQ = 2048, D = 1024, M = BATCH * SEQ, NH = 16, HD = 64, NE = 32, TOPK = 4, FF = 1024;
constexpr float RMS_EPS = 1e-6f, SW_LIMIT = 7.0f, SW_ALPHA = 1.702f;
constexpr int MT_MAX = M * TOPK / 256 + NE;
constexpr int NSLOT = MT_MAX * 256;
constexpr float C2 = 0.125f * 1.4426950408889634f;
constexpr float S8_W = 64.0f, S8_H = 8.0f, S8_ACT = 4.0f, S8_OUT = 16.0f;
constexpr int E8_UP = 127 - 9, E8_DOWN = 127 - 8;

constexpr size_t MiB = 1u << 20;
constexpr size_t WS_CTL = 0, CTL_ZERO_BYTES = 1 * MiB;
constexpr size_t WS_POOLW = 1 * MiB;
constexpr size_t WS_WQKV = 2 * MiB;
constexpr size_t WS_WO = 8 * MiB;
constexpr size_t WS_TOPE = 10 * MiB, WS_TOPP = WS_TOPE + 256 * 1024, WS_TOPW = WS_TOPP + 256 * 1024;
constexpr size_t WS_LIST = 12 * MiB;
constexpr size_t WS_WGU = 16 * MiB;
constexpr size_t WS_WDN = 272 * MiB;
constexpr size_t WS_WGU8 = WS_WGU + 128 * MiB;
constexpr size_t WS_WDN8 = WS_WDN + 64 * MiB;
constexpr size_t WS_X1 = 400 * MiB, WS_X2 = 464 * MiB, WS_X3 = 528 * MiB;
constexpr size_t WS_POOLED = 592 * MiB, WS_H2 = 624 * MiB, WS_HQ = 656 * MiB, WS_Q = 688 * MiB, WS_K = 720 * MiB, WS_V = 752 * MiB, WS_O = 784 * MiB;
constexpr size_t WS_ACT = 816 * MiB, WS_OUTS = 960 * MiB;
constexpr size_t WS_END = 1104 * MiB;
static_assert(WS_ACT + (size_t)NSLOT * 1024 * 2 <= WS_OUTS && WS_OUTS + (size_t)NSLOT * 1024 * 2 <= WS_END, "ws map");
constexpr int CW_TMO = 0, CW_CODE = 1;
constexpr int CW_BAR = 4096;
constexpr int CW_BAR2 = 8192;
constexpr int CW_ECNT = 16384;

constexpr int RING_BYTES = 131072;
constexpr int LDSCTL_OFF = RING_BYTES, MISC_OFF = LDSCTL_OFF + 320;
constexpr int TAB_OFF = 131584;
constexpr int TAB_ECNT = TAB_OFF, TAB_TBASE = TAB_OFF + 128, TAB_TEXP = TAB_OFF + 384, TAB_ROW = TAB_OFF + 1024;
constexpr int MAXU = 12;
constexpr int BIAS_OFF = TAB_ROW + MAXU * 1024;
constexpr int LDS_BYTES = 163840;
static_assert(BIAS_OFF % 16 == 0 && BIAS_OFF + 2 * 8 * 1024 <= LDS_BYTES, "LDS map");

constexpr int NWAVES = 8;
#ifndef MK_NFRONT
#define MK_NFRONT 144
#endif
constexpr int NFRONT = MK_NFRONT;
#ifndef MK_CV9
#define MK_CV9 8000
#endif
#ifndef MK_NR9
#define MK_NR9 96
#endif
constexpr int CV9 = MK_CV9, NR9 = MK_NR9;
#ifndef MK_CV3
#define MK_CV3 600
#endif
constexpr int CV3 = MK_CV3, G3 = 248;

#ifndef MK_TPROBE
#define MK_TPROBE -1
#endif
#ifndef MK_FP8_L0
#define MK_FP8_L0 3
#endif
constexpr bool FP8_U0 = (MK_FP8_L0 & 1) != 0, FP8_D0 = (MK_FP8_L0 & 2) != 0;

#define RLX_AGENT __ATOMIC_RELAXED, __HIP_MEMORY_SCOPE_AGENT
#define LDS_WAIT() asm volatile("s_waitcnt lgkmcnt(0)" ::: "memory")
#define VM_WAIT() asm volatile("s_waitcnt vmcnt(0)" ::: "memory")
__device__ __forceinline__ unsigned cvtpk(float lo, float hi) { f32x2 v = {lo, hi}; bf16x2_t b = __builtin_convertvector(v, bf16x2_t); return __builtin_bit_cast(unsigned, b); }
__device__ __forceinline__ unsigned cvtfp8x4(float a, float b, float c, float d) { int w = __builtin_amdgcn_cvt_pk_fp8_f32(a, b, 0, false); w = __builtin_amdgcn_cvt_pk_fp8_f32(c, d, w, true); return (unsigned)w; }
__device__ __forceinline__ float bf_lo(unsigned u) { return __uint_as_float(u << 16); }
__device__ __forceinline__ float bf_hi(unsigned u) { return __uint_as_float(u & 0xffff0000u); }
__device__ __forceinline__ int lane_id() { int r; asm volatile("v_mbcnt_lo_u32_b32 %0, -1, 0\n\tv_mbcnt_hi_u32_b32 %0, -1, %0" : "=v"(r)); return r; }
__device__ __forceinline__ float wave_sum(float v) {
#pragma unroll
    for (int o = 1; o < 64; o <<= 1) v += __shfl_xor(v, o);
    return v;
}

#define XB_TMO      128
#define XB_XCNT(j)  (256  + 64 * (j))
#define XB_XSUB(j)  (1280 + 64 * (j))
#define XB_XGEN(j)  (2304 + 64 * (j))
#define XB_TOP      3328
#define XB_TOPGEN   3392
#define XCD_BAR_WORDS 3456
#define XB_SPIN_CAP (1u << 18)
__device__ __forceinline__ unsigned xb_ld(unsigned* p)              { return __hip_atomic_load(p, __ATOMIC_RELAXED, __HIP_MEMORY_SCOPE_AGENT); }
__device__ __forceinline__ unsigned xb_add(unsigned* p, unsigned v) { return __hip_atomic_fetch_add(p, v, __ATOMIC_RELAXED, __HIP_MEMORY_SCOPE_AGENT); }
__device__ __forceinline__ unsigned xb_xcc_id() { return (unsigned)__builtin_amdgcn_s_getreg((3 << 11) | 20) & 0xFu; }
#define XB_SPIN(cond, bar) do { unsigned _sp = 0; while (cond) { __builtin_amdgcn_s_sleep(1); \
    if ((++_sp & 255u) == 0u) { if (xb_ld(&(bar)[XB_TMO])) break; if (_sp > XB_SPIN_CAP) { atomicAdd(&(bar)[XB_TMO], 1u); break; } } } } while (0)
struct XcdBarrier { unsigned* bar; unsigned x; volatile LAS unsigned* st; unsigned G; };
__device__ __forceinline__ XcdBarrier xcd_barrier_post(unsigned* bar, volatile LAS unsigned* st, unsigned G) {
    XcdBarrier b; b.bar = bar; b.x = xb_xcc_id(); b.st = st; b.G = G;
    if (threadIdx.x == 0) (void)xb_add(&bar[XB_XCNT(b.x)], 1u);
    return b;
}
__device__ __forceinline__ void xcd_barrier_complete(unsigned* bar, unsigned x, unsigned& nloc, unsigned& nx, const unsigned G) {
    unsigned sum, cnt, mine, sp = 0u;
    for (;;) {
        sum = 0u; cnt = 0u; mine = 0u;
#pragma unroll
        for (unsigned j = 0; j < 16; ++j) { const unsigned c = xb_ld(&bar[XB_XCNT(j)]); sum += c; cnt += (c > 0u) ? 1u : 0u; mine = (j == x) ? c : mine; }
        if (sum == G) break;
        __builtin_amdgcn_s_sleep(1);
        if ((++sp & 255u) == 0u) { if (xb_ld(&bar[XB_TMO])) break; if (sp > XB_SPIN_CAP) { atomicAdd(&bar[XB_TMO], 1u); break; } }
    }
    nloc = mine > 0u ? mine : 1u; nx = cnt > 0u ? cnt : 1u;
}
__device__ __forceinline__ void xcd_barrier(const XcdBarrier& b) {
    asm volatile("s_waitcnt vmcnt(0)" ::: "memory");
    __syncthreads();
    if (threadIdx.x == 0) {
        unsigned* bar = b.bar;
        __builtin_amdgcn_s_waitcnt(0);
        unsigned nloc = b.st[0], nx = b.st[1];
        if (nloc == 0u) { xcd_barrier_complete(bar, b.x, nloc, nx, b.G); b.st[0] = nloc; b.st[1] = nx; }
        const unsigned old = xb_add(&bar[XB_XSUB(b.x)], 1u);
        const unsigned gen = old / nloc;
        if (old + 1u == (gen + 1u) * nloc) {
            __builtin_amdgcn_fence(__ATOMIC_RELEASE, "agent");
            asm volatile("s_waitcnt vmcnt(0)" ::: "memory");
            const unsigned og = xb_add(&bar[XB_TOP], 1u);
            const unsigned tg = og / nx;
            if (og + 1u == (tg + 1u) * nx) xb_add(&bar[XB_TOPGEN], 1u);
            else XB_SPIN(xb_ld(&bar[XB_TOPGEN]) == tg, bar);
            __builtin_amdgcn_fence(__ATOMIC_ACQUIRE, "agent");
            xb_add(&bar[XB_XGEN(b.x)], 1u);
            asm volatile("s_waitcnt vmcnt(0)" ::: "memory");
        } else {
            XB_SPIN(xb_ld(&bar[XB_XGEN(b.x)]) == gen, bar);
            __builtin_amdgcn_fence(__ATOMIC_ACQUIRE, "agent");
            asm volatile("s_waitcnt vmcnt(0)" ::: "memory");
        }
    }
    __syncthreads();
}

namespace pg8 {
constexpr int BM = 256, BK = 64, HALF = 128, HTB = HALF * BK * 2, STAGE_BYTES = 8 * HTB, NXCD = 8, WGM = 8;
__host__ __device__ __forceinline__ int lds_byte(int r, int c) { const int st = (r >> 4) * 2 + (c >> 5), rr = r & 15, cc = c & 31, ob = rr * 64 + cc * 2; return st * 1024 + (ob ^ (((ob >> 9) & 1) << 5)); }
__host__ __device__ __forceinline__ void stage_rc(int b, int& R, int& C) { const int st = b / 1024, sb = b % 1024, swz = sb ^ (((sb >> 9) & 1) << 5); R = (st >> 1) * 16 + swz / 64; C = (st & 1) * 32 + (swz % 64) / 2; }
__host__ __device__ __forceinline__ int perm32(int rho) { const int n = rho >> 4, i = rho & 15; return 8 * (i >> 2) + 4 * n + (i & 3); }

struct Unit { int pm, pn, e; };
__device__ __forceinline__ void glds_sv(const char* base, unsigned voff, unsigned lds_dst) {
    unsigned keep;
    asm volatile("s_mov_b32 %0, m0\n\ts_mov_b32 m0, %3\n\ts_nop 0\n\tglobal_load_lds_dwordx4 %1, %2\n\ts_mov_b32 m0, %0" : "=&s"(keep) : "v"(voff), "s"(base), "s"(lds_dst) : "memory");
}
__device__ __forceinline__ const char* uni_ptr(const char* p) { const unsigned long long u = (unsigned long long)p; const unsigned lo = __builtin_amdgcn_readfirstlane((unsigned)u), hi = __builtin_amdgcn_readfirstlane((unsigned)(u >> 32)); return (const char*)(((unsigned long long)hi << 32) | lo); }
struct UD { const char* a; const char* b0; const char* b1; };

__device__ __forceinline__ bool order_next(int i, int G, int c, int nM, int nN, int& pm, int& pn) {
    const int L = i * G + c; const int nwg = nM * nN; if (L >= nwg) return false;
    int wgid = L; { const int q = nwg / NXCD, r = nwg % NXCD, xcd = wgid % NXCD, off = wgid / NXCD; wgid = (xcd < r ? xcd * (q + 1) : r * (q + 1) + (xcd - r) * q) + off; }
    const int nig = WGM * nN, gid = wgid / nig, fm = gid * WGM, gsz = (nM - fm) < WGM ? (nM - fm) : WGM;
    pm = fm + ((wgid % nig) % gsz); pn = (wgid % nig) / gsz; return true;
}

template <class Prob, class Epi, bool FP8 = false, int E8 = 127>
__device__ __forceinline__ void gemm_phase(LAS unsigned char* lds, const Prob& S, const Epi& E) {
    const int wid = S.wave, lane = lane_id(), tid = wid * 64 + lane, wr = wid >> 2, wc = wid & 3, fr = lane & 15, fq = lane >> 4;
    const int nt = S.Kb / 128;
    unsigned voffB[2];
#pragma unroll
    for (int i = 0; i < 2; ++i) { int R, C; stage_rc(tid * 16 + i * 8192, R, C); const int Rb = Epi::PERM ? ((R & ~31) + perm32(R & 31)) : R; voffB[i] = (unsigned)(Rb * S.ldb + C * 2); }
    const size_t kstep = (size_t)(BK * 2);
    const unsigned ldsb = (unsigned)__builtin_amdgcn_readfirstlane((int)(unsigned)(uintptr_t)lds + wid * 1024);
    const int aoff = lds_byte(wr * 64 + fr, fq * 8), boff = lds_byte(wc * 32 + fr, fq * 8);
#define PG8_SA(b, h) (((b) * 2 + (h)) * HTB)
#define PG8_SB(b, h) ((4 + (b) * 2 + (h)) * HTB)
#define PG8_STA(bufoff, gbase, va, h) do { _Pragma("unroll") for (int _i = 0; _i < 2; ++_i) glds_sv((const char*)(gbase), (va)[(h) * 2 + _i], ldsb + (unsigned)((bufoff) + _i * 8192)); } while (0)
#define PG8_STB(bufoff, gbase) do { _Pragma("unroll") for (int _i = 0; _i < 2; ++_i) glds_sv((const char*)(gbase), voffB[_i], ldsb + (unsigned)((bufoff) + _i * 8192)); } while (0)
#define PG8_LD8(p) __builtin_shufflevector(*(const LAS i32x4*)(p), *(const LAS i32x4*)((p) + 1024), 0, 1, 2, 3, 4, 5, 6, 7)
#define PG8_LDA(dst, b, h) do { _Pragma("unroll") for (int m = 0; m < 4; ++m) dst[m] = PG8_LD8(lds + PG8_SA(b, h) + aoff + m * 2048); } while (0)
#define PG8_LDB(dst, b, h) do { _Pragma("unroll") for (int n = 0; n < 2; ++n) dst[n] = PG8_LD8(lds + PG8_SB(b, h) + boff + n * 2048); } while (0)
#define PG8_HALF(x, k) __builtin_bit_cast(bf16x8, __builtin_shufflevector(x, x, 4 * (k), 4 * (k) + 1, 4 * (k) + 2, 4 * (k) + 3))
#define PG8_MMA(ai, bj, At, Bt) do { __builtin_amdgcn_s_setprio(1); _Pragma("unroll") for (int m = 0; m < 4; ++m) _Pragma("unroll") for (int n = 0; n < 2; ++n) { \
        if constexpr (FP8) acc[ai][bj][m][n] = __builtin_amdgcn_mfma_scale_f32_16x16x128_f8f6f4(Bt[n], At[m], acc[ai][bj][m][n], 0, 0, 0, E8, 0, 127); \
        else { acc[ai][bj][m][n] = __builtin_amdgcn_mfma_f32_16x16x32_bf16(PG8_HALF(Bt[n], 0), PG8_HALF(At[m], 0), acc[ai][bj][m][n], 0, 0, 0); \
               acc[ai][bj][m][n] = __builtin_amdgcn_mfma_f32_16x16x32_bf16(PG8_HALF(Bt[n], 1), PG8_HALF(At[m], 1), acc[ai][bj][m][n], 0, 0, 0); } } \
        __builtin_amdgcn_s_setprio(0); \
        if constexpr (FP8) asm volatile("" : "+v"(acc[ai][bj][0][0]), "+v"(acc[ai][bj][0][1]), "+v"(acc[ai][bj][1][0]), "+v"(acc[ai][bj][1][1]), "+v"(acc[ai][bj][2][0]), "+v"(acc[ai][bj][2][1]), "+v"(acc[ai][bj][3][0]), "+v"(acc[ai][bj][3][1])); \
        } while (0)
#define PG8_WAIT_V(n) asm volatile("s_waitcnt vmcnt(" #n ")" ::: "memory")
#define PG8_WAIT_SEAM(flag) asm volatile("s_cmp_lg_u32 %0, 0\n\ts_cbranch_scc1 1f\n\ts_waitcnt vmcnt(8)\n\ts_branch 2f\n1:\n\ts_waitcnt vmcnt(%1)\n2:" :: "s"(flag), "n"(RELAX) : "memory", "scc")
#define PG8_WAIT_L(n) asm volatile("s_waitcnt lgkmcnt(" #n ")" ::: "memory")
#define PG8_BAR __builtin_amdgcn_s_barrier()
#define PG8_SCHED __builtin_amdgcn_sched_barrier(0)
    Unit cur, nxt; UD cd, nd; unsigned cva[4]; int ui = 0;
    if (!S.next(0, cur)) return;
    S.desc(cur, cd); S.desc_va(0, cur, cva);
    constexpr int RELAX = 8 + Epi::NPRE + Epi::NST; static_assert(RELAX <= 63, "vmcnt is 6 bits");
    E.prefetch(cur, lds + BIAS_OFF + wid * 1024, lane);
    f32x4 acc[2][2][4][2];
#pragma unroll
    for (int a = 0; a < 2; ++a)
#pragma unroll
        for (int b = 0; b < 2; ++b)
#pragma unroll
            for (int m = 0; m < 4; ++m)
#pragma unroll
                for (int n = 0; n < 2; ++n) acc[a][b][m][n] = (f32x4){0.f, 0.f, 0.f, 0.f};
    i32x8 At[4], B0[2], B1[2];
    PG8_STB(PG8_SB(0, 0), cd.b0); PG8_STB(PG8_SB(0, 1), cd.b1); PG8_STA(PG8_SA(0, 0), cd.a, cva, 0); PG8_STA(PG8_SA(0, 1), cd.a, cva, 1);
    if (wr == 1) PG8_BAR;
    PG8_WAIT_V(2); PG8_BAR;
    PG8_STB(PG8_SB(1, 0), cd.b0 + kstep); PG8_STA(PG8_SA(1, 0), cd.a + kstep, cva, 0); PG8_STB(PG8_SB(1, 1), cd.b1 + kstep); PG8_STA(PG8_SA(1, 1), cd.a + kstep, cva, 1);
    PG8_WAIT_V(8); PG8_BAR;
    for (;;) {
        const bool has_next = S.next(ui + 1, nxt);
        if (has_next) S.desc(nxt, nd); else nd = cd;
#pragma clang loop unroll(disable)
        for (int t = 0; t < nt; t += 2) {
            const bool last = (t == nt - 2); const int seam = __builtin_amdgcn_readfirstlane((t == 0 && ui > 0) ? 1 : 0);
            const char* a2 = last ? nd.a : cd.a + (size_t)(t + 2) * kstep;
            const char* b20 = last ? nd.b0 : cd.b0 + (size_t)(t + 2) * kstep; const char* b21 = last ? nd.b1 : cd.b1 + (size_t)(t + 2) * kstep;
            const char* a3 = a2 + kstep; const char* b30 = b20 + kstep; const char* b31 = b21 + kstep;
            PG8_LDB(B0, 0, 0); PG8_LDB(B1, 0, 1); PG8_SCHED; PG8_LDA(At, 0, 0);
            PG8_WAIT_SEAM(seam);
            PG8_WAIT_L(0); PG8_BAR; PG8_MMA(0, 0, At, B0); PG8_MMA(0, 1, At, B1); PG8_BAR; PG8_SCHED;
            if (last && has_next) S.desc_va(ui + 1, nxt, cva);
            PG8_LDA(At, 0, 1); PG8_STB(PG8_SB(0, 0), b20); PG8_STB(PG8_SB(0, 1), b21); PG8_STA(PG8_SA(0, 0), a2, cva, 0);
            PG8_WAIT_SEAM(seam);
            PG8_WAIT_L(0); PG8_BAR; PG8_MMA(1, 0, At, B0); PG8_MMA(1, 1, At, B1); PG8_BAR; PG8_SCHED;
            PG8_LDB(B0, 1, 0); PG8_LDB(B1, 1, 1); PG8_SCHED; PG8_LDA(At, 1, 0); PG8_STA(PG8_SA(0, 1), a2, cva, 1);
            PG8_WAIT_SEAM(seam);
            PG8_WAIT_L(0); PG8_BAR; PG8_MMA(0, 0, At, B0); PG8_MMA(0, 1, At, B1); PG8_BAR; PG8_SCHED;
            PG8_LDA(At, 1, 1); PG8_STB(PG8_SB(1, 0), b30); PG8_STB(PG8_SB(1, 1), b31); PG8_STA(PG8_SA(1, 0), a3, cva, 0);
            PG8_WAIT_V(8); PG8_WAIT_L(0); PG8_BAR; PG8_MMA(1, 0, At, B0); PG8_MMA(1, 1, At, B1); PG8_BAR; PG8_SCHED;
            PG8_STA(PG8_SA(1, 1), a3, cva, 1);
        }
        if (has_next) E.prefetch(nxt, lds + BIAS_OFF + (((ui + 1) & 1) * 8 + wid) * 1024, lane);
        if (wr == 0) PG8_BAR;
        E(acc, cur, wr, wc, fr, fq, lds + BIAS_OFF + ((ui & 1) * 8 + wid) * 1024);
        if (!has_next) break;
#pragma unroll
        for (int a = 0; a < 2; ++a)
#pragma unroll
            for (int b = 0; b < 2; ++b)
#pragma unroll
                for (int m = 0; m < 4; ++m)
#pragma unroll
                    for (int n = 0; n < 2; ++n) acc[a][b][m][n] = (f32x4){0.f, 0.f, 0.f, 0.f};
        cur = nxt; cd = nd;
        ++ui;
        if (wr == 1) PG8_BAR;
    }
    PG8_WAIT_V(0);
    PG8_BAR;
#undef PG8_SA
#undef PG8_SB
#undef PG8_STA
#undef PG8_STB
#undef PG8_LDA
#undef PG8_LDB
#undef PG8_MMA
#undef PG8_LD8
#undef PG8_HALF
#undef PG8_WAIT_V
#undef PG8_WAIT_SEAM
#undef PG8_WAIT_L
#undef PG8_BAR
#undef PG8_SCHED
}
}

struct Frame {
    LAS unsigned char* lds;
    volatile LAS unsigned* MISC;
    gu32* ctl;
    int wave, G;
    unsigned char* ws;
};
struct Args { const float* in[15]; float* out; unsigned char* ws; };
#define KARG ((const __attribute__((address_space(4))) Args*)__builtin_amdgcn_kernarg_segment_ptr())
#define FIN(i) (KARG->in[i])
#define FOUT (KARG->out)

struct ProbDense {
    const char* A; const char* Bt; int lda, ldb, Kb, nM, nN, G, c, wave;
    __device__ __forceinline__ bool next(int i, pg8::Unit& u) const { u.e = 0; return pg8::order_next(i, G, c, nM, nN, u.pm, u.pn); }
    __device__ __forceinline__ void desc(const pg8::Unit& u, pg8::UD& d) const { d.a = pg8::uni_ptr(A + (size_t)u.pm * 256 * lda); d.b0 = pg8::uni_ptr(Bt + (size_t)u.pn * 256 * ldb); d.b1 = d.b0 + (size_t)128 * ldb; }
    __device__ __forceinline__ void desc_va(int, const pg8::Unit&, unsigned (&va)[4]) const {
#pragma unroll
        for (int i = 0; i < 2; ++i) { int R, C; pg8::stage_rc((wave * 64 + lane_id()) * 16 + i * 8192, R, C); va[i] = (unsigned)(R * lda + C * 2); va[2 + i] = va[i] + (unsigned)(128 * lda); }
    }
};
struct ProbPool {
    const char* A; const char* Bt; int ldb, Kb, G, c, wave;
    __device__ __forceinline__ bool next(int i, pg8::Unit& u) const { u.e = 0; return pg8::order_next(i, G, c, M / 256, 4, u.pm, u.pn); }
    __device__ __forceinline__ void desc(const pg8::Unit& u, pg8::UD& d) const { d.a = pg8::uni_ptr(A + (size_t)u.pm * 256 * D * 2 + (size_t)u.pn * 256 * 2); d.b0 = pg8::uni_ptr(Bt + (size_t)u.pn * 65536 * 2); d.b1 = d.b0 + (size_t)128 * 256 * 2; }
    __device__ __forceinline__ void desc_va(int, const pg8::Unit&, unsigned (&va)[4]) const {
#pragma unroll
        for (int i = 0; i < 2; ++i) { int R, C; pg8::stage_rc((wave * 64 + lane_id()) * 16 + i * 8192, R, C); va[i] = (unsigned)(R * D * 2 + C * 2); va[2 + i] = va[i] + (unsigned)(128 * D * 2); }
    }
};
struct ProbMoeUp {
    const char* A; const char* Bt; LAS unsigned char* lds; int ldb, Kb, nM, G, c, wave;
    __device__ __forceinline__ bool next(int i, pg8::Unit& u) const { if (!pg8::order_next(i, G, c, nM, 8, u.pm, u.pn)) return false; u.e = __builtin_amdgcn_readfirstlane((int)((const LAS unsigned char*)(lds + TAB_TEXP))[u.pm]); return true; }
    __device__ __forceinline__ void desc(const pg8::Unit& u, pg8::UD& d) const { d.a = pg8::uni_ptr(A); d.b0 = pg8::uni_ptr(Bt + ((size_t)u.e * 2048 + (size_t)u.pn * 256) * ldb); d.b1 = d.b0 + (size_t)128 * ldb; }
    __device__ __forceinline__ void desc_va(int ord, const pg8::Unit&, unsigned (&va)[4]) const {
        const LAS unsigned* rt = (const LAS unsigned*)(lds + TAB_ROW) + ord * 256;
#pragma unroll
        for (int i = 0; i < 2; ++i) { int R, C; pg8::stage_rc((wave * 64 + lane_id()) * 16 + i * 8192, R, C); va[i] = rt[R] + (unsigned)(C * 2); va[2 + i] = rt[128 + R] + (unsigned)(C * 2); }
    }
};
struct ProbMoeDown {
    const char* A; const char* Bt; LAS unsigned char* lds; int ldb, Kb, nM, G, c, wave;
    __device__ __forceinline__ bool next(int i, pg8::Unit& u) const { if (!pg8::order_next(i, G, c, nM, 4, u.pm, u.pn)) return false; u.e = __builtin_amdgcn_readfirstlane((int)((const LAS unsigned char*)(lds + TAB_TEXP))[u.pm]); return true; }
    __device__ __forceinline__ void desc(const pg8::Unit& u, pg8::UD& d) const { d.a = pg8::uni_ptr(A + (size_t)u.pm * 256 * ldb); d.b0 = pg8::uni_ptr(Bt + ((size_t)u.e * 1024 + (size_t)u.pn * 256) * ldb); d.b1 = d.b0 + (size_t)128 * ldb; }
    __device__ __forceinline__ void desc_va(int, const pg8::Unit&, unsigned (&va)[4]) const {
#pragma unroll
        for (int i = 0; i < 2; ++i) { int R, C; pg8::stage_rc((wave * 64 + lane_id()) * 16 + i * 8192, R, C); va[i] = (unsigned)(R * ldb + C * 2); va[2 + i] = va[i] + (unsigned)(128 * ldb); }
    }
};

struct EpiPool {
    static constexpr bool PERM = false; static constexpr int NST = 32, NPRE = 0;
    const float* x; float* X1; const float* scale;
    __device__ __forceinline__ void prefetch(const pg8::Unit&, LAS unsigned char*, int) const {}

    __device__ __forceinline__ void operator()(const f32x4 (&acc)[2][2][4][2], const pg8::Unit& u, int wr, int wc, int fr, int fq, LAS unsigned char* bl) const {
        const int row0 = u.pm * 256 + wr * 64 + fr, col0 = u.pn * 256 + wc * 32 + 4 * fq;
        f32x4 sv[2][2];
#pragma unroll
        for (int bj = 0; bj < 2; ++bj)
#pragma unroll
            for (int n = 0; n < 2; ++n) sv[bj][n] = *(const f32x4*)(scale + col0 + bj * 128 + n * 16);
#pragma unroll
        for (int ai = 0; ai < 2; ++ai)
#pragma unroll
            for (int m = 0; m < 4; ++m) { const size_t off = (size_t)(row0 + ai * 128 + m * 16) * D + col0;
#pragma unroll
                for (int bj = 0; bj < 2; ++bj)
#pragma unroll
                    for (int n = 0; n < 2; ++n) { const f32x4 xv = *(const f32x4*)(x + off + bj * 128 + n * 16); *(f32x4*)(X1 + off + bj * 128 + n * 16) = xv + acc[ai][bj][m][n] * sv[bj][n]; }
                if (m & 1) asm volatile("" ::: "memory"); }
    }
};
struct EpiRes {
    static constexpr bool PERM = false; static constexpr int NST = 32, NPRE = 0;
    const float* Xi; float* Xo;
    __device__ __forceinline__ void prefetch(const pg8::Unit&, LAS unsigned char*, int) const {}

    __device__ __forceinline__ void operator()(const f32x4 (&acc)[2][2][4][2], const pg8::Unit& u, int wr, int wc, int fr, int fq, LAS unsigned char* bl) const {
        const int row0 = u.pm * 256 + wr * 64 + fr, col0 = u.pn * 256 + wc * 32 + 4 * fq;
#pragma unroll
        for (int ai = 0; ai < 2; ++ai)
#pragma unroll
            for (int m = 0; m < 4; ++m) { const size_t off = (size_t)(row0 + ai * 128 + m * 16) * D + col0;
#pragma unroll
                for (int bj = 0; bj < 2; ++bj)
#pragma unroll
                    for (int n = 0; n < 2; ++n) { const f32x4 xv = *(const f32x4*)(Xi + off + bj * 128 + n * 16); *(f32x4*)(Xo + off + bj * 128 + n * 16) = xv + acc[ai][bj][m][n]; }
                if (m & 1) asm volatile("" ::: "memory"); }
    }
};
struct EpiQKV {
    static constexpr bool PERM = true; static constexpr int NST = 16, NPRE = 0;
    bf16* QKV; const LAS float* gl;
    __device__ __forceinline__ void prefetch(const pg8::Unit&, LAS unsigned char*, int) const {}

    __device__ __forceinline__ void operator()(const f32x4 (&acc)[2][2][4][2], const pg8::Unit& u, int wr, int wc, int fr, int fq, LAS unsigned char* bl) const {
        const int seg = u.pn >> 2, head = (u.pn & 3) * 4 + wc;
        f32x4 gv[2][2];
#pragma unroll
        for (int bj = 0; bj < 2; ++bj)
#pragma unroll
            for (int n = 0; n < 2; ++n) {
                if (seg == 2) gv[bj][n] = (f32x4){1.f, 1.f, 1.f, 1.f};
                else { const LAS float* g = gl + seg * 64 + bj * 32 + 8 * fq + 4 * n; gv[bj][n] = *(const LAS f32x4*)g; if (seg == 0) gv[bj][n] = gv[bj][n] * C2; } }
        bf16* base = QKV + (size_t)seg * M * D;
#pragma unroll
        for (int ai = 0; ai < 2; ++ai)
#pragma unroll
            for (int m = 0; m < 4; ++m) {
                const int t = u.pm * 256 + ai * 128 + wr * 64 + m * 16 + fr, b = t >> 11, s = t & (SEQ - 1);
                float rstd = 1.f;
                if (seg < 2) { float ss = 0.f;
#pragma unroll
                    for (int bj = 0; bj < 2; ++bj)
#pragma unroll
                        for (int n = 0; n < 2; ++n) { const f32x4 v = acc[ai][bj][m][n]; ss += (v[0] * v[0] + v[1] * v[1]) + (v[2] * v[2] + v[3] * v[3]); }
                    ss += __shfl_xor(ss, 16); ss += __shfl_xor(ss, 32);
                    rstd = 1.0f / sqrtf(ss * (1.0f / 64.0f) + RMS_EPS); }
                bf16* rowp = base + ((size_t)(b * NH + head) * SEQ + s) * HD + 8 * fq;
#pragma unroll
                for (int bj = 0; bj < 2; ++bj) { const f32x4 v0 = acc[ai][bj][m][0] * rstd * gv[bj][0], v1 = acc[ai][bj][m][1] * rstd * gv[bj][1];
                    u32x4 w; w.x = cvtpk(v0[0], v0[1]); w.y = cvtpk(v0[2], v0[3]); w.z = cvtpk(v1[0], v1[1]); w.w = cvtpk(v1[2], v1[3]);
                    *(u32x4*)(rowp + bj * 32) = w; }
            }
    }
};
template <bool OUT8> struct EpiGateUp {
    static constexpr bool PERM = true; static constexpr int NST = 8, NPRE = 1;
    bf16* ACT; const float* bias;
    __device__ __forceinline__ void prefetch(const pg8::Unit& u, LAS unsigned char* bl, int lane) const {
        pg8::glds_sv(pg8::uni_ptr((const char*)(bias + (size_t)u.e * 2048 + u.pn * 128)), (unsigned)((lane & 31) * 16 + (lane >> 5) * 4096), (unsigned)__builtin_amdgcn_readfirstlane((int)(unsigned)(uintptr_t)bl)); }
    __device__ __forceinline__ void operator()(const f32x4 (&acc)[2][2][4][2], const pg8::Unit& u, int wr, int wc, int fr, int fq, LAS unsigned char* bl) const {
        { const int le = lane_id(); fr = le & 15; fq = le >> 4; }
        const int lc = u.pn * 128 + wc * 32 + 8 * fq;
        const LAS float* bg = (const LAS float*)bl + wc * 32 + 8 * fq;
        f32x4 bv[2][2];
#pragma unroll
        for (int bj = 0; bj < 2; ++bj)
#pragma unroll
            for (int n = 0; n < 2; ++n) bv[bj][n] = *(const LAS f32x4*)(bg + bj * 128 + 4 * n);
#pragma unroll
        for (int ai = 0; ai < 2; ++ai)
#pragma unroll
            for (int m = 0; m < 4; ++m) {
                const size_t eoff = (size_t)(u.pm * 256 + ai * 128 + wr * 64 + m * 16 + fr) * FF + lc;
                float o[8];
#pragma unroll
                for (int n = 0; n < 2; ++n) { const f32x4 g4 = acc[ai][0][m][n] + bv[0][n], u4 = acc[ai][1][m][n] + bv[1][n];
#pragma unroll
                    for (int i = 0; i < 4; ++i) { const float g = fminf(g4[i], SW_LIMIT), up = fminf(fmaxf(u4[i], -SW_LIMIT), SW_LIMIT);
                        const float sg = __builtin_amdgcn_rcpf(1.0f + __builtin_amdgcn_exp2f(g * (-SW_ALPHA * 1.4426950408889634f)));
                        o[n * 4 + i] = (up + 1.0f) * (g * sg); } }
                if constexpr (OUT8) { u32x2 w; w.x = cvtfp8x4(o[0] * S8_ACT, o[1] * S8_ACT, o[2] * S8_ACT, o[3] * S8_ACT); w.y = cvtfp8x4(o[4] * S8_ACT, o[5] * S8_ACT, o[6] * S8_ACT, o[7] * S8_ACT);
                    *(u32x2*)((unsigned char*)ACT + eoff) = w; }
                else { u32x4 w; w.x = cvtpk(o[0], o[1]); w.y = cvtpk(o[2], o[3]); w.z = cvtpk(o[4], o[5]); w.w = cvtpk(o[6], o[7]);
                    *(u32x4*)(ACT + eoff) = w; }
            }
    }
};
template <bool OUT8> struct EpiDown {
    static constexpr bool PERM = true; static constexpr int NST = 16, NPRE = 1;
    bf16* OUTS; const float* bias;
    __device__ __forceinline__ void prefetch(const pg8::Unit& u, LAS unsigned char* bl, int lane) const {
        pg8::glds_sv(pg8::uni_ptr((const char*)(bias + (size_t)u.e * 1024 + u.pn * 256)), (unsigned)(lane * 16), (unsigned)__builtin_amdgcn_readfirstlane((int)(unsigned)(uintptr_t)bl)); }
    __device__ __forceinline__ void operator()(const f32x4 (&acc)[2][2][4][2], const pg8::Unit& u, int wr, int wc, int fr, int fq, LAS unsigned char* bl) const {
        const int col0 = u.pn * 256 + wc * 32 + 8 * fq;
        const LAS float* bd = (const LAS float*)bl + wc * 32 + 8 * fq;
        f32x4 bv[2][2];
#pragma unroll
        for (int bj = 0; bj < 2; ++bj)
#pragma unroll
            for (int n = 0; n < 2; ++n) bv[bj][n] = *(const LAS f32x4*)(bd + bj * 128 + 4 * n);
#pragma unroll
        for (int ai = 0; ai < 2; ++ai)
#pragma unroll
            for (int m = 0; m < 4; ++m) { bf16* rowp = OUTS + (size_t)(u.pm * 256 + ai * 128 + wr * 64 + m * 16 + fr) * D + col0;
#pragma unroll
                for (int bj = 0; bj < 2; ++bj) { const f32x4 v0 = acc[ai][bj][m][0] + bv[bj][0], v1 = acc[ai][bj][m][1] + bv[bj][1];
                    if constexpr (OUT8) { u32x2 w; w.x = cvtfp8x4(v0[0] * S8_OUT, v0[1] * S8_OUT, v0[2] * S8_OUT, v0[3] * S8_OUT); w.y = cvtfp8x4(v1[0] * S8_OUT, v1[1] * S8_OUT, v1[2] * S8_OUT, v1[3] * S8_OUT);
                        *(u32x2*)((unsigned char*)OUTS + (size_t)(u.pm * 256 + ai * 128 + wr * 64 + m * 16 + fr) * D + col0 + bj * 128) = w; }
                    else { u32x4 w; w.x = cvtpk(v0[0], v0[1]); w.y = cvtpk(v0[2], v0[3]); w.z = cvtpk(v1[0], v1[1]); w.w = cvtpk(v1[2], v1[3]);
                        *(u32x4*)(rowp + bj * 128) = w; } } }
    }
};

constexpr int CV_POOL = 4 * 2 * 4, CV_QKV = 8 * 48, CV_WO = 8 * 16, CV_GU1 = 32 * 8 * 32  , CV_DN1 = 32 * 8 * 16  ;
constexpr int CV_SMALL = CV_POOL + CV_QKV + CV_WO, CV_END = CV_SMALL + 2 * (CV_GU1 + CV_DN1);
struct CvtItem { const float* src; unsigned char* dst; int N, dpitch, fp8, hs; };
__device__ __forceinline__ CvtItem cvt_decode(Frame& F, int it) {
    CvtItem c; int r = it; c.fp8 = 0; c.hs = 32;
    if (r < CV_POOL) { const int g = r >> 3, q = r & 7, kb = q >> 2, nb = q & 3; c.N = 256; c.dpitch = 512;
        c.src = FIN(2) + (size_t)g * 65536 + (size_t)(kb * 128) * 256 + nb * 64; c.dst = F.ws + WS_POOLW + ((size_t)g * 65536 + (size_t)(nb * 64) * 256 + kb * 128) * 2; return c; }
    r -= CV_POOL;
    if (r < CV_QKV) { const int kb = r / 48, nb = r % 48, n0 = nb * 64, pn = n0 >> 8, w = (n0 & 255) >> 6; c.N = 3 * D; c.dpitch = 2 * D; c.hs = 128;
        c.src = FIN(4) + (size_t)(kb * 128) * (3 * D) + n0; c.dst = F.ws + WS_WQKV + ((size_t)(256 * pn + 32 * w) * D + kb * 128) * 2; return c; }
    r -= CV_QKV;
    if (r < CV_WO) { const int kb = r >> 4, nb = r & 15; c.N = D; c.dpitch = 2 * D;
        c.src = FIN(7) + (size_t)(kb * 128) * D + nb * 64; c.dst = F.ws + WS_WO + ((size_t)(nb * 64) * D + kb * 128) * 2; return c; }
    r -= CV_WO;
    int layer = 0;
    if (r >= CV_GU1 + CV_DN1) { r -= CV_GU1 + CV_DN1; layer = 1; }
    if (r < CV_GU1) { const int mat = layer * NE + (r >> 8), q = r & 255, kb = q >> 5, nb = q & 31; c.N = 2 * FF; c.fp8 = (layer == 1 || FP8_U0); c.dpitch = c.fp8 ? D : 2 * D;
        c.src = FIN(11) + (size_t)mat * D * 2 * FF + (size_t)(kb * 128) * (2 * FF) + nb * 64;
        const int n0 = nb * 64, cg = n0 & (FF - 1), drow = (cg >> 7) * 256 + (n0 >= FF ? 128 : 0) + (cg & 127);
        c.dst = c.fp8 ? F.ws + WS_WGU8 + (size_t)(1 - layer) * 64 * MiB + (size_t)(mat - layer * NE) * 2 * FF * D + (size_t)drow * D + kb * 128 : F.ws + WS_WGU + ((size_t)mat * 2 * FF * D + (size_t)drow * D + kb * 128) * 2; return c; }
    r -= CV_GU1;
    { const int mat = layer * NE + (r >> 7), q = r & 127, kb = q >> 4, nb = q & 15; c.N = D; c.fp8 = (layer == 1 || FP8_D0); c.dpitch = c.fp8 ? FF : 2 * FF;
        c.src = FIN(13) + (size_t)mat * FF * D + (size_t)(kb * 128) * D + nb * 64;
        c.dst = c.fp8 ? F.ws + WS_WDN8 + (size_t)(1 - layer) * 32 * MiB + (size_t)(mat - layer * NE) * D * FF + (size_t)(nb * 64) * FF + kb * 128 : F.ws + WS_WDN + ((size_t)mat * D * FF + (size_t)(nb * 64) * FF + kb * 128) * 2; return c; }
}
__device__ __forceinline__ void cvt_load(const CvtItem& c, int half, f32x4 (&v)[16], int lane) {
    const float* p = c.src + (size_t)(64 * half + (lane >> 4)) * c.N + 4 * (lane & 15);
#pragma unroll
    for (int i = 0; i < 16; ++i) v[i] = __builtin_nontemporal_load((const f32x4*)(p + (size_t)(4 * i) * c.N));
}
__device__ __forceinline__ s16x4 cvt_tr(LAS const unsigned char* p) { return __builtin_bit_cast(s16x4, __builtin_amdgcn_ds_read_tr16_b64_v4i16((LAS v4i16_t*)p)); }
constexpr int CVP = 136;
__device__ __forceinline__ void cvt_to_lds(const f32x4 (&v)[16], int half, LAS unsigned char* scr, int lane) {
    LAS unsigned char* wp = scr + (64 * half + (lane >> 4)) * CVP + (lane & 15) * 8;
#pragma unroll
    for (int i = 0; i < 16; ++i) { u32x2 w; w.x = cvtpk(v[i][0], v[i][1]); w.y = cvtpk(v[i][2], v[i][3]); *(LAS u32x2*)(wp + 4 * i * CVP) = w; }
}
__device__ __forceinline__ void cvt_emit(const CvtItem& c, LAS unsigned char* scr, int lane) {
    LDS_WAIT(); asm volatile("" ::: "memory");
    const int g = lane >> 4, i16 = lane & 15, r = i16 >> 2, cc = i16 & 3;
    if (c.fp8) {
#pragma unroll
        for (int nb = 0; nb < 4; ++nb)
#pragma unroll
            for (int ps = 0; ps < 2; ++ps) { const int kc = 4 * ps + g; LAS const unsigned char* rp = scr + (16 * kc + r) * CVP + cc * 8 + nb * 32;
                u32x4 o;
#pragma unroll
                for (int h = 0; h < 4; ++h) { const u32x2 t = __builtin_bit_cast(u32x2, cvt_tr(rp + (4 * h) * CVP));
                    const unsigned a = t.x + 0x03000300u, b = t.y + 0x03000300u;
                    o[h] = cvtfp8x4(__uint_as_float(a << 16), __uint_as_float(a & 0xffff0000u), __uint_as_float(b << 16), __uint_as_float(b & 0xffff0000u)); }
                const int n = 16 * nb + i16;
                *(u32x4*)(c.dst + (size_t)((n >> 5) * c.hs + (n & 31)) * c.dpitch + 16 * kc) = o; }
    } else {
#pragma unroll
        for (int nb = 0; nb < 4; ++nb)
#pragma unroll
            for (int ps = 0; ps < 4; ++ps) { const int kc = 4 * ps + g; LAS const unsigned char* rp = scr + (8 * kc + r) * CVP + cc * 8 + nb * 32;
                const u32x2 t0 = __builtin_bit_cast(u32x2, cvt_tr(rp)), t1 = __builtin_bit_cast(u32x2, cvt_tr(rp + 4 * CVP));
                const int n = 16 * nb + i16;
                *(u32x4*)(c.dst + (size_t)((n >> 5) * c.hs + (n & 31)) * c.dpitch + 16 * kc) = (u32x4){t0.x, t0.y, t1.x, t1.y}; }
    }
    LDS_WAIT(); asm volatile("" ::: "memory");
}
__device__ __forceinline__ void phase_convert(Frame& F, int item_lo, int item_hi, int bidx, int nblk) {
    const int lane = lane_id();
    LAS unsigned char* scr = F.lds + (F.wave < 7 ? F.wave * 17408 : 133120);
    const int gw = bidx * NWAVES + F.wave, NGW = nblk * NWAVES;
    int it = item_lo + gw; if (it >= item_hi) return;
    CvtItem c = cvt_decode(F, it); f32x4 va[16], vb[16]; cvt_load(c, 0, va, lane); cvt_load(c, 1, vb, lane);
    for (;;) {
        cvt_to_lds(va, 0, scr, lane); cvt_to_lds(vb, 1, scr, lane);
        const int itn = it + NGW; const bool more = itn < item_hi;
        CvtItem cn = c;
        if (more) { cn = cvt_decode(F, itn); cvt_load(cn, 0, va, lane); cvt_load(cn, 1, vb, lane); }
        cvt_emit(c, scr, lane);
        if (!more) break;
        c = cn; it = itn;
    }
}
__device__ __forceinline__ void phase_pooled(Frame& F, int bidx, int nblk) {
    const int lane = lane_id(), tid = F.wave * 64 + lane; (void)tid;
    LAS float* H = (LAS float*)F.lds;
    LAS float* RS = (LAS float*)(F.lds + 81920);
    bf16* P = (bf16*)(F.ws + WS_POOLED);
    for (int tile = bidx; tile < M / 64; tile += nblk) {
        const int t0 = tile * 64, s0 = t0 & (SEQ - 1);
        for (int i = F.wave; i < 79; i += NWAVES) {
            const int s = s0 - 15 + i; float r = 0.f;
            if (s >= 0) { const f32x4* xr = (const f32x4*)(FIN(0) + (size_t)(t0 - 15 + i) * D) + lane; float ss = 0.f;
#pragma unroll
                for (int j = 0; j < 4; ++j) { const f32x4 v = xr[64 * j]; ss += (v[0] * v[0] + v[1] * v[1]) + (v[2] * v[2] + v[3] * v[3]); }
                ss = wave_sum(ss); r = 1.0f / sqrtf(ss * (1.0f / D) + RMS_EPS); }
            if (lane == 0) RS[i] = r;
        }
        __syncthreads();
        for (int g = 0; g < 4; ++g) {
            const f32x4 gn = *((const f32x4*)(FIN(1) + g * 256) + lane);
            for (int i = F.wave; i < 79; i += NWAVES) {
                const int s = s0 - 15 + i; f32x4 v = (f32x4){0.f, 0.f, 0.f, 0.f};
                if (s >= 0) { v = *((const f32x4*)(FIN(0) + (size_t)(t0 - 15 + i) * D + g * 256) + lane); v = v * RS[i] * gn; }
                *((LAS f32x4*)(H + i * 256) + lane) = v;
            }
            __syncthreads();
            const int w = 2 << g, cp = tid & 127, rq = tid >> 7, i0 = 15 + rq * 16;
            const LAS f32x2* H2p = (const LAS f32x2*)H + cp;
            f32x2 S = (f32x2){0.f, 0.f};
            for (int j = i0 - w + 1; j <= i0; ++j) S += H2p[j * 128];
            for (int r = 0; r < 16; ++r) {
                const int i = i0 + r;
                if (r > 0) S += H2p[i * 128] - H2p[(i - w) * 128];
                const int s = s0 + rq * 16 + r; const int cnt = (s + 1 < w) ? (s + 1) : w;
                const f32x2 h = H2p[i * 128]; const float inv = 1.0f / (float)cnt;
                const f32x2 pv = S * inv - h;
                *(unsigned*)(P + (size_t)(t0 + rq * 16 + r) * D + g * 256 + 2 * cp) = cvtpk(pv[0], pv[1]);
            }
            __syncthreads();
        }
    }
}

__device__ __forceinline__ void moe_tables(Frame& F, int layer) {
    const int lane = lane_id(), tid = F.wave * 64 + lane; (void)tid;
    LAS int* ecnt = (LAS int*)(F.lds + TAB_ECNT); LAS int* tbase = (LAS int*)(F.lds + TAB_TBASE); LAS unsigned char* texp = (LAS unsigned char*)(F.lds + TAB_TEXP);
    if (tid < NE) ecnt[tid] = (int)__hip_atomic_load(F.ctl + CW_ECNT + layer * 2048 + tid * 64, RLX_AGENT);
    __syncthreads();
    if (tid == 0) { int a = 0; for (int e = 0; e < NE; ++e) { tbase[e] = a; a += (ecnt[e] + 255) >> 8; } tbase[NE] = a; }
    __syncthreads();
    if (tid < MT_MAX) { int e = 0; for (int q = 1; q < NE; ++q) if (tid >= tbase[q]) e = q; texp[tid] = (unsigned char)e; }
    __syncthreads();
}
template <bool H8>
__device__ __forceinline__ void phase_router(Frame& F, const float* src, const float* gain, bf16* dstH, int layer, int bidx, int nblk) {
    const int cl = layer;
    const int lane = lane_id(), tid = F.wave * 64 + lane;
    f32x4 gn[4];
#pragma unroll
    for (int j = 0; j < 4; ++j) gn[j] = *((const f32x4*)gain + lane + 64 * j);
    for (int tile = bidx; tile < M / 64; tile += nblk) {
        f32x4 v[8][4];
#pragma unroll
        for (int rr = 0; rr < 8; ++rr) {
            const int t = tile * 64 + F.wave * 8 + rr;
            const f32x4* xr = (const f32x4*)(src + (size_t)t * D) + lane;
#pragma unroll
            for (int j = 0; j < 4; ++j) v[rr][j] = xr[64 * j];
            {
                float ss = 0.f;
#pragma unroll
                for (int j = 0; j < 4; ++j) ss += (v[rr][j][0] * v[rr][j][0] + v[rr][j][1] * v[rr][j][1]) + (v[rr][j][2] * v[rr][j][2] + v[rr][j][3] * v[rr][j][3]);
                ss = wave_sum(ss); const float rstd = 1.0f / sqrtf(ss * (1.0f / D) + RMS_EPS);
                if constexpr (H8) { unsigned* ho = (unsigned*)((unsigned char*)dstH + (size_t)t * D) + lane;
#pragma unroll
                    for (int j = 0; j < 4; ++j) { v[rr][j] = v[rr][j] * rstd * gn[j]; ho[64 * j] = cvtfp8x4(v[rr][j][0] * S8_H, v[rr][j][1] * S8_H, v[rr][j][2] * S8_H, v[rr][j][3] * S8_H); } }
                else { u32x2* ho = (u32x2*)(dstH + (size_t)t * D) + lane;
#pragma unroll
                    for (int j = 0; j < 4; ++j) { v[rr][j] = v[rr][j] * rstd * gn[j]; u32x2 o; o.x = cvtpk(v[rr][j][0], v[rr][j][1]); o.y = cvtpk(v[rr][j][2], v[rr][j][3]); ho[64 * j] = o; } }
            }
        }
        {
            LAS float* HT = (LAS float*)F.lds;
            LAS float* WC = (LAS float*)(F.lds + 66560);
            LAS float* PART = (LAS float*)F.lds;
            LAS float* LG = (LAS float*)(F.lds + 66560);
            LAS int* lcnt = (LAS int*)(F.lds + 99328);
            LAS int* gbase = (LAS int*)(F.lds + 99328 + 128);
            const float* RW = FIN(9) + (size_t)layer * D * NE; const float* RB = FIN(10) + layer * NE;
            const int th = F.wave & 1, kq = F.wave >> 1, r32 = lane & 31, hi = lane >> 5;
            f32x16 acc = {};
            for (int j = 0; j < 4; ++j) {
                __syncthreads();
#pragma unroll
                for (int rr = 0; rr < 8; ++rr)
#pragma unroll
                    for (int i = 0; i < 4; ++i) HT[(4 * lane + i) * 65 + F.wave * 8 + rr] = v[rr][j][i];
                { const f32x4* wsrc = (const f32x4*)(RW + (size_t)j * 256 * NE); LAS f32x4* wdst = (LAS f32x4*)WC;
#pragma unroll
                    for (int q = 0; q < 4; ++q) wdst[tid + 512 * q] = wsrc[tid + 512 * q]; }
                __syncthreads();
                const LAS float* ap = HT + (kq * 64 + hi) * 65 + th * 32 + r32; const LAS float* bp = WC + (kq * 64 + hi) * 32 + r32;
#pragma unroll 8
                for (int s = 0; s < 32; ++s) acc = __builtin_amdgcn_mfma_f32_32x32x2f32(ap[s * 2 * 65], bp[s * 2 * 32], acc, 0, 0, 0);
            }
            __syncthreads();
#pragma unroll
            for (int r = 0; r < 16; ++r) { const int tok = th * 32 + (r & 3) + 8 * (r >> 2) + 4 * hi; PART[(kq * 64 + tok) * 33 + r32] = acc[r]; }
            if (tid < NE) lcnt[tid] = 0;
            __syncthreads();
            for (int q = tid; q < 64 * NE; q += 512) { const int tok = q >> 5, e = q & 31;
                LG[tok * 33 + e] = ((PART[tok * 33 + e] + PART[(64 + tok) * 33 + e]) + (PART[(128 + tok) * 33 + e] + PART[(192 + tok) * 33 + e])) + RB[e]; }
            __syncthreads();
            int te[4], lp[4]; float tw[4];
            if (F.wave == 0) {
                const int tok = lane; unsigned used = 0u; float tv[4];
#pragma unroll
                for (int k = 0; k < 4; ++k) { float best = -INFINITY; int bi = 0;
                    for (int e = 0; e < NE; ++e) { const float xv = LG[tok * 33 + e]; if (!((used >> e) & 1u) && xv > best) { best = xv; bi = e; } }
                    used |= 1u << bi; tv[k] = best; te[k] = bi; }
                float sum = 0.f;
#pragma unroll
                for (int k = 0; k < 4; ++k) { tw[k] = __expf(tv[k] - tv[0]); sum += tw[k]; }
                const float inv = 1.0f / sum;
#pragma unroll
                for (int k = 0; k < 4; ++k) { tw[k] *= inv; lp[k] = atomicAdd((int*)(lcnt + te[k]), 1); }
            }
            __syncthreads();
            if (tid < NE) { const int c = lcnt[tid]; gbase[tid] = c > 0 ? (int)__hip_atomic_fetch_add(F.ctl + CW_ECNT + cl * 2048 + tid * 64, (unsigned)c, RLX_AGENT) : 0; }
            __syncthreads();
            if (F.wave == 0) {
                const int t = tile * 64 + lane;
                int* list = (int*)(F.ws + WS_LIST); int* tope_w = (int*)(F.ws + WS_TOPE); int* topp_w = (int*)(F.ws + WS_TOPP); float* topw_w = (float*)(F.ws + WS_TOPW);
#pragma unroll
                for (int k = 0; k < 4; ++k) { const int pos = gbase[te[k]] + lp[k]; list[te[k] * M + pos] = t; tope_w[t * 4 + k] = te[k]; topp_w[t * 4 + k] = pos; topw_w[t * 4 + k] = tw[k]; }
            }
            __syncthreads();
        }
    }
}

template <bool NORM, bool O8>
__device__ __forceinline__ void phase_combine(Frame& F, const float* src, float* dstX, const float* gain, bf16* dstH, int layer) {
    const int lane = lane_id();
    moe_tables(F, layer);
    const LAS int* tbase = (const LAS int*)(F.lds + TAB_TBASE);
    const int* tope = (const int*)(F.ws + WS_TOPE); const int* topp = (const int*)(F.ws + WS_TOPP); const float* topw = (const float*)(F.ws + WS_TOPW);
    const unsigned char* OUTS = F.ws + WS_OUTS;
    constexpr int ORB = O8 ? D : 2 * D;
    f32x4 gn[4];
    if (NORM) {
#pragma unroll
        for (int q = 0; q < 4; ++q) gn[q] = *(const f32x4*)(gain + 8 * lane + 512 * (q >> 1) + 4 * (q & 1)); }
    for (int tile = blockIdx.x; tile < M / 64; tile += F.G) {
        const int t0 = tile * 64 + F.wave * 8;
        int e_l = 0, p_l = 0; float w_l = 0.f;
        if (lane < 32) { e_l = tope[t0 * 4 + lane]; p_l = topp[t0 * 4 + lane]; w_l = topw[t0 * 4 + lane]; }
        const int slot_l = tbase[e_l] * 256 + p_l;
        if (O8) w_l *= (1.0f / S8_OUT);
#pragma unroll
        for (int b = 0; b < 2; ++b) {
            f32x4 x[4][4];
#pragma unroll
            for (int r = 0; r < 4; ++r) { const f32x4* xr = (const f32x4*)(src + (size_t)(t0 + 4 * b + r) * D + 8 * lane); x[r][0] = xr[0]; x[r][1] = xr[1]; x[r][2] = xr[128]; x[r][3] = xr[129]; }
            u32x4 o[4][4][O8 ? 1 : 2];
#pragma unroll
            for (int r = 0; r < 4; ++r)
#pragma unroll
                for (int k = 0; k < 4; ++k) { const int slot = __builtin_amdgcn_readlane(slot_l, (4 * b + r) * 4 + k); const unsigned char* ob = OUTS + (size_t)slot * ORB;
                    if constexpr (O8) { const u32x2 lo = *(const u32x2*)(ob + 8 * lane), hi = *(const u32x2*)(ob + 512 + 8 * lane); o[r][k][0] = (u32x4){lo.x, lo.y, hi.x, hi.y}; }
                    else { o[r][k][0] = *(const u32x4*)(ob + 16 * lane); o[r][k][1] = *(const u32x4*)(ob + 1024 + 16 * lane); } }
#pragma unroll
            for (int r = 0; r < 4; ++r) {
#pragma unroll
                for (int k = 0; k < 4; ++k) { const float wk = __uint_as_float((unsigned)__builtin_amdgcn_readlane((int)__float_as_uint(w_l), (4 * b + r) * 4 + k));
                    if constexpr (O8) {
#pragma unroll
                        for (int q = 0; q < 4; ++q) { const f32x2 a = __builtin_amdgcn_cvt_pk_f32_fp8((int)o[r][k][0][q], false), c = __builtin_amdgcn_cvt_pk_f32_fp8((int)o[r][k][0][q], true);
                            x[r][q] += (f32x4){a[0], a[1], c[0], c[1]} * wk; } }
                    else {
#pragma unroll
                        for (int j = 0; j < 2; ++j) { const u32x4 v = o[r][k][j];
                            x[r][2 * j] += (f32x4){bf_lo(v.x), bf_hi(v.x), bf_lo(v.y), bf_hi(v.y)} * wk; x[r][2 * j + 1] += (f32x4){bf_lo(v.z), bf_hi(v.z), bf_lo(v.w), bf_hi(v.w)} * wk; } } }
                const int t = t0 + 4 * b + r;
                { f32x4* xo = (f32x4*)(dstX + (size_t)t * D + 8 * lane); xo[0] = x[r][0]; xo[1] = x[r][1]; xo[128] = x[r][2]; xo[129] = x[r][3]; }
                if (NORM) {
                    float ss = 0.f;
#pragma unroll
                    for (int q = 0; q < 4; ++q) ss += (x[r][q][0] * x[r][q][0] + x[r][q][1] * x[r][q][1]) + (x[r][q][2] * x[r][q][2] + x[r][q][3] * x[r][q][3]);
                    ss = wave_sum(ss); const float rstd = 1.0f / sqrtf(ss * (1.0f / D) + RMS_EPS);
#pragma unroll
                    for (int j = 0; j < 2; ++j) { const f32x4 a = x[r][2 * j] * rstd * gn[2 * j], c = x[r][2 * j + 1] * rstd * gn[2 * j + 1];
                        *(u32x4*)(dstH + (size_t)t * D + 8 * lane + 512 * j) = (u32x4){cvtpk(a[0], a[1]), cvtpk(a[2], a[3]), cvtpk(c[0], c[1]), cvtpk(c[2], c[3])}; }
                }
            }
        }
    }
}

template <bool FP8, bool OUT8>
__device__ __forceinline__ void phase_moe_up(Frame& F, int layer, int G = 0  ) {
    if (G == 0) G = F.G;
    const int lane = lane_id(), tid = F.wave * 64 + lane; (void)tid;
    moe_tables(F, layer);
    const LAS int* ecnt = (const LAS int*)(F.lds + TAB_ECNT); const LAS int* tbase = (const LAS int*)(F.lds + TAB_TBASE);
    const int rowb = FP8 ? D : 2 * D;
    ProbMoeUp S{(const char*)(F.ws + WS_H2), FP8 ? (const char*)(F.ws + WS_WGU8) + (size_t)(1 - layer) * 64 * MiB : (const char*)(F.ws + WS_WGU) + (size_t)layer * NE * 2048 * 1024 * 2, F.lds, rowb, rowb, __builtin_amdgcn_readfirstlane(tbase[NE]), G, (int)blockIdx.x, F.wave};
    {
        const int* list = (const int*)(F.ws + WS_LIST); LAS unsigned* rt = (LAS unsigned*)(F.lds + TAB_ROW);
        pg8::Unit u;
#pragma nounroll
        for (int ord = 0; ord < MAXU && S.next(ord, u); ++ord) {
            if (tid < 256) { const int p = (u.pm - tbase[u.e]) * 256 + tid; const int tok = (p < ecnt[u.e]) ? list[u.e * M + p] : 0; rt[ord * 256 + tid] = (unsigned)tok * (unsigned)rowb; }
        }
        __syncthreads();
    }
    EpiGateUp<OUT8> E{(bf16*)(F.ws + WS_ACT), FIN(12) + (size_t)layer * NE * 2048};
    pg8::gemm_phase<ProbMoeUp, EpiGateUp<OUT8>, FP8, E8_UP>(F.lds, S, E);
}
template <bool FP8, bool OUT8>
__device__ __forceinline__ void phase_moe_down(Frame& F, int layer, int G = 0) {
    if (G == 0) G = F.G;
    moe_tables(F, layer);
    const LAS int* tbase = (const LAS int*)(F.lds + TAB_TBASE);
    const int rowb = FP8 ? FF : 2 * FF;
    ProbMoeDown S{(const char*)(F.ws + WS_ACT), FP8 ? (const char*)(F.ws + WS_WDN8) + (size_t)(1 - layer) * 32 * MiB : (const char*)(F.ws + WS_WDN) + (size_t)layer * NE * 1024 * 1024 * 2, F.lds, rowb, rowb, __builtin_amdgcn_readfirstlane(tbase[NE]), G, (int)blockIdx.x, F.wave};
    EpiDown<OUT8> E{(bf16*)(F.ws + WS_OUTS), FIN(14) + (size_t)layer * NE * 1024};
    pg8::gemm_phase<ProbMoeDown, EpiDown<OUT8>, FP8, E8_DOWN>(F.lds, S, E);
}

__device__ __forceinline__ int crow(int r, int hi) { return (r & 3) + 8 * (r >> 2) + 4 * hi; }
typedef LAS const char* lds_cptr;
__device__ __forceinline__ s16x4 vtr(lds_cptr p) { return __builtin_bit_cast(s16x4, __builtin_amdgcn_ds_read_tr16_b64_v4i16((LAS v4i16_t*)p)); }
__device__ __forceinline__ void attn_pair(Frame& F, int bh, int qbA, int qbB) {
    const int lane = lane_id(), r32 = lane & 31, hi = lane >> 5, wid = F.wave, sub = wid >> 2, ws = wid & 3, tids = ws * 64 + lane;
    const bf16* Qh = (const bf16*)(F.ws + WS_Q) + (size_t)bh * SEQ * HD; const bf16* Kh = (const bf16*)(F.ws + WS_K) + (size_t)bh * SEQ * HD; const bf16* Vh = (const bf16*)(F.ws + WS_V) + (size_t)bh * SEQ * HD;
    const int q0 = (sub ? qbB : qbA) * 128, qw = q0 + 32 * ws, qpos = qw + r32, jd = qw >> 6, jtop = (q0 >> 6) + 1;
    LAS unsigned char* KB = F.lds + sub * 32768; LAS unsigned char* VB = KB + 16384; LAS unsigned char* OST = F.lds + 65536 + wid * 4096;
    const bf16* ksrc[2]; const bf16* vsrc[2];
#pragma unroll
    for (int i = 0; i < 2; ++i) { const int p = tids + 256 * i, wv = p >> 6, l = p & 63;
        ksrc[i] = Kh + (size_t)l * HD + wv * 8; vsrc[i] = Vh + (size_t)(16 * (wv & 3) + (l >> 2)) * HD + (wv >> 2) * 32 + (l & 3) * 8; }
    bf16x8 qr[4];
#pragma unroll
    for (int d0 = 0; d0 < 4; ++d0) qr[d0] = *(const bf16x8*)(Qh + (size_t)qpos * HD + d0 * 16 + hi * 8);
    f32x16 o0 = {}, o1 = {};
    float C = 0.f;
    int cur = 0;
    bool done = false;
    LAS int* flags = (LAS int*)(F.lds + 65536 + 32768);
    {
#pragma unroll
      for (int i = 0; i < 2; ++i) { const u32x4 kk = *(const u32x4*)(ksrc[i] + (size_t)jtop * 64 * HD), vv = *(const u32x4*)(vsrc[i] + (size_t)jtop * 64 * HD);
          *(LAS u32x4*)(KB + (tids + 256 * i) * 16) = kk; *(LAS u32x4*)(VB + (tids + 256 * i) * 16) = vv; } }
    u32x4 kA[2], vA[2], kB[2], vB[2];
    if (jtop > 0) {
#pragma unroll
        for (int i = 0; i < 2; ++i) { kA[i] = *(const u32x4*)(ksrc[i] + (size_t)(jtop - 1) * 64 * HD); vA[i] = *(const u32x4*)(vsrc[i] + (size_t)(jtop - 1) * 64 * HD); } }
    __syncthreads();
    bool brk = false;
#define ATT_STEP(KL, VL, KS, VS) do { const int j = jtop - st; \
        if (j > 1) { _Pragma("unroll") for (int i = 0; i < 2; ++i) { KL[i] = *(const u32x4*)(ksrc[i] + (size_t)(j - 2) * 64 * HD); VL[i] = *(const u32x4*)(vsrc[i] + (size_t)(j - 2) * 64 * HD); } } \
        att_compute(j); \
        if (j > 0) { _Pragma("unroll") for (int i = 0; i < 2; ++i) { *(LAS u32x4*)(KB + (cur ^ 1) * 8192 + (tids + 256 * i) * 16) = KS[i]; *(LAS u32x4*)(VB + (cur ^ 1) * 8192 + (tids + 256 * i) * 16) = VS[i]; } } \
        if (lane == 0) flags[(st & 1) * 8 + wid] = (done || j <= 0) ? 1 : 0; \
        __syncthreads(); \
        brk = __all(flags[(st & 1) * 8 + (lane & 7)] != 0); cur ^= 1; ++st; } while (0)
    auto att_compute = [&](const int j) __attribute__((always_inline)) {
        if (j >= 0 && j <= jd && !done) {
            const lds_cptr kb = (lds_cptr)(KB + cur * 8192) + hi * 1024 + r32 * 16;
            f32x16 p0 = {}, p1 = {};
#pragma unroll
            for (int d0 = 0; d0 < 4; ++d0) { const bf16x8 b0 = *(const LAS bf16x8*)(kb + d0 * 2048), b1 = *(const LAS bf16x8*)(kb + d0 * 2048 + 512);
                p0 = __builtin_amdgcn_mfma_f32_32x32x16_bf16(b0, qr[d0], p0, 0, 0, 0); p1 = __builtin_amdgcn_mfma_f32_32x32x16_bf16(b1, qr[d0], p1, 0, 0, 0); }
            float L0[16], L1[16];
#pragma unroll
            for (int r = 0; r < 16; ++r) { L0[r] = __builtin_amdgcn_logf(1.0f + __builtin_amdgcn_exp2f(p0[r])); L1[r] = __builtin_amdgcn_logf(1.0f + __builtin_amdgcn_exp2f(p1[r])); }
            if (j == jd) {
                const int kb0 = 64 * j + 4 * hi;
#pragma unroll
                for (int r = 0; r < 16; ++r) { const int kv = kb0 + (r & 3) + 8 * (r >> 2);
                    if (kv >= qpos) { L0[r] = 0.f; p0[r] = -INFINITY; } if (kv + 32 >= qpos) { L1[r] = 0.f; p1[r] = -INFINITY; } }
            }
            float tg[8];
#pragma unroll
            for (int g = 0; g < 4; ++g) {
                L0[4 * g + 2] += L0[4 * g + 3]; L0[4 * g + 1] += L0[4 * g + 2]; L0[4 * g] += L0[4 * g + 1]; tg[g] = L0[4 * g];
                L1[4 * g + 2] += L1[4 * g + 3]; L1[4 * g + 1] += L1[4 * g + 2]; L1[4 * g] += L1[4 * g + 1]; tg[4 + g] = L1[4 * g]; }
            float off[8]; float R = C;
#pragma unroll
            for (int g = 7; g >= 0; --g) {
                const auto rr = __builtin_amdgcn_permlane32_swap(__float_as_uint(tg[g]), __float_as_uint(tg[g]), false, false);
                const float tlo = __uint_as_float(rr[0]), thi = __uint_as_float(rr[1]);
                off[g] = R + (hi ? 0.f : thi);
                R += tlo + thi; }
            C = R;
#pragma unroll
            for (int g = 0; g < 4; ++g)
#pragma unroll
                for (int i = 0; i < 4; ++i) { p0[4 * g + i] = __builtin_amdgcn_exp2f(p0[4 * g + i] - (L0[4 * g + i] + off[g])); p1[4 * g + i] = __builtin_amdgcn_exp2f(p1[4 * g + i] - (L1[4 * g + i] + off[4 + g])); }
            u32x4 pw0, pw1, pw2, pw3;
            pw0 = (u32x4){cvtpk(p0[0], p0[1]), cvtpk(p0[2], p0[3]), cvtpk(p0[4], p0[5]), cvtpk(p0[6], p0[7])};
            pw1 = (u32x4){cvtpk(p0[8], p0[9]), cvtpk(p0[10], p0[11]), cvtpk(p0[12], p0[13]), cvtpk(p0[14], p0[15])};
            pw2 = (u32x4){cvtpk(p1[0], p1[1]), cvtpk(p1[2], p1[3]), cvtpk(p1[4], p1[5]), cvtpk(p1[6], p1[7])};
            pw3 = (u32x4){cvtpk(p1[8], p1[9]), cvtpk(p1[10], p1[11]), cvtpk(p1[12], p1[13]), cvtpk(p1[14], p1[15])};
            const lds_cptr vp = (lds_cptr)(VB + cur * 8192) + ((lane >> 4) & 1) * 32 + (lane & 3) * 8 + (4 * hi + ((lane & 15) >> 2)) * 64;
#define PVSTEP(OACC, D0, KS, PW) do { const s16x4 lo_ = vtr(vp + (D0) * 4096 + (KS) * 1024), hi_ = vtr(vp + (D0) * 4096 + (KS) * 1024 + 512); \
                const bf16x8 vf_ = (bf16x8){lo_[0], lo_[1], lo_[2], lo_[3], hi_[0], hi_[1], hi_[2], hi_[3]}; \
                OACC = __builtin_amdgcn_mfma_f32_32x32x16_bf16(__builtin_bit_cast(bf16x8, PW), vf_, OACC, 0, 0, 0); } while (0)
            PVSTEP(o0, 0, 0, pw0); PVSTEP(o1, 1, 0, pw0); PVSTEP(o0, 0, 1, pw1); PVSTEP(o1, 1, 1, pw1);
            PVSTEP(o0, 0, 2, pw2); PVSTEP(o1, 1, 2, pw2); PVSTEP(o0, 0, 3, pw3); PVSTEP(o1, 1, 3, pw3);
#undef PVSTEP
            done = __all(C > 150.0f);
        }
    };
    for (int st = 0; ; ) {
        ATT_STEP(kB, vB, kA, vA); if (brk) break;
        ATT_STEP(kA, vA, kB, vB); if (brk) break;
    }
#undef ATT_STEP
    { LAS bf16* stg = (LAS bf16*)OST;
#pragma unroll
      for (int r = 0; r < 16; ++r) { const int orow = crow(r, hi); stg[orow * 64 + r32] = (bf16)(cvtpk(o0[r], 0.f) & 0xffffu); stg[orow * 64 + 32 + r32] = (bf16)(cvtpk(o1[r], 0.f) & 0xffffu); }
      LDS_WAIT(); asm volatile("" ::: "memory");
      const int b = bh >> 4, h = bh & 15;
      bf16* Ow = (bf16*)(F.ws + WS_O) + ((size_t)b * SEQ + qw) * D + h * HD;
#pragma unroll
      for (int i = 0; i < 4; ++i) { const int row = i * 8 + (lane >> 3), ch = lane & 7; const u32x4 vv = *(const LAS u32x4*)(stg + row * 64 + ch * 8); *(u32x4*)(Ow + (size_t)row * D + ch * 8) = vv; } }
    __syncthreads();
}
__device__ __forceinline__ void phase_attn(Frame& F) {
    for (int v = blockIdx.x; v < BATCH * NH * 2; v += F.G) {
        const int bh = v >> 1, odd = v & 1;
        for (int i = 0; i < 4; ++i) { const int qa = 8 * odd + 2 * i; attn_pair(F, bh, qa, qa + 1); }
    }
}

__global__ void __launch_bounds__(NWAVES * 64, 2) fwd_kernel(Args args) {
    extern __shared__ __attribute__((aligned(16))) unsigned char lds[];
    Frame F;
    F.lds = (LAS unsigned char*)lds; F.MISC = (volatile LAS unsigned*)(F.lds + MISC_OFF);
    F.wave = __builtin_amdgcn_readfirstlane((int)threadIdx.x >> 6); F.G = gridDim.x;
    F.ws = args.ws; F.ctl = (gu32*)(args.ws + WS_CTL);
    for (int u = (int)threadIdx.x; u < (LDS_BYTES - LDSCTL_OFF) / 4; u += NWAVES * 64) ((LAS unsigned*)(F.lds + LDSCTL_OFF))[u] = 0u;
    __syncthreads();
    const XcdBarrier bar = xcd_barrier_post((unsigned*)(F.ctl + CW_BAR), F.MISC + 8, gridDim.x);
#define TP_PUT(i) do { if (threadIdx.x == 0) { const unsigned long long t_ = __builtin_amdgcn_s_memrealtime(); F.MISC[16 + 2 * (i)] = (unsigned)t_; F.MISC[17 + 2 * (i)] = (unsigned)(t_ >> 32); } } while (0)
#define SEAM(k) do { xcd_barrier(bar); if (MK_TPROBE == ((k) == 0 ? 3 : (k) + 1)) TP_PUT(0); if (MK_TPROBE == (k)) TP_PUT(1); } while (0)
    if (MK_TPROBE == 0) TP_PUT(0);
    float* X1 = (float*)(F.ws + WS_X1); float* X2 = (float*)(F.ws + WS_X2); float* X3 = (float*)(F.ws + WS_X3);

    const bool tuned = (F.G == 256);
    const int nfront = tuned ? NFRONT : F.G, cv3 = tuned ? CV3 : 0, cv9 = tuned ? CV9 : 0;
    {
        const int bx = (int)blockIdx.x;
        if (bx < nfront) {
            const XcdBarrier fbar = xcd_barrier_post((unsigned*)(F.ctl + CW_BAR2), F.MISC + 10, (unsigned)nfront);
            phase_convert(F, 0, CV_SMALL, bx, nfront); __syncthreads();
            phase_pooled(F, bx, nfront);
            xcd_barrier(fbar);
            { ProbPool S{(const char*)(F.ws + WS_POOLED), (const char*)(F.ws + WS_POOLW), 512, 512, nfront, bx, F.wave}; EpiPool E{FIN(0), X1, FIN(3)};
              pg8::gemm_phase<ProbPool, EpiPool>(F.lds, S, E); }
            xcd_barrier(fbar);
            phase_router<FP8_U0>(F, X1, FIN(8), (bf16*)(F.ws + WS_H2), 0, bx, nfront);
            if (nfront == F.G) phase_convert(F, CV_SMALL, CV_END, bx, F.G);
        } else {
            phase_convert(F, CV_SMALL, CV_END - cv9 - cv3, bx - nfront, F.G - nfront);
        }
    }
    SEAM(0);
    { const int bx = (int)blockIdx.x;
        if (cv3 > 0 && bx >= G3) phase_convert(F, CV_END - cv9 - cv3, CV_END - cv9, bx - G3, F.G - G3);
        else phase_moe_up<FP8_U0, FP8_D0>(F, 0, cv3 > 0 ? G3 : 0); }
    SEAM(3);
    phase_moe_down<FP8_D0, false>(F, 0);
    SEAM(4);
    phase_combine<true, false>(F, X1, X2, FIN(1) + D, (bf16*)(F.ws + WS_HQ), 0);
    SEAM(5);
    { ProbDense S{(const char*)(F.ws + WS_HQ), (const char*)(F.ws + WS_WQKV), 2 * D, 2 * D, 2 * D, M / 256, 12, F.G, (int)blockIdx.x, F.wave}; { const int l_ = lane_id(); if (F.wave == 0) { ((LAS float*)(F.lds + BIAS_OFF))[l_] = FIN(5)[l_]; ((LAS float*)(F.lds + BIAS_OFF))[64 + l_] = FIN(6)[l_]; } __syncthreads(); }
        EpiQKV E{(bf16*)(F.ws + WS_Q), (const LAS float*)(F.lds + BIAS_OFF)};
        pg8::gemm_phase<ProbDense, EpiQKV>(F.lds, S, E); }
    SEAM(6);
    phase_attn(F);
    SEAM(7);
    { ProbDense S{(const char*)(F.ws + WS_O), (const char*)(F.ws + WS_WO), 2 * D, 2 * D, 2 * D, M / 256, 4, F.G, (int)blockIdx.x, F.wave}; EpiRes E{X2, X3};
        pg8::gemm_phase<ProbDense, EpiRes>(F.lds, S, E); }
    SEAM(8);
    {
        const int bx = (int)blockIdx.x;
        if (cv9 == 0) phase_router<true>(F, X3, FIN(8) + D, (bf16*)(F.ws + WS_H2), 1, bx, F.G);
        else if (bx < NR9) phase_router<true>(F, X3, FIN(8) + D, (bf16*)(F.ws + WS_H2), 1, bx, NR9);
        else phase_convert(F, CV_END - cv9, CV_END, bx - NR9, F.G - NR9);
    }
    SEAM(9);
    phase_moe_up<true, true>(F, 1);
    SEAM(10);
    phase_moe_down<true, true>(F, 1);
    SEAM(11);
    phase_combine<false, true>(F, X3, FOUT, nullptr, nullptr, 1);
    if (MK_TPROBE >= 0) { if (MK_TPROBE == 12) TP_PUT(1);
        if (blockIdx.x == 0 && threadIdx.x == 0) { const unsigned long long tp0 = ((unsigned long long)F.MISC[17] << 32) | F.MISC[16], tp1 = ((unsigned long long)F.MISC[19] << 32) | F.MISC[18];
            const unsigned long long dt = (tp1 - tp0) * 4, ts = __builtin_amdgcn_s_memrealtime();
            while (__builtin_amdgcn_s_memrealtime() - ts < dt) __builtin_amdgcn_s_sleep(8); } }
#undef SEAM
}

extern "C" void kernel_launch(void* const* d_in, const int* in_sizes, int n_in, void* d_out, int out_size, void* d_ws, size_t ws_size, hipStream_t stream) {
    static int grid = 0;
    if (grid == 0) {
        if (n_in != 15 || in_sizes[0] != M * D || out_size != M * D || ws_size < WS_END) { fprintf(stderr, "kernel_launch: unexpected shapes (n_in %d, in0 %d, out %d, ws %zu, need %zu)\n", n_in, n_in > 0 ? in_sizes[0] : -1, out_size, ws_size, (size_t)WS_END); grid = -1; return; }
        int dev = 0, cus = 0, per_cu = 0;
        if (hipGetDevice(&dev) != hipSuccess || hipDeviceGetAttribute(&cus, hipDeviceAttributeMultiprocessorCount, dev) != hipSuccess) { grid = -1; return; }
        if (hipFuncSetAttribute((const void*)fwd_kernel, hipFuncAttributeMaxDynamicSharedMemorySize, LDS_BYTES) != hipSuccess) { fprintf(stderr, "kernel_launch: hipFuncSetAttribute failed\n"); grid = -1; return; }
        if (hipOccupancyMaxActiveBlocksPerMultiprocessor(&per_cu, (const void*)fwd_kernel, NWAVES * 64, LDS_BYTES) != hipSuccess || per_cu < 1) fprintf(stderr, "kernel_launch: occupancy query says %d\n", per_cu);
        (void)hipGetLastError();
        grid = cus;
    }
    if (grid < 0) return;
    (void)hipMemsetAsync((char*)d_ws + WS_CTL, 0, CTL_ZERO_BYTES, stream);
    Args a{};
    for (int i = 0; i < 15; ++i) a.in[i] = (const float*)d_in[i];
    a.out = (float*)d_out; a.ws = (unsigned char*)d_ws;
    hipLaunchKernelGGL(fwd_kernel, dim3(grid), dim3(NWAVES * 64), LDS_BYTES, stream, a);
    const hipError_t le = hipPeekAtLastError();
    if (le != hipSuccess) fprintf(stderr, "kernel_launch: launch failed: %s\n", hipGetErrorName(le));
}
```

```cpp
#include <hip/hip_runtime.h>
#include <cstdio>
#include <cstdint>

#define GAS __attribute__((address_space(1)))
#define LAS __attribute__((address_space(3)))
typedef unsigned short bf16;
typedef unsigned u32x4 __attribute__((ext_vector_type(4)));
typedef unsigned u32x2 __attribute__((ext_vector_type(2)));
typedef float f32x4 __attribute__((ext_vector_type(4)));
typedef float f32x2 __attribute__((ext_vector_type(2)));
typedef float f32x16 __attribute__((ext_vector_type(16)));
typedef short bf16x8 __attribute__((ext_vector_type(8)));
typedef short s16x4 __attribute__((ext_vector_type(4)));
typedef short v4i16_t __attribute__((ext_vector_type(4)));
typedef __bf16 bf16x2_t __attribute__((ext_vector_type(2)));
typedef int i32x8 __attribute__((ext_vector_type(8)));
typedef int i32x4 __attribute__((ext_vector_type(4)));
typedef GAS unsigned gu32;

constexpr int BATCH = 8, SEQ = 2048, D = 1024, M = BATCH * SEQ, NH = 16, HD = 64, NE = 32, TOPK = 4, FF = 1024;
constexpr float RMS_EPS = 1e-6f, SW_LIMIT = 7.0f, SW_ALPHA = 1.702f;
constexpr int MT_MAX = M * TOPK / 256 + NE;
constexpr int NSLOT = MT_MAX * 256;
constexpr float C2 = 0.125f * 1.4426950408889634f;
constexpr float S8_W = 64.0f, S8_H = 8.0f, S8_ACT = 4.0f, S8_OUT = 16.0f;
constexpr int E8_UP = 127 - 9, E8_DOWN = 127 - 8;

constexpr size_t MiB = 1u << 20;
constexpr size_t WS_CTL = 0, CTL_ZERO_BYTES = 1 * MiB;
constexpr size_t WS_POOLW = 1 * MiB;
constexpr size_t WS_WQKV = 2 * MiB;
constexpr size_t WS_WO = 8 * MiB;
constexpr size_t WS_TOPE = 10 * MiB, WS_TOPP = WS_TOPE + 256 * 1024, WS_TOPW = WS_TOPP + 256 * 1024;
constexpr size_t WS_LIST = 12 * MiB;
constexpr size_t WS_WGU = 16 * MiB;
constexpr size_t WS_WDN = 272 * MiB;
constexpr size_t WS_WGU8 = WS_WGU + 128 * MiB;
constexpr size_t WS_WDN8 = WS_WDN + 64 * MiB;
constexpr size_t WS_X1 = 400 * MiB, WS_X2 = 464 * MiB, WS_X3 = 528 * MiB;
constexpr size_t WS_POOLED = 592 * MiB, WS_H2 = 624 * MiB, WS_HQ = 656 * MiB, WS_Q = 688 * MiB, WS_K = 720 * MiB, WS_V = 752 * MiB, WS_O = 784 * MiB;
constexpr size_t WS_ACT = 816 * MiB, WS_OUTS = 960 * MiB;
constexpr size_t WS_END = 1104 * MiB;
static_assert(WS_ACT + (size_t)NSLOT * 1024 * 2 <= WS_OUTS && WS_OUTS + (size_t)NSLOT * 1024 * 2 <= WS_END, "ws map");
constexpr int CW_TMO = 0, CW_CODE = 1;
constexpr int CW_BAR = 4096;
constexpr int CW_BAR2 = 8192;
constexpr int CW_ECNT = 16384;

constexpr int RING_BYTES = 131072;
constexpr int LDSCTL_OFF = RING_BYTES, MISC_OFF = LDSCTL_OFF + 320;
constexpr int TAB_OFF = 131584;
constexpr int TAB_ECNT = TAB_OFF, TAB_TBASE = TAB_OFF + 128, TAB_TEXP = TAB_OFF + 384, TAB_ROW = TAB_OFF + 1024;
constexpr int MAXU = 12;
constexpr int BIAS_OFF = TAB_ROW + MAXU * 1024;
constexpr int LDS_BYTES = 163840;
static_assert(BIAS_OFF % 16 == 0 && BIAS_OFF + 2 * 8 * 1024 <= LDS_BYTES, "LDS map");

constexpr int NWAVES = 8;
#ifndef MK_NFRONT
#define MK_NFRONT 144
#endif
constexpr int NFRONT = MK_NFRONT;
#ifndef MK_CV9
#define MK_CV9 8000
#endif
#ifndef MK_NR9
#define MK_NR9 96
#endif
constexpr int CV9 = MK_CV9, NR9 = MK_NR9;
#ifndef MK_CV3
#define MK_CV3 600
#endif
constexpr int CV3 = MK_CV3, G3 = 248;

#ifndef MK_TPROBE
#define MK_TPROBE -1
#endif
#ifndef MK_FP8_L0
#define MK_FP8_L0 3
#endif
constexpr bool FP8_U0 = (MK_FP8_L0 & 1) != 0, FP8_D0 = (MK_FP8_L0 & 2) != 0;

#define RLX_AGENT __ATOMIC_RELAXED, __HIP_MEMORY_SCOPE_AGENT
#define LDS_WAIT() asm volatile("s_waitcnt lgkmcnt(0)" ::: "memory")
#define VM_WAIT() asm volatile("s_waitcnt vmcnt(0)" ::: "memory")
__device__ __forceinline__ unsigned cvtpk(float lo, float hi) { f32x2 v = {lo, hi}; bf16x2_t b = __builtin_convertvector(v, bf16x2_t); return __builtin_bit_cast(unsigned, b); }
__device__ __forceinline__ unsigned cvtfp8x4(float a, float b, float c, float d) { int w = __builtin_amdgcn_cvt_pk_fp8_f32(a, b, 0, false); w = __builtin_amdgcn_cvt_pk_fp8_f32(c, d, w, true); return (unsigned)w; }
__device__ __forceinline__ float bf_lo(unsigned u) { return __uint_as_float(u << 16); }
__device__ __forceinline__ float bf_hi(unsigned u) { return __uint_as_float(u & 0xffff0000u); }
__device__ __forceinline__ int lane_id() { int r; asm volatile("v_mbcnt_lo_u32_b32 %0, -1, 0\n\tv_mbcnt_hi_u32_b32 %0, -1, %0" : "=v"(r)); return r; }
__device__ __forceinline__ float wave_sum(float v) {
#pragma unroll
    for (int o = 1; o < 64; o <<= 1) v += __shfl_xor(v, o);
    return v;
}

#define XB_TMO      128
#define XB_XCNT(j)  (256  + 64 * (j))
#define XB_XSUB(j)  (1280 + 64 * (j))
#define XB_XGEN(j)  (2304 + 64 * (j))
#define XB_TOP      3328
#define XB_TOPGEN   3392
#define XCD_BAR_WORDS 3456
#define XB_SPIN_CAP (1u << 18)
__device__ __forceinline__ unsigned xb_ld(unsigned* p)              { return __hip_atomic_load(p, __ATOMIC_RELAXED, __HIP_MEMORY_SCOPE_AGENT); }
__device__ __forceinline__ unsigned xb_add(unsigned* p, unsigned v) { return __hip_atomic_fetch_add(p, v, __ATOMIC_RELAXED, __HIP_MEMORY_SCOPE_AGENT); }
__device__ __forceinline__ unsigned xb_xcc_id() { return (unsigned)__builtin_amdgcn_s_getreg((3 << 11) | 20) & 0xFu; }
#define XB_SPIN(cond, bar) do { unsigned _sp = 0; while (cond) { __builtin_amdgcn_s_sleep(1); \
    if ((++_sp & 255u) == 0u) { if (xb_ld(&(bar)[XB_TMO])) break; if (_sp > XB_SPIN_CAP) { atomicAdd(&(bar)[XB_TMO], 1u); break; } } } } while (0)
struct XcdBarrier { unsigned* bar; unsigned x; volatile LAS unsigned* st; unsigned G; };
__device__ __forceinline__ XcdBarrier xcd_barrier_post(unsigned* bar, volatile LAS unsigned* st, unsigned G) {
    XcdBarrier b; b.bar = bar; b.x = xb_xcc_id(); b.st = st; b.G = G;
    if (threadIdx.x == 0) (void)xb_add(&bar[XB_XCNT(b.x)], 1u);
    return b;
}
__device__ __forceinline__ void xcd_barrier_complete(unsigned* bar, unsigned x, unsigned& nloc, unsigned& nx, const unsigned G) {
    unsigned sum, cnt, mine, sp = 0u;
    for (;;) {
        sum = 0u; cnt = 0u; mine = 0u;
#pragma unroll
        for (unsigned j = 0; j < 16; ++j) { const unsigned c = xb_ld(&bar[XB_XCNT(j)]); sum += c; cnt += (c > 0u) ? 1u : 0u; mine = (j == x) ? c : mine; }
        if (sum == G) break;
        __builtin_amdgcn_s_sleep(1);
        if ((++sp & 255u) == 0u) { if (xb_ld(&bar[XB_TMO])) break; if (sp > XB_SPIN_CAP) { atomicAdd(&bar[XB_TMO], 1u); break; } }
    }
    nloc = mine > 0u ? mine : 1u; nx = cnt > 0u ? cnt : 1u;
}
__device__ __forceinline__ void xcd_barrier(const XcdBarrier& b) {
    asm volatile("s_waitcnt vmcnt(0)" ::: "memory");
    __syncthreads();
    if (threadIdx.x == 0) {
        unsigned* bar = b.bar;
        __builtin_amdgcn_s_waitcnt(0);
        unsigned nloc = b.st[0], nx = b.st[1];
        if (nloc == 0u) { xcd_barrier_complete(bar, b.x, nloc, nx, b.G); b.st[0] = nloc; b.st[1] = nx; }
        const unsigned old = xb_add(&bar[XB_XSUB(b.x)], 1u);
        const unsigned gen = old / nloc;
        if (old + 1u == (gen + 1u) * nloc) {
            __builtin_amdgcn_fence(__ATOMIC_RELEASE, "agent");
            asm volatile("s_waitcnt vmcnt(0)" ::: "memory");
            const unsigned og = xb_add(&bar[XB_TOP], 1u);
            const unsigned tg = og / nx;
            if (og + 1u == (tg + 1u) * nx) xb_add(&bar[XB_TOPGEN], 1u);
            else XB_SPIN(xb_ld(&bar[XB_TOPGEN]) == tg, bar);
            __builtin_amdgcn_fence(__ATOMIC_ACQUIRE, "agent");
            xb_add(&bar[XB_XGEN(b.x)], 1u);
            asm volatile("s_waitcnt vmcnt(0)" ::: "memory");
        } else {
            XB_SPIN(xb_ld(&bar[XB_XGEN(b.x)]) == gen, bar);
            __builtin_amdgcn_fence(__ATOMIC_ACQUIRE, "agent");
            asm volatile("s_waitcnt vmcnt(0)" ::: "memory");
        }
    }
    __syncthreads();
}

namespace pg8 {
constexpr int BM = 256, BK = 64, HALF = 128, HTB = HALF * BK * 2, STAGE_BYTES = 8 * HTB, NXCD = 8, WGM = 8;
__host__ __device__ __forceinline__ int lds_byte(int r, int c) { const int st = (r >> 4) * 2 + (c >> 5), rr = r & 15, cc = c & 31, ob = rr * 64 + cc * 2; return st * 1024 + (ob ^ (((ob >> 9) & 1) << 5)); }
__host__ __device__ __forceinline__ void stage_rc(int b, int& R, int& C) { const int st = b / 1024, sb = b % 1024, swz = sb ^ (((sb >> 9) & 1) << 5); R = (st >> 1) * 16 + swz / 64; C = (st & 1) * 32 + (swz % 64) / 2; }
__host__ __device__ __forceinline__ int perm32(int rho) { const int n = rho >> 4, i = rho & 15; return 8 * (i >> 2) + 4 * n + (i & 3); }

struct Unit { int pm, pn, e; };
__device__ __forceinline__ void glds_sv(const char* base, unsigned voff, unsigned lds_dst) {
    unsigned keep;
    asm volatile("s_mov_b32 %0, m0\n\ts_mov_b32 m0, %3\n\ts_nop 0\n\tglobal_load_lds_dwordx4 %1, %2\n\ts_mov_b32 m0, %0" : "=&s"(keep) : "v"(voff), "s"(base), "s"(lds_dst) : "memory");
}
__device__ __forceinline__ const char* uni_ptr(const char* p) { const unsigned long long u = (unsigned long long)p; const unsigned lo = __builtin_amdgcn_readfirstlane((unsigned)u), hi = __builtin_amdgcn_readfirstlane((unsigned)(u >> 32)); return (const char*)(((unsigned long long)hi << 32) | lo); }
struct UD { const char* a; const char* b0; const char* b1; };

__device__ __forceinline__ bool order_next(int i, int G, int c, int nM, int nN, int& pm, int& pn) {
    const int L = i * G + c; const int nwg = nM * nN; if (L >= nwg) return false;
    int wgid = L; { const int q = nwg / NXCD, r = nwg % NXCD, xcd = wgid % NXCD, off = wgid / NXCD; wgid = (xcd < r ? xcd * (q + 1) : r * (q + 1) + (xcd - r) * q) + off; }
    const int nig = WGM * nN, gid = wgid / nig, fm = gid * WGM, gsz = (nM - fm) < WGM ? (nM - fm) : WGM;
    pm = fm + ((wgid % nig) % gsz); pn = (wgid % nig) / gsz; return true;
}

template <class Prob, class Epi, bool FP8 = false, int E8 = 127>
__device__ __forceinline__ void gemm_phase(LAS unsigned char* lds, const Prob& S, const Epi& E) {
    const int wid = S.wave, lane = lane_id(), tid = wid * 64 + lane, wr = wid >> 2, wc = wid & 3, fr = lane & 15, fq = lane >> 4;
    const int nt = S.Kb / 128;
    unsigned voffB[2];
#pragma unroll
    for (int i = 0; i < 2; ++i) { int R, C; stage_rc(tid * 16 + i * 8192, R, C); const int Rb = Epi::PERM ? ((R & ~31) + perm32(R & 31)) : R; voffB[i] = (unsigned)(Rb * S.ldb + C * 2); }
    const size_t kstep = (size_t)(BK * 2);
    const unsigned ldsb = (unsigned)__builtin_amdgcn_readfirstlane((int)(unsigned)(uintptr_t)lds + wid * 1024);
    const int aoff = lds_byte(wr * 64 + fr, fq * 8), boff = lds_byte(wc * 32 + fr, fq * 8);
#define PG8_SA(b, h) (((b) * 2 + (h)) * HTB)
#define PG8_SB(b, h) ((4 + (b) * 2 + (h)) * HTB)
#define PG8_STA(bufoff, gbase, va, h) do { _Pragma("unroll") for (int _i = 0; _i < 2; ++_i) glds_sv((const char*)(gbase), (va)[(h) * 2 + _i], ldsb + (unsigned)((bufoff) + _i * 8192)); } while (0)
#define PG8_STB(bufoff, gbase) do { _Pragma("unroll") for (int _i = 0; _i < 2; ++_i) glds_sv((const char*)(gbase), voffB[_i], ldsb + (unsigned)((bufoff) + _i * 8192)); } while (0)
#define PG8_LD8(p) __builtin_shufflevector(*(const LAS i32x4*)(p), *(const LAS i32x4*)((p) + 1024), 0, 1, 2, 3, 4, 5, 6, 7)
#define PG8_LDA(dst, b, h) do { _Pragma("unroll") for (int m = 0; m < 4; ++m) dst[m] = PG8_LD8(lds + PG8_SA(b, h) + aoff + m * 2048); } while (0)
#define PG8_LDB(dst, b, h) do { _Pragma("unroll") for (int n = 0; n < 2; ++n) dst[n] = PG8_LD8(lds + PG8_SB(b, h) + boff + n * 2048); } while (0)
#define PG8_HALF(x, k) __builtin_bit_cast(bf16x8, __builtin_shufflevector(x, x, 4 * (k), 4 * (k) + 1, 4 * (k) + 2, 4 * (k) + 3))
#define PG8_MMA(ai, bj, At, Bt) do { __builtin_amdgcn_s_setprio(1); _Pragma("unroll") for (int m = 0; m < 4; ++m) _Pragma("unroll") for (int n = 0; n < 2; ++n) { \
        if constexpr (FP8) acc[ai][bj][m][n] = __builtin_amdgcn_mfma_scale_f32_16x16x128_f8f6f4(Bt[n], At[m], acc[ai][bj][m][n], 0, 0, 0, E8, 0, 127); \
        else { acc[ai][bj][m][n] = __builtin_amdgcn_mfma_f32_16x16x32_bf16(PG8_HALF(Bt[n], 0), PG8_HALF(At[m], 0), acc[ai][bj][m][n], 0, 0, 0); \
               acc[ai][bj][m][n] = __builtin_amdgcn_mfma_f32_16x16x32_bf16(PG8_HALF(Bt[n], 1), PG8_HALF(At[m], 1), acc[ai][bj][m][n], 0, 0, 0); } } \
        __builtin_amdgcn_s_setprio(0); \
        if constexpr (FP8) asm volatile("" : "+v"(acc[ai][bj][0][0]), "+v"(acc[ai][bj][0][1]), "+v"(acc[ai][bj][1][0]), "+v"(acc[ai][bj][1][1]), "+v"(acc[ai][bj][2][0]), "+v"(acc[ai][bj][2][1]), "+v"(acc[ai][bj][3][0]), "+v"(acc[ai][bj][3][1])); \
        } while (0)
#define PG8_WAIT_V(n) asm volatile("s_waitcnt vmcnt(" #n ")" ::: "memory")
#define PG8_WAIT_SEAM(flag) asm volatile("s_cmp_lg_u32 %0, 0\n\ts_cbranch_scc1 1f\n\ts_waitcnt vmcnt(8)\n\ts_branch 2f\n1:\n\ts_waitcnt vmcnt(%1)\n2:" :: "s"(flag), "n"(RELAX) : "memory", "scc")
#define PG8_WAIT_L(n) asm volatile("s_waitcnt lgkmcnt(" #n ")" ::: "memory")
#define PG8_BAR __builtin_amdgcn_s_barrier()
#define PG8_SCHED __builtin_amdgcn_sched_barrier(0)
    Unit cur, nxt; UD cd, nd; unsigned cva[4]; int ui = 0;
    if (!S.next(0, cur)) return;
    S.desc(cur, cd); S.desc_va(0, cur, cva);
    constexpr int RELAX = 8 + Epi::NPRE + Epi::NST; static_assert(RELAX <= 63, "vmcnt is 6 bits");
    E.prefetch(cur, lds + BIAS_OFF + wid * 1024, lane);
    f32x4 acc[2][2][4][2];
#pragma unroll
    for (int a = 0; a < 2; ++a)
#pragma unroll
        for (int b = 0; b < 2; ++b)
#pragma unroll
            for (int m = 0; m < 4; ++m)
#pragma unroll
                for (int n = 0; n < 2; ++n) acc[a][b][m][n] = (f32x4){0.f, 0.f, 0.f, 0.f};
    i32x8 At[4], B0[2], B1[2];
    PG8_STB(PG8_SB(0, 0), cd.b0); PG8_STB(PG8_SB(0, 1), cd.b1); PG8_STA(PG8_SA(0, 0), cd.a, cva, 0); PG8_STA(PG8_SA(0, 1), cd.a, cva, 1);
    if (wr == 1) PG8_BAR;
    PG8_WAIT_V(2); PG8_BAR;
    PG8_STB(PG8_SB(1, 0), cd.b0 + kstep); PG8_STA(PG8_SA(1, 0), cd.a + kstep, cva, 0); PG8_STB(PG8_SB(1, 1), cd.b1 + kstep); PG8_STA(PG8_SA(1, 1), cd.a + kstep, cva, 1);
    PG8_WAIT_V(8); PG8_BAR;
    for (;;) {
        const bool has_next = S.next(ui + 1, nxt);
        if (has_next) S.desc(nxt, nd); else nd = cd;
#pragma clang loop unroll(disable)
        for (int t = 0; t < nt; t += 2) {
            const bool last = (t == nt - 2); const int seam = __builtin_amdgcn_readfirstlane((t == 0 && ui > 0) ? 1 : 0);
            const char* a2 = last ? nd.a : cd.a + (size_t)(t + 2) * kstep;
            const char* b20 = last ? nd.b0 : cd.b0 + (size_t)(t + 2) * kstep; const char* b21 = last ? nd.b1 : cd.b1 + (size_t)(t + 2) * kstep;
            const char* a3 = a2 + kstep; const char* b30 = b20 + kstep; const char* b31 = b21 + kstep;
            PG8_LDB(B0, 0, 0); PG8_LDB(B1, 0, 1); PG8_SCHED; PG8_LDA(At, 0, 0);
            PG8_WAIT_SEAM(seam);
            PG8_WAIT_L(0); PG8_BAR; PG8_MMA(0, 0, At, B0); PG8_MMA(0, 1, At, B1); PG8_BAR; PG8_SCHED;
            if (last && has_next) S.desc_va(ui + 1, nxt, cva);
            PG8_LDA(At, 0, 1); PG8_STB(PG8_SB(0, 0), b20); PG8_STB(PG8_SB(0, 1), b21); PG8_STA(PG8_SA(0, 0), a2, cva, 0);
            PG8_WAIT_SEAM(seam);
            PG8_WAIT_L(0); PG8_BAR; PG8_MMA(1, 0, At, B0); PG8_MMA(1, 1, At, B1); PG8_BAR; PG8_SCHED;
            PG8_LDB(B0, 1, 0); PG8_LDB(B1, 1, 1); PG8_SCHED; PG8_LDA(At, 1, 0); PG8_STA(PG8_SA(0, 1), a2, cva, 1);
            PG8_WAIT_SEAM(seam);
            PG8_WAIT_L(0); PG8_BAR; PG8_MMA(0, 0, At, B0); PG8_MMA(0, 1, At, B1); PG8_BAR; PG8_SCHED;
            PG8_LDA(At, 1, 1); PG8_STB(PG8_SB(1, 0), b30); PG8_STB(PG8_SB(1, 1), b31); PG8_STA(PG8_SA(1, 0), a3, cva, 0);
            PG8_WAIT_V(8); PG8_WAIT_L(0); PG8_BAR; PG8_MMA(1, 0, At, B0); PG8_MMA(1, 1, At, B1); PG8_BAR; PG8_SCHED;
            PG8_STA(PG8_SA(1, 1), a3, cva, 1);
        }
        if (has_next) E.prefetch(nxt, lds + BIAS_OFF + (((ui + 1) & 1) * 8 + wid) * 1024, lane);
        if (wr == 0) PG8_BAR;
        E(acc, cur, wr, wc, fr, fq, lds + BIAS_OFF + ((ui & 1) * 8 + wid) * 1024);
        if (!has_next) break;
#pragma unroll
        for (int a = 0; a < 2; ++a)
#pragma unroll
            for (int b = 0; b < 2; ++b)
#pragma unroll
                for (int m = 0; m < 4; ++m)
#pragma unroll
                    for (int n = 0; n < 2; ++n) acc[a][b][m][n] = (f32x4){0.f, 0.f, 0.f, 0.f};
        cur = nxt; cd = nd;
        ++ui;
        if (wr == 1) PG8_BAR;
    }
    PG8_WAIT_V(0);
    PG8_BAR;
#undef PG8_SA
#undef PG8_SB
#undef PG8_STA
#undef PG8_STB
#undef PG8_LDA
#undef PG8_LDB
#undef PG8_MMA
#undef PG8_LD8
#undef PG8_HALF
#undef PG8_WAIT_V
#undef PG8_WAIT_SEAM
#undef PG8_WAIT_L
#undef PG8_BAR
#undef PG8_SCHED
}
}

struct Frame {
    LAS unsigned char* lds;
    volatile LAS unsigned* MISC;
    gu32* ctl;
    int wave, G;
    unsigned char* ws;
};
struct Args { const float* in[15]; float* out; unsigned char* ws; };
#define KARG ((const __attribute__((address_space(4))) Args*)__builtin_amdgcn_kernarg_segment_ptr())
#define FIN(i) (KARG->in[i])
#define FOUT (KARG->out)

struct ProbDense {
    const char* A; const char* Bt; int lda, ldb, Kb, nM, nN, G, c, wave;
    __device__ __forceinline__ bool next(int i, pg8::Unit& u) const { u.e = 0; return pg8::order_next(i, G, c, nM, nN, u.pm, u.pn); }
    __device__ __forceinline__ void desc(const pg8::Unit& u, pg8::UD& d) const { d.a = pg8::uni_ptr(A + (size_t)u.pm * 256 * lda); d.b0 = pg8::uni_ptr(Bt + (size_t)u.pn * 256 * ldb); d.b1 = d.b0 + (size_t)128 * ldb; }
    __device__ __forceinline__ void desc_va(int, const pg8::Unit&, unsigned (&va)[4]) const {
#pragma unroll
        for (int i = 0; i < 2; ++i) { int R, C; pg8::stage_rc((wave * 64 + lane_id()) * 16 + i * 8192, R, C); va[i] = (unsigned)(R * lda + C * 2); va[2 + i] = va[i] + (unsigned)(128 * lda); }
    }
};
struct ProbPool {
    const char* A; const char* Bt; int ldb, Kb, G, c, wave;
    __device__ __forceinline__ bool next(int i, pg8::Unit& u) const { u.e = 0; return pg8::order_next(i, G, c, M / 256, 4, u.pm, u.pn); }
    __device__ __forceinline__ void desc(const pg8::Unit& u, pg8::UD& d) const { d.a = pg8::uni_ptr(A + (size_t)u.pm * 256 * D * 2 + (size_t)u.pn * 256 * 2); d.b0 = pg8::uni_ptr(Bt + (size_t)u.pn * 65536 * 2); d.b1 = d.b0 + (size_t)128 * 256 * 2; }
    __device__ __forceinline__ void desc_va(int, const pg8::Unit&, unsigned (&va)[4]) const {
#pragma unroll
        for (int i = 0; i < 2; ++i) { int R, C; pg8::stage_rc((wave * 64 + lane_id()) * 16 + i * 8192, R, C); va[i] = (unsigned)(R * D * 2 + C * 2); va[2 + i] = va[i] + (unsigned)(128 * D * 2); }
    }
};
struct ProbMoeUp {
    const char* A; const char* Bt; LAS unsigned char* lds; int ldb, Kb, nM, G, c, wave;
    __device__ __forceinline__ bool next(int i, pg8::Unit& u) const { if (!pg8::order_next(i, G, c, nM, 8, u.pm, u.pn)) return false; u.e = __builtin_amdgcn_readfirstlane((int)((const LAS unsigned char*)(lds + TAB_TEXP))[u.pm]); return true; }
    __device__ __forceinline__ void desc(const pg8::Unit& u, pg8::UD& d) const { d.a = pg8::uni_ptr(A); d.b0 = pg8::uni_ptr(Bt + ((size_t)u.e * 2048 + (size_t)u.pn * 256) * ldb); d.b1 = d.b0 + (size_t)128 * ldb; }
    __device__ __forceinline__ void desc_va(int ord, const pg8::Unit&, unsigned (&va)[4]) const {
        const LAS unsigned* rt = (const LAS unsigned*)(lds + TAB_ROW) + ord * 256;
#pragma unroll
        for (int i = 0; i < 2; ++i) { int R, C; pg8::stage_rc((wave * 64 + lane_id()) * 16 + i * 8192, R, C); va[i] = rt[R] + (unsigned)(C * 2); va[2 + i] = rt[128 + R] + (unsigned)(C * 2); }
    }
};
struct ProbMoeDown {
    const char* A; const char* Bt; LAS unsigned char* lds; int ldb, Kb, nM, G, c, wave;
    __device__ __forceinline__ bool next(int i, pg8::Unit& u) const { if (!pg8::order_next(i, G, c, nM, 4, u.pm, u.pn)) return false; u.e = __builtin_amdgcn_readfirstlane((int)((const LAS unsigned char*)(lds + TAB_TEXP))[u.pm]); return true; }
    __device__ __forceinline__ void desc(const pg8::Unit& u, pg8::UD& d) const { d.a = pg8::uni_ptr(A + (size_t)u.pm * 256 * ldb); d.b0 = pg8::uni_ptr(Bt + ((size_t)u.e * 1024 + (size_t)u.pn * 256) * ldb); d.b1 = d.b0 + (size_t)128 * ldb; }
    __device__ __forceinline__ void desc_va(int, const pg8::Unit&, unsigned (&va)[4]) const {
#pragma unroll
        for (int i = 0; i < 2; ++i) { int R, C; pg8::stage_rc((wave * 64 + lane_id()) * 16 + i * 8192, R, C); va[i] = (unsigned)(R * ldb + C * 2); va[2 + i] = va[i] + (unsigned)(128 * ldb); }
    }
};

struct EpiPool {
    static constexpr bool PERM = false; static constexpr int NST = 32, NPRE = 0;
    const float* x; float* X1; const float* scale;
    __device__ __forceinline__ void prefetch(const pg8::Unit&, LAS unsigned char*, int) const {}

    __device__ __forceinline__ void operator()(const f32x4 (&acc)[2][2][4][2], const pg8::Unit& u, int wr, int wc, int fr, int fq, LAS unsigned char* bl) const {
        const int row0 = u.pm * 256 + wr * 64 + fr, col0 = u.pn * 256 + wc * 32 + 4 * fq;
        f32x4 sv[2][2];
#pragma unroll
        for (int bj = 0; bj < 2; ++bj)
#pragma unroll
            for (int n = 0; n < 2; ++n) sv[bj][n] = *(const f32x4*)(scale + col0 + bj * 128 + n * 16);
#pragma unroll
        for (int ai = 0; ai < 2; ++ai)
#pragma unroll
            for (int m = 0; m < 4; ++m) { const size_t off = (size_t)(row0 + ai * 128 + m * 16) * D + col0;
#pragma unroll
                for (int bj = 0; bj < 2; ++bj)
#pragma unroll
                    for (int n = 0; n < 2; ++n) { const f32x4 xv = *(const f32x4*)(x + off + bj * 128 + n * 16); *(f32x4*)(X1 + off + bj * 128 + n * 16) = xv + acc[ai][bj][m][n] * sv[bj][n]; }
                if (m & 1) asm volatile("" ::: "memory"); }
    }
};
struct EpiRes {
    static constexpr bool PERM = false; static constexpr int NST = 32, NPRE = 0;
    const float* Xi; float* Xo;
    __device__ __forceinline__ void prefetch(const pg8::Unit&, LAS unsigned char*, int) const {}

    __device__ __forceinline__ void operator()(const f32x4 (&acc)[2][2][4][2], const pg8::Unit& u, int wr, int wc, int fr, int fq, LAS unsigned char* bl) const {
        const int row0 = u.pm * 256 + wr * 64 + fr, col0 = u.pn * 256 + wc * 32 + 4 * fq;
#pragma unroll
        for (int ai = 0; ai < 2; ++ai)
#pragma unroll
            for (int m = 0; m < 4; ++m) { const size_t off = (size_t)(row0 + ai * 128 + m * 16) * D + col0;
#pragma unroll
                for (int bj = 0; bj < 2; ++bj)
#pragma unroll
                    for (int n = 0; n < 2; ++n) { const f32x4 xv = *(const f32x4*)(Xi + off + bj * 128 + n * 16); *(f32x4*)(Xo + off + bj * 128 + n * 16) = xv + acc[ai][bj][m][n]; }
                if (m & 1) asm volatile("" ::: "memory"); }
    }
};
struct EpiQKV {
    static constexpr bool PERM = true; static constexpr int NST = 16, NPRE = 0;
    bf16* QKV; const LAS float* gl;
    __device__ __forceinline__ void prefetch(const pg8::Unit&, LAS unsigned char*, int) const {}

    __device__ __forceinline__ void operator()(const f32x4 (&acc)[2][2][4][2], const pg8::Unit& u, int wr, int wc, int fr, int fq, LAS unsigned char* bl) const {
        const int seg = u.pn >> 2, head = (u.pn & 3) * 4 + wc;
        f32x4 gv[2][2];
#pragma unroll
        for (int bj = 0; bj < 2; ++bj)
#pragma unroll
            for (int n = 0; n < 2; ++n) {
                if (seg == 2) gv[bj][n] = (f32x4){1.f, 1.f, 1.f, 1.f};
                else { const LAS float* g = gl + seg * 64 + bj * 32 + 8 * fq + 4 * n; gv[bj][n] = *(const LAS f32x4*)g; if (seg == 0) gv[bj][n] = gv[bj][n] * C2; } }
        bf16* base = QKV + (size_t)seg * M * D;
#pragma unroll
        for (int ai = 0; ai < 2; ++ai)
#pragma unroll
            for (int m = 0; m < 4; ++m) {
                const int t = u.pm * 256 + ai * 128 + wr * 64 + m * 16 + fr, b = t >> 11, s = t & (SEQ - 1);
                float rstd = 1.f;
                if (seg < 2) { float ss = 0.f;
#pragma unroll
                    for (int bj = 0; bj < 2; ++bj)
#pragma unroll
                        for (int n = 0; n < 2; ++n) { const f32x4 v = acc[ai][bj][m][n]; ss += (v[0] * v[0] + v[1] * v[1]) + (v[2] * v[2] + v[3] * v[3]); }
                    ss += __shfl_xor(ss, 16); ss += __shfl_xor(ss, 32);
                    rstd = 1.0f / sqrtf(ss * (1.0f / 64.0f) + RMS_EPS); }
                bf16* rowp = base + ((size_t)(b * NH + head) * SEQ + s) * HD + 8 * fq;
#pragma unroll
                for (int bj = 0; bj < 2; ++bj) { const f32x4 v0 = acc[ai][bj][m][0] * rstd * gv[bj][0], v1 = acc[ai][bj][m][1] * rstd * gv[bj][1];
                    u32x4 w; w.x = cvtpk(v0[0], v0[1]); w.y = cvtpk(v0[2], v0[3]); w.z = cvtpk(v1[0], v1[1]); w.w = cvtpk(v1[2], v1[3]);
                    *(u32x4*)(rowp + bj * 32) = w; }
            }
    }
};
template <bool OUT8> struct EpiGateUp {
    static constexpr bool PERM = true; static constexpr int NST = 8, NPRE = 1;
    bf16* ACT; const float* bias;
    __device__ __forceinline__ void prefetch(const pg8::Unit& u, LAS unsigned char* bl, int lane) const {
        pg8::glds_sv(pg8::uni_ptr((const char*)(bias + (size_t)u.e * 2048 + u.pn * 128)), (unsigned)((lane & 31) * 16 + (lane >> 5) * 4096), (unsigned)__builtin_amdgcn_readfirstlane((int)(unsigned)(uintptr_t)bl)); }
    __device__ __forceinline__ void operator()(const f32x4 (&acc)[2][2][4][2], const pg8::Unit& u, int wr, int wc, int fr, int fq, LAS unsigned char* bl) const {
        { const int le = lane_id(); fr = le & 15; fq = le >> 4; }
        const int lc = u.pn * 128 + wc * 32 + 8 * fq;
        const LAS float* bg = (const LAS float*)bl + wc * 32 + 8 * fq;
        f32x4 bv[2][2];
#pragma unroll
        for (int bj = 0; bj < 2; ++bj)
#pragma unroll
            for (int n = 0; n < 2; ++n) bv[bj][n] = *(const LAS f32x4*)(bg + bj * 128 + 4 * n) + (bj ? 1.0f : 0.0f);
#pragma unroll
        for (int ai = 0; ai < 2; ++ai)
#pragma unroll
            for (int m = 0; m < 4; ++m) {
                const size_t eoff = (size_t)(u.pm * 256 + ai * 128 + wr * 64 + m * 16 + fr) * FF + lc;
                float o[8];
                constexpr float OS = OUT8 ? S8_ACT : 1.0f, IOS = 1.0f / OS;
#pragma unroll
                for (int n = 0; n < 2; ++n) { const f32x4 g4 = acc[ai][0][m][n] + bv[0][n], u4 = acc[ai][1][m][n] + bv[1][n];
#pragma unroll
                    for (int i = 0; i < 4; ++i) { const float g = fminf(g4[i], SW_LIMIT), up1 = __builtin_amdgcn_fmed3f(u4[i], 1.0f - SW_LIMIT, 1.0f + SW_LIMIT);
                        const float sg = __builtin_amdgcn_rcpf(__builtin_fmaf(__builtin_amdgcn_exp2f(g * (-SW_ALPHA * 1.4426950408889634f)), IOS, IOS));
                        o[n * 4 + i] = up1 * (g * sg); } }
                if constexpr (OUT8) { u32x2 w; w.x = cvtfp8x4(o[0], o[1], o[2], o[3]); w.y = cvtfp8x4(o[4], o[5], o[6], o[7]);
                    *(u32x2*)((unsigned char*)ACT + eoff) = w; }
                else { u32x4 w; w.x = cvtpk(o[0], o[1]); w.y = cvtpk(o[2], o[3]); w.z = cvtpk(o[4], o[5]); w.w = cvtpk(o[6], o[7]);
                    *(u32x4*)(ACT + eoff) = w; }
            }
    }
};
template <bool OUT8> struct EpiDown {
    static constexpr bool PERM = true; static constexpr int NST = 16, NPRE = 1;
    bf16* OUTS; const float* bias;
    __device__ __forceinline__ void prefetch(const pg8::Unit& u, LAS unsigned char* bl, int lane) const {
        pg8::glds_sv(pg8::uni_ptr((const char*)(bias + (size_t)u.e * 1024 + u.pn * 256)), (unsigned)(lane * 16), (unsigned)__builtin_amdgcn_readfirstlane((int)(unsigned)(uintptr_t)bl)); }
    __device__ __forceinline__ void operator()(const f32x4 (&acc)[2][2][4][2], const pg8::Unit& u, int wr, int wc, int fr, int fq, LAS unsigned char* bl) const {
        const int col0 = u.pn * 256 + wc * 32 + 8 * fq;
        const LAS float* bd = (const LAS float*)bl + wc * 32 + 8 * fq;
        f32x4 bv[2][2];
#pragma unroll
        for (int bj = 0; bj < 2; ++bj)
#pragma unroll
            for (int n = 0; n < 2; ++n) bv[bj][n] = *(const LAS f32x4*)(bd + bj * 128 + 4 * n);
#pragma unroll
        for (int ai = 0; ai < 2; ++ai)
#pragma unroll
            for (int m = 0; m < 4; ++m) { bf16* rowp = OUTS + (size_t)(u.pm * 256 + ai * 128 + wr * 64 + m * 16 + fr) * D + col0;
#pragma unroll
                for (int bj = 0; bj < 2; ++bj) { const f32x4 v0 = acc[ai][bj][m][0] + bv[bj][0], v1 = acc[ai][bj][m][1] + bv[bj][1];
                    if constexpr (OUT8) { u32x2 w; w.x = cvtfp8x4(v0[0] * S8_OUT, v0[1] * S8_OUT, v0[2] * S8_OUT, v0[3] * S8_OUT); w.y = cvtfp8x4(v1[0] * S8_OUT, v1[1] * S8_OUT, v1[2] * S8_OUT, v1[3] * S8_OUT);
                        *(u32x2*)((unsigned char*)OUTS + (size_t)(u.pm * 256 + ai * 128 + wr * 64 + m * 16 + fr) * D + col0 + bj * 128) = w; }
                    else { u32x4 w; w.x = cvtpk(v0[0], v0[1]); w.y = cvtpk(v0[2], v0[3]); w.z = cvtpk(v1[0], v1[1]); w.w = cvtpk(v1[2], v1[3]);
                        *(u32x4*)(rowp + bj * 128) = w; } } }
    }
};

constexpr int CV_POOL = 4 * 2 * 4, CV_QKV = 8 * 48, CV_WO = 8 * 16, CV_GU1 = 32 * 8 * 32  , CV_DN1 = 32 * 8 * 16  ;
constexpr int CV_SMALL = CV_POOL + CV_QKV + CV_WO, CV_END = CV_SMALL + 2 * (CV_GU1 + CV_DN1);
struct CvtItem { const float* src; unsigned char* dst; int N, dpitch, fp8, hs; };
__device__ __forceinline__ CvtItem cvt_decode(Frame& F, int it) {
    CvtItem c; int r = it; c.fp8 = 0; c.hs = 32;
    if (r < CV_POOL) { const int g = r >> 3, q = r & 7, kb = q >> 2, nb = q & 3; c.N = 256; c.dpitch = 512;
        c.src = FIN(2) + (size_t)g * 65536 + (size_t)(kb * 128) * 256 + nb * 64; c.dst = F.ws + WS_POOLW + ((size_t)g * 65536 + (size_t)(nb * 64) * 256 + kb * 128) * 2; return c; }
    r -= CV_POOL;
    if (r < CV_QKV) { const int kb = r / 48, nb = r % 48, n0 = nb * 64, pn = n0 >> 8, w = (n0 & 255) >> 6; c.N = 3 * D; c.dpitch = 2 * D; c.hs = 128;
        c.src = FIN(4) + (size_t)(kb * 128) * (3 * D) + n0; c.dst = F.ws + WS_WQKV + ((size_t)(256 * pn + 32 * w) * D + kb * 128) * 2; return c; }
    r -= CV_QKV;
    if (r < CV_WO) { const int kb = r >> 4, nb = r & 15; c.N = D; c.dpitch = 2 * D;
        c.src = FIN(7) + (size_t)(kb * 128) * D + nb * 64; c.dst = F.ws + WS_WO + ((size_t)(nb * 64) * D + kb * 128) * 2; return c; }
    r -= CV_WO;
    int layer = 0;
    if (r >= CV_GU1 + CV_DN1) { r -= CV_GU1 + CV_DN1; layer = 1; }
    if (r < CV_GU1) { const int mat = layer * NE + (r >> 8), q = r & 255, kb = q >> 5, nb = q & 31; c.N = 2 * FF; c.fp8 = (layer == 1 || FP8_U0); c.dpitch = c.fp8 ? D : 2 * D;
        c.src = FIN(11) + (size_t)mat * D * 2 * FF + (size_t)(kb * 128) * (2 * FF) + nb * 64;
        const int n0 = nb * 64, cg = n0 & (FF - 1), drow = (cg >> 7) * 256 + (n0 >= FF ? 128 : 0) + (cg & 127);
        c.dst = c.fp8 ? F.ws + WS_WGU8 + (size_t)(1 - layer) * 64 * MiB + (size_t)(mat - layer * NE) * 2 * FF * D + (size_t)drow * D + kb * 128 : F.ws + WS_WGU + ((size_t)mat * 2 * FF * D + (size_t)drow * D + kb * 128) * 2; return c; }
    r -= CV_GU1;
    { const int mat = layer * NE + (r >> 7), q = r & 127, kb = q >> 4, nb = q & 15; c.N = D; c.fp8 = (layer == 1 || FP8_D0); c.dpitch = c.fp8 ? FF : 2 * FF;
        c.src = FIN(13) + (size_t)mat * FF * D + (size_t)(kb * 128) * D + nb * 64;
        c.dst = c.fp8 ? F.ws + WS_WDN8 + (size_t)(1 - layer) * 32 * MiB + (size_t)(mat - layer * NE) * D * FF + (size_t)(nb * 64) * FF + kb * 128 : F.ws + WS_WDN + ((size_t)mat * D * FF + (size_t)(nb * 64) * FF + kb * 128) * 2; return c; }
}
__device__ __forceinline__ void cvt_load(const CvtItem& c, int half, f32x4 (&v)[16], int lane) {
    const float* p = c.src + (size_t)(64 * half + (lane >> 4)) * c.N + 4 * (lane & 15);
#pragma unroll
    for (int i = 0; i < 16; ++i) v[i] = __builtin_nontemporal_load((const f32x4*)(p + (size_t)(4 * i) * c.N));
}
__device__ __forceinline__ s16x4 cvt_tr(LAS const unsigned char* p) { return __builtin_bit_cast(s16x4, __builtin_amdgcn_ds_read_tr16_b64_v4i16((LAS v4i16_t*)p)); }
constexpr int CVP = 136;
__device__ __forceinline__ void cvt_to_lds(const f32x4 (&v)[16], int half, LAS unsigned char* scr, int lane) {
    LAS unsigned char* wp = scr + (64 * half + (lane >> 4)) * CVP + (lane & 15) * 8;
#pragma unroll
    for (int i = 0; i < 16; ++i) { u32x2 w; w.x = cvtpk(v[i][0], v[i][1]); w.y = cvtpk(v[i][2], v[i][3]); *(LAS u32x2*)(wp + 4 * i * CVP) = w; }
}
__device__ __forceinline__ void cvt_emit(const CvtItem& c, LAS unsigned char* scr, int lane) {
    LDS_WAIT(); asm volatile("" ::: "memory");
    const int g = lane >> 4, i16 = lane & 15, r = i16 >> 2, cc = i16 & 3;
    if (c.fp8) {
#pragma unroll
        for (int nb = 0; nb < 4; ++nb)
#pragma unroll
            for (int ps = 0; ps < 2; ++ps) { const int kc = 4 * ps + g; LAS const unsigned char* rp = scr + (16 * kc + r) * CVP + cc * 8 + nb * 32;
                u32x4 o;
#pragma unroll
                for (int h = 0; h < 4; ++h) { const u32x2 t = __builtin_bit_cast(u32x2, cvt_tr(rp + (4 * h) * CVP));
                    const unsigned a = t.x + 0x03000300u, b = t.y + 0x03000300u;
                    o[h] = cvtfp8x4(__uint_as_float(a << 16), __uint_as_float(a & 0xffff0000u), __uint_as_float(b << 16), __uint_as_float(b & 0xffff0000u)); }
                const int n = 16 * nb + i16;
                *(u32x4*)(c.dst + (size_t)((n >> 5) * c.hs + (n & 31)) * c.dpitch + 16 * kc) = o; }
    } else {
#pragma unroll
        for (int nb = 0; nb < 4; ++nb)
#pragma unroll
            for (int ps = 0; ps < 4; ++ps) { const int kc = 4 * ps + g; LAS const unsigned char* rp = scr + (8 * kc + r) * CVP + cc * 8 + nb * 32;
                const u32x2 t0 = __builtin_bit_cast(u32x2, cvt_tr(rp)), t1 = __builtin_bit_cast(u32x2, cvt_tr(rp + 4 * CVP));
                const int n = 16 * nb + i16;
                *(u32x4*)(c.dst + (size_t)((n >> 5) * c.hs + (n & 31)) * c.dpitch + 16 * kc) = (u32x4){t0.x, t0.y, t1.x, t1.y}; }
    }
    LDS_WAIT(); asm volatile("" ::: "memory");
}
__device__ __forceinline__ void phase_convert(Frame& F, int item_lo, int item_hi, int bidx, int nblk) {
    const int lane = lane_id();
    LAS unsigned char* scr = F.lds + (F.wave < 7 ? F.wave * 17408 : 133120);
    const int gw = bidx * NWAVES + F.wave, NGW = nblk * NWAVES;
    int it = item_lo + gw; if (it >= item_hi) return;
    CvtItem c = cvt_decode(F, it); f32x4 va[16], vb[16]; cvt_load(c, 0, va, lane); cvt_load(c, 1, vb, lane);
    for (;;) {
        cvt_to_lds(va, 0, scr, lane); cvt_to_lds(vb, 1, scr, lane);
        const int itn = it + NGW; const bool more = itn < item_hi;
        CvtItem cn = c;
        if (more) { cn = cvt_decode(F, itn); cvt_load(cn, 0, va, lane); cvt_load(cn, 1, vb, lane); }
        cvt_emit(c, scr, lane);
        if (!more) break;
        c = cn; it = itn;
    }
}
__device__ __forceinline__ void phase_pooled(Frame& F, int bidx, int nblk) {
    const int lane = lane_id(), tid = F.wave * 64 + lane; (void)tid;
    LAS float* H = (LAS float*)F.lds;
    LAS float* RS = (LAS float*)(F.lds + 81920);
    bf16* P = (bf16*)(F.ws + WS_POOLED);
    for (int tile = bidx; tile < M / 64; tile += nblk) {
        const int t0 = tile * 64, s0 = t0 & (SEQ - 1);
        for (int i = F.wave; i < 79; i += NWAVES) {
            const int s = s0 - 15 + i; float r = 0.f;
            if (s >= 0) { const f32x4* xr = (const f32x4*)(FIN(0) + (size_t)(t0 - 15 + i) * D) + lane; float ss = 0.f;
#pragma unroll
                for (int j = 0; j < 4; ++j) { const f32x4 v = xr[64 * j]; ss += (v[0] * v[0] + v[1] * v[1]) + (v[2] * v[2] + v[3] * v[3]); }
                ss = wave_sum(ss); r = 1.0f / sqrtf(ss * (1.0f / D) + RMS_EPS); }
            if (lane == 0) RS[i] = r;
        }
        __syncthreads();
        for (int g = 0; g < 4; ++g) {
            const f32x4 gn = *((const f32x4*)(FIN(1) + g * 256) + lane);
            for (int i = F.wave; i < 79; i += NWAVES) {
                const int s = s0 - 15 + i; f32x4 v = (f32x4){0.f, 0.f, 0.f, 0.f};
                if (s >= 0) { v = *((const f32x4*)(FIN(0) + (size_t)(t0 - 15 + i) * D + g * 256) + lane); v = v * RS[i] * gn; }
                *((LAS f32x4*)(H + i * 256) + lane) = v;
            }
            __syncthreads();
            const int w = 2 << g, cp = tid & 127, rq = tid >> 7, i0 = 15 + rq * 16;
            const LAS f32x2* H2p = (const LAS f32x2*)H + cp;
            f32x2 S = (f32x2){0.f, 0.f};
            for (int j = i0 - w + 1; j <= i0; ++j) S += H2p[j * 128];
            for (int r = 0; r < 16; ++r) {
                const int i = i0 + r;
                if (r > 0) S += H2p[i * 128] - H2p[(i - w) * 128];
                const int s = s0 + rq * 16 + r; const int cnt = (s + 1 < w) ? (s + 1) : w;
                const f32x2 h = H2p[i * 128]; const float inv = 1.0f / (float)cnt;
                const f32x2 pv = S * inv - h;
                *(unsigned*)(P + (size_t)(t0 + rq * 16 + r) * D + g * 256 + 2 * cp) = cvtpk(pv[0], pv[1]);
            }
            __syncthreads();
        }
    }
}

__device__ __forceinline__ void moe_tables(Frame& F, int layer) {
    const int lane = lane_id(), tid = F.wave * 64 + lane; (void)tid;
    LAS int* ecnt = (LAS int*)(F.lds + TAB_ECNT); LAS int* tbase = (LAS int*)(F.lds + TAB_TBASE); LAS unsigned char* texp = (LAS unsigned char*)(F.lds + TAB_TEXP);
    if (tid < NE) ecnt[tid] = (int)__hip_atomic_load(F.ctl + CW_ECNT + layer * 2048 + tid * 64, RLX_AGENT);
    __syncthreads();
    if (tid == 0) { int a = 0; for (int e = 0; e < NE; ++e) { tbase[e] = a; a += (ecnt[e] + 255) >> 8; } tbase[NE] = a; }
    __syncthreads();
    if (tid < MT_MAX) { int e = 0; for (int q = 1; q < NE; ++q) if (tid >= tbase[q]) e = q; texp[tid] = (unsigned char)e; }
    __syncthreads();
}
template <bool H8>
__device__ __forceinline__ void phase_router(Frame& F, const float* src, const float* gain, bf16* dstH, int layer, int bidx, int nblk) {
    const int cl = layer;
    const int lane = lane_id(), tid = F.wave * 64 + lane;
    f32x4 gn[4];
#pragma unroll
    for (int j = 0; j < 4; ++j) gn[j] = *((const f32x4*)gain + lane + 64 * j);
    for (int tile = bidx; tile < M / 64; tile += nblk) {
        f32x4 v[8][4];
#pragma unroll
        for (int rr = 0; rr < 8; ++rr) {
            const int t = tile * 64 + F.wave * 8 + rr;
            const f32x4* xr = (const f32x4*)(src + (size_t)t * D) + lane;
#pragma unroll
            for (int j = 0; j < 4; ++j) v[rr][j] = xr[64 * j];
            {
                float ss = 0.f;
#pragma unroll
                for (int j = 0; j < 4; ++j) ss += (v[rr][j][0] * v[rr][j][0] + v[rr][j][1] * v[rr][j][1]) + (v[rr][j][2] * v[rr][j][2] + v[rr][j][3] * v[rr][j][3]);
                ss = wave_sum(ss); const float rstd = 1.0f / sqrtf(ss * (1.0f / D) + RMS_EPS);
                if constexpr (H8) { unsigned* ho = (unsigned*)((unsigned char*)dstH + (size_t)t * D) + lane;
#pragma unroll
                    for (int j = 0; j < 4; ++j) { v[rr][j] = v[rr][j] * rstd * gn[j]; ho[64 * j] = cvtfp8x4(v[rr][j][0] * S8_H, v[rr][j][1] * S8_H, v[rr][j][2] * S8_H, v[rr][j][3] * S8_H); } }
                else { u32x2* ho = (u32x2*)(dstH + (size_t)t * D) + lane;
#pragma unroll
                    for (int j = 0; j < 4; ++j) { v[rr][j] = v[rr][j] * rstd * gn[j]; u32x2 o; o.x = cvtpk(v[rr][j][0], v[rr][j][1]); o.y = cvtpk(v[rr][j][2], v[rr][j][3]); ho[64 * j] = o; } }
            }
        }
        {
            LAS float* HT = (LAS float*)F.lds;
            LAS float* WC = (LAS float*)(F.lds + 66560);
            LAS float* PART = (LAS float*)F.lds;
            LAS float* LG = (LAS float*)(F.lds + 66560);
            LAS int* lcnt = (LAS int*)(F.lds + 99328);
            LAS int* gbase = (LAS int*)(F.lds + 99328 + 128);
            const float* RW = FIN(9) + (size_t)layer * D * NE; const float* RB = FIN(10) + layer * NE;
            const int th = F.wave & 1, kq = F.wave >> 1, r32 = lane & 31, hi = lane >> 5;
            f32x16 acc = {};
            for (int j = 0; j < 4; ++j) {
                __syncthreads();
#pragma unroll
                for (int rr = 0; rr < 8; ++rr)
#pragma unroll
                    for (int i = 0; i < 4; ++i) HT[(4 * lane + i) * 65 + F.wave * 8 + rr] = v[rr][j][i];
                { const f32x4* wsrc = (const f32x4*)(RW + (size_t)j * 256 * NE); LAS f32x4* wdst = (LAS f32x4*)WC;
#pragma unroll
                    for (int q = 0; q < 4; ++q) wdst[tid + 512 * q] = wsrc[tid + 512 * q]; }
                __syncthreads();
                const LAS float* ap = HT + (kq * 64 + hi) * 65 + th * 32 + r32; const LAS float* bp = WC + (kq * 64 + hi) * 32 + r32;
#pragma unroll 8
                for (int s = 0; s < 32; ++s) acc = __builtin_amdgcn_mfma_f32_32x32x2f32(ap[s * 2 * 65], bp[s * 2 * 32], acc, 0, 0, 0);
            }
            __syncthreads();
#pragma unroll
            for (int r = 0; r < 16; ++r) { const int tok = th * 32 + (r & 3) + 8 * (r >> 2) + 4 * hi; PART[(kq * 64 + tok) * 33 + r32] = acc[r]; }
            if (tid < NE) lcnt[tid] = 0;
            __syncthreads();
            for (int q = tid; q < 64 * NE; q += 512) { const int tok = q >> 5, e = q & 31;
                LG[tok * 33 + e] = ((PART[tok * 33 + e] + PART[(64 + tok) * 33 + e]) + (PART[(128 + tok) * 33 + e] + PART[(192 + tok) * 33 + e])) + RB[e]; }
            __syncthreads();
            int te[4], lp[4]; float tw[4];
            if (F.wave == 0) {
                const int tok = lane; unsigned used = 0u; float tv[4];
#pragma unroll
                for (int k = 0; k < 4; ++k) { float best = -INFINITY; int bi = 0;
                    for (int e = 0; e < NE; ++e) { const float xv = LG[tok * 33 + e]; if (!((used >> e) & 1u) && xv > best) { best = xv; bi = e; } }
                    used |= 1u << bi; tv[k] = best; te[k] = bi; }
                float sum = 0.f;
#pragma unroll
                for (int k = 0; k < 4; ++k) { tw[k] = __expf(tv[k] - tv[0]); sum += tw[k]; }
                const float inv = 1.0f / sum;
#pragma unroll
                for (int k = 0; k < 4; ++k) { tw[k] *= inv; lp[k] = atomicAdd((int*)(lcnt + te[k]), 1); }
            }
            __syncthreads();
            if (tid < NE) { const int c = lcnt[tid]; gbase[tid] = c > 0 ? (int)__hip_atomic_fetch_add(F.ctl + CW_ECNT + cl * 2048 + tid * 64, (unsigned)c, RLX_AGENT) : 0; }
            __syncthreads();
            if (F.wave == 0) {
                const int t = tile * 64 + lane;
                int* list = (int*)(F.ws + WS_LIST); int* tope_w = (int*)(F.ws + WS_TOPE); int* topp_w = (int*)(F.ws + WS_TOPP); float* topw_w = (float*)(F.ws + WS_TOPW);
#pragma unroll
                for (int k = 0; k < 4; ++k) { const int pos = gbase[te[k]] + lp[k]; list[te[k] * M + pos] = t; tope_w[t * 4 + k] = te[k]; topp_w[t * 4 + k] = pos; topw_w[t * 4 + k] = tw[k]; }
            }
            __syncthreads();
        }
    }
}

template <bool NORM, bool O8>
__device__ __forceinline__ void phase_combine(Frame& F, const float* src, float* dstX, const float* gain, bf16* dstH, int layer) {
    const int lane = lane_id();
    moe_tables(F, layer);
    const LAS int* tbase = (const LAS int*)(F.lds + TAB_TBASE);
    const int* tope = (const int*)(F.ws + WS_TOPE); const int* topp = (const int*)(F.ws + WS_TOPP); const float* topw = (const float*)(F.ws + WS_TOPW);
    const unsigned char* OUTS = F.ws + WS_OUTS;
    constexpr int ORB = O8 ? D : 2 * D;
    f32x4 gn[4];
    if (NORM) {
#pragma unroll
        for (int q = 0; q < 4; ++q) gn[q] = *(const f32x4*)(gain + 8 * lane + 512 * (q >> 1) + 4 * (q & 1)); }
    for (int tile = blockIdx.x; tile < M / 64; tile += F.G) {
        const int t0 = tile * 64 + F.wave * 8;
        int e_l = 0, p_l = 0; float w_l = 0.f;
        if (lane < 32) { e_l = tope[t0 * 4 + lane]; p_l = topp[t0 * 4 + lane]; w_l = topw[t0 * 4 + lane]; }
        const int slot_l = tbase[e_l] * 256 + p_l;
        if (O8) w_l *= (1.0f / S8_OUT);
#pragma unroll
        for (int b = 0; b < 2; ++b) {
            f32x4 x[4][4];
#pragma unroll
            for (int r = 0; r < 4; ++r) { const f32x4* xr = (const f32x4*)(src + (size_t)(t0 + 4 * b + r) * D + 8 * lane); x[r][0] = xr[0]; x[r][1] = xr[1]; x[r][2] = xr[128]; x[r][3] = xr[129]; }
            u32x4 o[4][4][O8 ? 1 : 2];
#pragma unroll
            for (int r = 0; r < 4; ++r)
#pragma unroll
                for (int k = 0; k < 4; ++k) { const int slot = __builtin_amdgcn_readlane(slot_l, (4 * b + r) * 4 + k); const unsigned char* ob = OUTS + (size_t)slot * ORB;
                    if constexpr (O8) { const u32x2 lo = *(const u32x2*)(ob + 8 * lane), hi = *(const u32x2*)(ob + 512 + 8 * lane); o[r][k][0] = (u32x4){lo.x, lo.y, hi.x, hi.y}; }
                    else { o[r][k][0] = *(const u32x4*)(ob + 16 * lane); o[r][k][1] = *(const u32x4*)(ob + 1024 + 16 * lane); } }
#pragma unroll
            for (int r = 0; r < 4; ++r) {
#pragma unroll
                for (int k = 0; k < 4; ++k) { const float wk = __uint_as_float((unsigned)__builtin_amdgcn_readlane((int)__float_as_uint(w_l), (4 * b + r) * 4 + k));
                    if constexpr (O8) {
#pragma unroll
                        for (int q = 0; q < 4; ++q) { const f32x2 a = __builtin_amdgcn_cvt_pk_f32_fp8((int)o[r][k][0][q], false), c = __builtin_amdgcn_cvt_pk_f32_fp8((int)o[r][k][0][q], true);
                            x[r][q] += (f32x4){a[0], a[1], c[0], c[1]} * wk; } }
                    else {
#pragma unroll
                        for (int j = 0; j < 2; ++j) { const u32x4 v = o[r][k][j];
                            x[r][2 * j] += (f32x4){bf_lo(v.x), bf_hi(v.x), bf_lo(v.y), bf_hi(v.y)} * wk; x[r][2 * j + 1] += (f32x4){bf_lo(v.z), bf_hi(v.z), bf_lo(v.w), bf_hi(v.w)} * wk; } } }
                const int t = t0 + 4 * b + r;
                { f32x4* xo = (f32x4*)(dstX + (size_t)t * D + 8 * lane); xo[0] = x[r][0]; xo[1] = x[r][1]; xo[128] = x[r][2]; xo[129] = x[r][3]; }
                if (NORM) {
                    float ss = 0.f;
#pragma unroll
                    for (int q = 0; q < 4; ++q) ss += (x[r][q][0] * x[r][q][0] + x[r][q][1] * x[r][q][1]) + (x[r][q][2] * x[r][q][2] + x[r][q][3] * x[r][q][3]);
                    ss = wave_sum(ss); const float rstd = 1.0f / sqrtf(ss * (1.0f / D) + RMS_EPS);
#pragma unroll
                    for (int j = 0; j < 2; ++j) { const f32x4 a = x[r][2 * j] * rstd * gn[2 * j], c = x[r][2 * j + 1] * rstd * gn[2 * j + 1];
                        *(u32x4*)(dstH + (size_t)t * D + 8 * lane + 512 * j) = (u32x4){cvtpk(a[0], a[1]), cvtpk(a[2], a[3]), cvtpk(c[0], c[1]), cvtpk(c[2], c[3])}; }
                }
            }
        }
    }
}

template <bool FP8, bool OUT8>
__device__ __forceinline__ void phase_moe_up(Frame& F, int layer, int G = 0  ) {
    if (G == 0) G = F.G;
    const int lane = lane_id(), tid = F.wave * 64 + lane; (void)tid;
    moe_tables(F, layer);
    const LAS int* ecnt = (const LAS int*)(F.lds + TAB_ECNT); const LAS int* tbase = (const LAS int*)(F.lds + TAB_TBASE);
    const int rowb = FP8 ? D : 2 * D;
    ProbMoeUp S{(const char*)(F.ws + WS_H2), FP8 ? (const char*)(F.ws + WS_WGU8) + (size_t)(1 - layer) * 64 * MiB : (const char*)(F.ws + WS_WGU) + (size_t)layer * NE * 2048 * 1024 * 2, F.lds, rowb, rowb, __builtin_amdgcn_readfirstlane(tbase[NE]), G, (int)blockIdx.x, F.wave};
    {
        const int* list = (const int*)(F.ws + WS_LIST); LAS unsigned* rt = (LAS unsigned*)(F.lds + TAB_ROW);
        pg8::Unit u;
#pragma nounroll
        for (int ord = 0; ord < MAXU && S.next(ord, u); ++ord) {
            if (tid < 256) { const int p = (u.pm - tbase[u.e]) * 256 + tid; const int tok = (p < ecnt[u.e]) ? list[u.e * M + p] : 0; rt[ord * 256 + tid] = (unsigned)tok * (unsigned)rowb; }
        }
        __syncthreads();
    }
    EpiGateUp<OUT8> E{(bf16*)(F.ws + WS_ACT), FIN(12) + (size_t)layer * NE * 2048};
    pg8::gemm_phase<ProbMoeUp, EpiGateUp<OUT8>, FP8, E8_UP>(F.lds, S, E);
}
template <bool FP8, bool OUT8>
__device__ __forceinline__ void phase_moe_down(Frame& F, int layer, int G = 0) {
    if (G == 0) G = F.G;
    moe_tables(F, layer);
    const LAS int* tbase = (const LAS int*)(F.lds + TAB_TBASE);
    const int rowb = FP8 ? FF : 2 * FF;
    ProbMoeDown S{(const char*)(F.ws + WS_ACT), FP8 ? (const char*)(F.ws + WS_WDN8) + (size_t)(1 - layer) * 32 * MiB : (const char*)(F.ws + WS_WDN) + (size_t)layer * NE * 1024 * 1024 * 2, F.lds, rowb, rowb, __builtin_amdgcn_readfirstlane(tbase[NE]), G, (int)blockIdx.x, F.wave};
    EpiDown<OUT8> E{(bf16*)(F.ws + WS_OUTS), FIN(14) + (size_t)layer * NE * 1024};
    pg8::gemm_phase<ProbMoeDown, EpiDown<OUT8>, FP8, E8_DOWN>(F.lds, S, E);
}

__device__ __forceinline__ int crow(int r, int hi) { return (r & 3) + 8 * (r >> 2) + 4 * hi; }
typedef LAS const char* lds_cptr;
__device__ __forceinline__ s16x4 vtr(lds_cptr p) { return __builtin_bit_cast(s16x4, __builtin_amdgcn_ds_read_tr16_b64_v4i16((LAS v4i16_t*)p)); }
__device__ __forceinline__ void attn_pair(Frame& F, int bh, int qbA, int qbB) {
    const int lane = lane_id(), r32 = lane & 31, hi = lane >> 5, wid = F.wave, sub = wid >> 2, ws = wid & 3, tids = ws * 64 + lane;
    const bf16* Qh = (const bf16*)(F.ws + WS_Q) + (size_t)bh * SEQ * HD; const bf16* Kh = (const bf16*)(F.ws + WS_K) + (size_t)bh * SEQ * HD; const bf16* Vh = (const bf16*)(F.ws + WS_V) + (size_t)bh * SEQ * HD;
    const int q0 = (sub ? qbB : qbA) * 128, qw = q0 + 32 * ws, qpos = qw + r32, jd = qw >> 6, jtop = (q0 >> 6) + 1;
    LAS unsigned char* KB = F.lds + sub * 32768; LAS unsigned char* VB = KB + 16384; LAS unsigned char* OST = F.lds + 65536 + wid * 4096;
    const bf16* ksrc[2]; const bf16* vsrc[2];
#pragma unroll
    for (int i = 0; i < 2; ++i) { const int p = tids + 256 * i, wv = p >> 6, l = p & 63;
        ksrc[i] = Kh + (size_t)l * HD + wv * 8; vsrc[i] = Vh + (size_t)(16 * (wv & 3) + (l >> 2)) * HD + (wv >> 2) * 32 + (l & 3) * 8; }
    bf16x8 qr[4];
#pragma unroll
    for (int d0 = 0; d0 < 4; ++d0) qr[d0] = *(const bf16x8*)(Qh + (size_t)qpos * HD + d0 * 16 + hi * 8);
    f32x16 o0 = {}, o1 = {};
    float C = 0.f;
    int cur = 0;
    bool done = false;
    LAS int* flags = (LAS int*)(F.lds + 65536 + 32768);
    {
#pragma unroll
      for (int i = 0; i < 2; ++i) { const u32x4 kk = *(const u32x4*)(ksrc[i] + (size_t)jtop * 64 * HD), vv = *(const u32x4*)(vsrc[i] + (size_t)jtop * 64 * HD);
          *(LAS u32x4*)(KB + (tids + 256 * i) * 16) = kk; *(LAS u32x4*)(VB + (tids + 256 * i) * 16) = vv; } }
    u32x4 kA[2], vA[2], kB[2], vB[2];
    if (jtop > 0) {
#pragma unroll
        for (int i = 0; i < 2; ++i) { kA[i] = *(const u32x4*)(ksrc[i] + (size_t)(jtop - 1) * 64 * HD); vA[i] = *(const u32x4*)(vsrc[i] + (size_t)(jtop - 1) * 64 * HD); } }
    __syncthreads();
    bool brk = false;
#define ATT_STEP(KL, VL, KS, VS) do { const int j = jtop - st; \
        if (j > 1) { _Pragma("unroll") for (int i = 0; i < 2; ++i) { KL[i] = *(const u32x4*)(ksrc[i] + (size_t)(j - 2) * 64 * HD); VL[i] = *(const u32x4*)(vsrc[i] + (size_t)(j - 2) * 64 * HD); } } \
        att_compute(j); \
        if (j > 0) { _Pragma("unroll") for (int i = 0; i < 2; ++i) { *(LAS u32x4*)(KB + (cur ^ 1) * 8192 + (tids + 256 * i) * 16) = KS[i]; *(LAS u32x4*)(VB + (cur ^ 1) * 8192 + (tids + 256 * i) * 16) = VS[i]; } } \
        if (lane == 0) flags[(st & 1) * 8 + wid] = (done || j <= 0) ? 1 : 0; \
        __syncthreads(); \
        brk = __all(flags[(st & 1) * 8 + (lane & 7)] != 0); cur ^= 1; ++st; } while (0)
    auto att_compute = [&](const int j) __attribute__((always_inline)) {
        if (j >= 0 && j <= jd && !done) {
            const lds_cptr kb = (lds_cptr)(KB + cur * 8192) + hi * 1024 + r32 * 16;
            f32x16 p0 = {}, p1 = {};
#pragma unroll
            for (int d0 = 0; d0 < 4; ++d0) { const bf16x8 b0 = *(const LAS bf16x8*)(kb + d0 * 2048), b1 = *(const LAS bf16x8*)(kb + d0 * 2048 + 512);
                p0 = __builtin_amdgcn_mfma_f32_32x32x16_bf16(b0, qr[d0], p0, 0, 0, 0); p1 = __builtin_amdgcn_mfma_f32_32x32x16_bf16(b1, qr[d0], p1, 0, 0, 0); }
            float L0[16], L1[16];
#pragma unroll
            for (int r = 0; r < 16; ++r) { L0[r] = __builtin_amdgcn_logf(1.0f + __builtin_amdgcn_exp2f(p0[r])); L1[r] = __builtin_amdgcn_logf(1.0f + __builtin_amdgcn_exp2f(p1[r])); }
            if (j == jd) {
                const int kb0 = 64 * j + 4 * hi;
#pragma unroll
                for (int r = 0; r < 16; ++r) { const int kv = kb0 + (r & 3) + 8 * (r >> 2);
                    if (kv >= qpos) { L0[r] = 0.f; p0[r] = -INFINITY; } if (kv + 32 >= qpos) { L1[r] = 0.f; p1[r] = -INFINITY; } }
            }
            float tg[8];
#pragma unroll
            for (int g = 0; g < 4; ++g) {
                L0[4 * g + 2] += L0[4 * g + 3]; L0[4 * g + 1] += L0[4 * g + 2]; L0[4 * g] += L0[4 * g + 1]; tg[g] = L0[4 * g];
                L1[4 * g + 2] += L1[4 * g + 3]; L1[4 * g + 1] += L1[4 * g + 2]; L1[4 * g] += L1[4 * g + 1]; tg[4 + g] = L1[4 * g]; }
            float off[8]; float R = C;
#pragma unroll
            for (int g = 7; g >= 0; --g) {
                const auto rr = __builtin_amdgcn_permlane32_swap(__float_as_uint(tg[g]), __float_as_uint(tg[g]), false, false);
                const float tlo = __uint_as_float(rr[0]), thi = __uint_as_float(rr[1]);
                off[g] = R + (hi ? 0.f : thi);
                R += tlo + thi; }
            C = R;
#pragma unroll
            for (int g = 0; g < 4; ++g)
#pragma unroll
                for (int i = 0; i < 4; ++i) { p0[4 * g + i] = __builtin_amdgcn_exp2f(p0[4 * g + i] - (L0[4 * g + i] + off[g])); p1[4 * g + i] = __builtin_amdgcn_exp2f(p1[4 * g + i] - (L1[4 * g + i] + off[4 + g])); }
            u32x4 pw0, pw1, pw2, pw3;
            pw0 = (u32x4){cvtpk(p0[0], p0[1]), cvtpk(p0[2], p0[3]), cvtpk(p0[4], p0[5]), cvtpk(p0[6], p0[7])};
            pw1 = (u32x4){cvtpk(p0[8], p0[9]), cvtpk(p0[10], p0[11]), cvtpk(p0[12], p0[13]), cvtpk(p0[14], p0[15])};
            pw2 = (u32x4){cvtpk(p1[0], p1[1]), cvtpk(p1[2], p1[3]), cvtpk(p1[4], p1[5]), cvtpk(p1[6], p1[7])};
            pw3 = (u32x4){cvtpk(p1[8], p1[9]), cvtpk(p1[10], p1[11]), cvtpk(p1[12], p1[13]), cvtpk(p1[14], p1[15])};
            const lds_cptr vp = (lds_cptr)(VB + cur * 8192) + ((lane >> 4) & 1) * 32 + (lane & 3) * 8 + (4 * hi + ((lane & 15) >> 2)) * 64;
#define PVSTEP(OACC, D0, KS, PW) do { const s16x4 lo_ = vtr(vp + (D0) * 4096 + (KS) * 1024), hi_ = vtr(vp + (D0) * 4096 + (KS) * 1024 + 512); \
                const bf16x8 vf_ = (bf16x8){lo_[0], lo_[1], lo_[2], lo_[3], hi_[0], hi_[1], hi_[2], hi_[3]}; \
                OACC = __builtin_amdgcn_mfma_f32_32x32x16_bf16(__builtin_bit_cast(bf16x8, PW), vf_, OACC, 0, 0, 0); } while (0)
            PVSTEP(o0, 0, 0, pw0); PVSTEP(o1, 1, 0, pw0); PVSTEP(o0, 0, 1, pw1); PVSTEP(o1, 1, 1, pw1);
            PVSTEP(o0, 0, 2, pw2); PVSTEP(o1, 1, 2, pw2); PVSTEP(o0, 0, 3, pw3); PVSTEP(o1, 1, 3, pw3);
#undef PVSTEP
            done = __all(C > 150.0f);
        }
    };
    for (int st = 0; ; ) {
        ATT_STEP(kB, vB, kA, vA); if (brk) break;
        ATT_STEP(kA, vA, kB, vB); if (brk) break;
    }
#undef ATT_STEP
    { LAS bf16* stg = (LAS bf16*)OST;
#pragma unroll
      for (int r = 0; r < 16; ++r) { const int orow = crow(r, hi); stg[orow * 64 + r32] = (bf16)(cvtpk(o0[r], 0.f) & 0xffffu); stg[orow * 64 + 32 + r32] = (bf16)(cvtpk(o1[r], 0.f) & 0xffffu); }
      LDS_WAIT(); asm volatile("" ::: "memory");
      const int b = bh >> 4, h = bh & 15;
      bf16* Ow = (bf16*)(F.ws + WS_O) + ((size_t)b * SEQ + qw) * D + h * HD;
#pragma unroll
      for (int i = 0; i < 4; ++i) { const int row = i * 8 + (lane >> 3), ch = lane & 7; const u32x4 vv = *(const LAS u32x4*)(stg + row * 64 + ch * 8); *(u32x4*)(Ow + (size_t)row * D + ch * 8) = vv; } }
    __syncthreads();
}
__device__ __forceinline__ void phase_attn(Frame& F) {
    for (int v = blockIdx.x; v < BATCH * NH * 2; v += F.G) {
        const int bh = v >> 1, odd = v & 1;
        for (int i = 0; i < 4; ++i) { const int qa = 8 * odd + 2 * i; attn_pair(F, bh, qa, qa + 1); }
    }
}

__global__ void __launch_bounds__(NWAVES * 64, 2) fwd_kernel(Args args) {
    extern __shared__ __attribute__((aligned(16))) unsigned char lds[];
    Frame F;
    F.lds = (LAS unsigned char*)lds; F.MISC = (volatile LAS unsigned*)(F.lds + MISC_OFF);
    F.wave = __builtin_amdgcn_readfirstlane((int)threadIdx.x >> 6); F.G = gridDim.x;
    F.ws = args.ws; F.ctl = (gu32*)(args.ws + WS_CTL);
    for (int u = (int)threadIdx.x; u < (LDS_BYTES - LDSCTL_OFF) / 4; u += NWAVES * 64) ((LAS unsigned*)(F.lds + LDSCTL_OFF))[u] = 0u;
    __syncthreads();
    const XcdBarrier bar = xcd_barrier_post((unsigned*)(F.ctl + CW_BAR), F.MISC + 8, gridDim.x);
#define TP_PUT(i) do { if (threadIdx.x == 0) { const unsigned long long t_ = __builtin_amdgcn_s_memrealtime(); F.MISC[16 + 2 * (i)] = (unsigned)t_; F.MISC[17 + 2 * (i)] = (unsigned)(t_ >> 32); } } while (0)
#define SEAM(k) do { xcd_barrier(bar); if (MK_TPROBE == ((k) == 0 ? 3 : (k) + 1)) TP_PUT(0); if (MK_TPROBE == (k)) TP_PUT(1); } while (0)
    if (MK_TPROBE == 0) TP_PUT(0);
    float* X1 = (float*)(F.ws + WS_X1); float* X2 = (float*)(F.ws + WS_X2); float* X3 = (float*)(F.ws + WS_X3);

    const bool tuned = (F.G == 256);
    const int nfront = tuned ? NFRONT : F.G, cv3 = tuned ? CV3 : 0, cv9 = tuned ? CV9 : 0;
    {
        const int bx = (int)blockIdx.x;
        if (bx < nfront) {
            const XcdBarrier fbar = xcd_barrier_post((unsigned*)(F.ctl + CW_BAR2), F.MISC + 10, (unsigned)nfront);
            phase_convert(F, 0, CV_SMALL, bx, nfront); __syncthreads();
            phase_pooled(F, bx, nfront);
            xcd_barrier(fbar);
            { ProbPool S{(const char*)(F.ws + WS_POOLED), (const char*)(F.ws + WS_POOLW), 512, 512, nfront, bx, F.wave}; EpiPool E{FIN(0), X1, FIN(3)};
              pg8::gemm_phase<ProbPool, EpiPool>(F.lds, S, E); }
            xcd_barrier(fbar);
            phase_router<FP8_U0>(F, X1, FIN(8), (bf16*)(F.ws + WS_H2), 0, bx, nfront);
            if (nfront == F.G) phase_convert(F, CV_SMALL, CV_END, bx, F.G);
        } else {
            phase_convert(F, CV_SMALL, CV_END - cv9 - cv3, bx - nfront, F.G - nfront);
        }
    }
    SEAM(0);
    { const int bx = (int)blockIdx.x;
        if (cv3 > 0 && bx >= G3) phase_convert(F, CV_END - cv9 - cv3, CV_END - cv9, bx - G3, F.G - G3);
        else phase_moe_up<FP8_U0, FP8_D0>(F, 0, cv3 > 0 ? G3 : 0); }
    SEAM(3);
    phase_moe_down<FP8_D0, false>(F, 0);
    SEAM(4);
    phase_combine<true, false>(F, X1, X2, FIN(1) + D, (bf16*)(F.ws + WS_HQ), 0);
    SEAM(5);
    { ProbDense S{(const char*)(F.ws + WS_HQ), (const char*)(F.ws + WS_WQKV), 2 * D, 2 * D, 2 * D, M / 256, 12, F.G, (int)blockIdx.x, F.wave}; { const int l_ = lane_id(); if (F.wave == 0) { ((LAS float*)(F.lds + BIAS_OFF))[l_] = FIN(5)[l_]; ((LAS float*)(F.lds + BIAS_OFF))[64 + l_] = FIN(6)[l_]; } __syncthreads(); }
        EpiQKV E{(bf16*)(F.ws + WS_Q), (const LAS float*)(F.lds + BIAS_OFF)};
        pg8::gemm_phase<ProbDense, EpiQKV>(F.lds, S, E); }
    SEAM(6);
    phase_attn(F);
    SEAM(7);
    { ProbDense S{(const char*)(F.ws + WS_O), (const char*)(F.ws + WS_WO), 2 * D, 2 * D, 2 * D, M / 256, 4, F.G, (int)blockIdx.x, F.wave}; EpiRes E{X2, X3};
        pg8::gemm_phase<ProbDense, EpiRes>(F.lds, S, E); }
    SEAM(8);
    {
        const int bx = (int)blockIdx.x;
        if (cv9 == 0) phase_router<true>(F, X3, FIN(8) + D, (bf16*)(F.ws + WS_H2), 1, bx, F.G);
        else if (bx < NR9) phase_router<true>(F, X3, FIN(8) + D, (bf16*)(F.ws + WS_H2), 1, bx, NR9);
        else phase_convert(F, CV_END - cv9, CV_END, bx - NR9, F.G - NR9);
    }
    SEAM(9);
    phase_moe_up<true, true>(F, 1);
    SEAM(10);
    phase_moe_down<true, true>(F, 1);
    SEAM(11);
    phase_combine<false, true>(F, X3, FOUT, nullptr, nullptr, 1);
    if (MK_TPROBE >= 0) { if (MK_TPROBE == 12) TP_PUT(1);
        if (blockIdx.x == 0 && threadIdx.x == 0) { const unsigned long long tp0 = ((unsigned long long)F.MISC[17] << 32) | F.MISC[16], tp1 = ((unsigned long long)F.MISC[19] << 32) | F.MISC[18];
            const unsigned long long dt = (tp1 - tp0) * 4, ts = __builtin_amdgcn_s_memrealtime();
            while (__builtin_amdgcn_s_memrealtime() - ts < dt) __builtin_amdgcn_s_sleep(8); } }
#undef SEAM
}

extern "C" void kernel_launch(void* const* d_in, const int* in_sizes, int n_in, void* d_out, int out_size, void* d_ws, size_t ws_size, hipStream_t stream) {
    static int grid = 0;
    if (grid == 0) {
        if (n_in != 15 || in_sizes[0] != M * D || out_size != M * D || ws_size < WS_END) { fprintf(stderr, "kernel_launch: unexpected shapes (n_in %d, in0 %d, out %d, ws %zu, need %zu)\n", n_in, n_in > 0 ? in_sizes[0] : -1, out_size, ws_size, (size_t)WS_END); grid = -1; return; }
        int dev = 0, cus = 0, per_cu = 0;
        if (hipGetDevice(&dev) != hipSuccess || hipDeviceGetAttribute(&cus, hipDeviceAttributeMultiprocessorCount, dev) != hipSuccess) { grid = -1; return; }
        if (hipFuncSetAttribute((const void*)fwd_kernel, hipFuncAttributeMaxDynamicSharedMemorySize, LDS_BYTES) != hipSuccess) { fprintf(stderr, "kernel_launch: hipFuncSetAttribute failed\n"); grid = -1; return; }
        if (hipOccupancyMaxActiveBlocksPerMultiprocessor(&per_cu, (const void*)fwd_kernel, NWAVES * 64, LDS_BYTES) != hipSuccess || per_cu < 1) fprintf(stderr, "kernel_launch: occupancy query says %d\n", per_cu);
        (void)hipGetLastError();
        grid = cus;
    }
    if (grid < 0) return;
    (void)hipMemsetAsync((char*)d_ws + WS_CTL, 0, CTL_ZERO_BYTES, stream);
    Args a{};
    for (int i = 0; i < 15; ++i) a.in[i] = (const float*)d_in[i];
    a.out = (float*)d_out; a.ws = (unsigned char*)d_ws;
    hipLaunchKernelGGL(fwd_kernel, dim3(grid), dim3(NWAVES * 64), LDS_BYTES, stream, a);
    const hipError_t le = hipPeekAtLastError();
    if (le != hipSuccess) fprintf(stderr, "kernel_launch: launch failed: %s\n", hipGetErrorName(le));
}
```

```cpp
#include <hip/hip_runtime.h>
#include <cstdio>
#include <cstdint>

#define GAS __attribute__((address_space(1)))
#define LAS __attribute__((address_space(3)))
typedef unsigned short bf16;
typedef unsigned u32x4 __attribute__((ext_vector_type(4)));
typedef unsigned u32x2 __attribute__((ext_vector_type(2)));
typedef float f32x4 __attribute__((ext_vector_type(4)));
typedef float f32x2 __attribute__((ext_vector_type(2)));
typedef float f32x16 __attribute__((ext_vector_type(16)));
typedef short bf16x8 __attribute__((ext_vector_type(8)));
typedef short s16x4 __attribute__((ext_vector_type(4)));
typedef short v4i16_t __attribute__((ext_vector_type(4)));
typedef __bf16 bf16x2_t __attribute__((ext_vector_type(2)));
typedef int i32x8 __attribute__((ext_vector_type(8)));
typedef int i32x4 __attribute__((ext_vector_type(4)));
typedef GAS unsigned gu32;

constexpr int BATCH = 8, SEQ = 2048, D = 1024, M = BATCH * SEQ, NH = 16, HD = 64, NE = 32, TOPK = 4, FF = 1024;
constexpr float RMS_EPS = 1e-6f, SW_LIMIT = 7.0f, SW_ALPHA = 1.702f;
constexpr int MT_MAX = M * TOPK / 256 + NE;
constexpr int NSLOT = MT_MAX * 256;
constexpr float C2 = 0.125f * 1.4426950408889634f;
constexpr float S8_W = 64.0f, S8_H = 8.0f, S8_ACT = 4.0f, S8_OUT = 16.0f;
constexpr int E8_UP = 127 - 9, E8_DOWN = 127 - 8;

constexpr size_t MiB = 1u << 20;
constexpr size_t WS_CTL = 0, CTL_ZERO_BYTES = 1 * MiB;
constexpr size_t WS_POOLW = 1 * MiB;
constexpr size_t WS_WQKV = 2 * MiB;
constexpr size_t WS_WO = 8 * MiB;
constexpr size_t WS_TOPE = 10 * MiB, WS_TOPP = WS_TOPE + 256 * 1024, WS_TOPW = WS_TOPP + 256 * 1024;
constexpr size_t WS_LIST = 12 * MiB;
constexpr size_t WS_WGU = 16 * MiB;
constexpr size_t WS_WDN = 272 * MiB;
constexpr size_t WS_WGU8 = WS_WGU + 128 * MiB;
constexpr size_t WS_WDN8 = WS_WDN + 64 * MiB;
constexpr size_t WS_X1 = 400 * MiB, WS_X2 = 464 * MiB, WS_X3 = 528 * MiB;
constexpr size_t WS_POOLED = 592 * MiB, WS_H2 = 624 * MiB, WS_HQ = 656 * MiB, WS_Q = 688 * MiB, WS_K = 720 * MiB, WS_V = 752 * MiB, WS_O = 784 * MiB;
constexpr size_t WS_ACT = 816 * MiB, WS_OUTS = 960 * MiB;
constexpr size_t WS_END = 1104 * MiB;
static_assert(WS_ACT + (size_t)NSLOT * 1024 * 2 <= WS_OUTS && WS_OUTS + (size_t)NSLOT * 1024 * 2 <= WS_END, "ws map");
constexpr int CW_TMO = 0, CW_CODE = 1;
constexpr int CW_BAR = 4096;
constexpr int CW_BAR2 = 8192;
constexpr int CW_ECNT = 16384;

constexpr int RING_BYTES = 131072;
constexpr int LDSCTL_OFF = RING_BYTES, MISC_OFF = LDSCTL_OFF + 320;
constexpr int TAB_OFF = 131584;
constexpr int TAB_ECNT = TAB_OFF, TAB_TBASE = TAB_OFF + 128, TAB_TEXP = TAB_OFF + 384, TAB_ROW = TAB_OFF + 1024;
constexpr int MAXU = 12;
constexpr int BIAS_OFF = TAB_ROW + MAXU * 1024;
constexpr int LDS_BYTES = 163840;
static_assert(BIAS_OFF % 16 == 0 && BIAS_OFF + 2 * 8 * 1024 <= LDS_BYTES, "LDS map");

constexpr int NWAVES = 8;
#ifndef MK_NFRONT
#define MK_NFRONT 144
#endif
constexpr int NFRONT = MK_NFRONT;
#ifndef MK_CV9
#define MK_CV9 8000
#endif
#ifndef MK_NR9
#define MK_NR9 96
#endif
constexpr int CV9 = MK_CV9, NR9 = MK_NR9;
#ifndef MK_CV3
#define MK_CV3 600
#endif
constexpr int CV3 = MK_CV3, G3 = 248;

#ifndef MK_TPROBE
#define MK_TPROBE -1
#endif
#ifndef MK_FP8_L0
#define MK_FP8_L0 3
#endif
constexpr bool FP8_U0 = (MK_FP8_L0 & 1) != 0, FP8_D0 = (MK_FP8_L0 & 2) != 0;

#define RLX_AGENT __ATOMIC_RELAXED, __HIP_MEMORY_SCOPE_AGENT
#define LDS_WAIT() asm volatile("s_waitcnt lgkmcnt(0)" ::: "memory")
#define VM_WAIT() asm volatile("s_waitcnt vmcnt(0)" ::: "memory")
__device__ __forceinline__ unsigned cvtpk(float lo, float hi) { f32x2 v = {lo, hi}; bf16x2_t b = __builtin_convertvector(v, bf16x2_t); return __builtin_bit_cast(unsigned, b); }
__device__ __forceinline__ unsigned cvtfp8x4(float a, float b, float c, float d) { int w = __builtin_amdgcn_cvt_pk_fp8_f32(a, b, 0, false); w = __builtin_amdgcn_cvt_pk_fp8_f32(c, d, w, true); return (unsigned)w; }
__device__ __forceinline__ float bf_lo(unsigned u) { return __uint_as_float(u << 16); }
__device__ __forceinline__ float bf_hi(unsigned u) { return __uint_as_float(u & 0xffff0000u); }
__device__ __forceinline__ int lane_id() { int r; asm volatile("v_mbcnt_lo_u32_b32 %0, -1, 0\n\tv_mbcnt_hi_u32_b32 %0, -1, %0" : "=v"(r)); return r; }
__device__ __forceinline__ float wave_sum(float v) {
#pragma unroll
    for (int o = 1; o < 64; o <<= 1) v += __shfl_xor(v, o);
    return v;
}

#define XB_TMO      128
#define XB_XCNT(j)  (256  + 64 * (j))
#define XB_XSUB(j)  (1280 + 64 * (j))
#define XB_XGEN(j)  (2304 + 64 * (j))
#define XB_TOP      3328
#define XB_TOPGEN   3392
#define XCD_BAR_WORDS 3456
#define XB_SPIN_CAP (1u << 18)
__device__ __forceinline__ unsigned xb_ld(unsigned* p)              { return __hip_atomic_load(p, __ATOMIC_RELAXED, __HIP_MEMORY_SCOPE_AGENT); }
__device__ __forceinline__ unsigned xb_add(unsigned* p, unsigned v) { return __hip_atomic_fetch_add(p, v, __ATOMIC_RELAXED, __HIP_MEMORY_SCOPE_AGENT); }
__device__ __forceinline__ unsigned xb_xcc_id() { return (unsigned)__builtin_amdgcn_s_getreg((3 << 11) | 20) & 0xFu; }
#define XB_SPIN(cond, bar) do { unsigned _sp = 0; while (cond) { __builtin_amdgcn_s_sleep(1); \
    if ((++_sp & 255u) == 0u) { if (xb_ld(&(bar)[XB_TMO])) break; if (_sp > XB_SPIN_CAP) { atomicAdd(&(bar)[XB_TMO], 1u); break; } } } } while (0)
struct XcdBarrier { unsigned* bar; unsigned x; volatile LAS unsigned* st; unsigned G; };
__device__ __forceinline__ XcdBarrier xcd_barrier_post(unsigned* bar, volatile LAS unsigned* st, unsigned G) {
    XcdBarrier b; b.bar = bar; b.x = xb_xcc_id(); b.st = st; b.G = G;
    if (threadIdx.x == 0) (void)xb_add(&bar[XB_XCNT(b.x)], 1u);
    return b;
}
__device__ __forceinline__ void xcd_barrier_complete(unsigned* bar, unsigned x, unsigned& nloc, unsigned& nx, const unsigned G) {
    unsigned sum, cnt, mine, sp = 0u;
    for (;;) {
        sum = 0u; cnt = 0u; mine = 0u;
#pragma unroll
        for (unsigned j = 0; j < 16; ++j) { const unsigned c = xb_ld(&bar[XB_XCNT(j)]); sum += c; cnt += (c > 0u) ? 1u : 0u; mine = (j == x) ? c : mine; }
        if (sum == G) break;
        __builtin_amdgcn_s_sleep(1);
        if ((++sp & 255u) == 0u) { if (xb_ld(&bar[XB_TMO])) break; if (sp > XB_SPIN_CAP) { atomicAdd(&bar[XB_TMO], 1u); break; } }
    }
    nloc = mine > 0u ? mine : 1u; nx = cnt > 0u ? cnt : 1u;
}
__device__ __forceinline__ void xcd_barrier(const XcdBarrier& b) {
    asm volatile("s_waitcnt vmcnt(0)" ::: "memory");
    __syncthreads();
    if (threadIdx.x == 0) {
        unsigned* bar = b.bar;
        __builtin_amdgcn_s_waitcnt(0);
        unsigned nloc = b.st[0], nx = b.st[1];
        if (nloc == 0u) { xcd_barrier_complete(bar, b.x, nloc, nx, b.G); b.st[0] = nloc; b.st[1] = nx; }
        const unsigned old = xb_add(&bar[XB_XSUB(b.x)], 1u);
        const unsigned gen = old / nloc;
        if (old + 1u == (gen + 1u) * nloc) {
            __builtin_amdgcn_fence(__ATOMIC_RELEASE, "agent");
            asm volatile("s_waitcnt vmcnt(0)" ::: "memory");
            const unsigned og = xb_add(&bar[XB_TOP], 1u);
            const unsigned tg = og / nx;
            if (og + 1u == (tg + 1u) * nx) xb_add(&bar[XB_TOPGEN], 1u);
            else XB_SPIN(xb_ld(&bar[XB_TOPGEN]) == tg, bar);
            __builtin_amdgcn_fence(__ATOMIC_ACQUIRE, "agent");
            xb_add(&bar[XB_XGEN(b.x)], 1u);
            asm volatile("s_waitcnt vmcnt(0)" ::: "memory");
        } else {
            XB_SPIN(xb_ld(&bar[XB_XGEN(b.x)]) == gen, bar);
            __builtin_amdgcn_fence(__ATOMIC_ACQUIRE, "agent");
            asm volatile("s_waitcnt vmcnt(0)" ::: "memory");
        }
    }
    __syncthreads();
}

namespace pg8 {
constexpr int BM = 256, BK = 64, HALF = 128, HTB = HALF * BK * 2, STAGE_BYTES = 8 * HTB, NXCD = 8, WGM = 8;
__host__ __device__ __forceinline__ int lds_byte(int r, int c) { const int st = (r >> 4) * 2 + (c >> 5), rr = r & 15, cc = c & 31, ob = rr * 64 + cc * 2; return st * 1024 + (ob ^ (((ob >> 9) & 1) << 5)); }
__host__ __device__ __forceinline__ void stage_rc(int b, int& R, int& C) { const int st = b / 1024, sb = b % 1024, swz = sb ^ (((sb >> 9) & 1) << 5); R = (st >> 1) * 16 + swz / 64; C = (st & 1) * 32 + (swz % 64) / 2; }
__host__ __device__ __forceinline__ int perm32(int rho) { const int n = rho >> 4, i = rho & 15; return 8 * (i >> 2) + 4 * n + (i & 3); }

struct Unit { int pm, pn, e; };
__device__ __forceinline__ void glds_sv(const char* base, unsigned voff, unsigned lds_dst) {
    unsigned keep;
    asm volatile("s_mov_b32 %0, m0\n\ts_mov_b32 m0, %3\n\ts_nop 0\n\tglobal_load_lds_dwordx4 %1, %2\n\ts_mov_b32 m0, %0" : "=&s"(keep) : "v"(voff), "s"(base), "s"(lds_dst) : "memory");
}
__device__ __forceinline__ const char* uni_ptr(const char* p) { const unsigned long long u = (unsigned long long)p; const unsigned lo = __builtin_amdgcn_readfirstlane((unsigned)u), hi = __builtin_amdgcn_readfirstlane((unsigned)(u >> 32)); return (const char*)(((unsigned long long)hi << 32) | lo); }
struct UD { const char* a; const char* b0; const char* b1; };

__device__ __forceinline__ bool order_next(int i, int G, int c, int nM, int nN, int& pm, int& pn) {
    const int L = i * G + c; const int nwg = nM * nN; if (L >= nwg) return false;
    int wgid = L; { const int q = nwg / NXCD, r = nwg % NXCD, xcd = wgid % NXCD, off = wgid / NXCD; wgid = (xcd < r ? xcd * (q + 1) : r * (q + 1) + (xcd - r) * q) + off; }
    const int nig = WGM * nN, gid = wgid / nig, fm = gid * WGM, gsz = (nM - fm) < WGM ? (nM - fm) : WGM;
    pm = fm + ((wgid % nig) % gsz); pn = (wgid % nig) / gsz; return true;
}

template <class Prob, class Epi, bool FP8 = false, int E8 = 127>
__device__ __forceinline__ void gemm_phase(LAS unsigned char* lds, const Prob& S, const Epi& E) {
    const int wid = S.wave, lane = lane_id(), tid = wid * 64 + lane, wr = wid >> 2, wc = wid & 3, fr = lane & 15, fq = lane >> 4;
    const int nt = S.Kb / 128;
    unsigned voffB[2];
#pragma unroll
    for (int i = 0; i < 2; ++i) { int R, C; stage_rc(tid * 16 + i * 8192, R, C); const int Rb = Epi::PERM ? ((R & ~31) + perm32(R & 31)) : R; voffB[i] = (unsigned)(Rb * S.ldb + C * 2); }
    const size_t kstep = (size_t)(BK * 2);
    const unsigned ldsb = (unsigned)__builtin_amdgcn_readfirstlane((int)(unsigned)(uintptr_t)lds + wid * 1024);
    const int aoff = lds_byte(wr * 64 + fr, fq * 8), boff = lds_byte(wc * 32 + fr, fq * 8);
#define PG8_SA(b, h) (((b) * 2 + (h)) * HTB)
#define PG8_SB(b, h) ((4 + (b) * 2 + (h)) * HTB)
#define PG8_STA(bufoff, gbase, va, h) do { _Pragma("unroll") for (int _i = 0; _i < 2; ++_i) glds_sv((const char*)(gbase), (va)[(h) * 2 + _i], ldsb + (unsigned)((bufoff) + _i * 8192)); } while (0)
#define PG8_STB(bufoff, gbase) do { _Pragma("unroll") for (int _i = 0; _i < 2; ++_i) glds_sv((const char*)(gbase), voffB[_i], ldsb + (unsigned)((bufoff) + _i * 8192)); } while (0)
#define PG8_LD8(p) __builtin_shufflevector(*(const LAS i32x4*)(p), *(const LAS i32x4*)((p) + 1024), 0, 1, 2, 3, 4, 5, 6, 7)
#define PG8_LDA(dst, b, h) do { _Pragma("unroll") for (int m = 0; m < 4; ++m) dst[m] = PG8_LD8(lds + PG8_SA(b, h) + aoff + m * 2048); } while (0)
#define PG8_LDB(dst, b, h) do { _Pragma("unroll") for (int n = 0; n < 2; ++n) dst[n] = PG8_LD8(lds + PG8_SB(b, h) + boff + n * 2048); } while (0)
#define PG8_HALF(x, k) __builtin_bit_cast(bf16x8, __builtin_shufflevector(x, x, 4 * (k), 4 * (k) + 1, 4 * (k) + 2, 4 * (k) + 3))
#define PG8_MMA(ai, bj, At, Bt) do { __builtin_amdgcn_s_setprio(1); _Pragma("unroll") for (int m = 0; m < 4; ++m) _Pragma("unroll") for (int n = 0; n < 2; ++n) { \
        if constexpr (FP8) acc[ai][bj][m][n] = __builtin_amdgcn_mfma_scale_f32_16x16x128_f8f6f4(Bt[n], At[m], acc[ai][bj][m][n], 0, 0, 0, E8, 0, 127); \
        else { acc[ai][bj][m][n] = __builtin_amdgcn_mfma_f32_16x16x32_bf16(PG8_HALF(Bt[n], 0), PG8_HALF(At[m], 0), acc[ai][bj][m][n], 0, 0, 0); \
               acc[ai][bj][m][n] = __builtin_amdgcn_mfma_f32_16x16x32_bf16(PG8_HALF(Bt[n], 1), PG8_HALF(At[m], 1), acc[ai][bj][m][n], 0, 0, 0); } } \
        __builtin_amdgcn_s_setprio(0); \
        if constexpr (FP8) asm volatile("" : "+v"(acc[ai][bj][0][0]), "+v"(acc[ai][bj][0][1]), "+v"(acc[ai][bj][1][0]), "+v"(acc[ai][bj][1][1]), "+v"(acc[ai][bj][2][0]), "+v"(acc[ai][bj][2][1]), "+v"(acc[ai][bj][3][0]), "+v"(acc[ai][bj][3][1])); \
        } while (0)
#define PG8_WAIT_V(n) asm volatile("s_waitcnt vmcnt(" #n ")" ::: "memory")
#define PG8_WAIT_SEAM(flag) asm volatile("s_cmp_lg_u32 %0, 0\n\ts_cbranch_scc1 1f\n\ts_waitcnt vmcnt(8)\n\ts_branch 2f\n1:\n\ts_waitcnt vmcnt(%1)\n2:" :: "s"(flag), "n"(RELAX) : "memory", "scc")
#define PG8_WAIT_L(n) asm volatile("s_waitcnt lgkmcnt(" #n ")" ::: "memory")
#define PG8_BAR __builtin_amdgcn_s_barrier()
#define PG8_SCHED __builtin_amdgcn_sched_barrier(0)
    Unit cur, nxt; UD cd, nd; unsigned cva[4]; int ui = 0;
    if (!S.next(0, cur)) return;
    S.desc(cur, cd); S.desc_va(0, cur, cva);
    constexpr int RELAX = 8 + Epi::NPRE + Epi::NST; static_assert(RELAX <= 63, "vmcnt is 6 bits");
    E.prefetch(cur, lds + BIAS_OFF + wid * 1024, lane);
    f32x4 acc[2][2][4][2];
#pragma unroll
    for (int a = 0; a < 2; ++a)
#pragma unroll
        for (int b = 0; b < 2; ++b)
#pragma unroll
            for (int m = 0; m < 4; ++m)
#pragma unroll
                for (int n = 0; n < 2; ++n) acc[a][b][m][n] = (f32x4){0.f, 0.f, 0.f, 0.f};
    i32x8 At[4], B0[2], B1[2];
    PG8_STB(PG8_SB(0, 0), cd.b0); PG8_STB(PG8_SB(0, 1), cd.b1); PG8_STA(PG8_SA(0, 0), cd.a, cva, 0); PG8_STA(PG8_SA(0, 1), cd.a, cva, 1);
    if (wr == 1) PG8_BAR;
    PG8_WAIT_V(2); PG8_BAR;
    PG8_STB(PG8_SB(1, 0), cd.b0 + kstep); PG8_STA(PG8_SA(1, 0), cd.a + kstep, cva, 0); PG8_STB(PG8_SB(1, 1), cd.b1 + kstep); PG8_STA(PG8_SA(1, 1), cd.a + kstep, cva, 1);
    PG8_WAIT_V(8); PG8_BAR;
    for (;;) {
        const bool has_next = S.next(ui + 1, nxt);
        if (has_next) S.desc(nxt, nd); else nd = cd;
#pragma clang loop unroll(disable)
        for (int t = 0; t < nt; t += 2) {
            const bool last = (t == nt - 2); const int seam = __builtin_amdgcn_readfirstlane((t == 0 && ui > 0) ? 1 : 0);
            const char* a2 = last ? nd.a : cd.a + (size_t)(t + 2) * kstep;
            const char* b20 = last ? nd.b0 : cd.b0 + (size_t)(t + 2) * kstep; const char* b21 = last ? nd.b1 : cd.b1 + (size_t)(t + 2) * kstep;
            const char* a3 = a2 + kstep; const char* b30 = b20 + kstep; const char* b31 = b21 + kstep;
            PG8_LDB(B0, 0, 0); PG8_LDB(B1, 0, 1); PG8_SCHED; PG8_LDA(At, 0, 0);
            PG8_WAIT_SEAM(seam);
            PG8_WAIT_L(0); PG8_BAR; PG8_MMA(0, 0, At, B0); PG8_MMA(0, 1, At, B1); PG8_BAR; PG8_SCHED;
            if (last && has_next) S.desc_va(ui + 1, nxt, cva);
            PG8_LDA(At, 0, 1); PG8_STB(PG8_SB(0, 0), b20); PG8_STB(PG8_SB(0, 1), b21); PG8_STA(PG8_SA(0, 0), a2, cva, 0);
            PG8_WAIT_SEAM(seam);
            PG8_WAIT_L(0); PG8_BAR; PG8_MMA(1, 0, At, B0); PG8_MMA(1, 1, At, B1); PG8_BAR; PG8_SCHED;
            PG8_LDB(B0, 1, 0); PG8_LDB(B1, 1, 1); PG8_SCHED; PG8_LDA(At, 1, 0); PG8_STA(PG8_SA(0, 1), a2, cva, 1);
            PG8_WAIT_SEAM(seam);
            PG8_WAIT_L(0); PG8_BAR; PG8_MMA(0, 0, At, B0); PG8_MMA(0, 1, At, B1); PG8_BAR; PG8_SCHED;
            PG8_LDA(At, 1, 1); PG8_STB(PG8_SB(1, 0), b30); PG8_STB(PG8_SB(1, 1), b31); PG8_STA(PG8_SA(1, 0), a3, cva, 0);
            PG8_WAIT_V(8); PG8_WAIT_L(0); PG8_BAR; PG8_MMA(1, 0, At, B0); PG8_MMA(1, 1, At, B1); PG8_BAR; PG8_SCHED;
            PG8_STA(PG8_SA(1, 1), a3, cva, 1);
        }
        if (has_next) E.prefetch(nxt, lds + BIAS_OFF + (((ui + 1) & 1) * 8 + wid) * 1024, lane);
        if (wr == 0) PG8_BAR;
        E(acc, cur, wr, wc, fr, fq, lds + BIAS_OFF + ((ui & 1) * 8 + wid) * 1024);
        if (!has_next) break;
#pragma unroll
        for (int a = 0; a < 2; ++a)
#pragma unroll
            for (int b = 0; b < 2; ++b)
#pragma unroll
                for (int m = 0; m < 4; ++m)
#pragma unroll
                    for (int n = 0; n < 2; ++n) acc[a][b][m][n] = (f32x4){0.f, 0.f, 0.f, 0.f};
        cur = nxt; cd = nd;
        ++ui;
        if (wr == 1) PG8_BAR;
    }
    PG8_WAIT_V(0);
    PG8_BAR;
#undef PG8_SA
#undef PG8_SB
#undef PG8_STA
#undef PG8_STB
#undef PG8_LDA
#undef PG8_LDB
#undef PG8_MMA
#undef PG8_LD8
#undef PG8_HALF
#undef PG8_WAIT_V
#undef PG8_WAIT_SEAM
#undef PG8_WAIT_L
#undef PG8_BAR
#undef PG8_SCHED
}
}

struct Frame {
    LAS unsigned char* lds;
    volatile LAS unsigned* MISC;
    gu32* ctl;
    int wave, G;
    unsigned char* ws;
};
struct Args { const float* in[15]; float* out; unsigned char* ws; };
#define KARG ((const __attribute__((address_space(4))) Args*)__builtin_amdgcn_kernarg_segment_ptr())
#define FIN(i) (KARG->in[i])
#define FOUT (KARG->out)

struct ProbDense {
    const char* A; const char* Bt; int lda, ldb, Kb, nM, nN, G, c, wave;
    __device__ __forceinline__ bool next(int i, pg8::Unit& u) const { u.e = 0; return pg8::order_next(i, G, c, nM, nN, u.pm, u.pn); }
    __device__ __forceinline__ void desc(const pg8::Unit& u, pg8::UD& d) const { d.a = pg8::uni_ptr(A + (size_t)u.pm * 256 * lda); d.b0 = pg8::uni_ptr(Bt + (size_t)u.pn * 256 * ldb); d.b1 = d.b0 + (size_t)128 * ldb; }
    __device__ __forceinline__ void desc_va(int, const pg8::Unit&, unsigned (&va)[4]) const {
#pragma unroll
        for (int i = 0; i < 2; ++i) { int R, C; pg8::stage_rc((wave * 64 + lane_id()) * 16 + i * 8192, R, C); va[i] = (unsigned)(R * lda + C * 2); va[2 + i] = va[i] + (unsigned)(128 * lda); }
    }
};
struct ProbPool {
    const char* A; const char* Bt; int ldb, Kb, G, c, wave;
    __device__ __forceinline__ bool next(int i, pg8::Unit& u) const { u.e = 0; return pg8::order_next(i, G, c, M / 256, 4, u.pm, u.pn); }
    __device__ __forceinline__ void desc(const pg8::Unit& u, pg8::UD& d) const { d.a = pg8::uni_ptr(A + (size_t)u.pm * 256 * D * 2 + (size_t)u.pn * 256 * 2); d.b0 = pg8::uni_ptr(Bt + (size_t)u.pn * 65536 * 2); d.b1 = d.b0 + (size_t)128 * 256 * 2; }
    __device__ __forceinline__ void desc_va(int, const pg8::Unit&, unsigned (&va)[4]) const {
#pragma unroll
        for (int i = 0; i < 2; ++i) { int R, C; pg8::stage_rc((wave * 64 + lane_id()) * 16 + i * 8192, R, C); va[i] = (unsigned)(R * D * 2 + C * 2); va[2 + i] = va[i] + (unsigned)(128 * D * 2); }
    }
};
struct ProbMoeUp {
    const char* A; const char* Bt; LAS unsigned char* lds; int ldb, Kb, nM, G, c, wave;
    __device__ __forceinline__ bool next(int i, pg8::Unit& u) const { if (!pg8::order_next(i, G, c, nM, 8, u.pm, u.pn)) return false; u.e = __builtin_amdgcn_readfirstlane((int)((const LAS unsigned char*)(lds + TAB_TEXP))[u.pm]); return true; }
    __device__ __forceinline__ void desc(const pg8::Unit& u, pg8::UD& d) const { d.a = pg8::uni_ptr(A); d.b0 = pg8::uni_ptr(Bt + ((size_t)u.e * 2048 + (size_t)u.pn * 256) * ldb); d.b1 = d.b0 + (size_t)128 * ldb; }
    __device__ __forceinline__ void desc_va(int ord, const pg8::Unit&, unsigned (&va)[4]) const {
        const LAS unsigned* rt = (const LAS unsigned*)(lds + TAB_ROW) + ord * 256;
#pragma unroll
        for (int i = 0; i < 2; ++i) { int R, C; pg8::stage_rc((wave * 64 + lane_id()) * 16 + i * 8192, R, C); va[i] = rt[R] + (unsigned)(C * 2); va[2 + i] = rt[128 + R] + (unsigned)(C * 2); }
    }
};
struct ProbMoeDown {
    const char* A; const char* Bt; LAS unsigned char* lds; int ldb, Kb, nM, G, c, wave;
    __device__ __forceinline__ bool next(int i, pg8::Unit& u) const { if (!pg8::order_next(i, G, c, nM, 4, u.pm, u.pn)) return false; u.e = __builtin_amdgcn_readfirstlane((int)((const LAS unsigned char*)(lds + TAB_TEXP))[u.pm]); return true; }
    __device__ __forceinline__ void desc(const pg8::Unit& u, pg8::UD& d) const { d.a = pg8::uni_ptr(A + (size_t)u.pm * 256 * ldb); d.b0 = pg8::uni_ptr(Bt + ((size_t)u.e * 1024 + (size_t)u.pn * 256) * ldb); d.b1 = d.b0 + (size_t)128 * ldb; }
    __device__ __forceinline__ void desc_va(int, const pg8::Unit&, unsigned (&va)[4]) const {
#pragma unroll
        for (int i = 0; i < 2; ++i) { int R, C; pg8::stage_rc((wave * 64 + lane_id()) * 16 + i * 8192, R, C); va[i] = (unsigned)(R * ldb + C * 2); va[2 + i] = va[i] + (unsigned)(128 * ldb); }
    }
};

struct EpiPool {
    static constexpr bool PERM = false; static constexpr int NST = 32, NPRE = 0;
    const float* x; float* X1; const float* scale;
    __device__ __forceinline__ void prefetch(const pg8::Unit&, LAS unsigned char*, int) const {}

    __device__ __forceinline__ void operator()(const f32x4 (&acc)[2][2][4][2], const pg8::Unit& u, int wr, int wc, int fr, int fq, LAS unsigned char* bl) const {
        const int row0 = u.pm * 256 + wr * 64 + fr, col0 = u.pn * 256 + wc * 32 + 4 * fq;
        f32x4 sv[2][2];
#pragma unroll
        for (int bj = 0; bj < 2; ++bj)
#pragma unroll
            for (int n = 0; n < 2; ++n) sv[bj][n] = *(const f32x4*)(scale + col0 + bj * 128 + n * 16);
#pragma unroll
        for (int ai = 0; ai < 2; ++ai)
#pragma unroll
            for (int m = 0; m < 4; ++m) { const size_t off = (size_t)(row0 + ai * 128 + m * 16) * D + col0;
#pragma unroll
                for (int bj = 0; bj < 2; ++bj)
#pragma unroll
                    for (int n = 0; n < 2; ++n) { const f32x4 xv = *(const f32x4*)(x + off + bj * 128 + n * 16); *(f32x4*)(X1 + off + bj * 128 + n * 16) = xv + acc[ai][bj][m][n] * sv[bj][n]; }
                if (m & 1) asm volatile("" ::: "memory"); }
    }
};
struct EpiRes {
    static constexpr bool PERM = false; static constexpr int NST = 32, NPRE = 0;
    const float* Xi; float* Xo;
    __device__ __forceinline__ void prefetch(const pg8::Unit&, LAS unsigned char*, int) const {}

    __device__ __forceinline__ void operator()(const f32x4 (&acc)[2][2][4][2], const pg8::Unit& u, int wr, int wc, int fr, int fq, LAS unsigned char* bl) const {
        const int row0 = u.pm * 256 + wr * 64 + fr, col0 = u.pn * 256 + wc * 32 + 4 * fq;
#pragma unroll
        for (int ai = 0; ai < 2; ++ai)
#pragma unroll
            for (int m = 0; m < 4; ++m) { const size_t off = (size_t)(row0 + ai * 128 + m * 16) * D + col0;
#pragma unroll
                for (int bj = 0; bj < 2; ++bj)
#pragma unroll
                    for (int n = 0; n < 2; ++n) { const f32x4 xv = *(const f32x4*)(Xi + off + bj * 128 + n * 16); *(f32x4*)(Xo + off + bj * 128 + n * 16) = xv + acc[ai][bj][m][n]; }
                if (m & 1) asm volatile("" ::: "memory"); }
    }
};
struct EpiQKV {
    static constexpr bool PERM = true; static constexpr int NST = 16, NPRE = 0;
    bf16* QKV; const LAS float* gl;
    __device__ __forceinline__ void prefetch(const pg8::Unit&, LAS unsigned char*, int) const {}

    __device__ __forceinline__ void operator()(const f32x4 (&acc)[2][2][4][2], const pg8::Unit& u, int wr, int wc, int fr, int fq, LAS unsigned char* bl) const {
        const int seg = u.pn >> 2, head = (u.pn & 3) * 4 + wc;
        f32x4 gv[2][2];
#pragma unroll
        for (int bj = 0; bj < 2; ++bj)
#pragma unroll
            for (int n = 0; n < 2; ++n) {
                if (seg == 2) gv[bj][n] = (f32x4){1.f, 1.f, 1.f, 1.f};
                else { const LAS float* g = gl + seg * 64 + bj * 32 + 8 * fq + 4 * n; gv[bj][n] = *(const LAS f32x4*)g; if (seg == 0) gv[bj][n] = gv[bj][n] * C2; } }
        bf16* base = QKV + (size_t)seg * M * D;
#pragma unroll
        for (int ai = 0; ai < 2; ++ai)
#pragma unroll
            for (int m = 0; m < 4; ++m) {
                const int t = u.pm * 256 + ai * 128 + wr * 64 + m * 16 + fr, b = t >> 11, s = t & (SEQ - 1);
                float rstd = 1.f;
                if (seg < 2) { float ss = 0.f;
#pragma unroll
                    for (int bj = 0; bj < 2; ++bj)
#pragma unroll
                        for (int n = 0; n < 2; ++n) { const f32x4 v = acc[ai][bj][m][n]; ss += (v[0] * v[0] + v[1] * v[1]) + (v[2] * v[2] + v[3] * v[3]); }
                    ss += __shfl_xor(ss, 16); ss += __shfl_xor(ss, 32);
                    rstd = 1.0f / sqrtf(ss * (1.0f / 64.0f) + RMS_EPS); }
                bf16* rowp = base + ((size_t)(b * NH + head) * SEQ + s) * HD + 8 * fq;
#pragma unroll
                for (int bj = 0; bj < 2; ++bj) { const f32x4 v0 = acc[ai][bj][m][0] * rstd * gv[bj][0], v1 = acc[ai][bj][m][1] * rstd * gv[bj][1];
                    u32x4 w; w.x = cvtpk(v0[0], v0[1]); w.y = cvtpk(v0[2], v0[3]); w.z = cvtpk(v1[0], v1[1]); w.w = cvtpk(v1[2], v1[3]);
                    *(u32x4*)(rowp + bj * 32) = w; }
            }
    }
};
template <bool OUT8> struct EpiGateUp {
    static constexpr bool PERM = true; static constexpr int NST = 8, NPRE = 1;
    bf16* ACT; const float* bias;
    __device__ __forceinline__ void prefetch(const pg8::Unit& u, LAS unsigned char* bl, int lane) const {
        pg8::glds_sv(pg8::uni_ptr((const char*)(bias + (size_t)u.e * 2048 + u.pn * 128)), (unsigned)((lane & 31) * 16 + (lane >> 5) * 4096), (unsigned)__builtin_amdgcn_readfirstlane((int)(unsigned)(uintptr_t)bl)); }
    __device__ __forceinline__ void operator()(const f32x4 (&acc)[2][2][4][2], const pg8::Unit& u, int wr, int wc, int fr, int fq, LAS unsigned char* bl) const {
        { const int le = lane_id(); fr = le & 15; fq = le >> 4; }
        const int lc = u.pn * 128 + wc * 32 + 8 * fq;
        const LAS float* bg = (const LAS float*)bl + wc * 32 + 8 * fq;
        f32x4 bv[2][2];
#pragma unroll
        for (int bj = 0; bj < 2; ++bj)
#pragma unroll
            for (int n = 0; n < 2; ++n) bv[bj][n] = *(const LAS f32x4*)(bg + bj * 128 + 4 * n) + (bj ? 1.0f : 0.0f);
#pragma unroll
        for (int ai = 0; ai < 2; ++ai)
#pragma unroll
            for (int m = 0; m < 4; ++m) {
                const size_t eoff = (size_t)(u.pm * 256 + ai * 128 + wr * 64 + m * 16 + fr) * FF + lc;
                float o[8];
                constexpr float OS = OUT8 ? S8_ACT : 1.0f, IOS = 1.0f / OS;
#pragma unroll
                for (int n = 0; n < 2; ++n) { const f32x4 g4 = acc[ai][0][m][n] + bv[0][n], u4 = acc[ai][1][m][n] + bv[1][n];
#pragma unroll
                    for (int i = 0; i < 4; ++i) { const float g = fminf(g4[i], SW_LIMIT), up1 = __builtin_amdgcn_fmed3f(u4[i], 1.0f - SW_LIMIT, 1.0f + SW_LIMIT);
                        const float sg = __builtin_amdgcn_rcpf(__builtin_fmaf(__builtin_amdgcn_exp2f(g * (-SW_ALPHA * 1.4426950408889634f)), IOS, IOS));
                        o[n * 4 + i] = up1 * (g * sg); } }
                if constexpr (OUT8) { u32x2 w; w.x = cvtfp8x4(o[0], o[1], o[2], o[3]); w.y = cvtfp8x4(o[4], o[5], o[6], o[7]);
                    *(u32x2*)((unsigned char*)ACT + eoff) = w; }
                else { u32x4 w; w.x = cvtpk(o[0], o[1]); w.y = cvtpk(o[2], o[3]); w.z = cvtpk(o[4], o[5]); w.w = cvtpk(o[6], o[7]);
                    *(u32x4*)(ACT + eoff) = w; }
            }
    }
};
template <bool OUT8> struct EpiDown {
    static constexpr bool PERM = true; static constexpr int NST = 16, NPRE = 1;
    bf16* OUTS; const float* bias;
    __device__ __forceinline__ void prefetch(const pg8::Unit& u, LAS unsigned char* bl, int lane) const {
        pg8::glds_sv(pg8::uni_ptr((const char*)(bias + (size_t)u.e * 1024 + u.pn * 256)), (unsigned)(lane * 16), (unsigned)__builtin_amdgcn_readfirstlane((int)(unsigned)(uintptr_t)bl)); }
    __device__ __forceinline__ void operator()(const f32x4 (&acc)[2][2][4][2], const pg8::Unit& u, int wr, int wc, int fr, int fq, LAS unsigned char* bl) const {
        const int col0 = u.pn * 256 + wc * 32 + 8 * fq;
        const LAS float* bd = (const LAS float*)bl + wc * 32 + 8 * fq;
        f32x4 bv[2][2];
#pragma unroll
        for (int bj = 0; bj < 2; ++bj)
#pragma unroll
            for (int n = 0; n < 2; ++n) bv[bj][n] = *(const LAS f32x4*)(bd + bj * 128 + 4 * n);
#pragma unroll
        for (int ai = 0; ai < 2; ++ai)
#pragma unroll
            for (int m = 0; m < 4; ++m) { bf16* rowp = OUTS + (size_t)(u.pm * 256 + ai * 128 + wr * 64 + m * 16 + fr) * D + col0;
#pragma unroll
                for (int bj = 0; bj < 2; ++bj) { const f32x4 v0 = acc[ai][bj][m][0] + bv[bj][0], v1 = acc[ai][bj][m][1] + bv[bj][1];
                    if constexpr (OUT8) { u32x2 w;
#define O8C(x) __builtin_amdgcn_fmed3f((x) * S8_OUT, -448.0f, 448.0f)
                        w.x = cvtfp8x4(O8C(v0[0]), O8C(v0[1]), O8C(v0[2]), O8C(v0[3])); w.y = cvtfp8x4(O8C(v1[0]), O8C(v1[1]), O8C(v1[2]), O8C(v1[3]));
#undef O8C
                        *(u32x2*)((unsigned char*)OUTS + (size_t)(u.pm * 256 + ai * 128 + wr * 64 + m * 16 + fr) * D + col0 + bj * 128) = w; }
                    else { u32x4 w; w.x = cvtpk(v0[0], v0[1]); w.y = cvtpk(v0[2], v0[3]); w.z = cvtpk(v1[0], v1[1]); w.w = cvtpk(v1[2], v1[3]);
                        *(u32x4*)(rowp + bj * 128) = w; } } }
    }
};

constexpr int CV_POOL = 4 * 2 * 4, CV_QKV = 8 * 48, CV_WO = 8 * 16, CV_GU1 = 32 * 8 * 32  , CV_DN1 = 32 * 8 * 16  ;
constexpr int CV_SMALL = CV_POOL + CV_QKV + CV_WO, CV_END = CV_SMALL + 2 * (CV_GU1 + CV_DN1);
struct CvtItem { const float* src; unsigned char* dst; int N, dpitch, fp8, hs; };
__device__ __forceinline__ CvtItem cvt_decode(Frame& F, int it) {
    CvtItem c; int r = it; c.fp8 = 0; c.hs = 32;
    if (r < CV_POOL) { const int g = r >> 3, q = r & 7, kb = q >> 2, nb = q & 3; c.N = 256; c.dpitch = 512;
        c.src = FIN(2) + (size_t)g * 65536 + (size_t)(kb * 128) * 256 + nb * 64; c.dst = F.ws + WS_POOLW + ((size_t)g * 65536 + (size_t)(nb * 64) * 256 + kb * 128) * 2; return c; }
    r -= CV_POOL;
    if (r < CV_QKV) { const int kb = r / 48, nb = r % 48, n0 = nb * 64, pn = n0 >> 8, w = (n0 & 255) >> 6; c.N = 3 * D; c.dpitch = 2 * D; c.hs = 128;
        c.src = FIN(4) + (size_t)(kb * 128) * (3 * D) + n0; c.dst = F.ws + WS_WQKV + ((size_t)(256 * pn + 32 * w) * D + kb * 128) * 2; return c; }
    r -= CV_QKV;
    if (r < CV_WO) { const int kb = r >> 4, nb = r & 15; c.N = D; c.dpitch = 2 * D;
        c.src = FIN(7) + (size_t)(kb * 128) * D + nb * 64; c.dst = F.ws + WS_WO + ((size_t)(nb * 64) * D + kb * 128) * 2; return c; }
    r -= CV_WO;
    int layer = 0;
    if (r >= CV_GU1 + CV_DN1) { r -= CV_GU1 + CV_DN1; layer = 1; }
    if (r < CV_GU1) { const int mat = layer * NE + (r >> 8), q = r & 255, kb = q >> 5, nb = q & 31; c.N = 2 * FF; c.fp8 = (layer == 1 || FP8_U0); c.dpitch = c.fp8 ? D : 2 * D;
        c.src = FIN(11) + (size_t)mat * D * 2 * FF + (size_t)(kb * 128) * (2 * FF) + nb * 64;
        const int n0 = nb * 64, cg = n0 & (FF - 1), drow = (cg >> 7) * 256 + (n0 >= FF ? 128 : 0) + (cg & 127);
        c.dst = c.fp8 ? F.ws + WS_WGU8 + (size_t)(1 - layer) * 64 * MiB + (size_t)(mat - layer * NE) * 2 * FF * D + (size_t)drow * D + kb * 128 : F.ws + WS_WGU + ((size_t)mat * 2 * FF * D + (size_t)drow * D + kb * 128) * 2; return c; }
    r -= CV_GU1;
    { const int mat = layer * NE + (r >> 7), q = r & 127, kb = q >> 4, nb = q & 15; c.N = D; c.fp8 = (layer == 1 || FP8_D0); c.dpitch = c.fp8 ? FF : 2 * FF;
        c.src = FIN(13) + (size_t)mat * FF * D + (size_t)(kb * 128) * D + nb * 64;
        c.dst = c.fp8 ? F.ws + WS_WDN8 + (size_t)(1 - layer) * 32 * MiB + (size_t)(mat - layer * NE) * D * FF + (size_t)(nb * 64) * FF + kb * 128 : F.ws + WS_WDN + ((size_t)mat * D * FF + (size_t)(nb * 64) * FF + kb * 128) * 2; return c; }
}
__device__ __forceinline__ void cvt_load(const CvtItem& c, int half, f32x4 (&v)[16], int lane) {
    const float* p = c.src + (size_t)(64 * half + (lane >> 4)) * c.N + 4 * (lane & 15);
#pragma unroll
    for (int i = 0; i < 16; ++i) v[i] = __builtin_nontemporal_load((const f32x4*)(p + (size_t)(4 * i) * c.N));
}
__device__ __forceinline__ s16x4 cvt_tr(LAS const unsigned char* p) { return __builtin_bit_cast(s16x4, __builtin_amdgcn_ds_read_tr16_b64_v4i16((LAS v4i16_t*)p)); }
constexpr int CVP = 136;
__device__ __forceinline__ void cvt_to_lds(const f32x4 (&v)[16], int half, LAS unsigned char* scr, int lane) {
    LAS unsigned char* wp = scr + (64 * half + (lane >> 4)) * CVP + (lane & 15) * 8;
#pragma unroll
    for (int i = 0; i < 16; ++i) { u32x2 w; w.x = cvtpk(v[i][0], v[i][1]); w.y = cvtpk(v[i][2], v[i][3]); *(LAS u32x2*)(wp + 4 * i * CVP) = w; }
}
__device__ __forceinline__ void cvt_emit(const CvtItem& c, LAS unsigned char* scr, int lane) {
    LDS_WAIT(); asm volatile("" ::: "memory");
    const int g = lane >> 4, i16 = lane & 15, r = i16 >> 2, cc = i16 & 3;
    if (c.fp8) {
#pragma unroll
        for (int nb = 0; nb < 4; ++nb)
#pragma unroll
            for (int ps = 0; ps < 2; ++ps) { const int kc = 4 * ps + g; LAS const unsigned char* rp = scr + (16 * kc + r) * CVP + cc * 8 + nb * 32;
                u32x4 o;
#pragma unroll
                for (int h = 0; h < 4; ++h) { const u32x2 t = __builtin_bit_cast(u32x2, cvt_tr(rp + (4 * h) * CVP));
                    const unsigned a = t.x + 0x03000300u, b = t.y + 0x03000300u;
                    o[h] = cvtfp8x4(__uint_as_float(a << 16), __uint_as_float(a & 0xffff0000u), __uint_as_float(b << 16), __uint_as_float(b & 0xffff0000u)); }
                const int n = 16 * nb + i16;
                *(u32x4*)(c.dst + (size_t)((n >> 5) * c.hs + (n & 31)) * c.dpitch + 16 * kc) = o; }
    } else {
#pragma unroll
        for (int nb = 0; nb < 4; ++nb)
#pragma unroll
            for (int ps = 0; ps < 4; ++ps) { const int kc = 4 * ps + g; LAS const unsigned char* rp = scr + (8 * kc + r) * CVP + cc * 8 + nb * 32;
                const u32x2 t0 = __builtin_bit_cast(u32x2, cvt_tr(rp)), t1 = __builtin_bit_cast(u32x2, cvt_tr(rp + 4 * CVP));
                const int n = 16 * nb + i16;
                *(u32x4*)(c.dst + (size_t)((n >> 5) * c.hs + (n & 31)) * c.dpitch + 16 * kc) = (u32x4){t0.x, t0.y, t1.x, t1.y}; }
    }
    LDS_WAIT(); asm volatile("" ::: "memory");
}
__device__ __forceinline__ void phase_convert(Frame& F, int item_lo, int item_hi, int bidx, int nblk) {
    const int lane = lane_id();
    LAS unsigned char* scr = F.lds + (F.wave < 7 ? F.wave * 17408 : 133120);
    const int gw = bidx * NWAVES + F.wave, NGW = nblk * NWAVES;
    int it = item_lo + gw; if (it >= item_hi) return;
    CvtItem c = cvt_decode(F, it); f32x4 va[16], vb[16]; cvt_load(c, 0, va, lane); cvt_load(c, 1, vb, lane);
    for (;;) {
        cvt_to_lds(va, 0, scr, lane); cvt_to_lds(vb, 1, scr, lane);
        const int itn = it + NGW; const bool more = itn < item_hi;
        CvtItem cn = c;
        if (more) { cn = cvt_decode(F, itn); cvt_load(cn, 0, va, lane); cvt_load(cn, 1, vb, lane); }
        cvt_emit(c, scr, lane);
        if (!more) break;
        c = cn; it = itn;
    }
}
__device__ __forceinline__ void phase_pooled(Frame& F, int bidx, int nblk) {
    const int lane = lane_id(), tid = F.wave * 64 + lane; (void)tid;
    LAS float* H = (LAS float*)F.lds;
    LAS float* RS = (LAS float*)(F.lds + 81920);
    bf16* P = (bf16*)(F.ws + WS_POOLED);
    for (int tile = bidx; tile < M / 64; tile += nblk) {
        const int t0 = tile * 64, s0 = t0 & (SEQ - 1);
        for (int i = F.wave; i < 79; i += NWAVES) {
            const int s = s0 - 15 + i; float r = 0.f;
            if (s >= 0) { const f32x4* xr = (const f32x4*)(FIN(0) + (size_t)(t0 - 15 + i) * D) + lane; float ss = 0.f;
#pragma unroll
                for (int j = 0; j < 4; ++j) { const f32x4 v = xr[64 * j]; ss += (v[0] * v[0] + v[1] * v[1]) + (v[2] * v[2] + v[3] * v[3]); }
                ss = wave_sum(ss); r = 1.0f / sqrtf(ss * (1.0f / D) + RMS_EPS); }
            if (lane == 0) RS[i] = r;
        }
        __syncthreads();
        for (int g = 0; g < 4; ++g) {
            const f32x4 gn = *((const f32x4*)(FIN(1) + g * 256) + lane);
            for (int i = F.wave; i < 79; i += NWAVES) {
                const int s = s0 - 15 + i; f32x4 v = (f32x4){0.f, 0.f, 0.f, 0.f};
                if (s >= 0) { v = *((const f32x4*)(FIN(0) + (size_t)(t0 - 15 + i) * D + g * 256) + lane); v = v * RS[i] * gn; }
                *((LAS f32x4*)(H + i * 256) + lane) = v;
            }
            __syncthreads();
            const int w = 2 << g, cp = tid & 127, rq = tid >> 7, i0 = 15 + rq * 16;
            const LAS f32x2* H2p = (const LAS f32x2*)H + cp;
            f32x2 S = (f32x2){0.f, 0.f};
            for (int j = i0 - w + 1; j <= i0; ++j) S += H2p[j * 128];
            for (int r = 0; r < 16; ++r) {
                const int i = i0 + r;
                if (r > 0) S += H2p[i * 128] - H2p[(i - w) * 128];
                const int s = s0 + rq * 16 + r; const int cnt = (s + 1 < w) ? (s + 1) : w;
                const f32x2 h = H2p[i * 128]; const float inv = 1.0f / (float)cnt;
                const f32x2 pv = S * inv - h;
                *(unsigned*)(P + (size_t)(t0 + rq * 16 + r) * D + g * 256 + 2 * cp) = cvtpk(pv[0], pv[1]);
            }
            __syncthreads();
        }
    }
}

__device__ __forceinline__ void moe_tables(Frame& F, int layer) {
    const int lane = lane_id(), tid = F.wave * 64 + lane; (void)tid;
    LAS int* ecnt = (LAS int*)(F.lds + TAB_ECNT); LAS int* tbase = (LAS int*)(F.lds + TAB_TBASE); LAS unsigned char* texp = (LAS unsigned char*)(F.lds + TAB_TEXP);
    if (tid < NE) ecnt[tid] = (int)__hip_atomic_load(F.ctl + CW_ECNT + layer * 2048 + tid * 64, RLX_AGENT);
    __syncthreads();
    if (tid == 0) { int a = 0; for (int e = 0; e < NE; ++e) { tbase[e] = a; a += (ecnt[e] + 255) >> 8; } tbase[NE] = a; }
    __syncthreads();
    if (tid < MT_MAX) { int e = 0; for (int q = 1; q < NE; ++q) if (tid >= tbase[q]) e = q; texp[tid] = (unsigned char)e; }
    __syncthreads();
}
template <bool H8>
__device__ __forceinline__ void phase_router(Frame& F, const float* src, const float* gain, bf16* dstH, int layer, int bidx, int nblk) {
    const int cl = layer;
    const int lane = lane_id(), tid = F.wave * 64 + lane;
    f32x4 gn[4];
#pragma unroll
    for (int j = 0; j < 4; ++j) gn[j] = *((const f32x4*)gain + lane + 64 * j);
    for (int tile = bidx; tile < M / 64; tile += nblk) {
        f32x4 v[8][4];
#pragma unroll
        for (int rr = 0; rr < 8; ++rr) {
            const int t = tile * 64 + F.wave * 8 + rr;
            const f32x4* xr = (const f32x4*)(src + (size_t)t * D) + lane;
#pragma unroll
            for (int j = 0; j < 4; ++j) v[rr][j] = xr[64 * j];
            {
                float ss = 0.f;
#pragma unroll
                for (int j = 0; j < 4; ++j) ss += (v[rr][j][0] * v[rr][j][0] + v[rr][j][1] * v[rr][j][1]) + (v[rr][j][2] * v[rr][j][2] + v[rr][j][3] * v[rr][j][3]);
                ss = wave_sum(ss); const float rstd = 1.0f / sqrtf(ss * (1.0f / D) + RMS_EPS);
                if constexpr (H8) { unsigned* ho = (unsigned*)((unsigned char*)dstH + (size_t)t * D) + lane;
#pragma unroll
                    for (int j = 0; j < 4; ++j) { v[rr][j] = v[rr][j] * rstd * gn[j]; ho[64 * j] = cvtfp8x4(v[rr][j][0] * S8_H, v[rr][j][1] * S8_H, v[rr][j][2] * S8_H, v[rr][j][3] * S8_H); } }
                else { u32x2* ho = (u32x2*)(dstH + (size_t)t * D) + lane;
#pragma unroll
                    for (int j = 0; j < 4; ++j) { v[rr][j] = v[rr][j] * rstd * gn[j]; u32x2 o; o.x = cvtpk(v[rr][j][0], v[rr][j][1]); o.y = cvtpk(v[rr][j][2], v[rr][j][3]); ho[64 * j] = o; } }
            }
        }
        {
            LAS float* HT = (LAS float*)F.lds;
            LAS float* WC = (LAS float*)(F.lds + 66560);
            LAS float* PART = (LAS float*)F.lds;
            LAS float* LG = (LAS float*)(F.lds + 66560);
            LAS int* lcnt = (LAS int*)(F.lds + 99328);
            LAS int* gbase = (LAS int*)(F.lds + 99328 + 128);
            const float* RW = FIN(9) + (size_t)layer * D * NE; const float* RB = FIN(10) + layer * NE;
            const int th = F.wave & 1, kq = F.wave >> 1, r32 = lane & 31, hi = lane >> 5;
            f32x16 acc = {};
            for (int j = 0; j < 4; ++j) {
                __syncthreads();
#pragma unroll
                for (int rr = 0; rr < 8; ++rr)
#pragma unroll
                    for (int i = 0; i < 4; ++i) HT[(4 * lane + i) * 65 + F.wave * 8 + rr] = v[rr][j][i];
                { const f32x4* wsrc = (const f32x4*)(RW + (size_t)j * 256 * NE); LAS f32x4* wdst = (LAS f32x4*)WC;
#pragma unroll
                    for (int q = 0; q < 4; ++q) wdst[tid + 512 * q] = wsrc[tid + 512 * q]; }
                __syncthreads();
                const LAS float* ap = HT + (kq * 64 + hi) * 65 + th * 32 + r32; const LAS float* bp = WC + (kq * 64 + hi) * 32 + r32;
#pragma unroll 8
                for (int s = 0; s < 32; ++s) acc = __builtin_amdgcn_mfma_f32_32x32x2f32(ap[s * 2 * 65], bp[s * 2 * 32], acc, 0, 0, 0);
            }
            __syncthreads();
#pragma unroll
            for (int r = 0; r < 16; ++r) { const int tok = th * 32 + (r & 3) + 8 * (r >> 2) + 4 * hi; PART[(kq * 64 + tok) * 33 + r32] = acc[r]; }
            if (tid < NE) lcnt[tid] = 0;
            __syncthreads();
            for (int q = tid; q < 64 * NE; q += 512) { const int tok = q >> 5, e = q & 31;
                LG[tok * 33 + e] = ((PART[tok * 33 + e] + PART[(64 + tok) * 33 + e]) + (PART[(128 + tok) * 33 + e] + PART[(192 + tok) * 33 + e])) + RB[e]; }
            __syncthreads();
            int te[4], lp[4]; float tw[4];
            if (F.wave == 0) {
                const int tok = lane; unsigned used = 0u; float tv[4];
#pragma unroll
                for (int k = 0; k < 4; ++k) { float best = -INFINITY; int bi = 0;
                    for (int e = 0; e < NE; ++e) { const float xv = LG[tok * 33 + e]; if (!((used >> e) & 1u) && xv > best) { best = xv; bi = e; } }
                    used |= 1u << bi; tv[k] = best; te[k] = bi; }
                float sum = 0.f;
#pragma unroll
                for (int k = 0; k < 4; ++k) { tw[k] = __expf(tv[k] - tv[0]); sum += tw[k]; }
                const float inv = 1.0f / sum;
#pragma unroll
                for (int k = 0; k < 4; ++k) { tw[k] *= inv; lp[k] = atomicAdd((int*)(lcnt + te[k]), 1); }
            }
            __syncthreads();
            if (tid < NE) { const int c = lcnt[tid]; gbase[tid] = c > 0 ? (int)__hip_atomic_fetch_add(F.ctl + CW_ECNT + cl * 2048 + tid * 64, (unsigned)c, RLX_AGENT) : 0; }
            __syncthreads();
            if (F.wave == 0) {
                const int t = tile * 64 + lane;
                int* list = (int*)(F.ws + WS_LIST); int* tope_w = (int*)(F.ws + WS_TOPE); int* topp_w = (int*)(F.ws + WS_TOPP); float* topw_w = (float*)(F.ws + WS_TOPW);
#pragma unroll
                for (int k = 0; k < 4; ++k) { const int pos = gbase[te[k]] + lp[k]; list[te[k] * M + pos] = t; tope_w[t * 4 + k] = te[k]; topp_w[t * 4 + k] = pos; topw_w[t * 4 + k] = tw[k]; }
            }
            __syncthreads();
        }
    }
}

template <bool NORM, bool O8>
__device__ __forceinline__ void phase_combine(Frame& F, const float* src, float* dstX, const float* gain, bf16* dstH, int layer) {
    const int lane = lane_id();
    moe_tables(F, layer);
    const LAS int* tbase = (const LAS int*)(F.lds + TAB_TBASE);
    const int* tope = (const int*)(F.ws + WS_TOPE); const int* topp = (const int*)(F.ws + WS_TOPP); const float* topw = (const float*)(F.ws + WS_TOPW);
    const unsigned char* OUTS = F.ws + WS_OUTS;
    constexpr int ORB = O8 ? D : 2 * D;
    f32x4 gn[4];
    if (NORM) {
#pragma unroll
        for (int q = 0; q < 4; ++q) gn[q] = *(const f32x4*)(gain + 8 * lane + 512 * (q >> 1) + 4 * (q & 1)); }
    for (int tile = blockIdx.x; tile < M / 64; tile += F.G) {
        const int t0 = tile * 64 + F.wave * 8;
        int e_l = 0, p_l = 0; float w_l = 0.f;
        if (lane < 32) { e_l = tope[t0 * 4 + lane]; p_l = topp[t0 * 4 + lane]; w_l = topw[t0 * 4 + lane]; }
        const int slot_l = tbase[e_l] * 256 + p_l;
        if (O8) w_l *= (1.0f / S8_OUT);
#pragma unroll
        for (int b = 0; b < 2; ++b) {
            f32x4 x[4][4];
#pragma unroll
            for (int r = 0; r < 4; ++r) { const f32x4* xr = (const f32x4*)(src + (size_t)(t0 + 4 * b + r) * D + 8 * lane); x[r][0] = xr[0]; x[r][1] = xr[1]; x[r][2] = xr[128]; x[r][3] = xr[129]; }
            u32x4 o[4][4][O8 ? 1 : 2];
#pragma unroll
            for (int r = 0; r < 4; ++r)
#pragma unroll
                for (int k = 0; k < 4; ++k) { const int slot = __builtin_amdgcn_readlane(slot_l, (4 * b + r) * 4 + k); const unsigned char* ob = OUTS + (size_t)slot * ORB;
                    if constexpr (O8) { const u32x2 lo = *(const u32x2*)(ob + 8 * lane), hi = *(const u32x2*)(ob + 512 + 8 * lane); o[r][k][0] = (u32x4){lo.x, lo.y, hi.x, hi.y}; }
                    else { o[r][k][0] = *(const u32x4*)(ob + 16 * lane); o[r][k][1] = *(const u32x4*)(ob + 1024 + 16 * lane); } }
#pragma unroll
            for (int r = 0; r < 4; ++r) {
#pragma unroll
                for (int k = 0; k < 4; ++k) { const float wk = __uint_as_float((unsigned)__builtin_amdgcn_readlane((int)__float_as_uint(w_l), (4 * b + r) * 4 + k));
                    if constexpr (O8) {
#pragma unroll
                        for (int q = 0; q < 4; ++q) { const f32x2 a = __builtin_amdgcn_cvt_pk_f32_fp8((int)o[r][k][0][q], false), c = __builtin_amdgcn_cvt_pk_f32_fp8((int)o[r][k][0][q], true);
                            x[r][q] += (f32x4){a[0], a[1], c[0], c[1]} * wk; } }
                    else {
#pragma unroll
                        for (int j = 0; j < 2; ++j) { const u32x4 v = o[r][k][j];
                            x[r][2 * j] += (f32x4){bf_lo(v.x), bf_hi(v.x), bf_lo(v.y), bf_hi(v.y)} * wk; x[r][2 * j + 1] += (f32x4){bf_lo(v.z), bf_hi(v.z), bf_lo(v.w), bf_hi(v.w)} * wk; } } }
                const int t = t0 + 4 * b + r;
                { f32x4* xo = (f32x4*)(dstX + (size_t)t * D + 8 * lane); xo[0] = x[r][0]; xo[1] = x[r][1]; xo[128] = x[r][2]; xo[129] = x[r][3]; }
                if (NORM) {
                    float ss = 0.f;
#pragma unroll
                    for (int q = 0; q < 4; ++q) ss += (x[r][q][0] * x[r][q][0] + x[r][q][1] * x[r][q][1]) + (x[r][q][2] * x[r][q][2] + x[r][q][3] * x[r][q][3]);
                    ss = wave_sum(ss); const float rstd = 1.0f / sqrtf(ss * (1.0f / D) + RMS_EPS);
#pragma unroll
                    for (int j = 0; j < 2; ++j) { const f32x4 a = x[r][2 * j] * rstd * gn[2 * j], c = x[r][2 * j + 1] * rstd * gn[2 * j + 1];
                        *(u32x4*)(dstH + (size_t)t * D + 8 * lane + 512 * j) = (u32x4){cvtpk(a[0], a[1]), cvtpk(a[2], a[3]), cvtpk(c[0], c[1]), cvtpk(c[2], c[3])}; }
                }
            }
        }
    }
}

template <bool FP8, bool OUT8>
__device__ __forceinline__ void phase_moe_up(Frame& F, int layer, int G = 0  ) {
    if (G == 0) G = F.G;
    const int lane = lane_id(), tid = F.wave * 64 + lane; (void)tid;
    moe_tables(F, layer);
    const LAS int* ecnt = (const LAS int*)(F.lds + TAB_ECNT); const LAS int* tbase = (const LAS int*)(F.lds + TAB_TBASE);
    const int rowb = FP8 ? D : 2 * D;
    ProbMoeUp S{(const char*)(F.ws + WS_H2), FP8 ? (const char*)(F.ws + WS_WGU8) + (size_t)(1 - layer) * 64 * MiB : (const char*)(F.ws + WS_WGU) + (size_t)layer * NE * 2048 * 1024 * 2, F.lds, rowb, rowb, __builtin_amdgcn_readfirstlane(tbase[NE]), G, (int)blockIdx.x, F.wave};
    {
        const int* list = (const int*)(F.ws + WS_LIST); LAS unsigned* rt = (LAS unsigned*)(F.lds + TAB_ROW);
        pg8::Unit u;
#pragma nounroll
        for (int ord = 0; ord < MAXU && S.next(ord, u); ++ord) {
            if (tid < 256) { const int p = (u.pm - tbase[u.e]) * 256 + tid; const int tok = (p < ecnt[u.e]) ? list[u.e * M + p] : 0; rt[ord * 256 + tid] = (unsigned)tok * (unsigned)rowb; }
        }
        __syncthreads();
    }
    EpiGateUp<OUT8> E{(bf16*)(F.ws + WS_ACT), FIN(12) + (size_t)layer * NE * 2048};
    pg8::gemm_phase<ProbMoeUp, EpiGateUp<OUT8>, FP8, E8_UP>(F.lds, S, E);
}
template <bool FP8, bool OUT8>
__device__ __forceinline__ void phase_moe_down(Frame& F, int layer, int G = 0) {
    if (G == 0) G = F.G;
    moe_tables(F, layer);
    const LAS int* tbase = (const LAS int*)(F.lds + TAB_TBASE);
    const int rowb = FP8 ? FF : 2 * FF;
    ProbMoeDown S{(const char*)(F.ws + WS_ACT), FP8 ? (const char*)(F.ws + WS_WDN8) + (size_t)(1 - layer) * 32 * MiB : (const char*)(F.ws + WS_WDN) + (size_t)layer * NE * 1024 * 1024 * 2, F.lds, rowb, rowb, __builtin_amdgcn_readfirstlane(tbase[NE]), G, (int)blockIdx.x, F.wave};
    EpiDown<OUT8> E{(bf16*)(F.ws + WS_OUTS), FIN(14) + (size_t)layer * NE * 1024};
    pg8::gemm_phase<ProbMoeDown, EpiDown<OUT8>, FP8, E8_DOWN>(F.lds, S, E);
}

__device__ __forceinline__ int crow(int r, int hi) { return (r & 3) + 8 * (r >> 2) + 4 * hi; }
typedef LAS const char* lds_cptr;
__device__ __forceinline__ s16x4 vtr(lds_cptr p) { return __builtin_bit_cast(s16x4, __builtin_amdgcn_ds_read_tr16_b64_v4i16((LAS v4i16_t*)p)); }
__device__ __forceinline__ void attn_pair(Frame& F, int bh, int qbA, int qbB) {
    const int lane = lane_id(), r32 = lane & 31, hi = lane >> 5, wid = F.wave, sub = wid >> 2, ws = wid & 3, tids = ws * 64 + lane;
    const bf16* Qh = (const bf16*)(F.ws + WS_Q) + (size_t)bh * SEQ * HD; const bf16* Kh = (const bf16*)(F.ws + WS_K) + (size_t)bh * SEQ * HD; const bf16* Vh = (const bf16*)(F.ws + WS_V) + (size_t)bh * SEQ * HD;
    const int q0 = (sub ? qbB : qbA) * 128, qw = q0 + 32 * ws, qpos = qw + r32, jd = qw >> 6, jtop = (q0 >> 6) + 1;
    LAS unsigned char* KB = F.lds + sub * 32768; LAS unsigned char* VB = KB + 16384; LAS unsigned char* OST = F.lds + 65536 + wid * 4096;
    const bf16* ksrc[2]; const bf16* vsrc[2];
#pragma unroll
    for (int i = 0; i < 2; ++i) { const int p = tids + 256 * i, wv = p >> 6, l = p & 63;
        ksrc[i] = Kh + (size_t)l * HD + wv * 8; vsrc[i] = Vh + (size_t)(16 * (wv & 3) + (l >> 2)) * HD + (wv >> 2) * 32 + (l & 3) * 8; }
    bf16x8 qr[4];
#pragma unroll
    for (int d0 = 0; d0 < 4; ++d0) qr[d0] = *(const bf16x8*)(Qh + (size_t)qpos * HD + d0 * 16 + hi * 8);
    f32x16 o0 = {}, o1 = {};
    float C = 0.f;
    int cur = 0;
    bool done = false;
    LAS int* flags = (LAS int*)(F.lds + 65536 + 32768);
    {
#pragma unroll
      for (int i = 0; i < 2; ++i) { const u32x4 kk = *(const u32x4*)(ksrc[i] + (size_t)jtop * 64 * HD), vv = *(const u32x4*)(vsrc[i] + (size_t)jtop * 64 * HD);
          *(LAS u32x4*)(KB + (tids + 256 * i) * 16) = kk; *(LAS u32x4*)(VB + (tids + 256 * i) * 16) = vv; } }
    u32x4 kA[2], vA[2], kB[2], vB[2];
    if (jtop > 0) {
#pragma unroll
        for (int i = 0; i < 2; ++i) { kA[i] = *(const u32x4*)(ksrc[i] + (size_t)(jtop - 1) * 64 * HD); vA[i] = *(const u32x4*)(vsrc[i] + (size_t)(jtop - 1) * 64 * HD); } }
    __syncthreads();
    bool brk = false;
#define ATT_STEP(KL, VL, KS, VS) do { const int j = jtop - st; \
        if (j > 1) { _Pragma("unroll") for (int i = 0; i < 2; ++i) { KL[i] = *(const u32x4*)(ksrc[i] + (size_t)(j - 2) * 64 * HD); VL[i] = *(const u32x4*)(vsrc[i] + (size_t)(j - 2) * 64 * HD); } } \
        att_compute(j); \
        if (j > 0) { _Pragma("unroll") for (int i = 0; i < 2; ++i) { *(LAS u32x4*)(KB + (cur ^ 1) * 8192 + (tids + 256 * i) * 16) = KS[i]; *(LAS u32x4*)(VB + (cur ^ 1) * 8192 + (tids + 256 * i) * 16) = VS[i]; } } \
        if (lane == 0) flags[(st & 1) * 8 + wid] = (done || j <= 0) ? 1 : 0; \
        __syncthreads(); \
        brk = __all(flags[(st & 1) * 8 + (lane & 7)] != 0); cur ^= 1; ++st; } while (0)
    auto att_compute = [&](const int j) __attribute__((always_inline)) {
        if (j >= 0 && j <= jd && !done) {
            const lds_cptr kb = (lds_cptr)(KB + cur * 8192) + hi * 1024 + r32 * 16;
            f32x16 p0 = {}, p1 = {};
#pragma unroll
            for (int d0 = 0; d0 < 4; ++d0) { const bf16x8 b0 = *(const LAS bf16x8*)(kb + d0 * 2048), b1 = *(const LAS bf16x8*)(kb + d0 * 2048 + 512);
                p0 = __builtin_amdgcn_mfma_f32_32x32x16_bf16(b0, qr[d0], p0, 0, 0, 0); p1 = __builtin_amdgcn_mfma_f32_32x32x16_bf16(b1, qr[d0], p1, 0, 0, 0); }
            float L0[16], L1[16];
#pragma unroll
            for (int r = 0; r < 16; ++r) { L0[r] = __builtin_amdgcn_logf(1.0f + __builtin_amdgcn_exp2f(p0[r])); L1[r] = __builtin_amdgcn_logf(1.0f + __builtin_amdgcn_exp2f(p1[r])); }
            if (j == jd) {
                const int kb0 = 64 * j + 4 * hi;
#pragma unroll
                for (int r = 0; r < 16; ++r) { const int kv = kb0 + (r & 3) + 8 * (r >> 2);
                    if (kv >= qpos) { L0[r] = 0.f; p0[r] = -INFINITY; } if (kv + 32 >= qpos) { L1[r] = 0.f; p1[r] = -INFINITY; } }
            }
            float tg[8];
#pragma unroll
            for (int g = 0; g < 4; ++g) {
                L0[4 * g + 2] += L0[4 * g + 3]; L0[4 * g + 1] += L0[4 * g + 2]; L0[4 * g] += L0[4 * g + 1]; tg[g] = L0[4 * g];
                L1[4 * g + 2] += L1[4 * g + 3]; L1[4 * g + 1] += L1[4 * g + 2]; L1[4 * g] += L1[4 * g + 1]; tg[4 + g] = L1[4 * g]; }
            float off[8]; float R = C;
#pragma unroll
            for (int g = 7; g >= 0; --g) {
                const auto rr = __builtin_amdgcn_permlane32_swap(__float_as_uint(tg[g]), __float_as_uint(tg[g]), false, false);
                const float tlo = __uint_as_float(rr[0]), thi = __uint_as_float(rr[1]);
                off[g] = R + (hi ? 0.f : thi);
                R += tlo + thi; }
            C = R;
#pragma unroll
            for (int g = 0; g < 4; ++g)
#pragma unroll
                for (int i = 0; i < 4; ++i) { p0[4 * g + i] = __builtin_amdgcn_exp2f(p0[4 * g + i] - (L0[4 * g + i] + off[g])); p1[4 * g + i] = __builtin_amdgcn_exp2f(p1[4 * g + i] - (L1[4 * g + i] + off[4 + g])); }
            u32x4 pw0, pw1, pw2, pw3;
            pw0 = (u32x4){cvtpk(p0[0], p0[1]), cvtpk(p0[2], p0[3]), cvtpk(p0[4], p0[5]), cvtpk(p0[6], p0[7])};
            pw1 = (u32x4){cvtpk(p0[8], p0[9]), cvtpk(p0[10], p0[11]), cvtpk(p0[12], p0[13]), cvtpk(p0[14], p0[15])};
            pw2 = (u32x4){cvtpk(p1[0], p1[1]), cvtpk(p1[2], p1[3]), cvtpk(p1[4], p1[5]), cvtpk(p1[6], p1[7])};
            pw3 = (u32x4){cvtpk(p1[8], p1[9]), cvtpk(p1[10], p1[11]), cvtpk(p1[12], p1[13]), cvtpk(p1[14], p1[15])};
            const lds_cptr vp = (lds_cptr)(VB + cur * 8192) + ((lane >> 4) & 1) * 32 + (lane & 3) * 8 + (4 * hi + ((lane & 15) >> 2)) * 64;
#define PVSTEP(OACC, D0, KS, PW) do { const s16x4 lo_ = vtr(vp + (D0) * 4096 + (KS) * 1024), hi_ = vtr(vp + (D0) * 4096 + (KS) * 1024 + 512); \
                const bf16x8 vf_ = (bf16x8){lo_[0], lo_[1], lo_[2], lo_[3], hi_[0], hi_[1], hi_[2], hi_[3]}; \
                OACC = __builtin_amdgcn_mfma_f32_32x32x16_bf16(__builtin_bit_cast(bf16x8, PW), vf_, OACC, 0, 0, 0); } while (0)
            PVSTEP(o0, 0, 0, pw0); PVSTEP(o1, 1, 0, pw0); PVSTEP(o0, 0, 1, pw1); PVSTEP(o1, 1, 1, pw1);
            PVSTEP(o0, 0, 2, pw2); PVSTEP(o1, 1, 2, pw2); PVSTEP(o0, 0, 3, pw3); PVSTEP(o1, 1, 3, pw3);
#undef PVSTEP
            done = __all(C > 150.0f);
        }
    };
    for (int st = 0; ; ) {
        ATT_STEP(kB, vB, kA, vA); if (brk) break;
        ATT_STEP(kA, vA, kB, vB); if (brk) break;
    }
#undef ATT_STEP
    { LAS bf16* stg = (LAS bf16*)OST;
#pragma unroll
      for (int r = 0; r < 16; ++r) { const int orow = crow(r, hi); stg[orow * 64 + r32] = (bf16)(cvtpk(o0[r], 0.f) & 0xffffu); stg[orow * 64 + 32 + r32] = (bf16)(cvtpk(o1[r], 0.f) & 0xffffu); }
      LDS_WAIT(); asm volatile("" ::: "memory");
      const int b = bh >> 4, h = bh & 15;
      bf16* Ow = (bf16*)(F.ws + WS_O) + ((size_t)b * SEQ + qw) * D + h * HD;
#pragma unroll
      for (int i = 0; i < 4; ++i) { const int row = i * 8 + (lane >> 3), ch = lane & 7; const u32x4 vv = *(const LAS u32x4*)(stg + row * 64 + ch * 8); *(u32x4*)(Ow + (size_t)row * D + ch * 8) = vv; } }
    __syncthreads();
}
__device__ __forceinline__ void phase_attn(Frame& F) {
    for (int v = blockIdx.x; v < BATCH * NH * 2; v += F.G) {
        const int bh = v >> 1, odd = v & 1;
        for (int i = 0; i < 4; ++i) { const int qa = 8 * odd + 2 * i; attn_pair(F, bh, qa, qa + 1); }
    }
}

__global__ void __launch_bounds__(NWAVES * 64, 2) fwd_kernel(Args args) {
    extern __shared__ __attribute__((aligned(16))) unsigned char lds[];
    Frame F;
    F.lds = (LAS unsigned char*)lds; F.MISC = (volatile LAS unsigned*)(F.lds + MISC_OFF);
    F.wave = __builtin_amdgcn_readfirstlane((int)threadIdx.x >> 6); F.G = gridDim.x;
    F.ws = args.ws; F.ctl = (gu32*)(args.ws + WS_CTL);
    for (int u = (int)threadIdx.x; u < (LDS_BYTES - LDSCTL_OFF) / 4; u += NWAVES * 64) ((LAS unsigned*)(F.lds + LDSCTL_OFF))[u] = 0u;
    __syncthreads();
    const XcdBarrier bar = xcd_barrier_post((unsigned*)(F.ctl + CW_BAR), F.MISC + 8, gridDim.x);
#define TP_PUT(i) do { if (threadIdx.x == 0) { const unsigned long long t_ = __builtin_amdgcn_s_memrealtime(); F.MISC[16 + 2 * (i)] = (unsigned)t_; F.MISC[17 + 2 * (i)] = (unsigned)(t_ >> 32); } } while (0)
#define SEAM(k) do { xcd_barrier(bar); if (MK_TPROBE == ((k) == 0 ? 3 : (k) + 1)) TP_PUT(0); if (MK_TPROBE == (k)) TP_PUT(1); } while (0)
    if (MK_TPROBE == 0) TP_PUT(0);
    float* X1 = (float*)(F.ws + WS_X1); float* X2 = (float*)(F.ws + WS_X2); float* X3 = (float*)(F.ws + WS_X3);

    const bool tuned = (F.G == 256);
    const int nfront = tuned ? NFRONT : F.G, cv3 = tuned ? CV3 : 0, cv9 = tuned ? CV9 : 0;
    {
        const int bx = (int)blockIdx.x;
        if (bx < nfront) {
            const XcdBarrier fbar = xcd_barrier_post((unsigned*)(F.ctl + CW_BAR2), F.MISC + 10, (unsigned)nfront);
            phase_convert(F, 0, CV_SMALL, bx, nfront); __syncthreads();
            phase_pooled(F, bx, nfront);
            xcd_barrier(fbar);
            { ProbPool S{(const char*)(F.ws + WS_POOLED), (const char*)(F.ws + WS_POOLW), 512, 512, nfront, bx, F.wave}; EpiPool E{FIN(0), X1, FIN(3)};
              pg8::gemm_phase<ProbPool, EpiPool>(F.lds, S, E); }
            xcd_barrier(fbar);
            phase_router<FP8_U0>(F, X1, FIN(8), (bf16*)(F.ws + WS_H2), 0, bx, nfront);
            if (nfront == F.G) phase_convert(F, CV_SMALL, CV_END, bx, F.G);
        } else {
            phase_convert(F, CV_SMALL, CV_END - cv9 - cv3, bx - nfront, F.G - nfront);
        }
    }
    SEAM(0);
    { const int bx = (int)blockIdx.x;
        if (cv3 > 0 && bx >= G3) phase_convert(F, CV_END - cv9 - cv3, CV_END - cv9, bx - G3, F.G - G3);
        else phase_moe_up<FP8_U0, FP8_D0>(F, 0, cv3 > 0 ? G3 : 0); }
    SEAM(3);
    phase_moe_down<FP8_D0, false>(F, 0);
    SEAM(4);
    phase_combine<true, false>(F, X1, X2, FIN(1) + D, (bf16*)(F.ws + WS_HQ), 0);
    SEAM(5);
    { ProbDense S{(const char*)(F.ws + WS_HQ), (const char*)(F.ws + WS_WQKV), 2 * D, 2 * D, 2 * D, M / 256, 12, F.G, (int)blockIdx.x, F.wave}; { const int l_ = lane_id(); if (F.wave == 0) { ((LAS float*)(F.lds + BIAS_OFF))[l_] = FIN(5)[l_]; ((LAS float*)(F.lds + BIAS_OFF))[64 + l_] = FIN(6)[l_]; } __syncthreads(); }
        EpiQKV E{(bf16*)(F.ws + WS_Q), (const LAS float*)(F.lds + BIAS_OFF)};
        pg8::gemm_phase<ProbDense, EpiQKV>(F.lds, S, E); }
    SEAM(6);
    phase_attn(F);
    SEAM(7);
    { ProbDense S{(const char*)(F.ws + WS_O), (const char*)(F.ws + WS_WO), 2 * D, 2 * D, 2 * D, M / 256, 4, F.G, (int)blockIdx.x, F.wave}; EpiRes E{X2, X3};
        pg8::gemm_phase<ProbDense, EpiRes>(F.lds, S, E); }
    SEAM(8);
    {
        const int bx = (int)blockIdx.x;
        if (cv9 == 0) phase_router<true>(F, X3, FIN(8) + D, (bf16*)(F.ws + WS_H2), 1, bx, F.G);
        else if (bx < NR9) phase_router<true>(F, X3, FIN(8) + D, (bf16*)(F.ws + WS_H2), 1, bx, NR9);
        else phase_convert(F, CV_END - cv9, CV_END, bx - NR9, F.G - NR9);
    }
    SEAM(9);
    phase_moe_up<true, true>(F, 1);
    SEAM(10);
    phase_moe_down<true, true>(F, 1);
    SEAM(11);
    phase_combine<false, true>(F, X3, FOUT, nullptr, nullptr, 1);
    if (MK_TPROBE >= 0) { if (MK_TPROBE == 12) TP_PUT(1);
        if (blockIdx.x == 0 && threadIdx.x == 0) { const unsigned long long tp0 = ((unsigned long long)F.MISC[17] << 32) | F.MISC[16], tp1 = ((unsigned long long)F.MISC[19] << 32) | F.MISC[18];
            const unsigned long long dt = (tp1 - tp0) * 4, ts = __builtin_amdgcn_s_memrealtime();
            while (__builtin_amdgcn_s_memrealtime() - ts < dt) __builtin_amdgcn_s_sleep(8); } }
#undef SEAM
}

extern "C" void kernel_launch(void* const* d_in, const int* in_sizes, int n_in, void* d_out, int out_size, void* d_ws, size_t ws_size, hipStream_t stream) {
    static int grid = 0;
    if (grid == 0) {
        if (n_in != 15 || in_sizes[0] != M * D || out_size != M * D || ws_size < WS_END) { fprintf(stderr, "kernel_launch: unexpected shapes (n_in %d, in0 %d, out %d, ws %zu, need %zu)\n", n_in, n_in > 0 ? in_sizes[0] : -1, out_size, ws_size, (size_t)WS_END); grid = -1; return; }
        int dev = 0, cus = 0, per_cu = 0;
        if (hipGetDevice(&dev) != hipSuccess || hipDeviceGetAttribute(&cus, hipDeviceAttributeMultiprocessorCount, dev) != hipSuccess) { grid = -1; return; }
        if (hipFuncSetAttribute((const void*)fwd_kernel, hipFuncAttributeMaxDynamicSharedMemorySize, LDS_BYTES) != hipSuccess) { fprintf(stderr, "kernel_launch: hipFuncSetAttribute failed\n"); grid = -1; return; }
        if (hipOccupancyMaxActiveBlocksPerMultiprocessor(&per_cu, (const void*)fwd_kernel, NWAVES * 64, LDS_BYTES) != hipSuccess || per_cu < 1) fprintf(stderr, "kernel_launch: occupancy query says %d\n", per_cu);
        (void)hipGetLastError();
        grid = cus;
    }
    if (grid < 0) return;
    (void)hipMemsetAsync((char*)d_ws + WS_CTL, 0, CTL_ZERO_BYTES, stream);
    Args a{};
    for (int i = 0; i < 15; ++i) a.in[i] = (const float*)d_in[i];
    a.out = (float*)d_out; a.ws = (unsigned char*)d_ws;
    hipLaunchKernelGGL(fwd_kernel, dim3(grid), dim3(NWAVES * 64), LDS_BYTES, stream, a);
    const hipError_t le = hipPeekAtLastError();
    if (le != hipSuccess) fprintf(stderr, "kernel_launch: launch failed: %s\n", hipGetErrorName(le));
}
```

```cpp
#include <hip/hip_runtime.h>
#include <cstdio>
#include <cstdint>

#define GAS __attribute__((address_space(1)))
#define LAS __attribute__((address_space(3)))
typedef unsigned short bf16;
typedef unsigned u32x4 __attribute__((ext_vector_type(4)));
typedef unsigned u32x2 __attribute__((ext_vector_type(2)));
typedef float f32x4 __attribute__((ext_vector_type(4)));
typedef float f32x2 __attribute__((ext_vector_type(2)));
typedef float f32x16 __attribute__((ext_vector_type(16)));
typedef short bf16x8 __attribute__((ext_vector_type(8)));
typedef short s16x4 __attribute__((ext_vector_type(4)));
typedef short v4i16_t __attribute__((ext_vector_type(4)));
typedef __bf16 bf16x2_t __attribute__((ext_vector_type(2)));
typedef int i32x8 __attribute__((ext_vector_type(8)));
typedef int i32x4 __attribute__((ext_vector_type(4)));
typedef GAS unsigned gu32;

constexpr int BATCH = 8, SEQ = 2048, D = 1024, M = BATCH * SEQ, NH = 16, HD = 64, NE = 32, TOPK = 4, FF = 1024;
constexpr float RMS_EPS = 1e-6f, SW_LIMIT = 7.0f, SW_ALPHA = 1.702f;
constexpr int MT_MAX = M * TOPK / 256 + NE;
constexpr int NSLOT = MT_MAX * 256;
constexpr float C2 = 0.125f * 1.4426950408889634f;
constexpr float S8_W = 64.0f, S8_H = 8.0f, S8_ACT = 4.0f, S8_OUT = 16.0f;
constexpr int E8_UP = 127 - 9, E8_DOWN = 127 - 8;

constexpr size_t MiB = 1u << 20;
constexpr size_t WS_CTL = 0, CTL_ZERO_BYTES = 128 * 1024;
constexpr size_t WS_POOLW = 1 * MiB;
constexpr size_t WS_WQKV = 2 * MiB;
constexpr size_t WS_WO = 8 * MiB;
constexpr size_t WS_TOPE = 10 * MiB, WS_TOPP = WS_TOPE + 256 * 1024, WS_TOPW = WS_TOPP + 256 * 1024;
constexpr size_t WS_LIST = 12 * MiB;
constexpr size_t WS_WGU = 16 * MiB;
constexpr size_t WS_WDN = 272 * MiB;
constexpr size_t WS_WGU8 = WS_WGU + 128 * MiB;
constexpr size_t WS_WDN8 = WS_WDN + 64 * MiB;
constexpr size_t WS_X1 = 400 * MiB, WS_X2 = 464 * MiB, WS_X3 = 528 * MiB;
constexpr size_t WS_POOLED = 592 * MiB, WS_H2 = 624 * MiB, WS_HQ = 656 * MiB, WS_Q = 688 * MiB, WS_K = 720 * MiB, WS_V = 752 * MiB, WS_O = 784 * MiB;
constexpr size_t WS_ACT = 816 * MiB, WS_OUTS = 960 * MiB;
constexpr size_t WS_END = 1104 * MiB;
static_assert(WS_ACT + (size_t)NSLOT * 1024 * 2 <= WS_OUTS && WS_OUTS + (size_t)NSLOT * 1024 * 2 <= WS_END, "ws map");
constexpr int CW_TMO = 0, CW_CODE = 1;
constexpr int CW_BAR = 4096;
constexpr int CW_BAR2 = 8192;
constexpr int CW_ECNT = 16384;

constexpr int RING_BYTES = 131072;
constexpr int LDSCTL_OFF = RING_BYTES, MISC_OFF = LDSCTL_OFF + 320;
constexpr int TAB_OFF = 131584;
constexpr int TAB_ECNT = TAB_OFF, TAB_TBASE = TAB_OFF + 128, TAB_TEXP = TAB_OFF + 384, TAB_ROW = TAB_OFF + 1024;
constexpr int MAXU = 12;
constexpr int BIAS_OFF = TAB_ROW + MAXU * 1024;
constexpr int LDS_BYTES = 163840;
static_assert(BIAS_OFF % 16 == 0 && BIAS_OFF + 2 * 8 * 1024 <= LDS_BYTES, "LDS map");

constexpr int NWAVES = 8;
#ifndef MK_NFRONT
#define MK_NFRONT 144
#endif
constexpr int NFRONT = MK_NFRONT;
#ifndef MK_CV9
#define MK_CV9 8000
#endif
#ifndef MK_NR9
#define MK_NR9 96
#endif
constexpr int CV9 = MK_CV9, NR9 = MK_NR9;
#ifndef MK_CV3
#define MK_CV3 600
#endif
constexpr int CV3 = MK_CV3, G3 = 248;

#ifndef MK_TPROBE
#define MK_TPROBE -1
#endif
#ifndef MK_FP8_L0
#define MK_FP8_L0 3
#endif
constexpr bool FP8_U0 = (MK_FP8_L0 & 1) != 0, FP8_D0 = (MK_FP8_L0 & 2) != 0;

#define RLX_AGENT __ATOMIC_RELAXED, __HIP_MEMORY_SCOPE_AGENT
#define LDS_WAIT() asm volatile("s_waitcnt lgkmcnt(0)" ::: "memory")
#define VM_WAIT() asm volatile("s_waitcnt vmcnt(0)" ::: "memory")
__device__ __forceinline__ unsigned cvtpk(float lo, float hi) { f32x2 v = {lo, hi}; bf16x2_t b = __builtin_convertvector(v, bf16x2_t); return __builtin_bit_cast(unsigned, b); }
__device__ __forceinline__ unsigned cvtfp8x4(float a, float b, float c, float d) { int w = __builtin_amdgcn_cvt_pk_fp8_f32(a, b, 0, false); w = __builtin_amdgcn_cvt_pk_fp8_f32(c, d, w, true); return (unsigned)w; }
__device__ __forceinline__ float bf_lo(unsigned u) { return __uint_as_float(u << 16); }
__device__ __forceinline__ float bf_hi(unsigned u) { return __uint_as_float(u & 0xffff0000u); }
__device__ __forceinline__ int lane_id() { int r; asm volatile("v_mbcnt_lo_u32_b32 %0, -1, 0\n\tv_mbcnt_hi_u32_b32 %0, -1, %0" : "=v"(r)); return r; }
__device__ __forceinline__ float wave_sum(float v) {
#pragma unroll
    for (int o = 1; o < 64; o <<= 1) v += __shfl_xor(v, o);
    return v;
}

#define XB_TMO      128
#define XB_XCNT(j)  (256  + 64 * (j))
#define XB_XSUB(j)  (1280 + 64 * (j))
#define XB_XGEN(j)  (2304 + 64 * (j))
#define XB_TOP      3328
#define XB_TOPGEN   3392
#define XCD_BAR_WORDS 3456
#define XB_SPIN_CAP (1u << 18)
__device__ __forceinline__ unsigned xb_ld(unsigned* p)              { return __hip_atomic_load(p, __ATOMIC_RELAXED, __HIP_MEMORY_SCOPE_AGENT); }
__device__ __forceinline__ unsigned xb_add(unsigned* p, unsigned v) { return __hip_atomic_fetch_add(p, v, __ATOMIC_RELAXED, __HIP_MEMORY_SCOPE_AGENT); }
__device__ __forceinline__ unsigned xb_xcc_id() { return (unsigned)__builtin_amdgcn_s_getreg((3 << 11) | 20) & 0xFu; }
#define XB_SPIN(cond, bar) do { unsigned _sp = 0; while (cond) { __builtin_amdgcn_s_sleep(1); \
    if ((++_sp & 255u) == 0u) { if (xb_ld(&(bar)[XB_TMO])) break; if (_sp > XB_SPIN_CAP) { atomicAdd(&(bar)[XB_TMO], 1u); break; } } } } while (0)
struct XcdBarrier { unsigned* bar; unsigned x; volatile LAS unsigned* st; unsigned G; };
__device__ __forceinline__ XcdBarrier xcd_barrier_post(unsigned* bar, volatile LAS unsigned* st, unsigned G) {
    XcdBarrier b; b.bar = bar; b.x = xb_xcc_id(); b.st = st; b.G = G;
    if (threadIdx.x == 0) (void)xb_add(&bar[XB_XCNT(b.x)], 1u);
    return b;
}
__device__ __forceinline__ void xcd_barrier_complete(unsigned* bar, unsigned x, unsigned& nloc, unsigned& nx, const unsigned G) {
    unsigned sum, cnt, mine, sp = 0u;
    for (;;) {
        sum = 0u; cnt = 0u; mine = 0u;
#pragma unroll
        for (unsigned j = 0; j < 16; ++j) { const unsigned c = xb_ld(&bar[XB_XCNT(j)]); sum += c; cnt += (c > 0u) ? 1u : 0u; mine = (j == x) ? c : mine; }
        if (sum == G) break;
        __builtin_amdgcn_s_sleep(1);
        if ((++sp & 255u) == 0u) { if (xb_ld(&bar[XB_TMO])) break; if (sp > XB_SPIN_CAP) { atomicAdd(&bar[XB_TMO], 1u); break; } }
    }
    nloc = mine > 0u ? mine : 1u; nx = cnt > 0u ? cnt : 1u;
}
__device__ __forceinline__ void xcd_barrier(const XcdBarrier& b) {
    asm volatile("s_waitcnt vmcnt(0)" ::: "memory");
    __syncthreads();
    if (threadIdx.x == 0) {
        unsigned* bar = b.bar;
        __builtin_amdgcn_s_waitcnt(0);
        unsigned nloc = b.st[0], nx = b.st[1];
        if (nloc == 0u) { xcd_barrier_complete(bar, b.x, nloc, nx, b.G); b.st[0] = nloc; b.st[1] = nx; }
        const unsigned old = xb_add(&bar[XB_XSUB(b.x)], 1u);
        const unsigned gen = old / nloc;
        if (old + 1u == (gen + 1u) * nloc) {
            __builtin_amdgcn_fence(__ATOMIC_RELEASE, "agent");
            asm volatile("s_waitcnt vmcnt(0)" ::: "memory");
            const unsigned og = xb_add(&bar[XB_TOP], 1u);
            const unsigned tg = og / nx;
            if (og + 1u == (tg + 1u) * nx) xb_add(&bar[XB_TOPGEN], 1u);
            else XB_SPIN(xb_ld(&bar[XB_TOPGEN]) == tg, bar);
            __builtin_amdgcn_fence(__ATOMIC_ACQUIRE, "agent");
            xb_add(&bar[XB_XGEN(b.x)], 1u);
            asm volatile("s_waitcnt vmcnt(0)" ::: "memory");
        } else {
            XB_SPIN(xb_ld(&bar[XB_XGEN(b.x)]) == gen, bar);
            __builtin_amdgcn_fence(__ATOMIC_ACQUIRE, "agent");
            asm volatile("s_waitcnt vmcnt(0)" ::: "memory");
        }
    }
    __syncthreads();
}

namespace pg8 {
constexpr int BM = 256, BK = 64, HALF = 128, HTB = HALF * BK * 2, STAGE_BYTES = 8 * HTB, NXCD = 8, WGM = 8;
__host__ __device__ __forceinline__ int lds_byte(int r, int c) { const int st = (r >> 4) * 2 + (c >> 5), rr = r & 15, cc = c & 31, ob = rr * 64 + cc * 2; return st * 1024 + (ob ^ (((ob >> 9) & 1) << 5)); }
__host__ __device__ __forceinline__ void stage_rc(int b, int& R, int& C) { const int st = b / 1024, sb = b % 1024, swz = sb ^ (((sb >> 9) & 1) << 5); R = (st >> 1) * 16 + swz / 64; C = (st & 1) * 32 + (swz % 64) / 2; }
__host__ __device__ __forceinline__ int perm32(int rho) { const int n = rho >> 4, i = rho & 15; return 8 * (i >> 2) + 4 * n + (i & 3); }

struct Unit { int pm, pn, e; };
__device__ __forceinline__ void glds_sv(const char* base, unsigned voff, unsigned lds_dst) {
    unsigned keep;
    asm volatile("s_mov_b32 %0, m0\n\ts_mov_b32 m0, %3\n\ts_nop 0\n\tglobal_load_lds_dwordx4 %1, %2\n\ts_mov_b32 m0, %0" : "=&s"(keep) : "v"(voff), "s"(base), "s"(lds_dst) : "memory");
}
__device__ __forceinline__ const char* uni_ptr(const char* p) { const unsigned long long u = (unsigned long long)p; const unsigned lo = __builtin_amdgcn_readfirstlane((unsigned)u), hi = __builtin_amdgcn_readfirstlane((unsigned)(u >> 32)); return (const char*)(((unsigned long long)hi << 32) | lo); }
struct UD { const char* a; const char* b0; const char* b1; };

__device__ __forceinline__ bool order_next(int i, int G, int c, int nM, int nN, int& pm, int& pn) {
    const int L = i * G + c; const int nwg = nM * nN; if (L >= nwg) return false;
    int wgid = L; { const int q = nwg / NXCD, r = nwg % NXCD, xcd = wgid % NXCD, off = wgid / NXCD; wgid = (xcd < r ? xcd * (q + 1) : r * (q + 1) + (xcd - r) * q) + off; }
    const int nig = WGM * nN, gid = wgid / nig, fm = gid * WGM, gsz = (nM - fm) < WGM ? (nM - fm) : WGM;
    pm = fm + ((wgid % nig) % gsz); pn = (wgid % nig) / gsz; return true;
}

template <class Prob, class Epi, bool FP8 = false, int E8 = 127>
__device__ __forceinline__ void gemm_phase(LAS unsigned char* lds, const Prob& S, const Epi& E) {
    const int wid = S.wave, lane = lane_id(), tid = wid * 64 + lane, wr = wid >> 2, wc = wid & 3, fr = lane & 15, fq = lane >> 4;
    const int nt = S.Kb / 128;
    unsigned voffB[2];
#pragma unroll
    for (int i = 0; i < 2; ++i) { int R, C; stage_rc(tid * 16 + i * 8192, R, C); const int Rb = Epi::PERM ? ((R & ~31) + perm32(R & 31)) : R; voffB[i] = (unsigned)(Rb * S.ldb + C * 2); }
    const size_t kstep = (size_t)(BK * 2);
    const unsigned ldsb = (unsigned)__builtin_amdgcn_readfirstlane((int)(unsigned)(uintptr_t)lds + wid * 1024);
    const int aoff = lds_byte(wr * 64 + fr, fq * 8), boff = lds_byte(wc * 32 + fr, fq * 8);
#define PG8_SA(b, h) (((b) * 2 + (h)) * HTB)
#define PG8_SB(b, h) ((4 + (b) * 2 + (h)) * HTB)
#define PG8_STA(bufoff, gbase, va, h) do { _Pragma("unroll") for (int _i = 0; _i < 2; ++_i) glds_sv((const char*)(gbase), (va)[(h) * 2 + _i], ldsb + (unsigned)((bufoff) + _i * 8192)); } while (0)
#define PG8_STB(bufoff, gbase) do { _Pragma("unroll") for (int _i = 0; _i < 2; ++_i) glds_sv((const char*)(gbase), voffB[_i], ldsb + (unsigned)((bufoff) + _i * 8192)); } while (0)
#define PG8_LD8(p) __builtin_shufflevector(*(const LAS i32x4*)(p), *(const LAS i32x4*)((p) + 1024), 0, 1, 2, 3, 4, 5, 6, 7)
#define PG8_LDA(dst, b, h) do { _Pragma("unroll") for (int m = 0; m < 4; ++m) dst[m] = PG8_LD8(lds + PG8_SA(b, h) + aoff + m * 2048); } while (0)
#define PG8_LDB(dst, b, h) do { _Pragma("unroll") for (int n = 0; n < 2; ++n) dst[n] = PG8_LD8(lds + PG8_SB(b, h) + boff + n * 2048); } while (0)
#define PG8_HALF(x, k) __builtin_bit_cast(bf16x8, __builtin_shufflevector(x, x, 4 * (k), 4 * (k) + 1, 4 * (k) + 2, 4 * (k) + 3))
#define PG8_MMA(ai, bj, At, Bt) do { __builtin_amdgcn_s_setprio(1); _Pragma("unroll") for (int m = 0; m < 4; ++m) _Pragma("unroll") for (int n = 0; n < 2; ++n) { \
        if constexpr (FP8) acc[ai][bj][m][n] = __builtin_amdgcn_mfma_scale_f32_16x16x128_f8f6f4(Bt[n], At[m], acc[ai][bj][m][n], 0, 0, 0, E8, 0, 127); \
        else { acc[ai][bj][m][n] = __builtin_amdgcn_mfma_f32_16x16x32_bf16(PG8_HALF(Bt[n], 0), PG8_HALF(At[m], 0), acc[ai][bj][m][n], 0, 0, 0); \
               acc[ai][bj][m][n] = __builtin_amdgcn_mfma_f32_16x16x32_bf16(PG8_HALF(Bt[n], 1), PG8_HALF(At[m], 1), acc[ai][bj][m][n], 0, 0, 0); } } \
        __builtin_amdgcn_s_setprio(0); \
        if constexpr (FP8) asm volatile("" : "+v"(acc[ai][bj][0][0]), "+v"(acc[ai][bj][0][1]), "+v"(acc[ai][bj][1][0]), "+v"(acc[ai][bj][1][1]), "+v"(acc[ai][bj][2][0]), "+v"(acc[ai][bj][2][1]), "+v"(acc[ai][bj][3][0]), "+v"(acc[ai][bj][3][1])); \
        } while (0)
#define PG8_WAIT_V(n) asm volatile("s_waitcnt vmcnt(" #n ")" ::: "memory")
#define PG8_WAIT_SEAM(flag) asm volatile("s_cmp_lg_u32 %0, 0\n\ts_cbranch_scc1 1f\n\ts_waitcnt vmcnt(8)\n\ts_branch 2f\n1:\n\ts_waitcnt vmcnt(%1)\n2:" :: "s"(flag), "n"(RELAX) : "memory", "scc")
#define PG8_WAIT_L(n) asm volatile("s_waitcnt lgkmcnt(" #n ")" ::: "memory")
#define PG8_BAR __builtin_amdgcn_s_barrier()
#define PG8_SCHED __builtin_amdgcn_sched_barrier(0)
    Unit cur, nxt; UD cd, nd; unsigned cva[4]; int ui = 0;
    if (!S.next(0, cur)) return;
    S.desc(cur, cd); S.desc_va(0, cur, cva);
    constexpr int RELAX = 8 + Epi::NPRE + Epi::NST; static_assert(RELAX <= 63, "vmcnt is 6 bits");
    E.prefetch(cur, lds + BIAS_OFF + wid * 1024, lane);
    f32x4 acc[2][2][4][2];
#pragma unroll
    for (int a = 0; a < 2; ++a)
#pragma unroll
        for (int b = 0; b < 2; ++b)
#pragma unroll
            for (int m = 0; m < 4; ++m)
#pragma unroll
                for (int n = 0; n < 2; ++n) acc[a][b][m][n] = (f32x4){0.f, 0.f, 0.f, 0.f};
    i32x8 At[4], B0[2], B1[2];
    PG8_STB(PG8_SB(0, 0), cd.b0); PG8_STB(PG8_SB(0, 1), cd.b1); PG8_STA(PG8_SA(0, 0), cd.a, cva, 0); PG8_STA(PG8_SA(0, 1), cd.a, cva, 1);
    if (wr == 1) PG8_BAR;
    PG8_WAIT_V(2); PG8_BAR;
    PG8_STB(PG8_SB(1, 0), cd.b0 + kstep); PG8_STA(PG8_SA(1, 0), cd.a + kstep, cva, 0); PG8_STB(PG8_SB(1, 1), cd.b1 + kstep); PG8_STA(PG8_SA(1, 1), cd.a + kstep, cva, 1);
    PG8_WAIT_V(8); PG8_BAR;
    for (;;) {
        const bool has_next = S.next(ui + 1, nxt);
        if (has_next) S.desc(nxt, nd); else nd = cd;
#pragma clang loop unroll(disable)
        for (int t = 0; t < nt; t += 2) {
            const bool last = (t == nt - 2); const int seam = __builtin_amdgcn_readfirstlane((t == 0 && ui > 0) ? 1 : 0);
            const char* a2 = last ? nd.a : cd.a + (size_t)(t + 2) * kstep;
            const char* b20 = last ? nd.b0 : cd.b0 + (size_t)(t + 2) * kstep; const char* b21 = last ? nd.b1 : cd.b1 + (size_t)(t + 2) * kstep;
            const char* a3 = a2 + kstep; const char* b30 = b20 + kstep; const char* b31 = b21 + kstep;
            PG8_LDB(B0, 0, 0); PG8_LDB(B1, 0, 1); PG8_SCHED; PG8_LDA(At, 0, 0);
            PG8_WAIT_SEAM(seam);
            PG8_WAIT_L(0); PG8_BAR; PG8_MMA(0, 0, At, B0); PG8_MMA(0, 1, At, B1); PG8_BAR; PG8_SCHED;
            if (last && has_next) S.desc_va(ui + 1, nxt, cva);
            PG8_LDA(At, 0, 1); PG8_STB(PG8_SB(0, 0), b20); PG8_STB(PG8_SB(0, 1), b21); PG8_STA(PG8_SA(0, 0), a2, cva, 0);
            PG8_WAIT_SEAM(seam);
            PG8_WAIT_L(0); PG8_BAR; PG8_MMA(1, 0, At, B0); PG8_MMA(1, 1, At, B1); PG8_BAR; PG8_SCHED;
            PG8_LDB(B0, 1, 0); PG8_LDB(B1, 1, 1); PG8_SCHED; PG8_LDA(At, 1, 0); PG8_STA(PG8_SA(0, 1), a2, cva, 1);
            PG8_WAIT_SEAM(seam);
            PG8_WAIT_L(0); PG8_BAR; PG8_MMA(0, 0, At, B0); PG8_MMA(0, 1, At, B1); PG8_BAR; PG8_SCHED;
            PG8_LDA(At, 1, 1); PG8_STB(PG8_SB(1, 0), b30); PG8_STB(PG8_SB(1, 1), b31); PG8_STA(PG8_SA(1, 0), a3, cva, 0);
            PG8_WAIT_V(8); PG8_WAIT_L(0); PG8_BAR; PG8_MMA(1, 0, At, B0); PG8_MMA(1, 1, At, B1); PG8_BAR; PG8_SCHED;
            PG8_STA(PG8_SA(1, 1), a3, cva, 1);
        }
        if (has_next) E.prefetch(nxt, lds + BIAS_OFF + (((ui + 1) & 1) * 8 + wid) * 1024, lane);
        if (wr == 0) PG8_BAR;
        E(acc, cur, wr, wc, fr, fq, lds + BIAS_OFF + ((ui & 1) * 8 + wid) * 1024);
        if (!has_next) break;
#pragma unroll
        for (int a = 0; a < 2; ++a)
#pragma unroll
            for (int b = 0; b < 2; ++b)
#pragma unroll
                for (int m = 0; m < 4; ++m)
#pragma unroll
                    for (int n = 0; n < 2; ++n) acc[a][b][m][n] = (f32x4){0.f, 0.f, 0.f, 0.f};
        cur = nxt; cd = nd;
        ++ui;
        if (wr == 1) PG8_BAR;
    }
    PG8_WAIT_V(0);
    PG8_BAR;
#undef PG8_SA
#undef PG8_SB
#undef PG8_STA
#undef PG8_STB
#undef PG8_LDA
#undef PG8_LDB
#undef PG8_MMA
#undef PG8_LD8
#undef PG8_HALF
#undef PG8_WAIT_V
#undef PG8_WAIT_SEAM
#undef PG8_WAIT_L
#undef PG8_BAR
#undef PG8_SCHED
}
}

struct Frame {
    LAS unsigned char* lds;
    volatile LAS unsigned* MISC;
    gu32* ctl;
    int wave, G;
    unsigned char* ws;
};
struct Args { const float* in[15]; float* out; unsigned char* ws; };
#define KARG ((const __attribute__((address_space(4))) Args*)__builtin_amdgcn_kernarg_segment_ptr())
#define FIN(i) (KARG->in[i])
#define FOUT (KARG->out)

struct ProbDense {
    const char* A; const char* Bt; int lda, ldb, Kb, nM, nN, G, c, wave;
    __device__ __forceinline__ bool next(int i, pg8::Unit& u) const { u.e = 0; return pg8::order_next(i, G, c, nM, nN, u.pm, u.pn); }
    __device__ __forceinline__ void desc(const pg8::Unit& u, pg8::UD& d) const { d.a = pg8::uni_ptr(A + (size_t)u.pm * 256 * lda); d.b0 = pg8::uni_ptr(Bt + (size_t)u.pn * 256 * ldb); d.b1 = d.b0 + (size_t)128 * ldb; }
    __device__ __forceinline__ void desc_va(int, const pg8::Unit&, unsigned (&va)[4]) const {
#pragma unroll
        for (int i = 0; i < 2; ++i) { int R, C; pg8::stage_rc((wave * 64 + lane_id()) * 16 + i * 8192, R, C); va[i] = (unsigned)(R * lda + C * 2); va[2 + i] = va[i] + (unsigned)(128 * lda); }
    }
};
struct ProbPool {
    const char* A; const char* Bt; int ldb, Kb, G, c, wave;
    __device__ __forceinline__ bool next(int i, pg8::Unit& u) const { u.e = 0; return pg8::order_next(i, G, c, M / 256, 4, u.pm, u.pn); }
    __device__ __forceinline__ void desc(const pg8::Unit& u, pg8::UD& d) const { d.a = pg8::uni_ptr(A + (size_t)u.pm * 256 * D * 2 + (size_t)u.pn * 256 * 2); d.b0 = pg8::uni_ptr(Bt + (size_t)u.pn * 65536 * 2); d.b1 = d.b0 + (size_t)128 * 256 * 2; }
    __device__ __forceinline__ void desc_va(int, const pg8::Unit&, unsigned (&va)[4]) const {
#pragma unroll
        for (int i = 0; i < 2; ++i) { int R, C; pg8::stage_rc((wave * 64 + lane_id()) * 16 + i * 8192, R, C); va[i] = (unsigned)(R * D * 2 + C * 2); va[2 + i] = va[i] + (unsigned)(128 * D * 2); }
    }
};
struct ProbMoeUp {
    const char* A; const char* Bt; LAS unsigned char* lds; int ldb, Kb, nM, G, c, wave;
    __device__ __forceinline__ bool next(int i, pg8::Unit& u) const { if (!pg8::order_next(i, G, c, nM, 8, u.pm, u.pn)) return false; u.e = __builtin_amdgcn_readfirstlane((int)((const LAS unsigned char*)(lds + TAB_TEXP))[u.pm]); return true; }
    __device__ __forceinline__ void desc(const pg8::Unit& u, pg8::UD& d) const { d.a = pg8::uni_ptr(A); d.b0 = pg8::uni_ptr(Bt + ((size_t)u.e * 2048 + (size_t)u.pn * 256) * ldb); d.b1 = d.b0 + (size_t)128 * ldb; }
    __device__ __forceinline__ void desc_va(int ord, const pg8::Unit&, unsigned (&va)[4]) const {
        const LAS unsigned* rt = (const LAS unsigned*)(lds + TAB_ROW) + ord * 256;
#pragma unroll
        for (int i = 0; i < 2; ++i) { int R, C; pg8::stage_rc((wave * 64 + lane_id()) * 16 + i * 8192, R, C); va[i] = rt[R] + (unsigned)(C * 2); va[2 + i] = rt[128 + R] + (unsigned)(C * 2); }
    }
};
struct ProbMoeDown {
    const char* A; const char* Bt; LAS unsigned char* lds; int ldb, Kb, nM, G, c, wave;
    __device__ __forceinline__ bool next(int i, pg8::Unit& u) const { if (!pg8::order_next(i, G, c, nM, 4, u.pm, u.pn)) return false; u.e = __builtin_amdgcn_readfirstlane((int)((const LAS unsigned char*)(lds + TAB_TEXP))[u.pm]); return true; }
    __device__ __forceinline__ void desc(const pg8::Unit& u, pg8::UD& d) const { d.a = pg8::uni_ptr(A + (size_t)u.pm * 256 * ldb); d.b0 = pg8::uni_ptr(Bt + ((size_t)u.e * 1024 + (size_t)u.pn * 256) * ldb); d.b1 = d.b0 + (size_t)128 * ldb; }
    __device__ __forceinline__ void desc_va(int, const pg8::Unit&, unsigned (&va)[4]) const {
#pragma unroll
        for (int i = 0; i < 2; ++i) { int R, C; pg8::stage_rc((wave * 64 + lane_id()) * 16 + i * 8192, R, C); va[i] = (unsigned)(R * ldb + C * 2); va[2 + i] = va[i] + (unsigned)(128 * ldb); }
    }
};

struct EpiPool {
    static constexpr bool PERM = false; static constexpr int NST = 32, NPRE = 0;
    const float* x; float* X1; const float* scale;
    __device__ __forceinline__ void prefetch(const pg8::Unit&, LAS unsigned char*, int) const {}

    __device__ __forceinline__ void operator()(const f32x4 (&acc)[2][2][4][2], const pg8::Unit& u, int wr, int wc, int fr, int fq, LAS unsigned char* bl) const {
        const int row0 = u.pm * 256 + wr * 64 + fr, col0 = u.pn * 256 + wc * 32 + 4 * fq;
        f32x4 sv[2][2];
#pragma unroll
        for (int bj = 0; bj < 2; ++bj)
#pragma unroll
            for (int n = 0; n < 2; ++n) sv[bj][n] = *(const f32x4*)(scale + col0 + bj * 128 + n * 16);
#pragma unroll
        for (int ai = 0; ai < 2; ++ai)
#pragma unroll
            for (int m = 0; m < 4; ++m) { const size_t off = (size_t)(row0 + ai * 128 + m * 16) * D + col0;
#pragma unroll
                for (int bj = 0; bj < 2; ++bj)
#pragma unroll
                    for (int n = 0; n < 2; ++n) { const f32x4 xv = *(const f32x4*)(x + off + bj * 128 + n * 16); *(f32x4*)(X1 + off + bj * 128 + n * 16) = xv + acc[ai][bj][m][n] * sv[bj][n]; }
                if (m & 1) asm volatile("" ::: "memory"); }
    }
};
struct EpiRes {
    static constexpr bool PERM = false; static constexpr int NST = 32, NPRE = 0;
    const float* Xi; float* Xo;
    __device__ __forceinline__ void prefetch(const pg8::Unit&, LAS unsigned char*, int) const {}

    __device__ __forceinline__ void operator()(const f32x4 (&acc)[2][2][4][2], const pg8::Unit& u, int wr, int wc, int fr, int fq, LAS unsigned char* bl) const {
        const int row0 = u.pm * 256 + wr * 64 + fr, col0 = u.pn * 256 + wc * 32 + 4 * fq;
#pragma unroll
        for (int ai = 0; ai < 2; ++ai)
#pragma unroll
            for (int m = 0; m < 4; ++m) { const size_t off = (size_t)(row0 + ai * 128 + m * 16) * D + col0;
#pragma unroll
                for (int bj = 0; bj < 2; ++bj)
#pragma unroll
                    for (int n = 0; n < 2; ++n) { const f32x4 xv = *(const f32x4*)(Xi + off + bj * 128 + n * 16); *(f32x4*)(Xo + off + bj * 128 + n * 16) = xv + acc[ai][bj][m][n]; }
                if (m & 1) asm volatile("" ::: "memory"); }
    }
};
struct EpiQKV {
    static constexpr bool PERM = true; static constexpr int NST = 16, NPRE = 0;
    bf16* QKV; const LAS float* gl;
    __device__ __forceinline__ void prefetch(const pg8::Unit&, LAS unsigned char*, int) const {}

    __device__ __forceinline__ void operator()(const f32x4 (&acc)[2][2][4][2], const pg8::Unit& u, int wr, int wc, int fr, int fq, LAS unsigned char* bl) const {
        const int seg = u.pn >> 2, head = (u.pn & 3) * 4 + wc;
        f32x4 gv[2][2];
#pragma unroll
        for (int bj = 0; bj < 2; ++bj)
#pragma unroll
            for (int n = 0; n < 2; ++n) {
                if (seg == 2) gv[bj][n] = (f32x4){1.f, 1.f, 1.f, 1.f};
                else { const LAS float* g = gl + seg * 64 + bj * 32 + 8 * fq + 4 * n; gv[bj][n] = *(const LAS f32x4*)g; if (seg == 0) gv[bj][n] = gv[bj][n] * C2; } }
        bf16* base = QKV + (size_t)seg * M * D;
#pragma unroll
        for (int ai = 0; ai < 2; ++ai)
#pragma unroll
            for (int m = 0; m < 4; ++m) {
                const int t = u.pm * 256 + ai * 128 + wr * 64 + m * 16 + fr, b = t >> 11, s = t & (SEQ - 1);
                float rstd = 1.f;
                if (seg < 2) { float ss = 0.f;
#pragma unroll
                    for (int bj = 0; bj < 2; ++bj)
#pragma unroll
                        for (int n = 0; n < 2; ++n) { const f32x4 v = acc[ai][bj][m][n]; ss += (v[0] * v[0] + v[1] * v[1]) + (v[2] * v[2] + v[3] * v[3]); }
                    ss += __shfl_xor(ss, 16); ss += __shfl_xor(ss, 32);
                    rstd = 1.0f / sqrtf(ss * (1.0f / 64.0f) + RMS_EPS); }
                bf16* rowp = base + ((size_t)(b * NH + head) * SEQ + s) * HD + 8 * fq;
#pragma unroll
                for (int bj = 0; bj < 2; ++bj) { const f32x4 v0 = acc[ai][bj][m][0] * rstd * gv[bj][0], v1 = acc[ai][bj][m][1] * rstd * gv[bj][1];
                    u32x4 w; w.x = cvtpk(v0[0], v0[1]); w.y = cvtpk(v0[2], v0[3]); w.z = cvtpk(v1[0], v1[1]); w.w = cvtpk(v1[2], v1[3]);
                    *(u32x4*)(rowp + bj * 32) = w; }
            }
    }
};
template <bool OUT8> struct EpiGateUp {
    static constexpr bool PERM = true; static constexpr int NST = 8, NPRE = 1;
    bf16* ACT; const float* bias;
    __device__ __forceinline__ void prefetch(const pg8::Unit& u, LAS unsigned char* bl, int lane) const {
        pg8::glds_sv(pg8::uni_ptr((const char*)(bias + (size_t)u.e * 2048 + u.pn * 128)), (unsigned)((lane & 31) * 16 + (lane >> 5) * 4096), (unsigned)__builtin_amdgcn_readfirstlane((int)(unsigned)(uintptr_t)bl)); }
    __device__ __forceinline__ void operator()(const f32x4 (&acc)[2][2][4][2], const pg8::Unit& u, int wr, int wc, int fr, int fq, LAS unsigned char* bl) const {
        { const int le = lane_id(); fr = le & 15; fq = le >> 4; }
        const int lc = u.pn * 128 + wc * 32 + 8 * fq;
        const LAS float* bg = (const LAS float*)bl + wc * 32 + 8 * fq;
        f32x4 bv[2][2];
#pragma unroll
        for (int bj = 0; bj < 2; ++bj)
#pragma unroll
            for (int n = 0; n < 2; ++n) bv[bj][n] = *(const LAS f32x4*)(bg + bj * 128 + 4 * n) + (bj ? 1.0f : 0.0f);
#pragma unroll
        for (int ai = 0; ai < 2; ++ai)
#pragma unroll
            for (int m = 0; m < 4; ++m) {
                const size_t eoff = (size_t)(u.pm * 256 + ai * 128 + wr * 64 + m * 16 + fr) * FF + lc;
                float o[8];
                constexpr float OS = OUT8 ? S8_ACT : 1.0f, IOS = 1.0f / OS;
#pragma unroll
                for (int n = 0; n < 2; ++n) { const f32x4 g4 = acc[ai][0][m][n] + bv[0][n], u4 = acc[ai][1][m][n] + bv[1][n];
#pragma unroll
                    for (int i = 0; i < 4; ++i) { const float g = fminf(g4[i], SW_LIMIT), up1 = __builtin_amdgcn_fmed3f(u4[i], 1.0f - SW_LIMIT, 1.0f + SW_LIMIT);
                        const float sg = __builtin_amdgcn_rcpf(__builtin_fmaf(__builtin_amdgcn_exp2f(g * (-SW_ALPHA * 1.4426950408889634f)), IOS, IOS));
                        o[n * 4 + i] = up1 * (g * sg); } }
                if constexpr (OUT8) { u32x2 w; w.x = cvtfp8x4(o[0], o[1], o[2], o[3]); w.y = cvtfp8x4(o[4], o[5], o[6], o[7]);
                    *(u32x2*)((unsigned char*)ACT + eoff) = w; }
                else { u32x4 w; w.x = cvtpk(o[0], o[1]); w.y = cvtpk(o[2], o[3]); w.z = cvtpk(o[4], o[5]); w.w = cvtpk(o[6], o[7]);
                    *(u32x4*)(ACT + eoff) = w; }
            }
    }
};
template <bool OUT8> struct EpiDown {
    static constexpr bool PERM = true; static constexpr int NST = 16, NPRE = 1;
    bf16* OUTS; const float* bias;
    __device__ __forceinline__ void prefetch(const pg8::Unit& u, LAS unsigned char* bl, int lane) const {
        pg8::glds_sv(pg8::uni_ptr((const char*)(bias + (size_t)u.e * 1024 + u.pn * 256)), (unsigned)(lane * 16), (unsigned)__builtin_amdgcn_readfirstlane((int)(unsigned)(uintptr_t)bl)); }
    __device__ __forceinline__ void operator()(const f32x4 (&acc)[2][2][4][2], const pg8::Unit& u, int wr, int wc, int fr, int fq, LAS unsigned char* bl) const {
        const int col0 = u.pn * 256 + wc * 32 + 8 * fq;
        const LAS float* bd = (const LAS float*)bl + wc * 32 + 8 * fq;
        f32x4 bv[2][2];
#pragma unroll
        for (int bj = 0; bj < 2; ++bj)
#pragma unroll
            for (int n = 0; n < 2; ++n) bv[bj][n] = *(const LAS f32x4*)(bd + bj * 128 + 4 * n);
#pragma unroll
        for (int ai = 0; ai < 2; ++ai)
#pragma unroll
            for (int m = 0; m < 4; ++m) { bf16* rowp = OUTS + (size_t)(u.pm * 256 + ai * 128 + wr * 64 + m * 16 + fr) * D + col0;
#pragma unroll
                for (int bj = 0; bj < 2; ++bj) { const f32x4 v0 = acc[ai][bj][m][0] + bv[bj][0], v1 = acc[ai][bj][m][1] + bv[bj][1];
                    if constexpr (OUT8) { u32x2 w;
#define O8C(x) __builtin_amdgcn_fmed3f((x) * S8_OUT, -448.0f, 448.0f)
                        w.x = cvtfp8x4(O8C(v0[0]), O8C(v0[1]), O8C(v0[2]), O8C(v0[3])); w.y = cvtfp8x4(O8C(v1[0]), O8C(v1[1]), O8C(v1[2]), O8C(v1[3]));
#undef O8C
                        *(u32x2*)((unsigned char*)OUTS + (size_t)(u.pm * 256 + ai * 128 + wr * 64 + m * 16 + fr) * D + col0 + bj * 128) = w; }
                    else { u32x4 w; w.x = cvtpk(v0[0], v0[1]); w.y = cvtpk(v0[2], v0[3]); w.z = cvtpk(v1[0], v1[1]); w.w = cvtpk(v1[2], v1[3]);
                        *(u32x4*)(rowp + bj * 128) = w; } } }
    }
};

constexpr int CV_POOL = 4 * 2 * 4, CV_QKV = 8 * 48, CV_WO = 8 * 16, CV_GU1 = 32 * 8 * 32  , CV_DN1 = 32 * 8 * 16  ;
constexpr int CV_SMALL = CV_POOL + CV_QKV + CV_WO, CV_END = CV_SMALL + 2 * (CV_GU1 + CV_DN1);
struct CvtItem { const float* src; unsigned char* dst; int N, dpitch, fp8, hs; };
__device__ __forceinline__ CvtItem cvt_decode(Frame& F, int it) {
    CvtItem c; int r = it; c.fp8 = 0; c.hs = 32;
    if (r < CV_POOL) { const int g = r >> 3, q = r & 7, kb = q >> 2, nb = q & 3; c.N = 256; c.dpitch = 512;
        c.src = FIN(2) + (size_t)g * 65536 + (size_t)(kb * 128) * 256 + nb * 64; c.dst = F.ws + WS_POOLW + ((size_t)g * 65536 + (size_t)(nb * 64) * 256 + kb * 128) * 2; return c; }
    r -= CV_POOL;
    if (r < CV_QKV) { const int kb = r / 48, nb = r % 48, n0 = nb * 64, pn = n0 >> 8, w = (n0 & 255) >> 6; c.N = 3 * D; c.dpitch = 2 * D; c.hs = 128;
        c.src = FIN(4) + (size_t)(kb * 128) * (3 * D) + n0; c.dst = F.ws + WS_WQKV + ((size_t)(256 * pn + 32 * w) * D + kb * 128) * 2; return c; }
    r -= CV_QKV;
    if (r < CV_WO) { const int kb = r >> 4, nb = r & 15; c.N = D; c.dpitch = 2 * D;
        c.src = FIN(7) + (size_t)(kb * 128) * D + nb * 64; c.dst = F.ws + WS_WO + ((size_t)(nb * 64) * D + kb * 128) * 2; return c; }
    r -= CV_WO;
    int layer = 0;
    if (r >= CV_GU1 + CV_DN1) { r -= CV_GU1 + CV_DN1; layer = 1; }
    if (r < CV_GU1) { const int mat = layer * NE + (r >> 8), q = r & 255, kb = q >> 5, nb = q & 31; c.N = 2 * FF; c.fp8 = (layer == 1 || FP8_U0); c.dpitch = c.fp8 ? D : 2 * D;
        c.src = FIN(11) + (size_t)mat * D * 2 * FF + (size_t)(kb * 128) * (2 * FF) + nb * 64;
        const int n0 = nb * 64, cg = n0 & (FF - 1), drow = (cg >> 7) * 256 + (n0 >= FF ? 128 : 0) + (cg & 127);
        c.dst = c.fp8 ? F.ws + WS_WGU8 + (size_t)(1 - layer) * 64 * MiB + (size_t)(mat - layer * NE) * 2 * FF * D + (size_t)drow * D + kb * 128 : F.ws + WS_WGU + ((size_t)mat * 2 * FF * D + (size_t)drow * D + kb * 128) * 2; return c; }
    r -= CV_GU1;
    { const int mat = layer * NE + (r >> 7), q = r & 127, kb = q >> 4, nb = q & 15; c.N = D; c.fp8 = (layer == 1 || FP8_D0); c.dpitch = c.fp8 ? FF : 2 * FF;
        c.src = FIN(13) + (size_t)mat * FF * D + (size_t)(kb * 128) * D + nb * 64;
        c.dst = c.fp8 ? F.ws + WS_WDN8 + (size_t)(1 - layer) * 32 * MiB + (size_t)(mat - layer * NE) * D * FF + (size_t)(nb * 64) * FF + kb * 128 : F.ws + WS_WDN + ((size_t)mat * D * FF + (size_t)(nb * 64) * FF + kb * 128) * 2; return c; }
}
__device__ __forceinline__ void cvt_load(const CvtItem& c, int half, f32x4 (&v)[16], int lane) {
    const float* p = c.src + (size_t)(64 * half + (lane >> 4)) * c.N + 4 * (lane & 15);
#pragma unroll
    for (int i = 0; i < 16; ++i) v[i] = __builtin_nontemporal_load((const f32x4*)(p + (size_t)(4 * i) * c.N));
}
__device__ __forceinline__ s16x4 cvt_tr(LAS const unsigned char* p) { return __builtin_bit_cast(s16x4, __builtin_amdgcn_ds_read_tr16_b64_v4i16((LAS v4i16_t*)p)); }
constexpr int CVP = 136;
__device__ __forceinline__ void cvt_to_lds(const f32x4 (&v)[16], int half, LAS unsigned char* scr, int lane) {
    LAS unsigned char* wp = scr + (64 * half + (lane >> 4)) * CVP + (lane & 15) * 8;
#pragma unroll
    for (int i = 0; i < 16; ++i) { u32x2 w; w.x = cvtpk(v[i][0], v[i][1]); w.y = cvtpk(v[i][2], v[i][3]); *(LAS u32x2*)(wp + 4 * i * CVP) = w; }
}
__device__ __forceinline__ void cvt_emit(const CvtItem& c, LAS unsigned char* scr, int lane) {
    LDS_WAIT(); asm volatile("" ::: "memory");
    const int g = lane >> 4, i16 = lane & 15, r = i16 >> 2, cc = i16 & 3;
    if (c.fp8) {
#pragma unroll
        for (int nb = 0; nb < 4; ++nb)
#pragma unroll
            for (int ps = 0; ps < 2; ++ps) { const int kc = 4 * ps + g; LAS const unsigned char* rp = scr + (16 * kc + r) * CVP + cc * 8 + nb * 32;
                u32x4 o;
#pragma unroll
                for (int h = 0; h < 4; ++h) { const u32x2 t = __builtin_bit_cast(u32x2, cvt_tr(rp + (4 * h) * CVP));
                    const unsigned a = t.x + 0x03000300u, b = t.y + 0x03000300u;
                    o[h] = cvtfp8x4(__uint_as_float(a << 16), __uint_as_float(a & 0xffff0000u), __uint_as_float(b << 16), __uint_as_float(b & 0xffff0000u)); }
                const int n = 16 * nb + i16;
                *(u32x4*)(c.dst + (size_t)((n >> 5) * c.hs + (n & 31)) * c.dpitch + 16 * kc) = o; }
    } else {
#pragma unroll
        for (int nb = 0; nb < 4; ++nb)
#pragma unroll
            for (int ps = 0; ps < 4; ++ps) { const int kc = 4 * ps + g; LAS const unsigned char* rp = scr + (8 * kc + r) * CVP + cc * 8 + nb * 32;
                const u32x2 t0 = __builtin_bit_cast(u32x2, cvt_tr(rp)), t1 = __builtin_bit_cast(u32x2, cvt_tr(rp + 4 * CVP));
                const int n = 16 * nb + i16;
                *(u32x4*)(c.dst + (size_t)((n >> 5) * c.hs + (n & 31)) * c.dpitch + 16 * kc) = (u32x4){t0.x, t0.y, t1.x, t1.y}; }
    }
    LDS_WAIT(); asm volatile("" ::: "memory");
}
__device__ __forceinline__ void phase_convert(Frame& F, int item_lo, int item_hi, int bidx, int nblk) {
    const int lane = lane_id();
    LAS unsigned char* scr = F.lds + (F.wave < 7 ? F.wave * 17408 : 133120);
    const int gw = bidx * NWAVES + F.wave, NGW = nblk * NWAVES;
    int it = item_lo + gw; if (it >= item_hi) return;
    CvtItem c = cvt_decode(F, it); f32x4 va[16], vb[16]; cvt_load(c, 0, va, lane); cvt_load(c, 1, vb, lane);
    for (;;) {
        cvt_to_lds(va, 0, scr, lane); cvt_to_lds(vb, 1, scr, lane);
        const int itn = it + NGW; const bool more = itn < item_hi;
        CvtItem cn = c;
        if (more) { cn = cvt_decode(F, itn); cvt_load(cn, 0, va, lane); cvt_load(cn, 1, vb, lane); }
        cvt_emit(c, scr, lane);
        if (!more) break;
        c = cn; it = itn;
    }
}
__device__ __forceinline__ void phase_pooled(Frame& F, int bidx, int nblk) {
    const int lane = lane_id(), tid = F.wave * 64 + lane; (void)tid;
    LAS float* H = (LAS float*)F.lds;
    LAS float* RS = (LAS float*)(F.lds + 81920);
    bf16* P = (bf16*)(F.ws + WS_POOLED);
    for (int tile = bidx; tile < M / 64; tile += nblk) {
        const int t0 = tile * 64, s0 = t0 & (SEQ - 1);
        for (int i = F.wave; i < 79; i += NWAVES) {
            const int s = s0 - 15 + i; float r = 0.f;
            if (s >= 0) { const f32x4* xr = (const f32x4*)(FIN(0) + (size_t)(t0 - 15 + i) * D) + lane; float ss = 0.f;
#pragma unroll
                for (int j = 0; j < 4; ++j) { const f32x4 v = xr[64 * j]; ss += (v[0] * v[0] + v[1] * v[1]) + (v[2] * v[2] + v[3] * v[3]); }
                ss = wave_sum(ss); r = 1.0f / sqrtf(ss * (1.0f / D) + RMS_EPS); }
            if (lane == 0) RS[i] = r;
        }
        __syncthreads();
        for (int g = 0; g < 4; ++g) {
            const f32x4 gn = *((const f32x4*)(FIN(1) + g * 256) + lane);
            for (int i = F.wave; i < 79; i += NWAVES) {
                const int s = s0 - 15 + i; f32x4 v = (f32x4){0.f, 0.f, 0.f, 0.f};
                if (s >= 0) { v = *((const f32x4*)(FIN(0) + (size_t)(t0 - 15 + i) * D + g * 256) + lane); v = v * RS[i] * gn; }
                *((LAS f32x4*)(H + i * 256) + lane) = v;
            }
            __syncthreads();
            const int w = 2 << g, cp = tid & 127, rq = tid >> 7, i0 = 15 + rq * 16;
            const LAS f32x2* H2p = (const LAS f32x2*)H + cp;
            f32x2 S = (f32x2){0.f, 0.f};
            for (int j = i0 - w + 1; j <= i0; ++j) S += H2p[j * 128];
            for (int r = 0; r < 16; ++r) {
                const int i = i0 + r;
                if (r > 0) S += H2p[i * 128] - H2p[(i - w) * 128];
                const int s = s0 + rq * 16 + r; const int cnt = (s + 1 < w) ? (s + 1) : w;
                const f32x2 h = H2p[i * 128]; const float inv = 1.0f / (float)cnt;
                const f32x2 pv = S * inv - h;
                *(unsigned*)(P + (size_t)(t0 + rq * 16 + r) * D + g * 256 + 2 * cp) = cvtpk(pv[0], pv[1]);
            }
            __syncthreads();
        }
    }
}

__device__ __forceinline__ void moe_tables(Frame& F, int layer) {
    const int lane = lane_id(), tid = F.wave * 64 + lane; (void)tid;
    LAS int* ecnt = (LAS int*)(F.lds + TAB_ECNT); LAS int* tbase = (LAS int*)(F.lds + TAB_TBASE); LAS unsigned char* texp = (LAS unsigned char*)(F.lds + TAB_TEXP);
    if (tid < NE) ecnt[tid] = (int)__hip_atomic_load(F.ctl + CW_ECNT + layer * 2048 + tid * 64, RLX_AGENT);
    __syncthreads();
    if (tid == 0) { int a = 0; for (int e = 0; e < NE; ++e) { tbase[e] = a; a += (ecnt[e] + 255) >> 8; } tbase[NE] = a; }
    __syncthreads();
    if (tid < MT_MAX) { int e = 0; for (int q = 1; q < NE; ++q) if (tid >= tbase[q]) e = q; texp[tid] = (unsigned char)e; }
    __syncthreads();
}
template <bool H8>
__device__ __forceinline__ void phase_router(Frame& F, const float* src, const float* gain, bf16* dstH, int layer, int bidx, int nblk) {
    const int cl = layer;
    const int lane = lane_id(), tid = F.wave * 64 + lane;
    f32x4 gn[4];
#pragma unroll
    for (int j = 0; j < 4; ++j) gn[j] = *((const f32x4*)gain + lane + 64 * j);
    for (int tile = bidx; tile < M / 64; tile += nblk) {
        f32x4 v[8][4];
#pragma unroll
        for (int rr = 0; rr < 8; ++rr) {
            const int t = tile * 64 + F.wave * 8 + rr;
            const f32x4* xr = (const f32x4*)(src + (size_t)t * D) + lane;
#pragma unroll
            for (int j = 0; j < 4; ++j) v[rr][j] = xr[64 * j];
            {
                float ss = 0.f;
#pragma unroll
                for (int j = 0; j < 4; ++j) ss += (v[rr][j][0] * v[rr][j][0] + v[rr][j][1] * v[rr][j][1]) + (v[rr][j][2] * v[rr][j][2] + v[rr][j][3] * v[rr][j][3]);
                ss = wave_sum(ss); const float rstd = 1.0f / sqrtf(ss * (1.0f / D) + RMS_EPS);
                if constexpr (H8) { unsigned* ho = (unsigned*)((unsigned char*)dstH + (size_t)t * D) + lane;
#pragma unroll
                    for (int j = 0; j < 4; ++j) { v[rr][j] = v[rr][j] * rstd * gn[j]; ho[64 * j] = cvtfp8x4(v[rr][j][0] * S8_H, v[rr][j][1] * S8_H, v[rr][j][2] * S8_H, v[rr][j][3] * S8_H); } }
                else { u32x2* ho = (u32x2*)(dstH + (size_t)t * D) + lane;
#pragma unroll
                    for (int j = 0; j < 4; ++j) { v[rr][j] = v[rr][j] * rstd * gn[j]; u32x2 o; o.x = cvtpk(v[rr][j][0], v[rr][j][1]); o.y = cvtpk(v[rr][j][2], v[rr][j][3]); ho[64 * j] = o; } }
            }
        }
        {
            LAS float* HT = (LAS float*)F.lds;
            LAS float* WC = (LAS float*)(F.lds + 66560);
            LAS float* PART = (LAS float*)F.lds;
            LAS float* LG = (LAS float*)(F.lds + 66560);
            LAS int* lcnt = (LAS int*)(F.lds + 99328);
            LAS int* gbase = (LAS int*)(F.lds + 99328 + 128);
            const float* RW = FIN(9) + (size_t)layer * D * NE; const float* RB = FIN(10) + layer * NE;
            const int th = F.wave & 1, kq = F.wave >> 1, r32 = lane & 31, hi = lane >> 5;
            f32x16 acc = {};
            for (int j = 0; j < 4; ++j) {
                __syncthreads();
#pragma unroll
                for (int rr = 0; rr < 8; ++rr)
#pragma unroll
                    for (int i = 0; i < 4; ++i) HT[(4 * lane + i) * 65 + F.wave * 8 + rr] = v[rr][j][i];
                { const f32x4* wsrc = (const f32x4*)(RW + (size_t)j * 256 * NE); LAS f32x4* wdst = (LAS f32x4*)WC;
#pragma unroll
                    for (int q = 0; q < 4; ++q) wdst[tid + 512 * q] = wsrc[tid + 512 * q]; }
                __syncthreads();
                const LAS float* ap = HT + (kq * 64 + hi) * 65 + th * 32 + r32; const LAS float* bp = WC + (kq * 64 + hi) * 32 + r32;
#pragma unroll 8
                for (int s = 0; s < 32; ++s) acc = __builtin_amdgcn_mfma_f32_32x32x2f32(ap[s * 2 * 65], bp[s * 2 * 32], acc, 0, 0, 0);
            }
            __syncthreads();
#pragma unroll
            for (int r = 0; r < 16; ++r) { const int tok = th * 32 + (r & 3) + 8 * (r >> 2) + 4 * hi; PART[(kq * 64 + tok) * 33 + r32] = acc[r]; }
            if (tid < NE) lcnt[tid] = 0;
            __syncthreads();
            for (int q = tid; q < 64 * NE; q += 512) { const int tok = q >> 5, e = q & 31;
                LG[tok * 33 + e] = ((PART[tok * 33 + e] + PART[(64 + tok) * 33 + e]) + (PART[(128 + tok) * 33 + e] + PART[(192 + tok) * 33 + e])) + RB[e]; }
            __syncthreads();
            int te[4], lp[4]; float tw[4];
            if (F.wave == 0) {
                const int tok = lane; unsigned used = 0u; float tv[4];
#pragma unroll
                for (int k = 0; k < 4; ++k) { float best = -INFINITY; int bi = 0;
                    for (int e = 0; e < NE; ++e) { const float xv = LG[tok * 33 + e]; if (!((used >> e) & 1u) && xv > best) { best = xv; bi = e; } }
                    used |= 1u << bi; tv[k] = best; te[k] = bi; }
                float sum = 0.f;
#pragma unroll
                for (int k = 0; k < 4; ++k) { tw[k] = __expf(tv[k] - tv[0]); sum += tw[k]; }
                const float inv = 1.0f / sum;
#pragma unroll
                for (int k = 0; k < 4; ++k) { tw[k] *= inv; lp[k] = atomicAdd((int*)(lcnt + te[k]), 1); }
            }
            __syncthreads();
            if (tid < NE) { const int c = lcnt[tid]; gbase[tid] = c > 0 ? (int)__hip_atomic_fetch_add(F.ctl + CW_ECNT + cl * 2048 + tid * 64, (unsigned)c, RLX_AGENT) : 0; }
            __syncthreads();
            if (F.wave == 0) {
                const int t = tile * 64 + lane;
                int* list = (int*)(F.ws + WS_LIST); int* tope_w = (int*)(F.ws + WS_TOPE); int* topp_w = (int*)(F.ws + WS_TOPP); float* topw_w = (float*)(F.ws + WS_TOPW);
#pragma unroll
                for (int k = 0; k < 4; ++k) { const int pos = gbase[te[k]] + lp[k]; list[te[k] * M + pos] = t; tope_w[t * 4 + k] = te[k]; topp_w[t * 4 + k] = pos; topw_w[t * 4 + k] = tw[k]; }
            }
            __syncthreads();
        }
    }
}

template <bool NORM, bool O8>
__device__ __forceinline__ void phase_combine(Frame& F, const float* src, float* dstX, const float* gain, bf16* dstH, int layer) {
    const int lane = lane_id();
    moe_tables(F, layer);
    const LAS int* tbase = (const LAS int*)(F.lds + TAB_TBASE);
    const int* tope = (const int*)(F.ws + WS_TOPE); const int* topp = (const int*)(F.ws + WS_TOPP); const float* topw = (const float*)(F.ws + WS_TOPW);
    const unsigned char* OUTS = F.ws + WS_OUTS;
    constexpr int ORB = O8 ? D : 2 * D;
    f32x4 gn[4];
    if (NORM) {
#pragma unroll
        for (int q = 0; q < 4; ++q) gn[q] = *(const f32x4*)(gain + 8 * lane + 512 * (q >> 1) + 4 * (q & 1)); }
    for (int tile = blockIdx.x; tile < M / 64; tile += F.G) {
        const int t0 = tile * 64 + F.wave * 8;
        int e_l = 0, p_l = 0; float w_l = 0.f;
        if (lane < 32) { e_l = tope[t0 * 4 + lane]; p_l = topp[t0 * 4 + lane]; w_l = topw[t0 * 4 + lane]; }
        const int slot_l = tbase[e_l] * 256 + p_l;
        if (O8) w_l *= (1.0f / S8_OUT);
#pragma unroll
        for (int b = 0; b < 2; ++b) {
            f32x4 x[4][4];
#pragma unroll
            for (int r = 0; r < 4; ++r) { const f32x4* xr = (const f32x4*)(src + (size_t)(t0 + 4 * b + r) * D + 8 * lane); x[r][0] = xr[0]; x[r][1] = xr[1]; x[r][2] = xr[128]; x[r][3] = xr[129]; }
            u32x4 o[4][4][O8 ? 1 : 2];
#pragma unroll
            for (int r = 0; r < 4; ++r)
#pragma unroll
                for (int k = 0; k < 4; ++k) { const int slot = __builtin_amdgcn_readlane(slot_l, (4 * b + r) * 4 + k); const unsigned char* ob = OUTS + (size_t)slot * ORB;
                    if constexpr (O8) { const u32x2 lo = *(const u32x2*)(ob + 8 * lane), hi = *(const u32x2*)(ob + 512 + 8 * lane); o[r][k][0] = (u32x4){lo.x, lo.y, hi.x, hi.y}; }
                    else { o[r][k][0] = *(const u32x4*)(ob + 16 * lane); o[r][k][1] = *(const u32x4*)(ob + 1024 + 16 * lane); } }
#pragma unroll
            for (int r = 0; r < 4; ++r) {
#pragma unroll
                for (int k = 0; k < 4; ++k) { const float wk = __uint_as_float((unsigned)__builtin_amdgcn_readlane((int)__float_as_uint(w_l), (4 * b + r) * 4 + k));
                    if constexpr (O8) {
#pragma unroll
                        for (int q = 0; q < 4; ++q) { const f32x2 a = __builtin_amdgcn_cvt_pk_f32_fp8((int)o[r][k][0][q], false), c = __builtin_amdgcn_cvt_pk_f32_fp8((int)o[r][k][0][q], true);
                            x[r][q] += (f32x4){a[0], a[1], c[0], c[1]} * wk; } }
                    else {
#pragma unroll
                        for (int j = 0; j < 2; ++j) { const u32x4 v = o[r][k][j];
                            x[r][2 * j] += (f32x4){bf_lo(v.x), bf_hi(v.x), bf_lo(v.y), bf_hi(v.y)} * wk; x[r][2 * j + 1] += (f32x4){bf_lo(v.z), bf_hi(v.z), bf_lo(v.w), bf_hi(v.w)} * wk; } } }
                const int t = t0 + 4 * b + r;
                { f32x4* xo = (f32x4*)(dstX + (size_t)t * D + 8 * lane); xo[0] = x[r][0]; xo[1] = x[r][1]; xo[128] = x[r][2]; xo[129] = x[r][3]; }
                if (NORM) {
                    float ss = 0.f;
#pragma unroll
                    for (int q = 0; q < 4; ++q) ss += (x[r][q][0] * x[r][q][0] + x[r][q][1] * x[r][q][1]) + (x[r][q][2] * x[r][q][2] + x[r][q][3] * x[r][q][3]);
                    ss = wave_sum(ss); const float rstd = 1.0f / sqrtf(ss * (1.0f / D) + RMS_EPS);
#pragma unroll
                    for (int j = 0; j < 2; ++j) { const f32x4 a = x[r][2 * j] * rstd * gn[2 * j], c = x[r][2 * j + 1] * rstd * gn[2 * j + 1];
                        *(u32x4*)(dstH + (size_t)t * D + 8 * lane + 512 * j) = (u32x4){cvtpk(a[0], a[1]), cvtpk(a[2], a[3]), cvtpk(c[0], c[1]), cvtpk(c[2], c[3])}; }
                }
            }
        }
    }
}

template <bool FP8, bool OUT8>
__device__ __forceinline__ void phase_moe_up(Frame& F, int layer, int G = 0  ) {
    if (G == 0) G = F.G;
    const int lane = lane_id(), tid = F.wave * 64 + lane; (void)tid;
    moe_tables(F, layer);
    const LAS int* ecnt = (const LAS int*)(F.lds + TAB_ECNT); const LAS int* tbase = (const LAS int*)(F.lds + TAB_TBASE);
    const int rowb = FP8 ? D : 2 * D;
    ProbMoeUp S{(const char*)(F.ws + WS_H2), FP8 ? (const char*)(F.ws + WS_WGU8) + (size_t)(1 - layer) * 64 * MiB : (const char*)(F.ws + WS_WGU) + (size_t)layer * NE * 2048 * 1024 * 2, F.lds, rowb, rowb, __builtin_amdgcn_readfirstlane(tbase[NE]), G, (int)blockIdx.x, F.wave};
    {
        const int* list = (const int*)(F.ws + WS_LIST); LAS unsigned* rt = (LAS unsigned*)(F.lds + TAB_ROW);
        pg8::Unit u;
#pragma nounroll
        for (int ord = 0; ord < MAXU && S.next(ord, u); ++ord) {
            if (tid < 256) { const int p = (u.pm - tbase[u.e]) * 256 + tid; const int tok = (p < ecnt[u.e]) ? list[u.e * M + p] : 0; rt[ord * 256 + tid] = (unsigned)tok * (unsigned)rowb; }
        }
        __syncthreads();
    }
    EpiGateUp<OUT8> E{(bf16*)(F.ws + WS_ACT), FIN(12) + (size_t)layer * NE * 2048};
    pg8::gemm_phase<ProbMoeUp, EpiGateUp<OUT8>, FP8, E8_UP>(F.lds, S, E);
}
template <bool FP8, bool OUT8>
__device__ __forceinline__ void phase_moe_down(Frame& F, int layer, int G = 0) {
    if (G == 0) G = F.G;
    moe_tables(F, layer);
    const LAS int* tbase = (const LAS int*)(F.lds + TAB_TBASE);
    const int rowb = FP8 ? FF : 2 * FF;
    ProbMoeDown S{(const char*)(F.ws + WS_ACT), FP8 ? (const char*)(F.ws + WS_WDN8) + (size_t)(1 - layer) * 32 * MiB : (const char*)(F.ws + WS_WDN) + (size_t)layer * NE * 1024 * 1024 * 2, F.lds, rowb, rowb, __builtin_amdgcn_readfirstlane(tbase[NE]), G, (int)blockIdx.x, F.wave};
    EpiDown<OUT8> E{(bf16*)(F.ws + WS_OUTS), FIN(14) + (size_t)layer * NE * 1024};
    pg8::gemm_phase<ProbMoeDown, EpiDown<OUT8>, FP8, E8_DOWN>(F.lds, S, E);
}

__device__ __forceinline__ int crow(int r, int hi) { return (r & 3) + 8 * (r >> 2) + 4 * hi; }
typedef LAS const char* lds_cptr;
__device__ __forceinline__ s16x4 vtr(lds_cptr p) { return __builtin_bit_cast(s16x4, __builtin_amdgcn_ds_read_tr16_b64_v4i16((LAS v4i16_t*)p)); }
__device__ __forceinline__ void attn_pair(Frame& F, int bh, int qbA, int qbB) {
    const int lane = lane_id(), r32 = lane & 31, hi = lane >> 5, wid = F.wave, sub = wid >> 2, ws = wid & 3, tids = ws * 64 + lane;
    const bf16* Qh = (const bf16*)(F.ws + WS_Q) + (size_t)bh * SEQ * HD; const bf16* Kh = (const bf16*)(F.ws + WS_K) + (size_t)bh * SEQ * HD; const bf16* Vh = (const bf16*)(F.ws + WS_V) + (size_t)bh * SEQ * HD;
    const int q0 = (sub ? qbB : qbA) * 128, qw = q0 + 32 * ws, qpos = qw + r32, jd = qw >> 6, jtop = (q0 >> 6) + 1;
    LAS unsigned char* KB = F.lds + sub * 32768; LAS unsigned char* VB = KB + 16384; LAS unsigned char* OST = F.lds + 65536 + wid * 4096;
    const bf16* ksrc[2]; const bf16* vsrc[2];
#pragma unroll
    for (int i = 0; i < 2; ++i) { const int p = tids + 256 * i, wv = p >> 6, l = p & 63;
        ksrc[i] = Kh + (size_t)l * HD + wv * 8; vsrc[i] = Vh + (size_t)(16 * (wv & 3) + (l >> 2)) * HD + (wv >> 2) * 32 + (l & 3) * 8; }
    bf16x8 qr[4];
#pragma unroll
    for (int d0 = 0; d0 < 4; ++d0) qr[d0] = *(const bf16x8*)(Qh + (size_t)qpos * HD + d0 * 16 + hi * 8);
    f32x16 o0 = {}, o1 = {};
    float C = 0.f;
    int cur = 0;
    bool done = false;
    LAS int* flags = (LAS int*)(F.lds + 65536 + 32768);
    {
#pragma unroll
      for (int i = 0; i < 2; ++i) { const u32x4 kk = *(const u32x4*)(ksrc[i] + (size_t)jtop * 64 * HD), vv = *(const u32x4*)(vsrc[i] + (size_t)jtop * 64 * HD);
          *(LAS u32x4*)(KB + (tids + 256 * i) * 16) = kk; *(LAS u32x4*)(VB + (tids + 256 * i) * 16) = vv; } }
    u32x4 kA[2], vA[2], kB[2], vB[2];
    if (jtop > 0) {
#pragma unroll
        for (int i = 0; i < 2; ++i) { kA[i] = *(const u32x4*)(ksrc[i] + (size_t)(jtop - 1) * 64 * HD); vA[i] = *(const u32x4*)(vsrc[i] + (size_t)(jtop - 1) * 64 * HD); } }
    __syncthreads();
    bool brk = false;
#define ATT_STEP(KL, VL, KS, VS) do { const int j = jtop - st; \
        if (j > 1) { _Pragma("unroll") for (int i = 0; i < 2; ++i) { KL[i] = *(const u32x4*)(ksrc[i] + (size_t)(j - 2) * 64 * HD); VL[i] = *(const u32x4*)(vsrc[i] + (size_t)(j - 2) * 64 * HD); } } \
        att_compute(j); \
        if (j > 0) { _Pragma("unroll") for (int i = 0; i < 2; ++i) { *(LAS u32x4*)(KB + (cur ^ 1) * 8192 + (tids + 256 * i) * 16) = KS[i]; *(LAS u32x4*)(VB + (cur ^ 1) * 8192 + (tids + 256 * i) * 16) = VS[i]; } } \
        if (lane == 0) flags[(st & 1) * 8 + wid] = (done || j <= 0) ? 1 : 0; \
        __syncthreads(); \
        brk = __all(flags[(st & 1) * 8 + (lane & 7)] != 0); cur ^= 1; ++st; } while (0)
    auto att_compute = [&](const int j) __attribute__((always_inline)) {
        if (j >= 0 && j <= jd && !done) {
            const lds_cptr kb = (lds_cptr)(KB + cur * 8192) + hi * 1024 + r32 * 16;
            f32x16 p0 = {}, p1 = {};
#pragma unroll
            for (int d0 = 0; d0 < 4; ++d0) { const bf16x8 b0 = *(const LAS bf16x8*)(kb + d0 * 2048), b1 = *(const LAS bf16x8*)(kb + d0 * 2048 + 512);
                p0 = __builtin_amdgcn_mfma_f32_32x32x16_bf16(b0, qr[d0], p0, 0, 0, 0); p1 = __builtin_amdgcn_mfma_f32_32x32x16_bf16(b1, qr[d0], p1, 0, 0, 0); }
            float L0[16], L1[16];
#pragma unroll
            for (int r = 0; r < 16; ++r) { L0[r] = __builtin_amdgcn_logf(1.0f + __builtin_amdgcn_exp2f(p0[r])); L1[r] = __builtin_amdgcn_logf(1.0f + __builtin_amdgcn_exp2f(p1[r])); }
            if (j == jd) {
                const int kb0 = 64 * j + 4 * hi;
#pragma unroll
                for (int r = 0; r < 16; ++r) { const int kv = kb0 + (r & 3) + 8 * (r >> 2);
                    if (kv >= qpos) { L0[r] = 0.f; p0[r] = -INFINITY; } if (kv + 32 >= qpos) { L1[r] = 0.f; p1[r] = -INFINITY; } }
            }
            float tg[8];
#pragma unroll
            for (int g = 0; g < 4; ++g) {
                L0[4 * g + 2] += L0[4 * g + 3]; L0[4 * g + 1] += L0[4 * g + 2]; L0[4 * g] += L0[4 * g + 1]; tg[g] = L0[4 * g];
                L1[4 * g + 2] += L1[4 * g + 3]; L1[4 * g + 1] += L1[4 * g + 2]; L1[4 * g] += L1[4 * g + 1]; tg[4 + g] = L1[4 * g]; }
            float off[8]; float R = C;
#pragma unroll
            for (int g = 7; g >= 0; --g) {
                const auto rr = __builtin_amdgcn_permlane32_swap(__float_as_uint(tg[g]), __float_as_uint(tg[g]), false, false);
                const float tlo = __uint_as_float(rr[0]), thi = __uint_as_float(rr[1]);
                off[g] = R + (hi ? 0.f : thi);
                R += tlo + thi; }
            C = R;
#pragma unroll
            for (int g = 0; g < 4; ++g)
#pragma unroll
                for (int i = 0; i < 4; ++i) { p0[4 * g + i] = __builtin_amdgcn_exp2f(p0[4 * g + i] - (L0[4 * g + i] + off[g])); p1[4 * g + i] = __builtin_amdgcn_exp2f(p1[4 * g + i] - (L1[4 * g + i] + off[4 + g])); }
            u32x4 pw0, pw1, pw2, pw3;
            pw0 = (u32x4){cvtpk(p0[0], p0[1]), cvtpk(p0[2], p0[3]), cvtpk(p0[4], p0[5]), cvtpk(p0[6], p0[7])};
            pw1 = (u32x4){cvtpk(p0[8], p0[9]), cvtpk(p0[10], p0[11]), cvtpk(p0[12], p0[13]), cvtpk(p0[14], p0[15])};
            pw2 = (u32x4){cvtpk(p1[0], p1[1]), cvtpk(p1[2], p1[3]), cvtpk(p1[4], p1[5]), cvtpk(p1[6], p1[7])};
            pw3 = (u32x4){cvtpk(p1[8], p1[9]), cvtpk(p1[10], p1[11]), cvtpk(p1[12], p1[13]), cvtpk(p1[14], p1[15])};
            const lds_cptr vp = (lds_cptr)(VB + cur * 8192) + ((lane >> 4) & 1) * 32 + (lane & 3) * 8 + (4 * hi + ((lane & 15) >> 2)) * 64;
#define PVSTEP(OACC, D0, KS, PW) do { const s16x4 lo_ = vtr(vp + (D0) * 4096 + (KS) * 1024), hi_ = vtr(vp + (D0) * 4096 + (KS) * 1024 + 512); \
                const bf16x8 vf_ = (bf16x8){lo_[0], lo_[1], lo_[2], lo_[3], hi_[0], hi_[1], hi_[2], hi_[3]}; \
                OACC = __builtin_amdgcn_mfma_f32_32x32x16_bf16(__builtin_bit_cast(bf16x8, PW), vf_, OACC, 0, 0, 0); } while (0)
            PVSTEP(o0, 0, 0, pw0); PVSTEP(o1, 1, 0, pw0); PVSTEP(o0, 0, 1, pw1); PVSTEP(o1, 1, 1, pw1);
            PVSTEP(o0, 0, 2, pw2); PVSTEP(o1, 1, 2, pw2); PVSTEP(o0, 0, 3, pw3); PVSTEP(o1, 1, 3, pw3);
#undef PVSTEP
            done = __all(C > 150.0f);
        }
    };
    for (int st = 0; ; ) {
        ATT_STEP(kB, vB, kA, vA); if (brk) break;
        ATT_STEP(kA, vA, kB, vB); if (brk) break;
    }
#undef ATT_STEP
    { LAS bf16* stg = (LAS bf16*)OST;
#pragma unroll
      for (int r = 0; r < 16; ++r) { const int orow = crow(r, hi); stg[orow * 64 + r32] = (bf16)(cvtpk(o0[r], 0.f) & 0xffffu); stg[orow * 64 + 32 + r32] = (bf16)(cvtpk(o1[r], 0.f) & 0xffffu); }
      LDS_WAIT(); asm volatile("" ::: "memory");
      const int b = bh >> 4, h = bh & 15;
      bf16* Ow = (bf16*)(F.ws + WS_O) + ((size_t)b * SEQ + qw) * D + h * HD;
#pragma unroll
      for (int i = 0; i < 4; ++i) { const int row = i * 8 + (lane >> 3), ch = lane & 7; const u32x4 vv = *(const LAS u32x4*)(stg + row * 64 + ch * 8); *(u32x4*)(Ow + (size_t)row * D + ch * 8) = vv; } }
    __syncthreads();
}
__device__ __forceinline__ void phase_attn(Frame& F) {
    for (int v = blockIdx.x; v < BATCH * NH * 2; v += F.G) {
        const int bh = v >> 1, odd = v & 1;
        for (int i = 0; i < 4; ++i) { const int qa = 8 * odd + 2 * i; attn_pair(F, bh, qa, qa + 1); }
    }
}

__global__ void __launch_bounds__(NWAVES * 64, 2) fwd_kernel(Args args) {
    extern __shared__ __attribute__((aligned(16))) unsigned char lds[];
    Frame F;
    F.lds = (LAS unsigned char*)lds; F.MISC = (volatile LAS unsigned*)(F.lds + MISC_OFF);
    F.wave = __builtin_amdgcn_readfirstlane((int)threadIdx.x >> 6); F.G = gridDim.x;
    F.ws = args.ws; F.ctl = (gu32*)(args.ws + WS_CTL);
    for (int u = (int)threadIdx.x; u < (LDS_BYTES - LDSCTL_OFF) / 4; u += NWAVES * 64) ((LAS unsigned*)(F.lds + LDSCTL_OFF))[u] = 0u;
    __syncthreads();
    const XcdBarrier bar = xcd_barrier_post((unsigned*)(F.ctl + CW_BAR), F.MISC + 8, gridDim.x);
#define TP_PUT(i) do { if (threadIdx.x == 0) { const unsigned long long t_ = __builtin_amdgcn_s_memrealtime(); F.MISC[16 + 2 * (i)] = (unsigned)t_; F.MISC[17 + 2 * (i)] = (unsigned)(t_ >> 32); } } while (0)
#define SEAM(k) do { xcd_barrier(bar); if (MK_TPROBE == ((k) == 0 ? 3 : (k) + 1)) TP_PUT(0); if (MK_TPROBE == (k)) TP_PUT(1); } while (0)
    if (MK_TPROBE == 0) TP_PUT(0);
    float* X1 = (float*)(F.ws + WS_X1); float* X2 = (float*)(F.ws + WS_X2); float* X3 = (float*)(F.ws + WS_X3);

    const bool tuned = (F.G == 256);
    const int nfront = tuned ? NFRONT : F.G, cv3 = tuned ? CV3 : 0, cv9 = tuned ? CV9 : 0;
    {
        const int bx = (int)blockIdx.x;
        if (bx < nfront) {
            const XcdBarrier fbar = xcd_barrier_post((unsigned*)(F.ctl + CW_BAR2), F.MISC + 10, (unsigned)nfront);
            phase_convert(F, 0, CV_SMALL, bx, nfront); __syncthreads();
            phase_pooled(F, bx, nfront);
            xcd_barrier(fbar);
            { ProbPool S{(const char*)(F.ws + WS_POOLED), (const char*)(F.ws + WS_POOLW), 512, 512, nfront, bx, F.wave}; EpiPool E{FIN(0), X1, FIN(3)};
              pg8::gemm_phase<ProbPool, EpiPool>(F.lds, S, E); }
            xcd_barrier(fbar);
            phase_router<FP8_U0>(F, X1, FIN(8), (bf16*)(F.ws + WS_H2), 0, bx, nfront);
            if (nfront == F.G) phase_convert(F, CV_SMALL, CV_END, bx, F.G);
        } else {
            phase_convert(F, CV_SMALL, CV_END - cv9 - cv3, bx - nfront, F.G - nfront);
        }
    }
    SEAM(0);
    { const int bx = (int)blockIdx.x;
        if (cv3 > 0 && bx >= G3) phase_convert(F, CV_END - cv9 - cv3, CV_END - cv9, bx - G3, F.G - G3);
        else phase_moe_up<FP8_U0, FP8_D0>(F, 0, cv3 > 0 ? G3 : 0); }
    SEAM(3);
    phase_moe_down<FP8_D0, false>(F, 0);
    SEAM(4);
    phase_combine<true, false>(F, X1, X2, FIN(1) + D, (bf16*)(F.ws + WS_HQ), 0);
    SEAM(5);
    { ProbDense S{(const char*)(F.ws + WS_HQ), (const char*)(F.ws + WS_WQKV), 2 * D, 2 * D, 2 * D, M / 256, 12, F.G, (int)blockIdx.x, F.wave}; { const int l_ = lane_id(); if (F.wave == 0) { ((LAS float*)(F.lds + BIAS_OFF))[l_] = FIN(5)[l_]; ((LAS float*)(F.lds + BIAS_OFF))[64 + l_] = FIN(6)[l_]; } __syncthreads(); }
        EpiQKV E{(bf16*)(F.ws + WS_Q), (const LAS float*)(F.lds + BIAS_OFF)};
        pg8::gemm_phase<ProbDense, EpiQKV>(F.lds, S, E); }
    SEAM(6);
    phase_attn(F);
    SEAM(7);
    { ProbDense S{(const char*)(F.ws + WS_O), (const char*)(F.ws + WS_WO), 2 * D, 2 * D, 2 * D, M / 256, 4, F.G, (int)blockIdx.x, F.wave}; EpiRes E{X2, X3};
        pg8::gemm_phase<ProbDense, EpiRes>(F.lds, S, E); }
    SEAM(8);
    {
        const int bx = (int)blockIdx.x;
        if (cv9 == 0) phase_router<true>(F, X3, FIN(8) + D, (bf16*)(F.ws + WS_H2), 1, bx, F.G);
        else if (bx < NR9) phase_router<true>(F, X3, FIN(8) + D, (bf16*)(F.ws + WS_H2), 1, bx, NR9);
        else phase_convert(F, CV_END - cv9, CV_END, bx - NR9, F.G - NR9);
    }
    SEAM(9);
    phase_moe_up<true, true>(F, 1);
    SEAM(10);
    phase_moe_down<true, true>(F, 1);
    SEAM(11);
    phase_combine<false, true>(F, X3, FOUT, nullptr, nullptr, 1);
    if (MK_TPROBE >= 0) { if (MK_TPROBE == 12) TP_PUT(1);
        if (blockIdx.x == 0 && threadIdx.x == 0) { const unsigned long long tp0 = ((unsigned long long)F.MISC[17] << 32) | F.MISC[16], tp1 = ((unsigned long long)F.MISC[19] << 32) | F.MISC[18];
            const unsigned long long dt = (tp1 - tp0) * 4, ts = __builtin_amdgcn_s_memrealtime();
            while (__builtin_amdgcn_s_memrealtime() - ts < dt) __builtin_amdgcn_s_sleep(8); } }
#undef SEAM
}

extern "C" void kernel_launch(void* const* d_in, const int* in_sizes, int n_in, void* d_out, int out_size, void* d_ws, size_t ws_size, hipStream_t stream) {
    static int grid = 0;
    if (grid == 0) {
        if (n_in != 15 || in_sizes[0] != M * D || out_size != M * D || ws_size < WS_END) { fprintf(stderr, "kernel_launch: unexpected shapes (n_in %d, in0 %d, out %d, ws %zu, need %zu)\n", n_in, n_in > 0 ? in_sizes[0] : -1, out_size, ws_size, (size_t)WS_END); grid = -1; return; }
        int dev = 0, cus = 0, per_cu = 0;
        if (hipGetDevice(&dev) != hipSuccess || hipDeviceGetAttribute(&cus, hipDeviceAttributeMultiprocessorCount, dev) != hipSuccess) { grid = -1; return; }
        if (hipFuncSetAttribute((const void*)fwd_kernel, hipFuncAttributeMaxDynamicSharedMemorySize, LDS_BYTES) != hipSuccess) { fprintf(stderr, "kernel_launch: hipFuncSetAttribute failed\n"); grid = -1; return; }
        if (hipOccupancyMaxActiveBlocksPerMultiprocessor(&per_cu, (const void*)fwd_kernel, NWAVES * 64, LDS_BYTES) != hipSuccess || per_cu < 1) fprintf(stderr, "kernel_launch: occupancy query says %d\n", per_cu);
        (void)hipGetLastError();
        grid = cus;
    }
    if (grid < 0) return;
    (void)hipMemsetAsync((char*)d_ws + WS_CTL, 0, CTL_ZERO_BYTES, stream);
    Args a{};
    for (int i = 0; i < 15; ++i) a.in[i] = (const float*)d_in[i];
    a.out = (float*)d_out; a.ws = (unsigned char*)d_ws;
    hipLaunchKernelGGL(fwd_kernel, dim3(grid), dim3(NWAVES * 64), LDS_BYTES, stream, a);
    const hipError_t le = hipPeekAtLastError();
    if (le != hipSuccess) fprintf(stderr, "kernel_launch: launch failed: %s\n", hipGetErrorName(le));
}
```

```cpp
#include <hip/hip_runtime.h>
#include <cstdio>
#include <cstdint>

#define GAS __attribute__((address_space(1)))
#define LAS __attribute__((address_space(3)))
typedef unsigned short bf16;
typedef unsigned u32x4 __attribute__((ext_vector_type(4)));
typedef unsigned u32x2 __attribute__((ext_vector_type(2)));
typedef float f32x4 __attribute__((ext_vector_type(4)));
typedef float f32x2 __attribute__((ext_vector_type(2)));
typedef float f32x16 __attribute__((ext_vector_type(16)));
typedef short bf16x8 __attribute__((ext_vector_type(8)));
typedef short s16x4 __attribute__((ext_vector_type(4)));
typedef short v4i16_t __attribute__((ext_vector_type(4)));
typedef __bf16 bf16x2_t __attribute__((ext_vector_type(2)));
typedef int i32x8 __attribute__((ext_vector_type(8)));
typedef int i32x4 __attribute__((ext_vector_type(4)));
typedef GAS unsigned gu32;

constexpr int BATCH = 8, SEQ = 2048, D = 1024, M = BATCH * SEQ, NH = 16, HD = 64, NE = 32, TOPK = 4, FF = 1024;
constexpr float RMS_EPS = 1e-6f, SW_LIMIT = 7.0f, SW_ALPHA = 1.702f;
constexpr int MT_MAX = M * TOPK / 256 + NE;
constexpr int NSLOT = MT_MAX * 256;
constexpr float C2 = 0.125f * 1.4426950408889634f;
constexpr float S8_W = 64.0f, S8_H = 8.0f, S8_ACT = 4.0f, S8_OUT = 16.0f;
constexpr int E8_UP = 127 - 9, E8_DOWN = 127 - 8;

constexpr size_t MiB = 1u << 20;
constexpr size_t WS_CTL = 0, CTL_ZERO_BYTES = 128 * 1024;
constexpr size_t WS_POOLW = 1 * MiB;
constexpr size_t WS_WQKV = 2 * MiB;
constexpr size_t WS_WO = 8 * MiB;
constexpr size_t WS_TOPE = 10 * MiB, WS_TOPP = WS_TOPE + 256 * 1024, WS_TOPW = WS_TOPP + 256 * 1024;
constexpr size_t WS_LIST = 12 * MiB;
constexpr size_t WS_WGU = 16 * MiB;
constexpr size_t WS_WDN = 272 * MiB;
constexpr size_t WS_WGU8 = WS_WGU + 128 * MiB;
constexpr size_t WS_WDN8 = WS_WDN + 64 * MiB;
constexpr size_t WS_X1 = 400 * MiB, WS_X2 = 464 * MiB, WS_X3 = 528 * MiB;
constexpr size_t WS_POOLED = 592 * MiB, WS_H2 = 624 * MiB, WS_HQ = 656 * MiB, WS_Q = 688 * MiB, WS_K = 720 * MiB, WS_V = 752 * MiB, WS_O = 784 * MiB;
constexpr size_t WS_ACT = 816 * MiB, WS_OUTS = 960 * MiB;
constexpr size_t WS_END = 1104 * MiB;
static_assert(WS_ACT + (size_t)NSLOT * 1024 * 2 <= WS_OUTS && WS_OUTS + (size_t)NSLOT * 1024 * 2 <= WS_END, "ws map");
constexpr int CW_TMO = 0, CW_CODE = 1;
constexpr int CW_BAR = 4096;
constexpr int CW_BAR2 = 8192;
constexpr int CW_ECNT = 16384;

constexpr int RING_BYTES = 131072;
constexpr int LDSCTL_OFF = RING_BYTES, MISC_OFF = LDSCTL_OFF + 320;
constexpr int TAB_OFF = 131584;
constexpr int TAB_ECNT = TAB_OFF, TAB_TBASE = TAB_OFF + 128, TAB_TEXP = TAB_OFF + 384, TAB_ROW = TAB_OFF + 1024;
constexpr int MAXU = 12;
constexpr int BIAS_OFF = TAB_ROW + MAXU * 1024;
constexpr int LDS_BYTES = 163840;
static_assert(BIAS_OFF % 16 == 0 && BIAS_OFF + 2 * 8 * 1024 <= LDS_BYTES, "LDS map");

constexpr int NWAVES = 8;
#ifndef MK_NFRONT
#define MK_NFRONT 144
#endif
constexpr int NFRONT = MK_NFRONT;
#ifndef MK_CV9
#define MK_CV9 8000
#endif
#ifndef MK_NR9
#define MK_NR9 96
#endif
constexpr int CV9 = MK_CV9, NR9 = MK_NR9;
#ifndef MK_CV3
#define MK_CV3 600
#endif
constexpr int CV3 = MK_CV3, G3 = 248;

#ifndef MK_TPROBE
#define MK_TPROBE -1
#endif
#ifndef MK_X16
#define MK_X16 1
#endif
constexpr bool X16 = MK_X16;
#ifndef MK_FP8_L0
#define MK_FP8_L0 3
#endif
constexpr bool FP8_U0 = (MK_FP8_L0 & 1) != 0, FP8_D0 = (MK_FP8_L0 & 2) != 0;

#define RLX_AGENT __ATOMIC_RELAXED, __HIP_MEMORY_SCOPE_AGENT
#define LDS_WAIT() asm volatile("s_waitcnt lgkmcnt(0)" ::: "memory")
#define VM_WAIT() asm volatile("s_waitcnt vmcnt(0)" ::: "memory")
__device__ __forceinline__ unsigned cvtpk(float lo, float hi) { f32x2 v = {lo, hi}; bf16x2_t b = __builtin_convertvector(v, bf16x2_t); return __builtin_bit_cast(unsigned, b); }
__device__ __forceinline__ unsigned cvtfp8x4(float a, float b, float c, float d) { int w = __builtin_amdgcn_cvt_pk_fp8_f32(a, b, 0, false); w = __builtin_amdgcn_cvt_pk_fp8_f32(c, d, w, true); return (unsigned)w; }
__device__ __forceinline__ f32x4 xs_ld4(const void* base, size_t off) {
    if constexpr (X16) { const u32x2 v = *(const u32x2*)((const bf16*)base + off); return (f32x4){__uint_as_float(v.x << 16), __uint_as_float(v.x & 0xffff0000u), __uint_as_float(v.y << 16), __uint_as_float(v.y & 0xffff0000u)}; }
    else return *(const f32x4*)((const float*)base + off);
}
__device__ __forceinline__ void xs_st4(void* base, size_t off, f32x4 v) {
    if constexpr (X16) { u32x2 w; w.x = cvtpk(v[0], v[1]); w.y = cvtpk(v[2], v[3]); *(u32x2*)((bf16*)base + off) = w; }
    else *(f32x4*)((float*)base + off) = v;
}
__device__ __forceinline__ float bf_lo(unsigned u) { return __uint_as_float(u << 16); }
__device__ __forceinline__ float bf_hi(unsigned u) { return __uint_as_float(u & 0xffff0000u); }
__device__ __forceinline__ int lane_id() { int r; asm volatile("v_mbcnt_lo_u32_b32 %0, -1, 0\n\tv_mbcnt_hi_u32_b32 %0, -1, %0" : "=v"(r)); return r; }
__device__ __forceinline__ float wave_sum(float v) {
#pragma unroll
    for (int o = 1; o < 64; o <<= 1) v += __shfl_xor(v, o);
    return v;
}

#define XB_TMO      128
#define XB_XCNT(j)  (256  + 64 * (j))
#define XB_XSUB(j)  (1280 + 64 * (j))
#define XB_XGEN(j)  (2304 + 64 * (j))
#define XB_TOP      3328
#define XB_TOPGEN   3392
#define XCD_BAR_WORDS 3456
#define XB_SPIN_CAP (1u << 18)
__device__ __forceinline__ unsigned xb_ld(unsigned* p)              { return __hip_atomic_load(p, __ATOMIC_RELAXED, __HIP_MEMORY_SCOPE_AGENT); }
__device__ __forceinline__ unsigned xb_add(unsigned* p, unsigned v) { return __hip_atomic_fetch_add(p, v, __ATOMIC_RELAXED, __HIP_MEMORY_SCOPE_AGENT); }
__device__ __forceinline__ unsigned xb_xcc_id() { return (unsigned)__builtin_amdgcn_s_getreg((3 << 11) | 20) & 0xFu; }
#define XB_SPIN(cond, bar) do { unsigned _sp = 0; while (cond) { __builtin_amdgcn_s_sleep(1); \
    if ((++_sp & 255u) == 0u) { if (xb_ld(&(bar)[XB_TMO])) break; if (_sp > XB_SPIN_CAP) { atomicAdd(&(bar)[XB_TMO], 1u); break; } } } } while (0)
struct XcdBarrier { unsigned* bar; unsigned x; volatile LAS unsigned* st; unsigned G; };
__device__ __forceinline__ XcdBarrier xcd_barrier_post(unsigned* bar, volatile LAS unsigned* st, unsigned G) {
    XcdBarrier b; b.bar = bar; b.x = xb_xcc_id(); b.st = st; b.G = G;
    if (threadIdx.x == 0) (void)xb_add(&bar[XB_XCNT(b.x)], 1u);
    return b;
}
__device__ __forceinline__ void xcd_barrier_complete(unsigned* bar, unsigned x, unsigned& nloc, unsigned& nx, const unsigned G) {
    unsigned sum, cnt, mine, sp = 0u;
    for (;;) {
        sum = 0u; cnt = 0u; mine = 0u;
#pragma unroll
        for (unsigned j = 0; j < 16; ++j) { const unsigned c = xb_ld(&bar[XB_XCNT(j)]); sum += c; cnt += (c > 0u) ? 1u : 0u; mine = (j == x) ? c : mine; }
        if (sum == G) break;
        __builtin_amdgcn_s_sleep(1);
        if ((++sp & 255u) == 0u) { if (xb_ld(&bar[XB_TMO])) break; if (sp > XB_SPIN_CAP) { atomicAdd(&bar[XB_TMO], 1u); break; } }
    }
    nloc = mine > 0u ? mine : 1u; nx = cnt > 0u ? cnt : 1u;
}
__device__ __forceinline__ void xcd_barrier(const XcdBarrier& b) {
    asm volatile("s_waitcnt vmcnt(0)" ::: "memory");
    __syncthreads();
    if (threadIdx.x == 0) {
        unsigned* bar = b.bar;
        __builtin_amdgcn_s_waitcnt(0);
        unsigned nloc = b.st[0], nx = b.st[1];
        if (nloc == 0u) { xcd_barrier_complete(bar, b.x, nloc, nx, b.G); b.st[0] = nloc; b.st[1] = nx; }
        const unsigned old = xb_add(&bar[XB_XSUB(b.x)], 1u);
        const unsigned gen = old / nloc;
        if (old + 1u == (gen + 1u) * nloc) {
            __builtin_amdgcn_fence(__ATOMIC_RELEASE, "agent");
            asm volatile("s_waitcnt vmcnt(0)" ::: "memory");
            const unsigned og = xb_add(&bar[XB_TOP], 1u);
            const unsigned tg = og / nx;
            if (og + 1u == (tg + 1u) * nx) xb_add(&bar[XB_TOPGEN], 1u);
            else XB_SPIN(xb_ld(&bar[XB_TOPGEN]) == tg, bar);
            __builtin_amdgcn_fence(__ATOMIC_ACQUIRE, "agent");
            xb_add(&bar[XB_XGEN(b.x)], 1u);
            asm volatile("s_waitcnt vmcnt(0)" ::: "memory");
        } else {
            XB_SPIN(xb_ld(&bar[XB_XGEN(b.x)]) == gen, bar);
            __builtin_amdgcn_fence(__ATOMIC_ACQUIRE, "agent");
            asm volatile("s_waitcnt vmcnt(0)" ::: "memory");
        }
    }
    __syncthreads();
}

namespace pg8 {
constexpr int BM = 256, BK = 64, HALF = 128, HTB = HALF * BK * 2, STAGE_BYTES = 8 * HTB, NXCD = 8, WGM = 8;
__host__ __device__ __forceinline__ int lds_byte(int r, int c) { const int st = (r >> 4) * 2 + (c >> 5), rr = r & 15, cc = c & 31, ob = rr * 64 + cc * 2; return st * 1024 + (ob ^ (((ob >> 9) & 1) << 5)); }
__host__ __device__ __forceinline__ void stage_rc(int b, int& R, int& C) { const int st = b / 1024, sb = b % 1024, swz = sb ^ (((sb >> 9) & 1) << 5); R = (st >> 1) * 16 + swz / 64; C = (st & 1) * 32 + (swz % 64) / 2; }
__host__ __device__ __forceinline__ int perm32(int rho) { const int n = rho >> 4, i = rho & 15; return 8 * (i >> 2) + 4 * n + (i & 3); }

struct Unit { int pm, pn, e; };
__device__ __forceinline__ void glds_sv(const char* base, unsigned voff, unsigned lds_dst) {
    unsigned keep;
    asm volatile("s_mov_b32 %0, m0\n\ts_mov_b32 m0, %3\n\ts_nop 0\n\tglobal_load_lds_dwordx4 %1, %2\n\ts_mov_b32 m0, %0" : "=&s"(keep) : "v"(voff), "s"(base), "s"(lds_dst) : "memory");
}
__device__ __forceinline__ const char* uni_ptr(const char* p) { const unsigned long long u = (unsigned long long)p; const unsigned lo = __builtin_amdgcn_readfirstlane((unsigned)u), hi = __builtin_amdgcn_readfirstlane((unsigned)(u >> 32)); return (const char*)(((unsigned long long)hi << 32) | lo); }
struct UD { const char* a; const char* b0; const char* b1; };

__device__ __forceinline__ bool order_next(int i, int G, int c, int nM, int nN, int& pm, int& pn) {
    const int L = i * G + c; const int nwg = nM * nN; if (L >= nwg) return false;
    int wgid = L; { const int q = nwg / NXCD, r = nwg % NXCD, xcd = wgid % NXCD, off = wgid / NXCD; wgid = (xcd < r ? xcd * (q + 1) : r * (q + 1) + (xcd - r) * q) + off; }
    const int nig = WGM * nN, gid = wgid / nig, fm = gid * WGM, gsz = (nM - fm) < WGM ? (nM - fm) : WGM;
    pm = fm + ((wgid % nig) % gsz); pn = (wgid % nig) / gsz; return true;
}

template <class Prob, class Epi, bool FP8 = false, int E8 = 127>
__device__ __forceinline__ void gemm_phase(LAS unsigned char* lds, const Prob& S, const Epi& E) {
    const int wid = S.wave, lane = lane_id(), tid = wid * 64 + lane, wr = wid >> 2, wc = wid & 3, fr = lane & 15, fq = lane >> 4;
    const int nt = S.Kb / 128;
    unsigned voffB[2];
#pragma unroll
    for (int i = 0; i < 2; ++i) { int R, C; stage_rc(tid * 16 + i * 8192, R, C); const int Rb = Epi::PERM ? ((R & ~31) + perm32(R & 31)) : R; voffB[i] = (unsigned)(Rb * S.ldb + C * 2); }
    const size_t kstep = (size_t)(BK * 2);
    const unsigned ldsb = (unsigned)__builtin_amdgcn_readfirstlane((int)(unsigned)(uintptr_t)lds + wid * 1024);
    const int aoff = lds_byte(wr * 64 + fr, fq * 8), boff = lds_byte(wc * 32 + fr, fq * 8);
#define PG8_SA(b, h) (((b) * 2 + (h)) * HTB)
#define PG8_SB(b, h) ((4 + (b) * 2 + (h)) * HTB)
#define PG8_STA(bufoff, gbase, va, h) do { _Pragma("unroll") for (int _i = 0; _i < 2; ++_i) glds_sv((const char*)(gbase), (va)[(h) * 2 + _i], ldsb + (unsigned)((bufoff) + _i * 8192)); } while (0)
#define PG8_STB(bufoff, gbase) do { _Pragma("unroll") for (int _i = 0; _i < 2; ++_i) glds_sv((const char*)(gbase), voffB[_i], ldsb + (unsigned)((bufoff) + _i * 8192)); } while (0)
#define PG8_LD8(p) __builtin_shufflevector(*(const LAS i32x4*)(p), *(const LAS i32x4*)((p) + 1024), 0, 1, 2, 3, 4, 5, 6, 7)
#define PG8_LDA(dst, b, h) do { _Pragma("unroll") for (int m = 0; m < 4; ++m) dst[m] = PG8_LD8(lds + PG8_SA(b, h) + aoff + m * 2048); } while (0)
#define PG8_LDB(dst, b, h) do { _Pragma("unroll") for (int n = 0; n < 2; ++n) dst[n] = PG8_LD8(lds + PG8_SB(b, h) + boff + n * 2048); } while (0)
#define PG8_HALF(x, k) __builtin_bit_cast(bf16x8, __builtin_shufflevector(x, x, 4 * (k), 4 * (k) + 1, 4 * (k) + 2, 4 * (k) + 3))
#define PG8_MMA(ai, bj, At, Bt) do { __builtin_amdgcn_s_setprio(1); _Pragma("unroll") for (int m = 0; m < 4; ++m) _Pragma("unroll") for (int n = 0; n < 2; ++n) { \
        if constexpr (FP8) acc[ai][bj][m][n] = __builtin_amdgcn_mfma_scale_f32_16x16x128_f8f6f4(Bt[n], At[m], acc[ai][bj][m][n], 0, 0, 0, E8, 0, 127); \
        else { acc[ai][bj][m][n] = __builtin_amdgcn_mfma_f32_16x16x32_bf16(PG8_HALF(Bt[n], 0), PG8_HALF(At[m], 0), acc[ai][bj][m][n], 0, 0, 0); \
               acc[ai][bj][m][n] = __builtin_amdgcn_mfma_f32_16x16x32_bf16(PG8_HALF(Bt[n], 1), PG8_HALF(At[m], 1), acc[ai][bj][m][n], 0, 0, 0); } } \
        __builtin_amdgcn_s_setprio(0); \
        if constexpr (FP8) asm volatile("" : "+v"(acc[ai][bj][0][0]), "+v"(acc[ai][bj][0][1]), "+v"(acc[ai][bj][1][0]), "+v"(acc[ai][bj][1][1]), "+v"(acc[ai][bj][2][0]), "+v"(acc[ai][bj][2][1]), "+v"(acc[ai][bj][3][0]), "+v"(acc[ai][bj][3][1])); \
        } while (0)
#define PG8_WAIT_V(n) asm volatile("s_waitcnt vmcnt(" #n ")" ::: "memory")
#define PG8_WAIT_SEAM(flag) asm volatile("s_cmp_lg_u32 %0, 0\n\ts_cbranch_scc1 1f\n\ts_waitcnt vmcnt(8)\n\ts_branch 2f\n1:\n\ts_waitcnt vmcnt(%1)\n2:" :: "s"(flag), "n"(RELAX) : "memory", "scc")
#define PG8_WAIT_L(n) asm volatile("s_waitcnt lgkmcnt(" #n ")" ::: "memory")
#define PG8_BAR __builtin_amdgcn_s_barrier()
#define PG8_SCHED __builtin_amdgcn_sched_barrier(0)
    Unit cur, nxt; UD cd, nd; unsigned cva[4]; int ui = 0;
    if (!S.next(0, cur)) return;
    S.desc(cur, cd); S.desc_va(0, cur, cva);
    constexpr int RELAX = 8 + Epi::NPRE + Epi::NST; static_assert(RELAX <= 63, "vmcnt is 6 bits");
    E.prefetch(cur, lds + BIAS_OFF + wid * 1024, lane);
    f32x4 acc[2][2][4][2];
#pragma unroll
    for (int a = 0; a < 2; ++a)
#pragma unroll
        for (int b = 0; b < 2; ++b)
#pragma unroll
            for (int m = 0; m < 4; ++m)
#pragma unroll
                for (int n = 0; n < 2; ++n) acc[a][b][m][n] = (f32x4){0.f, 0.f, 0.f, 0.f};
    i32x8 At[4], B0[2], B1[2];
    PG8_STB(PG8_SB(0, 0), cd.b0); PG8_STB(PG8_SB(0, 1), cd.b1); PG8_STA(PG8_SA(0, 0), cd.a, cva, 0); PG8_STA(PG8_SA(0, 1), cd.a, cva, 1);
    if (wr == 1) PG8_BAR;
    PG8_WAIT_V(2); PG8_BAR;
    PG8_STB(PG8_SB(1, 0), cd.b0 + kstep); PG8_STA(PG8_SA(1, 0), cd.a + kstep, cva, 0); PG8_STB(PG8_SB(1, 1), cd.b1 + kstep); PG8_STA(PG8_SA(1, 1), cd.a + kstep, cva, 1);
    PG8_WAIT_V(8); PG8_BAR;
    for (;;) {
        const bool has_next = S.next(ui + 1, nxt);
        if (has_next) S.desc(nxt, nd); else nd = cd;
#pragma clang loop unroll(disable)
        for (int t = 0; t < nt; t += 2) {
            const bool last = (t == nt - 2); const int seam = __builtin_amdgcn_readfirstlane((t == 0 && ui > 0) ? 1 : 0);
            const char* a2 = last ? nd.a : cd.a + (size_t)(t + 2) * kstep;
            const char* b20 = last ? nd.b0 : cd.b0 + (size_t)(t + 2) * kstep; const char* b21 = last ? nd.b1 : cd.b1 + (size_t)(t + 2) * kstep;
            const char* a3 = a2 + kstep; const char* b30 = b20 + kstep; const char* b31 = b21 + kstep;
            PG8_LDB(B0, 0, 0); PG8_LDB(B1, 0, 1); PG8_SCHED; PG8_LDA(At, 0, 0);
            PG8_WAIT_SEAM(seam);
            PG8_WAIT_L(0); PG8_BAR; PG8_MMA(0, 0, At, B0); PG8_MMA(0, 1, At, B1); PG8_BAR; PG8_SCHED;
            if (last && has_next) S.desc_va(ui + 1, nxt, cva);
            PG8_LDA(At, 0, 1); PG8_STB(PG8_SB(0, 0), b20); PG8_STB(PG8_SB(0, 1), b21); PG8_STA(PG8_SA(0, 0), a2, cva, 0);
            PG8_WAIT_SEAM(seam);
            PG8_WAIT_L(0); PG8_BAR; PG8_MMA(1, 0, At, B0); PG8_MMA(1, 1, At, B1); PG8_BAR; PG8_SCHED;
            PG8_LDB(B0, 1, 0); PG8_LDB(B1, 1, 1); PG8_SCHED; PG8_LDA(At, 1, 0); PG8_STA(PG8_SA(0, 1), a2, cva, 1);
            PG8_WAIT_SEAM(seam);
            PG8_WAIT_L(0); PG8_BAR; PG8_MMA(0, 0, At, B0); PG8_MMA(0, 1, At, B1); PG8_BAR; PG8_SCHED;
            PG8_LDA(At, 1, 1); PG8_STB(PG8_SB(1, 0), b30); PG8_STB(PG8_SB(1, 1), b31); PG8_STA(PG8_SA(1, 0), a3, cva, 0);
            PG8_WAIT_V(8); PG8_WAIT_L(0); PG8_BAR; PG8_MMA(1, 0, At, B0); PG8_MMA(1, 1, At, B1); PG8_BAR; PG8_SCHED;
            PG8_STA(PG8_SA(1, 1), a3, cva, 1);
        }
        if (has_next) E.prefetch(nxt, lds + BIAS_OFF + (((ui + 1) & 1) * 8 + wid) * 1024, lane);
        if (wr == 0) PG8_BAR;
        E(acc, cur, wr, wc, fr, fq, lds + BIAS_OFF + ((ui & 1) * 8 + wid) * 1024);
        if (!has_next) break;
#pragma unroll
        for (int a = 0; a < 2; ++a)
#pragma unroll
            for (int b = 0; b < 2; ++b)
#pragma unroll
                for (int m = 0; m < 4; ++m)
#pragma unroll
                    for (int n = 0; n < 2; ++n) acc[a][b][m][n] = (f32x4){0.f, 0.f, 0.f, 0.f};
        cur = nxt; cd = nd;
        ++ui;
        if (wr == 1) PG8_BAR;
    }
    PG8_WAIT_V(0);
    PG8_BAR;
#undef PG8_SA
#undef PG8_SB
#undef PG8_STA
#undef PG8_STB
#undef PG8_LDA
#undef PG8_LDB
#undef PG8_MMA
#undef PG8_LD8
#undef PG8_HALF
#undef PG8_WAIT_V
#undef PG8_WAIT_SEAM
#undef PG8_WAIT_L
#undef PG8_BAR
#undef PG8_SCHED
}
}

struct Frame {
    LAS unsigned char* lds;
    volatile LAS unsigned* MISC;
    gu32* ctl;
    int wave, G;
    unsigned char* ws;
};
struct Args { const float* in[15]; float* out; unsigned char* ws; };
#define KARG ((const __attribute__((address_space(4))) Args*)__builtin_amdgcn_kernarg_segment_ptr())
#define FIN(i) (KARG->in[i])
#define FOUT (KARG->out)

struct ProbDense {
    const char* A; const char* Bt; int lda, ldb, Kb, nM, nN, G, c, wave;
    __device__ __forceinline__ bool next(int i, pg8::Unit& u) const { u.e = 0; return pg8::order_next(i, G, c, nM, nN, u.pm, u.pn); }
    __device__ __forceinline__ void desc(const pg8::Unit& u, pg8::UD& d) const { d.a = pg8::uni_ptr(A + (size_t)u.pm * 256 * lda); d.b0 = pg8::uni_ptr(Bt + (size_t)u.pn * 256 * ldb); d.b1 = d.b0 + (size_t)128 * ldb; }
    __device__ __forceinline__ void desc_va(int, const pg8::Unit&, unsigned (&va)[4]) const {
#pragma unroll
        for (int i = 0; i < 2; ++i) { int R, C; pg8::stage_rc((wave * 64 + lane_id()) * 16 + i * 8192, R, C); va[i] = (unsigned)(R * lda + C * 2); va[2 + i] = va[i] + (unsigned)(128 * lda); }
    }
};
struct ProbPool {
    const char* A; const char* Bt; int ldb, Kb, G, c, wave;
    __device__ __forceinline__ bool next(int i, pg8::Unit& u) const { u.e = 0; return pg8::order_next(i, G, c, M / 256, 4, u.pm, u.pn); }
    __device__ __forceinline__ void desc(const pg8::Unit& u, pg8::UD& d) const { d.a = pg8::uni_ptr(A + (size_t)u.pm * 256 * D * 2 + (size_t)u.pn * 256 * 2); d.b0 = pg8::uni_ptr(Bt + (size_t)u.pn * 65536 * 2); d.b1 = d.b0 + (size_t)128 * 256 * 2; }
    __device__ __forceinline__ void desc_va(int, const pg8::Unit&, unsigned (&va)[4]) const {
#pragma unroll
        for (int i = 0; i < 2; ++i) { int R, C; pg8::stage_rc((wave * 64 + lane_id()) * 16 + i * 8192, R, C); va[i] = (unsigned)(R * D * 2 + C * 2); va[2 + i] = va[i] + (unsigned)(128 * D * 2); }
    }
};
struct ProbMoeUp {
    const char* A; const char* Bt; LAS unsigned char* lds; int ldb, Kb, nM, G, c, wave;
    __device__ __forceinline__ bool next(int i, pg8::Unit& u) const { if (!pg8::order_next(i, G, c, nM, 8, u.pm, u.pn)) return false; u.e = __builtin_amdgcn_readfirstlane((int)((const LAS unsigned char*)(lds + TAB_TEXP))[u.pm]); return true; }
    __device__ __forceinline__ void desc(const pg8::Unit& u, pg8::UD& d) const { d.a = pg8::uni_ptr(A); d.b0 = pg8::uni_ptr(Bt + ((size_t)u.e * 2048 + (size_t)u.pn * 256) * ldb); d.b1 = d.b0 + (size_t)128 * ldb; }
    __device__ __forceinline__ void desc_va(int ord, const pg8::Unit&, unsigned (&va)[4]) const {
        const LAS unsigned* rt = (const LAS unsigned*)(lds + TAB_ROW) + ord * 256;
#pragma unroll
        for (int i = 0; i < 2; ++i) { int R, C; pg8::stage_rc((wave * 64 + lane_id()) * 16 + i * 8192, R, C); va[i] = rt[R] + (unsigned)(C * 2); va[2 + i] = rt[128 + R] + (unsigned)(C * 2); }
    }
};
struct ProbMoeDown {
    const char* A; const char* Bt; LAS unsigned char* lds; int ldb, Kb, nM, G, c, wave;
    __device__ __forceinline__ bool next(int i, pg8::Unit& u) const { if (!pg8::order_next(i, G, c, nM, 4, u.pm, u.pn)) return false; u.e = __builtin_amdgcn_readfirstlane((int)((const LAS unsigned char*)(lds + TAB_TEXP))[u.pm]); return true; }
    __device__ __forceinline__ void desc(const pg8::Unit& u, pg8::UD& d) const { d.a = pg8::uni_ptr(A + (size_t)u.pm * 256 * ldb); d.b0 = pg8::uni_ptr(Bt + ((size_t)u.e * 1024 + (size_t)u.pn * 256) * ldb); d.b1 = d.b0 + (size_t)128 * ldb; }
    __device__ __forceinline__ void desc_va(int, const pg8::Unit&, unsigned (&va)[4]) const {
#pragma unroll
        for (int i = 0; i < 2; ++i) { int R, C; pg8::stage_rc((wave * 64 + lane_id()) * 16 + i * 8192, R, C); va[i] = (unsigned)(R * ldb + C * 2); va[2 + i] = va[i] + (unsigned)(128 * ldb); }
    }
};

struct EpiPool {
    static constexpr bool PERM = false; static constexpr int NST = 32, NPRE = 0;
    const float* x; float* X1; const float* scale;
    __device__ __forceinline__ void prefetch(const pg8::Unit&, LAS unsigned char*, int) const {}

    __device__ __forceinline__ void operator()(const f32x4 (&acc)[2][2][4][2], const pg8::Unit& u, int wr, int wc, int fr, int fq, LAS unsigned char* bl) const {
        const int row0 = u.pm * 256 + wr * 64 + fr, col0 = u.pn * 256 + wc * 32 + 4 * fq;
        f32x4 sv[2][2];
#pragma unroll
        for (int bj = 0; bj < 2; ++bj)
#pragma unroll
            for (int n = 0; n < 2; ++n) sv[bj][n] = *(const f32x4*)(scale + col0 + bj * 128 + n * 16);
#pragma unroll
        for (int ai = 0; ai < 2; ++ai)
#pragma unroll
            for (int m = 0; m < 4; ++m) { const size_t off = (size_t)(row0 + ai * 128 + m * 16) * D + col0;
#pragma unroll
                for (int bj = 0; bj < 2; ++bj)
#pragma unroll
                    for (int n = 0; n < 2; ++n) { const f32x4 xv = *(const f32x4*)(x + off + bj * 128 + n * 16); xs_st4(X1, off + bj * 128 + n * 16, xv + acc[ai][bj][m][n] * sv[bj][n]); }
                if (m & 1) asm volatile("" ::: "memory"); }
    }
};
struct EpiRes {
    static constexpr bool PERM = false; static constexpr int NST = 32, NPRE = 0;
    const float* Xi; float* Xo;
    __device__ __forceinline__ void prefetch(const pg8::Unit&, LAS unsigned char*, int) const {}

    __device__ __forceinline__ void operator()(const f32x4 (&acc)[2][2][4][2], const pg8::Unit& u, int wr, int wc, int fr, int fq, LAS unsigned char* bl) const {
        const int row0 = u.pm * 256 + wr * 64 + fr, col0 = u.pn * 256 + wc * 32 + 4 * fq;
#pragma unroll
        for (int ai = 0; ai < 2; ++ai)
#pragma unroll
            for (int m = 0; m < 4; ++m) { const size_t off = (size_t)(row0 + ai * 128 + m * 16) * D + col0;
#pragma unroll
                for (int bj = 0; bj < 2; ++bj)
#pragma unroll
                    for (int n = 0; n < 2; ++n) { const f32x4 xv = xs_ld4(Xi, off + bj * 128 + n * 16); xs_st4(Xo, off + bj * 128 + n * 16, xv + acc[ai][bj][m][n]); }
                if (m & 1) asm volatile("" ::: "memory"); }
    }
};
struct EpiQKV {
    static constexpr bool PERM = true; static constexpr int NST = 16, NPRE = 0;
    bf16* QKV; const LAS float* gl;
    __device__ __forceinline__ void prefetch(const pg8::Unit&, LAS unsigned char*, int) const {}

    __device__ __forceinline__ void operator()(const f32x4 (&acc)[2][2][4][2], const pg8::Unit& u, int wr, int wc, int fr, int fq, LAS unsigned char* bl) const {
        const int seg = u.pn >> 2, head = (u.pn & 3) * 4 + wc;
        f32x4 gv[2][2];
#pragma unroll
        for (int bj = 0; bj < 2; ++bj)
#pragma unroll
            for (int n = 0; n < 2; ++n) {
                if (seg == 2) gv[bj][n] = (f32x4){1.f, 1.f, 1.f, 1.f};
                else { const LAS float* g = gl + seg * 64 + bj * 32 + 8 * fq + 4 * n; gv[bj][n] = *(const LAS f32x4*)g; if (seg == 0) gv[bj][n] = gv[bj][n] * C2; } }
        bf16* base = QKV + (size_t)seg * M * D;
#pragma unroll
        for (int ai = 0; ai < 2; ++ai)
#pragma unroll
            for (int m = 0; m < 4; ++m) {
                const int t = u.pm * 256 + ai * 128 + wr * 64 + m * 16 + fr, b = t >> 11, s = t & (SEQ - 1);
                float rstd = 1.f;
                if (seg < 2) { float ss = 0.f;
#pragma unroll
                    for (int bj = 0; bj < 2; ++bj)
#pragma unroll
                        for (int n = 0; n < 2; ++n) { const f32x4 v = acc[ai][bj][m][n]; ss += (v[0] * v[0] + v[1] * v[1]) + (v[2] * v[2] + v[3] * v[3]); }
                    ss += __shfl_xor(ss, 16); ss += __shfl_xor(ss, 32);
                    rstd = 1.0f / sqrtf(ss * (1.0f / 64.0f) + RMS_EPS); }
                bf16* rowp = base + ((size_t)(b * NH + head) * SEQ + s) * HD + 8 * fq;
#pragma unroll
                for (int bj = 0; bj < 2; ++bj) { const f32x4 v0 = acc[ai][bj][m][0] * rstd * gv[bj][0], v1 = acc[ai][bj][m][1] * rstd * gv[bj][1];
                    u32x4 w; w.x = cvtpk(v0[0], v0[1]); w.y = cvtpk(v0[2], v0[3]); w.z = cvtpk(v1[0], v1[1]); w.w = cvtpk(v1[2], v1[3]);
                    *(u32x4*)(rowp + bj * 32) = w; }
            }
    }
};
template <bool OUT8> struct EpiGateUp {
    static constexpr bool PERM = true; static constexpr int NST = 8, NPRE = 1;
    bf16* ACT; const float* bias;
    __device__ __forceinline__ void prefetch(const pg8::Unit& u, LAS unsigned char* bl, int lane) const {
        pg8::glds_sv(pg8::uni_ptr((const char*)(bias + (size_t)u.e * 2048 + u.pn * 128)), (unsigned)((lane & 31) * 16 + (lane >> 5) * 4096), (unsigned)__builtin_amdgcn_readfirstlane((int)(unsigned)(uintptr_t)bl)); }
    __device__ __forceinline__ void operator()(const f32x4 (&acc)[2][2][4][2], const pg8::Unit& u, int wr, int wc, int fr, int fq, LAS unsigned char* bl) const {
        { const int le = lane_id(); fr = le & 15; fq = le >> 4; }
        const int lc = u.pn * 128 + wc * 32 + 8 * fq;
        const LAS float* bg = (const LAS float*)bl + wc * 32 + 8 * fq;
        f32x4 bv[2][2];
#pragma unroll
        for (int bj = 0; bj < 2; ++bj)
#pragma unroll
            for (int n = 0; n < 2; ++n) bv[bj][n] = *(const LAS f32x4*)(bg + bj * 128 + 4 * n) + (bj ? 1.0f : 0.0f);
#pragma unroll
        for (int ai = 0; ai < 2; ++ai)
#pragma unroll
            for (int m = 0; m < 4; ++m) {
                const size_t eoff = (size_t)(u.pm * 256 + ai * 128 + wr * 64 + m * 16 + fr) * FF + lc;
                float o[8];
                constexpr float OS = OUT8 ? S8_ACT : 1.0f, IOS = 1.0f / OS;
#pragma unroll
                for (int n = 0; n < 2; ++n) { const f32x4 g4 = acc[ai][0][m][n] + bv[0][n], u4 = acc[ai][1][m][n] + bv[1][n];
#pragma unroll
                    for (int i = 0; i < 4; ++i) { const float g = fminf(g4[i], SW_LIMIT), up1 = __builtin_amdgcn_fmed3f(u4[i], 1.0f - SW_LIMIT, 1.0f + SW_LIMIT);
                        const float sg = __builtin_amdgcn_rcpf(__builtin_fmaf(__builtin_amdgcn_exp2f(g * (-SW_ALPHA * 1.4426950408889634f)), IOS, IOS));
                        o[n * 4 + i] = up1 * (g * sg); } }
                if constexpr (OUT8) { u32x2 w; w.x = cvtfp8x4(o[0], o[1], o[2], o[3]); w.y = cvtfp8x4(o[4], o[5], o[6], o[7]);
                    *(u32x2*)((unsigned char*)ACT + eoff) = w; }
                else { u32x4 w; w.x = cvtpk(o[0], o[1]); w.y = cvtpk(o[2], o[3]); w.z = cvtpk(o[4], o[5]); w.w = cvtpk(o[6], o[7]);
                    *(u32x4*)(ACT + eoff) = w; }
            }
    }
};
template <bool OUT8> struct EpiDown {
    static constexpr bool PERM = true; static constexpr int NST = 16, NPRE = 1;
    bf16* OUTS; const float* bias;
    __device__ __forceinline__ void prefetch(const pg8::Unit& u, LAS unsigned char* bl, int lane) const {
        pg8::glds_sv(pg8::uni_ptr((const char*)(bias + (size_t)u.e * 1024 + u.pn * 256)), (unsigned)(lane * 16), (unsigned)__builtin_amdgcn_readfirstlane((int)(unsigned)(uintptr_t)bl)); }
    __device__ __forceinline__ void operator()(const f32x4 (&acc)[2][2][4][2], const pg8::Unit& u, int wr, int wc, int fr, int fq, LAS unsigned char* bl) const {
        const int col0 = u.pn * 256 + wc * 32 + 8 * fq;
        const LAS float* bd = (const LAS float*)bl + wc * 32 + 8 * fq;
        f32x4 bv[2][2];
#pragma unroll
        for (int bj = 0; bj < 2; ++bj)
#pragma unroll
            for (int n = 0; n < 2; ++n) bv[bj][n] = *(const LAS f32x4*)(bd + bj * 128 + 4 * n);
#pragma unroll
        for (int ai = 0; ai < 2; ++ai)
#pragma unroll
            for (int m = 0; m < 4; ++m) { bf16* rowp = OUTS + (size_t)(u.pm * 256 + ai * 128 + wr * 64 + m * 16 + fr) * D + col0;
#pragma unroll
                for (int bj = 0; bj < 2; ++bj) { const f32x4 v0 = acc[ai][bj][m][0] + bv[bj][0], v1 = acc[ai][bj][m][1] + bv[bj][1];
                    if constexpr (OUT8) { u32x2 w;
#define O8C(x) __builtin_amdgcn_fmed3f((x) * S8_OUT, -448.0f, 448.0f)
                        w.x = cvtfp8x4(O8C(v0[0]), O8C(v0[1]), O8C(v0[2]), O8C(v0[3])); w.y = cvtfp8x4(O8C(v1[0]), O8C(v1[1]), O8C(v1[2]), O8C(v1[3]));
#undef O8C
                        *(u32x2*)((unsigned char*)OUTS + (size_t)(u.pm * 256 + ai * 128 + wr * 64 + m * 16 + fr) * D + col0 + bj * 128) = w; }
                    else { u32x4 w; w.x = cvtpk(v0[0], v0[1]); w.y = cvtpk(v0[2], v0[3]); w.z = cvtpk(v1[0], v1[1]); w.w = cvtpk(v1[2], v1[3]);
                        *(u32x4*)(rowp + bj * 128) = w; } } }
    }
};

constexpr int CV_POOL = 4 * 2 * 4, CV_QKV = 8 * 48, CV_WO = 8 * 16, CV_GU1 = 32 * 8 * 32  , CV_DN1 = 32 * 8 * 16  ;
constexpr int CV_SMALL = CV_POOL + CV_QKV + CV_WO, CV_END = CV_SMALL + 2 * (CV_GU1 + CV_DN1);
struct CvtItem { const float* src; unsigned char* dst; int N, dpitch, fp8, hs; };
__device__ __forceinline__ CvtItem cvt_decode(Frame& F, int it) {
    CvtItem c; int r = it; c.fp8 = 0; c.hs = 32;
    if (r < CV_POOL) { const int g = r >> 3, q = r & 7, kb = q >> 2, nb = q & 3; c.N = 256; c.dpitch = 512;
        c.src = FIN(2) + (size_t)g * 65536 + (size_t)(kb * 128) * 256 + nb * 64; c.dst = F.ws + WS_POOLW + ((size_t)g * 65536 + (size_t)(nb * 64) * 256 + kb * 128) * 2; return c; }
    r -= CV_POOL;
    if (r < CV_QKV) { const int kb = r / 48, nb = r % 48, n0 = nb * 64, pn = n0 >> 8, w = (n0 & 255) >> 6; c.N = 3 * D; c.dpitch = 2 * D; c.hs = 128;
        c.src = FIN(4) + (size_t)(kb * 128) * (3 * D) + n0; c.dst = F.ws + WS_WQKV + ((size_t)(256 * pn + 32 * w) * D + kb * 128) * 2; return c; }
    r -= CV_QKV;
    if (r < CV_WO) { const int kb = r >> 4, nb = r & 15; c.N = D; c.dpitch = 2 * D;
        c.src = FIN(7) + (size_t)(kb * 128) * D + nb * 64; c.dst = F.ws + WS_WO + ((size_t)(nb * 64) * D + kb * 128) * 2; return c; }
    r -= CV_WO;
    int layer = 0;
    if (r >= CV_GU1 + CV_DN1) { r -= CV_GU1 + CV_DN1; layer = 1; }
    if (r < CV_GU1) { const int mat = layer * NE + (r >> 8), q = r & 255, kb = q >> 5, nb = q & 31; c.N = 2 * FF; c.fp8 = (layer == 1 || FP8_U0); c.dpitch = c.fp8 ? D : 2 * D;
        c.src = FIN(11) + (size_t)mat * D * 2 * FF + (size_t)(kb * 128) * (2 * FF) + nb * 64;
        const int n0 = nb * 64, cg = n0 & (FF - 1), drow = (cg >> 7) * 256 + (n0 >= FF ? 128 : 0) + (cg & 127);
        c.dst = c.fp8 ? F.ws + WS_WGU8 + (size_t)(1 - layer) * 64 * MiB + (size_t)(mat - layer * NE) * 2 * FF * D + (size_t)drow * D + kb * 128 : F.ws + WS_WGU + ((size_t)mat * 2 * FF * D + (size_t)drow * D + kb * 128) * 2; return c; }
    r -= CV_GU1;
    { const int mat = layer * NE + (r >> 7), q = r & 127, kb = q >> 4, nb = q & 15; c.N = D; c.fp8 = (layer == 1 || FP8_D0); c.dpitch = c.fp8 ? FF : 2 * FF;
        c.src = FIN(13) + (size_t)mat * FF * D + (size_t)(kb * 128) * D + nb * 64;
        c.dst = c.fp8 ? F.ws + WS_WDN8 + (size_t)(1 - layer) * 32 * MiB + (size_t)(mat - layer * NE) * D * FF + (size_t)(nb * 64) * FF + kb * 128 : F.ws + WS_WDN + ((size_t)mat * D * FF + (size_t)(nb * 64) * FF + kb * 128) * 2; return c; }
}
__device__ __forceinline__ void cvt_load(const CvtItem& c, int half, f32x4 (&v)[16], int lane) {
    const float* p = c.src + (size_t)(64 * half + (lane >> 4)) * c.N + 4 * (lane & 15);
#pragma unroll
    for (int i = 0; i < 16; ++i) v[i] = __builtin_nontemporal_load((const f32x4*)(p + (size_t)(4 * i) * c.N));
}
__device__ __forceinline__ s16x4 cvt_tr(LAS const unsigned char* p) { return __builtin_bit_cast(s16x4, __builtin_amdgcn_ds_read_tr16_b64_v4i16((LAS v4i16_t*)p)); }
constexpr int CVP = 136;
__device__ __forceinline__ void cvt_to_lds(const f32x4 (&v)[16], int half, LAS unsigned char* scr, int lane) {
    LAS unsigned char* wp = scr + (64 * half + (lane >> 4)) * CVP + (lane & 15) * 8;
#pragma unroll
    for (int i = 0; i < 16; ++i) { u32x2 w; w.x = cvtpk(v[i][0], v[i][1]); w.y = cvtpk(v[i][2], v[i][3]); *(LAS u32x2*)(wp + 4 * i * CVP) = w; }
}
__device__ __forceinline__ void cvt_emit(const CvtItem& c, LAS unsigned char* scr, int lane) {
    LDS_WAIT(); asm volatile("" ::: "memory");
    const int g = lane >> 4, i16 = lane & 15, r = i16 >> 2, cc = i16 & 3;
    if (c.fp8) {
#pragma unroll
        for (int nb = 0; nb < 4; ++nb)
#pragma unroll
            for (int ps = 0; ps < 2; ++ps) { const int kc = 4 * ps + g; LAS const unsigned char* rp = scr + (16 * kc + r) * CVP + cc * 8 + nb * 32;
                u32x4 o;
#pragma unroll
                for (int h = 0; h < 4; ++h) { const u32x2 t = __builtin_bit_cast(u32x2, cvt_tr(rp + (4 * h) * CVP));
                    const unsigned a = t.x + 0x03000300u, b = t.y + 0x03000300u;
                    o[h] = cvtfp8x4(__uint_as_float(a << 16), __uint_as_float(a & 0xffff0000u), __uint_as_float(b << 16), __uint_as_float(b & 0xffff0000u)); }
                const int n = 16 * nb + i16;
                *(u32x4*)(c.dst + (size_t)((n >> 5) * c.hs + (n & 31)) * c.dpitch + 16 * kc) = o; }
    } else {
#pragma unroll
        for (int nb = 0; nb < 4; ++nb)
#pragma unroll
            for (int ps = 0; ps < 4; ++ps) { const int kc = 4 * ps + g; LAS const unsigned char* rp = scr + (8 * kc + r) * CVP + cc * 8 + nb * 32;
                const u32x2 t0 = __builtin_bit_cast(u32x2, cvt_tr(rp)), t1 = __builtin_bit_cast(u32x2, cvt_tr(rp + 4 * CVP));
                const int n = 16 * nb + i16;
                *(u32x4*)(c.dst + (size_t)((n >> 5) * c.hs + (n & 31)) * c.dpitch + 16 * kc) = (u32x4){t0.x, t0.y, t1.x, t1.y}; }
    }
    LDS_WAIT(); asm volatile("" ::: "memory");
}
__device__ __forceinline__ void phase_convert(Frame& F, int item_lo, int item_hi, int bidx, int nblk) {
    const int lane = lane_id();
    LAS unsigned char* scr = F.lds + (F.wave < 7 ? F.wave * 17408 : 133120);
    const int gw = bidx * NWAVES + F.wave, NGW = nblk * NWAVES;
    int it = item_lo + gw; if (it >= item_hi) return;
    CvtItem c = cvt_decode(F, it); f32x4 va[16], vb[16]; cvt_load(c, 0, va, lane); cvt_load(c, 1, vb, lane);
    for (;;) {
        cvt_to_lds(va, 0, scr, lane); cvt_to_lds(vb, 1, scr, lane);
        const int itn = it + NGW; const bool more = itn < item_hi;
        CvtItem cn = c;
        if (more) { cn = cvt_decode(F, itn); cvt_load(cn, 0, va, lane); cvt_load(cn, 1, vb, lane); }
        cvt_emit(c, scr, lane);
        if (!more) break;
        c = cn; it = itn;
    }
}
__device__ __forceinline__ void phase_pooled(Frame& F, int bidx, int nblk) {
    const int lane = lane_id(), tid = F.wave * 64 + lane; (void)tid;
    LAS float* H = (LAS float*)F.lds;
    LAS float* RS = (LAS float*)(F.lds + 81920);
    bf16* P = (bf16*)(F.ws + WS_POOLED);
    for (int tile = bidx; tile < M / 64; tile += nblk) {
        const int t0 = tile * 64, s0 = t0 & (SEQ - 1);
        for (int i = F.wave; i < 79; i += NWAVES) {
            const int s = s0 - 15 + i; float r = 0.f;
            if (s >= 0) { const f32x4* xr = (const f32x4*)(FIN(0) + (size_t)(t0 - 15 + i) * D) + lane; float ss = 0.f;
#pragma unroll
                for (int j = 0; j < 4; ++j) { const f32x4 v = xr[64 * j]; ss += (v[0] * v[0] + v[1] * v[1]) + (v[2] * v[2] + v[3] * v[3]); }
                ss = wave_sum(ss); r = 1.0f / sqrtf(ss * (1.0f / D) + RMS_EPS); }
            if (lane == 0) RS[i] = r;
        }
        __syncthreads();
        for (int g = 0; g < 4; ++g) {
            const f32x4 gn = *((const f32x4*)(FIN(1) + g * 256) + lane);
            for (int i = F.wave; i < 79; i += NWAVES) {
                const int s = s0 - 15 + i; f32x4 v = (f32x4){0.f, 0.f, 0.f, 0.f};
                if (s >= 0) { v = *((const f32x4*)(FIN(0) + (size_t)(t0 - 15 + i) * D + g * 256) + lane); v = v * RS[i] * gn; }
                *((LAS f32x4*)(H + i * 256) + lane) = v;
            }
            __syncthreads();
            const int w = 2 << g, cp = tid & 127, rq = tid >> 7, i0 = 15 + rq * 16;
            const LAS f32x2* H2p = (const LAS f32x2*)H + cp;
            f32x2 S = (f32x2){0.f, 0.f};
            for (int j = i0 - w + 1; j <= i0; ++j) S += H2p[j * 128];
            for (int r = 0; r < 16; ++r) {
                const int i = i0 + r;
                if (r > 0) S += H2p[i * 128] - H2p[(i - w) * 128];
                const int s = s0 + rq * 16 + r; const int cnt = (s + 1 < w) ? (s + 1) : w;
                const f32x2 h = H2p[i * 128]; const float inv = 1.0f / (float)cnt;
                const f32x2 pv = S * inv - h;
                *(unsigned*)(P + (size_t)(t0 + rq * 16 + r) * D + g * 256 + 2 * cp) = cvtpk(pv[0], pv[1]);
            }
            __syncthreads();
        }
    }
}

__device__ __forceinline__ void moe_tables(Frame& F, int layer) {
    const int lane = lane_id(), tid = F.wave * 64 + lane; (void)tid;
    LAS int* ecnt = (LAS int*)(F.lds + TAB_ECNT); LAS int* tbase = (LAS int*)(F.lds + TAB_TBASE); LAS unsigned char* texp = (LAS unsigned char*)(F.lds + TAB_TEXP);
    if (tid < NE) ecnt[tid] = (int)__hip_atomic_load(F.ctl + CW_ECNT + layer * 2048 + tid * 64, RLX_AGENT);
    __syncthreads();
    if (tid == 0) { int a = 0; for (int e = 0; e < NE; ++e) { tbase[e] = a; a += (ecnt[e] + 255) >> 8; } tbase[NE] = a; }
    __syncthreads();
    if (tid < MT_MAX) { int e = 0; for (int q = 1; q < NE; ++q) if (tid >= tbase[q]) e = q; texp[tid] = (unsigned char)e; }
    __syncthreads();
}
template <bool H8>
__device__ __forceinline__ void phase_router(Frame& F, const float* src, const float* gain, bf16* dstH, int layer, int bidx, int nblk) {
    const int cl = layer;
    const int lane = lane_id(), tid = F.wave * 64 + lane;
    f32x4 gn[4];
#pragma unroll
    for (int j = 0; j < 4; ++j) gn[j] = *((const f32x4*)gain + lane + 64 * j);
    for (int tile = bidx; tile < M / 64; tile += nblk) {
        f32x4 v[8][4];
#pragma unroll
        for (int rr = 0; rr < 8; ++rr) {
            const int t = tile * 64 + F.wave * 8 + rr;
#pragma unroll
            for (int j = 0; j < 4; ++j) v[rr][j] = xs_ld4(src, (size_t)t * D + 4 * lane + 256 * j);
            {
                float ss = 0.f;
#pragma unroll
                for (int j = 0; j < 4; ++j) ss += (v[rr][j][0] * v[rr][j][0] + v[rr][j][1] * v[rr][j][1]) + (v[rr][j][2] * v[rr][j][2] + v[rr][j][3] * v[rr][j][3]);
                ss = wave_sum(ss); const float rstd = 1.0f / sqrtf(ss * (1.0f / D) + RMS_EPS);
                if constexpr (H8) { unsigned* ho = (unsigned*)((unsigned char*)dstH + (size_t)t * D) + lane;
#pragma unroll
                    for (int j = 0; j < 4; ++j) { v[rr][j] = v[rr][j] * rstd * gn[j]; ho[64 * j] = cvtfp8x4(v[rr][j][0] * S8_H, v[rr][j][1] * S8_H, v[rr][j][2] * S8_H, v[rr][j][3] * S8_H); } }
                else { u32x2* ho = (u32x2*)(dstH + (size_t)t * D) + lane;
#pragma unroll
                    for (int j = 0; j < 4; ++j) { v[rr][j] = v[rr][j] * rstd * gn[j]; u32x2 o; o.x = cvtpk(v[rr][j][0], v[rr][j][1]); o.y = cvtpk(v[rr][j][2], v[rr][j][3]); ho[64 * j] = o; } }
            }
        }
        {
            LAS float* HT = (LAS float*)F.lds;
            LAS float* WC = (LAS float*)(F.lds + 66560);
            LAS float* PART = (LAS float*)F.lds;
            LAS float* LG = (LAS float*)(F.lds + 66560);
            LAS int* lcnt = (LAS int*)(F.lds + 99328);
            LAS int* gbase = (LAS int*)(F.lds + 99328 + 128);
            const float* RW = FIN(9) + (size_t)layer * D * NE; const float* RB = FIN(10) + layer * NE;
            const int th = F.wave & 1, kq = F.wave >> 1, r32 = lane & 31, hi = lane >> 5;
            f32x16 acc = {};
            for (int j = 0; j < 4; ++j) {
                __syncthreads();
#pragma unroll
                for (int rr = 0; rr < 8; ++rr)
#pragma unroll
                    for (int i = 0; i < 4; ++i) HT[(4 * lane + i) * 65 + F.wave * 8 + rr] = v[rr][j][i];
                { const f32x4* wsrc = (const f32x4*)(RW + (size_t)j * 256 * NE); LAS f32x4* wdst = (LAS f32x4*)WC;
#pragma unroll
                    for (int q = 0; q < 4; ++q) wdst[tid + 512 * q] = wsrc[tid + 512 * q]; }
                __syncthreads();
                const LAS float* ap = HT + (kq * 64 + hi) * 65 + th * 32 + r32; const LAS float* bp = WC + (kq * 64 + hi) * 32 + r32;
#pragma unroll 8
                for (int s = 0; s < 32; ++s) acc = __builtin_amdgcn_mfma_f32_32x32x2f32(ap[s * 2 * 65], bp[s * 2 * 32], acc, 0, 0, 0);
            }
            __syncthreads();
#pragma unroll
            for (int r = 0; r < 16; ++r) { const int tok = th * 32 + (r & 3) + 8 * (r >> 2) + 4 * hi; PART[(kq * 64 + tok) * 33 + r32] = acc[r]; }
            if (tid < NE) lcnt[tid] = 0;
            __syncthreads();
            for (int q = tid; q < 64 * NE; q += 512) { const int tok = q >> 5, e = q & 31;
                LG[tok * 33 + e] = ((PART[tok * 33 + e] + PART[(64 + tok) * 33 + e]) + (PART[(128 + tok) * 33 + e] + PART[(192 + tok) * 33 + e])) + RB[e]; }
            __syncthreads();
            int te[4], lp[4]; float tw[4];
            if (F.wave == 0) {
                const int tok = lane; unsigned used = 0u; float tv[4];
#pragma unroll
                for (int k = 0; k < 4; ++k) { float best = -INFINITY; int bi = 0;
                    for (int e = 0; e < NE; ++e) { const float xv = LG[tok * 33 + e]; if (!((used >> e) & 1u) && xv > best) { best = xv; bi = e; } }
                    used |= 1u << bi; tv[k] = best; te[k] = bi; }
                float sum = 0.f;
#pragma unroll
                for (int k = 0; k < 4; ++k) { tw[k] = __expf(tv[k] - tv[0]); sum += tw[k]; }
                const float inv = 1.0f / sum;
#pragma unroll
                for (int k = 0; k < 4; ++k) { tw[k] *= inv; lp[k] = atomicAdd((int*)(lcnt + te[k]), 1); }
            }
            __syncthreads();
            if (tid < NE) { const int c = lcnt[tid]; gbase[tid] = c > 0 ? (int)__hip_atomic_fetch_add(F.ctl + CW_ECNT + cl * 2048 + tid * 64, (unsigned)c, RLX_AGENT) : 0; }
            __syncthreads();
            if (F.wave == 0) {
                const int t = tile * 64 + lane;
                int* list = (int*)(F.ws + WS_LIST); int* tope_w = (int*)(F.ws + WS_TOPE); int* topp_w = (int*)(F.ws + WS_TOPP); float* topw_w = (float*)(F.ws + WS_TOPW);
#pragma unroll
                for (int k = 0; k < 4; ++k) { const int pos = gbase[te[k]] + lp[k]; list[te[k] * M + pos] = t; tope_w[t * 4 + k] = te[k]; topp_w[t * 4 + k] = pos; topw_w[t * 4 + k] = tw[k]; }
            }
            __syncthreads();
        }
    }
}

template <bool NORM, bool O8, bool DSTF32  >
__device__ __forceinline__ void phase_combine(Frame& F, const float* src, float* dstX, const float* gain, bf16* dstH, int layer) {
    const int lane = lane_id();
    moe_tables(F, layer);
    const LAS int* tbase = (const LAS int*)(F.lds + TAB_TBASE);
    const int* tope = (const int*)(F.ws + WS_TOPE); const int* topp = (const int*)(F.ws + WS_TOPP); const float* topw = (const float*)(F.ws + WS_TOPW);
    const unsigned char* OUTS = F.ws + WS_OUTS;
    constexpr int ORB = O8 ? D : 2 * D;
    f32x4 gn[4];
    if (NORM) {
#pragma unroll
        for (int q = 0; q < 4; ++q) gn[q] = *(const f32x4*)(gain + 8 * lane + 512 * (q >> 1) + 4 * (q & 1)); }
    for (int tile = blockIdx.x; tile < M / 64; tile += F.G) {
        const int t0 = tile * 64 + F.wave * 8;
        int e_l = 0, p_l = 0; float w_l = 0.f;
        if (lane < 32) { e_l = tope[t0 * 4 + lane]; p_l = topp[t0 * 4 + lane]; w_l = topw[t0 * 4 + lane]; }
        const int slot_l = tbase[e_l] * 256 + p_l;
        if (O8) w_l *= (1.0f / S8_OUT);
#pragma unroll
        for (int b = 0; b < 2; ++b) {
            f32x4 x[4][4];
#pragma unroll
            for (int r = 0; r < 4; ++r) { const size_t ro = (size_t)(t0 + 4 * b + r) * D + 8 * lane; x[r][0] = xs_ld4(src, ro); x[r][1] = xs_ld4(src, ro + 4); x[r][2] = xs_ld4(src, ro + 512); x[r][3] = xs_ld4(src, ro + 516); }
            u32x4 o[4][4][O8 ? 1 : 2];
#pragma unroll
            for (int r = 0; r < 4; ++r)
#pragma unroll
                for (int k = 0; k < 4; ++k) { const int slot = __builtin_amdgcn_readlane(slot_l, (4 * b + r) * 4 + k); const unsigned char* ob = OUTS + (size_t)slot * ORB;
                    if constexpr (O8) { const u32x2 lo = *(const u32x2*)(ob + 8 * lane), hi = *(const u32x2*)(ob + 512 + 8 * lane); o[r][k][0] = (u32x4){lo.x, lo.y, hi.x, hi.y}; }
                    else { o[r][k][0] = *(const u32x4*)(ob + 16 * lane); o[r][k][1] = *(const u32x4*)(ob + 1024 + 16 * lane); } }
#pragma unroll
            for (int r = 0; r < 4; ++r) {
#pragma unroll
                for (int k = 0; k < 4; ++k) { const float wk = __uint_as_float((unsigned)__builtin_amdgcn_readlane((int)__float_as_uint(w_l), (4 * b + r) * 4 + k));
                    if constexpr (O8) {
#pragma unroll
                        for (int q = 0; q < 4; ++q) { const f32x2 a = __builtin_amdgcn_cvt_pk_f32_fp8((int)o[r][k][0][q], false), c = __builtin_amdgcn_cvt_pk_f32_fp8((int)o[r][k][0][q], true);
                            x[r][q] += (f32x4){a[0], a[1], c[0], c[1]} * wk; } }
                    else {
#pragma unroll
                        for (int j = 0; j < 2; ++j) { const u32x4 v = o[r][k][j];
                            x[r][2 * j] += (f32x4){bf_lo(v.x), bf_hi(v.x), bf_lo(v.y), bf_hi(v.y)} * wk; x[r][2 * j + 1] += (f32x4){bf_lo(v.z), bf_hi(v.z), bf_lo(v.w), bf_hi(v.w)} * wk; } } }
                const int t = t0 + 4 * b + r;
                if constexpr (DSTF32) { f32x4* xo = (f32x4*)(dstX + (size_t)t * D + 8 * lane); xo[0] = x[r][0]; xo[1] = x[r][1]; xo[128] = x[r][2]; xo[129] = x[r][3]; }
                else { const size_t ro = (size_t)t * D + 8 * lane; xs_st4(dstX, ro, x[r][0]); xs_st4(dstX, ro + 4, x[r][1]); xs_st4(dstX, ro + 512, x[r][2]); xs_st4(dstX, ro + 516, x[r][3]); }
                if (NORM) {
                    float ss = 0.f;
#pragma unroll
                    for (int q = 0; q < 4; ++q) ss += (x[r][q][0] * x[r][q][0] + x[r][q][1] * x[r][q][1]) + (x[r][q][2] * x[r][q][2] + x[r][q][3] * x[r][q][3]);
                    ss = wave_sum(ss); const float rstd = 1.0f / sqrtf(ss * (1.0f / D) + RMS_EPS);
#pragma unroll
                    for (int j = 0; j < 2; ++j) { const f32x4 a = x[r][2 * j] * rstd * gn[2 * j], c = x[r][2 * j + 1] * rstd * gn[2 * j + 1];
                        *(u32x4*)(dstH + (size_t)t * D + 8 * lane + 512 * j) = (u32x4){cvtpk(a[0], a[1]), cvtpk(a[2], a[3]), cvtpk(c[0], c[1]), cvtpk(c[2], c[3])}; }
                }
            }
        }
    }
}

template <bool FP8, bool OUT8>
__device__ __forceinline__ void phase_moe_up(Frame& F, int layer, int G = 0  ) {
    if (G == 0) G = F.G;
    const int lane = lane_id(), tid = F.wave * 64 + lane; (void)tid;
    moe_tables(F, layer);
    const LAS int* ecnt = (const LAS int*)(F.lds + TAB_ECNT); const LAS int* tbase = (const LAS int*)(F.lds + TAB_TBASE);
    const int rowb = FP8 ? D : 2 * D;
    ProbMoeUp S{(const char*)(F.ws + WS_H2), FP8 ? (const char*)(F.ws + WS_WGU8) + (size_t)(1 - layer) * 64 * MiB : (const char*)(F.ws + WS_WGU) + (size_t)layer * NE * 2048 * 1024 * 2, F.lds, rowb, rowb, __builtin_amdgcn_readfirstlane(tbase[NE]), G, (int)blockIdx.x, F.wave};
    {
        const int* list = (const int*)(F.ws + WS_LIST); LAS unsigned* rt = (LAS unsigned*)(F.lds + TAB_ROW);
        pg8::Unit u;
#pragma nounroll
        for (int ord = 0; ord < MAXU && S.next(ord, u); ++ord) {
            if (tid < 256) { const int p = (u.pm - tbase[u.e]) * 256 + tid; const int tok = (p < ecnt[u.e]) ? list[u.e * M + p] : 0; rt[ord * 256 + tid] = (unsigned)tok * (unsigned)rowb; }
        }
        __syncthreads();
    }
    EpiGateUp<OUT8> E{(bf16*)(F.ws + WS_ACT), FIN(12) + (size_t)layer * NE * 2048};
    pg8::gemm_phase<ProbMoeUp, EpiGateUp<OUT8>, FP8, E8_UP>(F.lds, S, E);
}
template <bool FP8, bool OUT8>
__device__ __forceinline__ void phase_moe_down(Frame& F, int layer, int G = 0) {
    if (G == 0) G = F.G;
    moe_tables(F, layer);
    const LAS int* tbase = (const LAS int*)(F.lds + TAB_TBASE);
    const int rowb = FP8 ? FF : 2 * FF;
    ProbMoeDown S{(const char*)(F.ws + WS_ACT), FP8 ? (const char*)(F.ws + WS_WDN8) + (size_t)(1 - layer) * 32 * MiB : (const char*)(F.ws + WS_WDN) + (size_t)layer * NE * 1024 * 1024 * 2, F.lds, rowb, rowb, __builtin_amdgcn_readfirstlane(tbase[NE]), G, (int)blockIdx.x, F.wave};
    EpiDown<OUT8> E{(bf16*)(F.ws + WS_OUTS), FIN(14) + (size_t)layer * NE * 1024};
    pg8::gemm_phase<ProbMoeDown, EpiDown<OUT8>, FP8, E8_DOWN>(F.lds, S, E);
}

__device__ __forceinline__ int crow(int r, int hi) { return (r & 3) + 8 * (r >> 2) + 4 * hi; }
typedef LAS const char* lds_cptr;
__device__ __forceinline__ s16x4 vtr(lds_cptr p) { return __builtin_bit_cast(s16x4, __builtin_amdgcn_ds_read_tr16_b64_v4i16((LAS v4i16_t*)p)); }
__device__ __forceinline__ void attn_pair(Frame& F, int bh, int qbA, int qbB) {
    const int lane = lane_id(), r32 = lane & 31, hi = lane >> 5, wid = F.wave, sub = wid >> 2, ws = wid & 3, tids = ws * 64 + lane;
    const bf16* Qh = (const bf16*)(F.ws + WS_Q) + (size_t)bh * SEQ * HD; const bf16* Kh = (const bf16*)(F.ws + WS_K) + (size_t)bh * SEQ * HD; const bf16* Vh = (const bf16*)(F.ws + WS_V) + (size_t)bh * SEQ * HD;
    const int q0 = (sub ? qbB : qbA) * 128, qw = q0 + 32 * ws, qpos = qw + r32, jd = qw >> 6, jtop = (q0 >> 6) + 1;
    LAS unsigned char* KB = F.lds + sub * 32768; LAS unsigned char* VB = KB + 16384; LAS unsigned char* OST = F.lds + 65536 + wid * 4096;
    const bf16* ksrc[2]; const bf16* vsrc[2];
#pragma unroll
    for (int i = 0; i < 2; ++i) { const int p = tids + 256 * i, wv = p >> 6, l = p & 63;
        ksrc[i] = Kh + (size_t)l * HD + wv * 8; vsrc[i] = Vh + (size_t)(16 * (wv & 3) + (l >> 2)) * HD + (wv >> 2) * 32 + (l & 3) * 8; }
    bf16x8 qr[4];
#pragma unroll
    for (int d0 = 0; d0 < 4; ++d0) qr[d0] = *(const bf16x8*)(Qh + (size_t)qpos * HD + d0 * 16 + hi * 8);
    f32x16 o0 = {}, o1 = {};
    float C = 0.f;
    int cur = 0;
    bool done = false;
    LAS int* flags = (LAS int*)(F.lds + 65536 + 32768);
    {
#pragma unroll
      for (int i = 0; i < 2; ++i) { const u32x4 kk = *(const u32x4*)(ksrc[i] + (size_t)jtop * 64 * HD), vv = *(const u32x4*)(vsrc[i] + (size_t)jtop * 64 * HD);
          *(LAS u32x4*)(KB + (tids + 256 * i) * 16) = kk; *(LAS u32x4*)(VB + (tids + 256 * i) * 16) = vv; } }
    u32x4 kA[2], vA[2], kB[2], vB[2];
    if (jtop > 0) {
#pragma unroll
        for (int i = 0; i < 2; ++i) { kA[i] = *(const u32x4*)(ksrc[i] + (size_t)(jtop - 1) * 64 * HD); vA[i] = *(const u32x4*)(vsrc[i] + (size_t)(jtop - 1) * 64 * HD); } }
    __syncthreads();
    bool brk = false;
#define ATT_STEP(KL, VL, KS, VS) do { const int j = jtop - st; \
        if (j > 1) { _Pragma("unroll") for (int i = 0; i < 2; ++i) { KL[i] = *(const u32x4*)(ksrc[i] + (size_t)(j - 2) * 64 * HD); VL[i] = *(const u32x4*)(vsrc[i] + (size_t)(j - 2) * 64 * HD); } } \
        att_compute(j); \
        if (j > 0) { _Pragma("unroll") for (int i = 0; i < 2; ++i) { *(LAS u32x4*)(KB + (cur ^ 1) * 8192 + (tids + 256 * i) * 16) = KS[i]; *(LAS u32x4*)(VB + (cur ^ 1) * 8192 + (tids + 256 * i) * 16) = VS[i]; } } \
        if (lane == 0) flags[(st & 1) * 8 + wid] = (done || j <= 0) ? 1 : 0; \
        __syncthreads(); \
        brk = __all(flags[(st & 1) * 8 + (lane & 7)] != 0); cur ^= 1; ++st; } while (0)
    auto att_compute = [&](const int j) __attribute__((always_inline)) {
        if (j >= 0 && j <= jd && !done) {
            const lds_cptr kb = (lds_cptr)(KB + cur * 8192) + hi * 1024 + r32 * 16;
            f32x16 p0 = {}, p1 = {};
#pragma unroll
            for (int d0 = 0; d0 < 4; ++d0) { const bf16x8 b0 = *(const LAS bf16x8*)(kb + d0 * 2048), b1 = *(const LAS bf16x8*)(kb + d0 * 2048 + 512);
                p0 = __builtin_amdgcn_mfma_f32_32x32x16_bf16(b0, qr[d0], p0, 0, 0, 0); p1 = __builtin_amdgcn_mfma_f32_32x32x16_bf16(b1, qr[d0], p1, 0, 0, 0); }
            float L0[16], L1[16];
#pragma unroll
            for (int r = 0; r < 16; ++r) { L0[r] = __builtin_amdgcn_logf(1.0f + __builtin_amdgcn_exp2f(p0[r])); L1[r] = __builtin_amdgcn_logf(1.0f + __builtin_amdgcn_exp2f(p1[r])); }
            if (j == jd) {
                const int kb0 = 64 * j + 4 * hi;
#pragma unroll
                for (int r = 0; r < 16; ++r) { const int kv = kb0 + (r & 3) + 8 * (r >> 2);
                    if (kv >= qpos) { L0[r] = 0.f; p0[r] = -INFINITY; } if (kv + 32 >= qpos) { L1[r] = 0.f; p1[r] = -INFINITY; } }
            }
            float tg[8];
#pragma unroll
            for (int g = 0; g < 4; ++g) {
                L0[4 * g + 2] += L0[4 * g + 3]; L0[4 * g + 1] += L0[4 * g + 2]; L0[4 * g] += L0[4 * g + 1]; tg[g] = L0[4 * g];
                L1[4 * g + 2] += L1[4 * g + 3]; L1[4 * g + 1] += L1[4 * g + 2]; L1[4 * g] += L1[4 * g + 1]; tg[4 + g] = L1[4 * g]; }
            float off[8]; float R = C;
#pragma unroll
            for (int g = 7; g >= 0; --g) {
                const auto rr = __builtin_amdgcn_permlane32_swap(__float_as_uint(tg[g]), __float_as_uint(tg[g]), false, false);
                const float tlo = __uint_as_float(rr[0]), thi = __uint_as_float(rr[1]);
                off[g] = R + (hi ? 0.f : thi);
                R += tlo + thi; }
            C = R;
#pragma unroll
            for (int g = 0; g < 4; ++g)
#pragma unroll
                for (int i = 0; i < 4; ++i) { p0[4 * g + i] = __builtin_amdgcn_exp2f(p0[4 * g + i] - (L0[4 * g + i] + off[g])); p1[4 * g + i] = __builtin_amdgcn_exp2f(p1[4 * g + i] - (L1[4 * g + i] + off[4 + g])); }
            u32x4 pw0, pw1, pw2, pw3;
            pw0 = (u32x4){cvtpk(p0[0], p0[1]), cvtpk(p0[2], p0[3]), cvtpk(p0[4], p0[5]), cvtpk(p0[6], p0[7])};
            pw1 = (u32x4){cvtpk(p0[8], p0[9]), cvtpk(p0[10], p0[11]), cvtpk(p0[12], p0[13]), cvtpk(p0[14], p0[15])};
            pw2 = (u32x4){cvtpk(p1[0], p1[1]), cvtpk(p1[2], p1[3]), cvtpk(p1[4], p1[5]), cvtpk(p1[6], p1[7])};
            pw3 = (u32x4){cvtpk(p1[8], p1[9]), cvtpk(p1[10], p1[11]), cvtpk(p1[12], p1[13]), cvtpk(p1[14], p1[15])};
            const lds_cptr vp = (lds_cptr)(VB + cur * 8192) + ((lane >> 4) & 1) * 32 + (lane & 3) * 8 + (4 * hi + ((lane & 15) >> 2)) * 64;
#define PVSTEP(OACC, D0, KS, PW) do { const s16x4 lo_ = vtr(vp + (D0) * 4096 + (KS) * 1024), hi_ = vtr(vp + (D0) * 4096 + (KS) * 1024 + 512); \
                const bf16x8 vf_ = (bf16x8){lo_[0], lo_[1], lo_[2], lo_[3], hi_[0], hi_[1], hi_[2], hi_[3]}; \
                OACC = __builtin_amdgcn_mfma_f32_32x32x16_bf16(__builtin_bit_cast(bf16x8, PW), vf_, OACC, 0, 0, 0); } while (0)
            PVSTEP(o0, 0, 0, pw0); PVSTEP(o1, 1, 0, pw0); PVSTEP(o0, 0, 1, pw1); PVSTEP(o1, 1, 1, pw1);
            PVSTEP(o0, 0, 2, pw2); PVSTEP(o1, 1, 2, pw2); PVSTEP(o0, 0, 3, pw3); PVSTEP(o1, 1, 3, pw3);
#undef PVSTEP
            done = __all(C > 150.0f);
        }
    };
    for (int st = 0; ; ) {
        ATT_STEP(kB, vB, kA, vA); if (brk) break;
        ATT_STEP(kA, vA, kB, vB); if (brk) break;
    }
#undef ATT_STEP
    { LAS bf16* stg = (LAS bf16*)OST;
#pragma unroll
      for (int r = 0; r < 16; ++r) { const int orow = crow(r, hi); stg[orow * 64 + r32] = (bf16)(cvtpk(o0[r], 0.f) & 0xffffu); stg[orow * 64 + 32 + r32] = (bf16)(cvtpk(o1[r], 0.f) & 0xffffu); }
      LDS_WAIT(); asm volatile("" ::: "memory");
      const int b = bh >> 4, h = bh & 15;
      bf16* Ow = (bf16*)(F.ws + WS_O) + ((size_t)b * SEQ + qw) * D + h * HD;
#pragma unroll
      for (int i = 0; i < 4; ++i) { const int row = i * 8 + (lane >> 3), ch = lane & 7; const u32x4 vv = *(const LAS u32x4*)(stg + row * 64 + ch * 8); *(u32x4*)(Ow + (size_t)row * D + ch * 8) = vv; } }
    __syncthreads();
}
__device__ __forceinline__ void phase_attn(Frame& F) {
    for (int v = blockIdx.x; v < BATCH * NH * 2; v += F.G) {
        const int bh = v >> 1, odd = v & 1;
        for (int i = 0; i < 4; ++i) { const int qa = 8 * odd + 2 * i; attn_pair(F, bh, qa, qa + 1); }
    }
}

__global__ void __launch_bounds__(NWAVES * 64, 2) fwd_kernel(Args args) {
    extern __shared__ __attribute__((aligned(16))) unsigned char lds[];
    Frame F;
    F.lds = (LAS unsigned char*)lds; F.MISC = (volatile LAS unsigned*)(F.lds + MISC_OFF);
    F.wave = __builtin_amdgcn_readfirstlane((int)threadIdx.x >> 6); F.G = gridDim.x;
    F.ws = args.ws; F.ctl = (gu32*)(args.ws + WS_CTL);
    for (int u = (int)threadIdx.x; u < (LDS_BYTES - LDSCTL_OFF) / 4; u += NWAVES * 64) ((LAS unsigned*)(F.lds + LDSCTL_OFF))[u] = 0u;
    __syncthreads();
    const XcdBarrier bar = xcd_barrier_post((unsigned*)(F.ctl + CW_BAR), F.MISC + 8, gridDim.x);
#define TP_PUT(i) do { if (threadIdx.x == 0) { const unsigned long long t_ = __builtin_amdgcn_s_memrealtime(); F.MISC[16 + 2 * (i)] = (unsigned)t_; F.MISC[17 + 2 * (i)] = (unsigned)(t_ >> 32); } } while (0)
#define SEAM(k) do { xcd_barrier(bar); if (MK_TPROBE == ((k) == 0 ? 3 : (k) + 1)) TP_PUT(0); if (MK_TPROBE == (k)) TP_PUT(1); } while (0)
    if (MK_TPROBE == 0) TP_PUT(0);
    float* X1 = (float*)(F.ws + WS_X1); float* X2 = (float*)(F.ws + WS_X2); float* X3 = (float*)(F.ws + WS_X3);

    const bool tuned = (F.G == 256);
    const int nfront = tuned ? NFRONT : F.G, cv3 = tuned ? CV3 : 0, cv9 = tuned ? CV9 : 0;
    {
        const int bx = (int)blockIdx.x;
        if (bx < nfront) {
            const XcdBarrier fbar = xcd_barrier_post((unsigned*)(F.ctl + CW_BAR2), F.MISC + 10, (unsigned)nfront);
            phase_convert(F, 0, CV_SMALL, bx, nfront); __syncthreads();
            phase_pooled(F, bx, nfront);
            xcd_barrier(fbar);
            { ProbPool S{(const char*)(F.ws + WS_POOLED), (const char*)(F.ws + WS_POOLW), 512, 512, nfront, bx, F.wave}; EpiPool E{FIN(0), X1, FIN(3)};
              pg8::gemm_phase<ProbPool, EpiPool>(F.lds, S, E); }
            xcd_barrier(fbar);
            phase_router<FP8_U0>(F, X1, FIN(8), (bf16*)(F.ws + WS_H2), 0, bx, nfront);
            if (nfront == F.G) phase_convert(F, CV_SMALL, CV_END, bx, F.G);
        } else {
            phase_convert(F, CV_SMALL, CV_END - cv9 - cv3, bx - nfront, F.G - nfront);
        }
    }
    SEAM(0);
    { const int bx = (int)blockIdx.x;
        if (cv3 > 0 && bx >= G3) phase_convert(F, CV_END - cv9 - cv3, CV_END - cv9, bx - G3, F.G - G3);
        else phase_moe_up<FP8_U0, FP8_D0>(F, 0, cv3 > 0 ? G3 : 0); }
    SEAM(3);
    phase_moe_down<FP8_D0, false>(F, 0);
    SEAM(4);
    phase_combine<true, false, false>(F, X1, X2, FIN(1) + D, (bf16*)(F.ws + WS_HQ), 0);
    SEAM(5);
    { ProbDense S{(const char*)(F.ws + WS_HQ), (const char*)(F.ws + WS_WQKV), 2 * D, 2 * D, 2 * D, M / 256, 12, F.G, (int)blockIdx.x, F.wave}; { const int l_ = lane_id(); if (F.wave == 0) { ((LAS float*)(F.lds + BIAS_OFF))[l_] = FIN(5)[l_]; ((LAS float*)(F.lds + BIAS_OFF))[64 + l_] = FIN(6)[l_]; } __syncthreads(); }
        EpiQKV E{(bf16*)(F.ws + WS_Q), (const LAS float*)(F.lds + BIAS_OFF)};
        pg8::gemm_phase<ProbDense, EpiQKV>(F.lds, S, E); }
    SEAM(6);
    phase_attn(F);
    SEAM(7);
    { ProbDense S{(const char*)(F.ws + WS_O), (const char*)(F.ws + WS_WO), 2 * D, 2 * D, 2 * D, M / 256, 4, F.G, (int)blockIdx.x, F.wave}; EpiRes E{X2, X3};
        pg8::gemm_phase<ProbDense, EpiRes>(F.lds, S, E); }
    SEAM(8);
    {
        const int bx = (int)blockIdx.x;
        if (cv9 == 0) phase_router<true>(F, X3, FIN(8) + D, (bf16*)(F.ws + WS_H2), 1, bx, F.G);
        else if (bx < NR9) phase_router<true>(F, X3, FIN(8) + D, (bf16*)(F.ws + WS_H2), 1, bx, NR9);
        else phase_convert(F, CV_END - cv9, CV_END, bx - NR9, F.G - NR9);
    }
    SEAM(9);
    phase_moe_up<true, true>(F, 1);
    SEAM(10);
    phase_moe_down<true, true>(F, 1);
    SEAM(11);
    phase_combine<false, true, true>(F, X3, FOUT, nullptr, nullptr, 1);
    if (MK_TPROBE >= 0) { if (MK_TPROBE == 12) TP_PUT(1);
        if (blockIdx.x == 0 && threadIdx.x == 0) { const unsigned long long tp0 = ((unsigned long long)F.MISC[17] << 32) | F.MISC[16], tp1 = ((unsigned long long)F.MISC[19] << 32) | F.MISC[18];
            const unsigned long long dt = (tp1 - tp0) * 4, ts = __builtin_amdgcn_s_memrealtime();
            while (__builtin_amdgcn_s_memrealtime() - ts < dt) __builtin_amdgcn_s_sleep(8); } }
#undef SEAM
}

extern "C" void kernel_launch(void* const* d_in, const int* in_sizes, int n_in, void* d_out, int out_size, void* d_ws, size_t ws_size, hipStream_t stream) {
    static int grid = 0;
    if (grid == 0) {
        if (n_in != 15 || in_sizes[0] != M * D || out_size != M * D || ws_size < WS_END) { fprintf(stderr, "kernel_launch: unexpected shapes (n_in %d, in0 %d, out %d, ws %zu, need %zu)\n", n_in, n_in > 0 ? in_sizes[0] : -1, out_size, ws_size, (size_t)WS_END); grid = -1; return; }
        int dev = 0, cus = 0, per_cu = 0;
        if (hipGetDevice(&dev) != hipSuccess || hipDeviceGetAttribute(&cus, hipDeviceAttributeMultiprocessorCount, dev) != hipSuccess) { grid = -1; return; }
        if (hipFuncSetAttribute((const void*)fwd_kernel, hipFuncAttributeMaxDynamicSharedMemorySize, LDS_BYTES) != hipSuccess) { fprintf(stderr, "kernel_launch: hipFuncSetAttribute failed\n"); grid = -1; return; }
        if (hipOccupancyMaxActiveBlocksPerMultiprocessor(&per_cu, (const void*)fwd_kernel, NWAVES * 64, LDS_BYTES) != hipSuccess || per_cu < 1) fprintf(stderr, "kernel_launch: occupancy query says %d\n", per_cu);
        (void)hipGetLastError();
        grid = cus;
    }
    if (grid < 0) return;
    (void)hipMemsetAsync((char*)d_ws + WS_CTL, 0, CTL_ZERO_BYTES, stream);
    Args a{};
    for (int i = 0; i < 15; ++i) a.in[i] = (const float*)d_in[i];
    a.out = (float*)d_out; a.ws = (unsigned char*)d_ws;
    hipLaunchKernelGGL(fwd_kernel, dim3(grid), dim3(NWAVES * 64), LDS_BYTES, stream, a);
    const hipError_t le = hipPeekAtLastError();
    if (le != hipSuccess) fprintf(stderr, "kernel_launch: launch failed: %s\n", hipGetErrorName(le));
}
```

```cpp
#include <hip/hip_runtime.h>
#include <cstdio>
#include <cstdint>

#define GAS __attribute__((address_space(1)))
#define LAS __attribute__((address_space(3)))
typedef unsigned short bf16;
typedef unsigned u32x4 __attribute__((ext_vector_type(4)));
typedef unsigned u32x2 __attribute__((ext_vector_type(2)));
typedef float f32x4 __attribute__((ext_vector_type(4)));
typedef float f32x2 __attribute__((ext_vector_type(2)));
typedef float f32x16 __attribute__((ext_vector_type(16)));
typedef short bf16x8 __attribute__((ext_vector_type(8)));
typedef short s16x4 __attribute__((ext_vector_type(4)));
typedef short v4i16_t __attribute__((ext_vector_type(4)));
typedef __bf16 bf16x2_t __attribute__((ext_vector_type(2)));
typedef int i32x8 __attribute__((ext_vector_type(8)));
typedef int i32x4 __attribute__((ext_vector_type(4)));
typedef GAS unsigned gu32;

constexpr int BATCH = 8, SEQ = 2048, D = 1024, M = BATCH * SEQ, NH = 16, HD = 64, NE = 32, TOPK = 4, FF = 1024;
constexpr float RMS_EPS = 1e-6f, SW_LIMIT = 7.0f, SW_ALPHA = 1.702f;
constexpr int MT_MAX = M * TOPK / 256 + NE;
constexpr int NSLOT = MT_MAX * 256;
constexpr float C2 = 0.125f * 1.4426950408889634f;
constexpr float S8_W = 64.0f, S8_H = 8.0f, S8_ACT = 4.0f, S8_OUT = 16.0f;
constexpr int E8_UP = 127 - 9, E8_DOWN = 127 - 8;

constexpr size_t MiB = 1u << 20;
constexpr size_t WS_CTL = 0, CTL_ZERO_BYTES = 128 * 1024;
constexpr size_t WS_POOLW = 1 * MiB;
constexpr size_t WS_WQKV = 2 * MiB;
constexpr size_t WS_WO = 8 * MiB;
constexpr size_t WS_TOPE = 10 * MiB, WS_TOPP = WS_TOPE + 256 * 1024, WS_TOPW = WS_TOPP + 256 * 1024;
constexpr size_t WS_LIST = 12 * MiB;
constexpr size_t WS_WGU = 16 * MiB;
constexpr size_t WS_WDN = 272 * MiB;
constexpr size_t WS_WGU8 = WS_WGU + 128 * MiB;
constexpr size_t WS_WDN8 = WS_WDN + 64 * MiB;
constexpr size_t WS_X1 = 400 * MiB, WS_X2 = 464 * MiB, WS_X3 = 528 * MiB;
constexpr size_t WS_POOLED = 592 * MiB, WS_H2 = 624 * MiB, WS_HQ = 656 * MiB, WS_Q = 688 * MiB, WS_K = 720 * MiB, WS_V = 752 * MiB, WS_O = 784 * MiB;
constexpr size_t WS_ACT = 816 * MiB, WS_OUTS = 960 * MiB;
constexpr size_t WS_END = 1104 * MiB;
static_assert(WS_ACT + (size_t)NSLOT * 1024 * 2 <= WS_OUTS && WS_OUTS + (size_t)NSLOT * 1024 * 2 <= WS_END, "ws map");
constexpr int CW_TMO = 0, CW_CODE = 1;
constexpr int CW_BAR = 4096;
constexpr int CW_BAR2 = 8192;
constexpr int CW_ECNT = 16384;

constexpr int RING_BYTES = 131072;
constexpr int LDSCTL_OFF = RING_BYTES, MISC_OFF = LDSCTL_OFF + 320;
constexpr int TAB_OFF = 131584;
constexpr int TAB_ECNT = TAB_OFF, TAB_TBASE = TAB_OFF + 128, TAB_TEXP = TAB_OFF + 384, TAB_ROW = TAB_OFF + 1024;
constexpr int MAXU = 12;
constexpr int BIAS_OFF = TAB_ROW + MAXU * 1024;
constexpr int LDS_BYTES = 163840;
static_assert(BIAS_OFF % 16 == 0 && BIAS_OFF + 2 * 8 * 1024 <= LDS_BYTES, "LDS map");

constexpr int NWAVES = 8;
#ifndef MK_NFRONT
#define MK_NFRONT 144
#endif
constexpr int NFRONT = MK_NFRONT;
#ifndef MK_CV9
#define MK_CV9 8000
#endif
#ifndef MK_NR9
#define MK_NR9 96
#endif
constexpr int CV9 = MK_CV9, NR9 = MK_NR9;
#ifndef MK_CV3
#define MK_CV3 600
#endif
constexpr int CV3 = MK_CV3, G3 = 248;

#ifndef MK_TPROBE
#define MK_TPROBE -1
#endif
#ifndef MK_X16
#define MK_X16 1
#endif
constexpr bool X16 = MK_X16;
#ifndef MK_OUT8_L0
#define MK_OUT8_L0 1
#endif
constexpr bool OUT8_L0 = MK_OUT8_L0;
#ifndef MK_FP8_L0
#define MK_FP8_L0 3
#endif
constexpr bool FP8_U0 = (MK_FP8_L0 & 1) != 0, FP8_D0 = (MK_FP8_L0 & 2) != 0;

#define RLX_AGENT __ATOMIC_RELAXED, __HIP_MEMORY_SCOPE_AGENT
#define LDS_WAIT() asm volatile("s_waitcnt lgkmcnt(0)" ::: "memory")
#define VM_WAIT() asm volatile("s_waitcnt vmcnt(0)" ::: "memory")
__device__ __forceinline__ unsigned cvtpk(float lo, float hi) { f32x2 v = {lo, hi}; bf16x2_t b = __builtin_convertvector(v, bf16x2_t); return __builtin_bit_cast(unsigned, b); }
__device__ __forceinline__ unsigned cvtfp8x4(float a, float b, float c, float d) { int w = __builtin_amdgcn_cvt_pk_fp8_f32(a, b, 0, false); w = __builtin_amdgcn_cvt_pk_fp8_f32(c, d, w, true); return (unsigned)w; }
__device__ __forceinline__ f32x4 xs_ld4(const void* base, size_t off) {
    if constexpr (X16) { const u32x2 v = *(const u32x2*)((const bf16*)base + off); return (f32x4){__uint_as_float(v.x << 16), __uint_as_float(v.x & 0xffff0000u), __uint_as_float(v.y << 16), __uint_as_float(v.y & 0xffff0000u)}; }
    else return *(const f32x4*)((const float*)base + off);
}
__device__ __forceinline__ void xs_st4(void* base, size_t off, f32x4 v) {
    if constexpr (X16) { u32x2 w; w.x = cvtpk(v[0], v[1]); w.y = cvtpk(v[2], v[3]); *(u32x2*)((bf16*)base + off) = w; }
    else *(f32x4*)((float*)base + off) = v;
}
__device__ __forceinline__ float bf_lo(unsigned u) { return __uint_as_float(u << 16); }
__device__ __forceinline__ float bf_hi(unsigned u) { return __uint_as_float(u & 0xffff0000u); }
__device__ __forceinline__ int lane_id() { int r; asm volatile("v_mbcnt_lo_u32_b32 %0, -1, 0\n\tv_mbcnt_hi_u32_b32 %0, -1, %0" : "=v"(r)); return r; }
__device__ __forceinline__ float wave_sum(float v) {
#pragma unroll
    for (int o = 1; o < 64; o <<= 1) v += __shfl_xor(v, o);
    return v;
}

#define XB_TMO      128
#define XB_XCNT(j)  (256  + 64 * (j))
#define XB_XSUB(j)  (1280 + 64 * (j))
#define XB_XGEN(j)  (2304 + 64 * (j))
#define XB_TOP      3328
#define XB_TOPGEN   3392
#define XCD_BAR_WORDS 3456
#define XB_SPIN_CAP (1u << 18)
__device__ __forceinline__ unsigned xb_ld(unsigned* p)              { return __hip_atomic_load(p, __ATOMIC_RELAXED, __HIP_MEMORY_SCOPE_AGENT); }
__device__ __forceinline__ unsigned xb_add(unsigned* p, unsigned v) { return __hip_atomic_fetch_add(p, v, __ATOMIC_RELAXED, __HIP_MEMORY_SCOPE_AGENT); }
__device__ __forceinline__ unsigned xb_xcc_id() { return (unsigned)__builtin_amdgcn_s_getreg((3 << 11) | 20) & 0xFu; }
#define XB_SPIN(cond, bar) do { unsigned _sp = 0; while (cond) { __builtin_amdgcn_s_sleep(1); \
    if ((++_sp & 255u) == 0u) { if (xb_ld(&(bar)[XB_TMO])) break; if (_sp > XB_SPIN_CAP) { atomicAdd(&(bar)[XB_TMO], 1u); break; } } } } while (0)
struct XcdBarrier { unsigned* bar; unsigned x; volatile LAS unsigned* st; unsigned G; };
__device__ __forceinline__ XcdBarrier xcd_barrier_post(unsigned* bar, volatile LAS unsigned* st, unsigned G) {
    XcdBarrier b; b.bar = bar; b.x = xb_xcc_id(); b.st = st; b.G = G;
    if (threadIdx.x == 0) (void)xb_add(&bar[XB_XCNT(b.x)], 1u);
    return b;
}
__device__ __forceinline__ void xcd_barrier_complete(unsigned* bar, unsigned x, unsigned& nloc, unsigned& nx, const unsigned G) {
    unsigned sum, cnt, mine, sp = 0u;
    for (;;) {
        sum = 0u; cnt = 0u; mine = 0u;
#pragma unroll
        for (unsigned j = 0; j < 16; ++j) { const unsigned c = xb_ld(&bar[XB_XCNT(j)]); sum += c; cnt += (c > 0u) ? 1u : 0u; mine = (j == x) ? c : mine; }
        if (sum == G) break;
        __builtin_amdgcn_s_sleep(1);
        if ((++sp & 255u) == 0u) { if (xb_ld(&bar[XB_TMO])) break; if (sp > XB_SPIN_CAP) { atomicAdd(&bar[XB_TMO], 1u); break; } }
    }
    nloc = mine > 0u ? mine : 1u; nx = cnt > 0u ? cnt : 1u;
}
__device__ __forceinline__ void xcd_barrier(const XcdBarrier& b) {
    asm volatile("s_waitcnt vmcnt(0)" ::: "memory");
    __syncthreads();
    if (threadIdx.x == 0) {
        unsigned* bar = b.bar;
        __builtin_amdgcn_s_waitcnt(0);
        unsigned nloc = b.st[0], nx = b.st[1];
        if (nloc == 0u) { xcd_barrier_complete(bar, b.x, nloc, nx, b.G); b.st[0] = nloc; b.st[1] = nx; }
        const unsigned old = xb_add(&bar[XB_XSUB(b.x)], 1u);
        const unsigned gen = old / nloc;
        if (old + 1u == (gen + 1u) * nloc) {
            __builtin_amdgcn_fence(__ATOMIC_RELEASE, "agent");
            asm volatile("s_waitcnt vmcnt(0)" ::: "memory");
            const unsigned og = xb_add(&bar[XB_TOP], 1u);
            const unsigned tg = og / nx;
            if (og + 1u == (tg + 1u) * nx) xb_add(&bar[XB_TOPGEN], 1u);
            else XB_SPIN(xb_ld(&bar[XB_TOPGEN]) == tg, bar);
            __builtin_amdgcn_fence(__ATOMIC_ACQUIRE, "agent");
            xb_add(&bar[XB_XGEN(b.x)], 1u);
            asm volatile("s_waitcnt vmcnt(0)" ::: "memory");
        } else {
            XB_SPIN(xb_ld(&bar[XB_XGEN(b.x)]) == gen, bar);
            __builtin_amdgcn_fence(__ATOMIC_ACQUIRE, "agent");
            asm volatile("s_waitcnt vmcnt(0)" ::: "memory");
        }
    }
    __syncthreads();
}

namespace pg8 {
constexpr int BM = 256, BK = 64, HALF = 128, HTB = HALF * BK * 2, STAGE_BYTES = 8 * HTB, NXCD = 8, WGM = 8;
__host__ __device__ __forceinline__ int lds_byte(int r, int c) { const int st = (r >> 4) * 2 + (c >> 5), rr = r & 15, cc = c & 31, ob = rr * 64 + cc * 2; return st * 1024 + (ob ^ (((ob >> 9) & 1) << 5)); }
__host__ __device__ __forceinline__ void stage_rc(int b, int& R, int& C) { const int st = b / 1024, sb = b % 1024, swz = sb ^ (((sb >> 9) & 1) << 5); R = (st >> 1) * 16 + swz / 64; C = (st & 1) * 32 + (swz % 64) / 2; }
__host__ __device__ __forceinline__ int perm32(int rho) { const int n = rho >> 4, i = rho & 15; return 8 * (i >> 2) + 4 * n + (i & 3); }

struct Unit { int pm, pn, e; };
__device__ __forceinline__ void glds_sv(const char* base, unsigned voff, unsigned lds_dst) {
    unsigned keep;
    asm volatile("s_mov_b32 %0, m0\n\ts_mov_b32 m0, %3\n\ts_nop 0\n\tglobal_load_lds_dwordx4 %1, %2\n\ts_mov_b32 m0, %0" : "=&s"(keep) : "v"(voff), "s"(base), "s"(lds_dst) : "memory");
}
__device__ __forceinline__ const char* uni_ptr(const char* p) { const unsigned long long u = (unsigned long long)p; const unsigned lo = __builtin_amdgcn_readfirstlane((unsigned)u), hi = __builtin_amdgcn_readfirstlane((unsigned)(u >> 32)); return (const char*)(((unsigned long long)hi << 32) | lo); }
struct UD { const char* a; const char* b0; const char* b1; };

__device__ __forceinline__ bool order_next(int i, int G, int c, int nM, int nN, int& pm, int& pn) {
    const int L = i * G + c; const int nwg = nM * nN; if (L >= nwg) return false;
    int wgid = L; { const int q = nwg / NXCD, r = nwg % NXCD, xcd = wgid % NXCD, off = wgid / NXCD; wgid = (xcd < r ? xcd * (q + 1) : r * (q + 1) + (xcd - r) * q) + off; }
    const int nig = WGM * nN, gid = wgid / nig, fm = gid * WGM, gsz = (nM - fm) < WGM ? (nM - fm) : WGM;
    pm = fm + ((wgid % nig) % gsz); pn = (wgid % nig) / gsz; return true;
}

template <class Prob, class Epi, bool FP8 = false, int E8 = 127>
__device__ __forceinline__ void gemm_phase(LAS unsigned char* lds, const Prob& S, const Epi& E) {
    const int wid = S.wave, lane = lane_id(), tid = wid * 64 + lane, wr = wid >> 2, wc = wid & 3, fr = lane & 15, fq = lane >> 4;
    const int nt = S.Kb / 128;
    unsigned voffB[2];
#pragma unroll
    for (int i = 0; i < 2; ++i) { int R, C; stage_rc(tid * 16 + i * 8192, R, C); const int Rb = Epi::PERM ? ((R & ~31) + perm32(R & 31)) : R; voffB[i] = (unsigned)(Rb * S.ldb + C * 2); }
    const size_t kstep = (size_t)(BK * 2);
    const unsigned ldsb = (unsigned)__builtin_amdgcn_readfirstlane((int)(unsigned)(uintptr_t)lds + wid * 1024);
    const int aoff = lds_byte(wr * 64 + fr, fq * 8), boff = lds_byte(wc * 32 + fr, fq * 8);
#define PG8_SA(b, h) (((b) * 2 + (h)) * HTB)
#define PG8_SB(b, h) ((4 + (b) * 2 + (h)) * HTB)
#define PG8_STA(bufoff, gbase, va, h) do { _Pragma("unroll") for (int _i = 0; _i < 2; ++_i) glds_sv((const char*)(gbase), (va)[(h) * 2 + _i], ldsb + (unsigned)((bufoff) + _i * 8192)); } while (0)
#define PG8_STB(bufoff, gbase) do { _Pragma("unroll") for (int _i = 0; _i < 2; ++_i) glds_sv((const char*)(gbase), voffB[_i], ldsb + (unsigned)((bufoff) + _i * 8192)); } while (0)
#define PG8_LD8(p) __builtin_shufflevector(*(const LAS i32x4*)(p), *(const LAS i32x4*)((p) + 1024), 0, 1, 2, 3, 4, 5, 6, 7)
#define PG8_LDA(dst, b, h) do { _Pragma("unroll") for (int m = 0; m < 4; ++m) dst[m] = PG8_LD8(lds + PG8_SA(b, h) + aoff + m * 2048); } while (0)
#define PG8_LDB(dst, b, h) do { _Pragma("unroll") for (int n = 0; n < 2; ++n) dst[n] = PG8_LD8(lds + PG8_SB(b, h) + boff + n * 2048); } while (0)
#define PG8_HALF(x, k) __builtin_bit_cast(bf16x8, __builtin_shufflevector(x, x, 4 * (k), 4 * (k) + 1, 4 * (k) + 2, 4 * (k) + 3))
#define PG8_MMA(ai, bj, At, Bt) do { __builtin_amdgcn_s_setprio(1); _Pragma("unroll") for (int m = 0; m < 4; ++m) _Pragma("unroll") for (int n = 0; n < 2; ++n) { \
        if constexpr (FP8) acc[ai][bj][m][n] = __builtin_amdgcn_mfma_scale_f32_16x16x128_f8f6f4(Bt[n], At[m], acc[ai][bj][m][n], 0, 0, 0, E8, 0, 127); \
        else { acc[ai][bj][m][n] = __builtin_amdgcn_mfma_f32_16x16x32_bf16(PG8_HALF(Bt[n], 0), PG8_HALF(At[m], 0), acc[ai][bj][m][n], 0, 0, 0); \
               acc[ai][bj][m][n] = __builtin_amdgcn_mfma_f32_16x16x32_bf16(PG8_HALF(Bt[n], 1), PG8_HALF(At[m], 1), acc[ai][bj][m][n], 0, 0, 0); } } \
        __builtin_amdgcn_s_setprio(0); \
        if constexpr (FP8) asm volatile("" : "+v"(acc[ai][bj][0][0]), "+v"(acc[ai][bj][0][1]), "+v"(acc[ai][bj][1][0]), "+v"(acc[ai][bj][1][1]), "+v"(acc[ai][bj][2][0]), "+v"(acc[ai][bj][2][1]), "+v"(acc[ai][bj][3][0]), "+v"(acc[ai][bj][3][1])); \
        } while (0)
#define PG8_WAIT_V(n) asm volatile("s_waitcnt vmcnt(" #n ")" ::: "memory")
#define PG8_WAIT_SEAM(flag) asm volatile("s_cmp_lg_u32 %0, 0\n\ts_cbranch_scc1 1f\n\ts_waitcnt vmcnt(8)\n\ts_branch 2f\n1:\n\ts_waitcnt vmcnt(%1)\n2:" :: "s"(flag), "n"(RELAX) : "memory", "scc")
#define PG8_WAIT_L(n) asm volatile("s_waitcnt lgkmcnt(" #n ")" ::: "memory")
#define PG8_BAR __builtin_amdgcn_s_barrier()
#define PG8_SCHED __builtin_amdgcn_sched_barrier(0)
    Unit cur, nxt; UD cd, nd; unsigned cva[4]; int ui = 0;
    if (!S.next(0, cur)) return;
    S.desc(cur, cd); S.desc_va(0, cur, cva);
    constexpr int RELAX = 8 + Epi::NPRE + Epi::NST; static_assert(RELAX <= 63, "vmcnt is 6 bits");
    E.prefetch(cur, lds + BIAS_OFF + wid * 1024, lane);
    f32x4 acc[2][2][4][2];
#pragma unroll
    for (int a = 0; a < 2; ++a)
#pragma unroll
        for (int b = 0; b < 2; ++b)
#pragma unroll
            for (int m = 0; m < 4; ++m)
#pragma unroll
                for (int n = 0; n < 2; ++n) acc[a][b][m][n] = (f32x4){0.f, 0.f, 0.f, 0.f};
    i32x8 At[4], B0[2], B1[2];
    PG8_STB(PG8_SB(0, 0), cd.b0); PG8_STB(PG8_SB(0, 1), cd.b1); PG8_STA(PG8_SA(0, 0), cd.a, cva, 0); PG8_STA(PG8_SA(0, 1), cd.a, cva, 1);
    if (wr == 1) PG8_BAR;
    PG8_WAIT_V(2); PG8_BAR;
    PG8_STB(PG8_SB(1, 0), cd.b0 + kstep); PG8_STA(PG8_SA(1, 0), cd.a + kstep, cva, 0); PG8_STB(PG8_SB(1, 1), cd.b1 + kstep); PG8_STA(PG8_SA(1, 1), cd.a + kstep, cva, 1);
    PG8_WAIT_V(8); PG8_BAR;
    for (;;) {
        const bool has_next = S.next(ui + 1, nxt);
        if (has_next) S.desc(nxt, nd); else nd = cd;
#pragma clang loop unroll(disable)
        for (int t = 0; t < nt; t += 2) {
            const bool last = (t == nt - 2); const int seam = __builtin_amdgcn_readfirstlane((t == 0 && ui > 0) ? 1 : 0);
            const char* a2 = last ? nd.a : cd.a + (size_t)(t + 2) * kstep;
            const char* b20 = last ? nd.b0 : cd.b0 + (size_t)(t + 2) * kstep; const char* b21 = last ? nd.b1 : cd.b1 + (size_t)(t + 2) * kstep;
            const char* a3 = a2 + kstep; const char* b30 = b20 + kstep; const char* b31 = b21 + kstep;
            PG8_LDB(B0, 0, 0); PG8_LDB(B1, 0, 1); PG8_SCHED; PG8_LDA(At, 0, 0);
            PG8_WAIT_SEAM(seam);
            PG8_WAIT_L(0); PG8_BAR; PG8_MMA(0, 0, At, B0); PG8_MMA(0, 1, At, B1); PG8_BAR; PG8_SCHED;
            if (last && has_next) S.desc_va(ui + 1, nxt, cva);
            PG8_LDA(At, 0, 1); PG8_STB(PG8_SB(0, 0), b20); PG8_STB(PG8_SB(0, 1), b21); PG8_STA(PG8_SA(0, 0), a2, cva, 0);
            PG8_WAIT_SEAM(seam);
            PG8_WAIT_L(0); PG8_BAR; PG8_MMA(1, 0, At, B0); PG8_MMA(1, 1, At, B1); PG8_BAR; PG8_SCHED;
            PG8_LDB(B0, 1, 0); PG8_LDB(B1, 1, 1); PG8_SCHED; PG8_LDA(At, 1, 0); PG8_STA(PG8_SA(0, 1), a2, cva, 1);
            PG8_WAIT_SEAM(seam);
            PG8_WAIT_L(0); PG8_BAR; PG8_MMA(0, 0, At, B0); PG8_MMA(0, 1, At, B1); PG8_BAR; PG8_SCHED;
            PG8_LDA(At, 1, 1); PG8_STB(PG8_SB(1, 0), b30); PG8_STB(PG8_SB(1, 1), b31); PG8_STA(PG8_SA(1, 0), a3, cva, 0);
            PG8_WAIT_V(8); PG8_WAIT_L(0); PG8_BAR; PG8_MMA(1, 0, At, B0); PG8_MMA(1, 1, At, B1); PG8_BAR; PG8_SCHED;
            PG8_STA(PG8_SA(1, 1), a3, cva, 1);
        }
        if (has_next) E.prefetch(nxt, lds + BIAS_OFF + (((ui + 1) & 1) * 8 + wid) * 1024, lane);
        if (wr == 0) PG8_BAR;
        E(acc, cur, wr, wc, fr, fq, lds + BIAS_OFF + ((ui & 1) * 8 + wid) * 1024);
        if (!has_next) break;
#pragma unroll
        for (int a = 0; a < 2; ++a)
#pragma unroll
            for (int b = 0; b < 2; ++b)
#pragma unroll
                for (int m = 0; m < 4; ++m)
#pragma unroll
                    for (int n = 0; n < 2; ++n) acc[a][b][m][n] = (f32x4){0.f, 0.f, 0.f, 0.f};
        cur = nxt; cd = nd;
        ++ui;
        if (wr == 1) PG8_BAR;
    }
    PG8_WAIT_V(0);
    PG8_BAR;
#undef PG8_SA
#undef PG8_SB
#undef PG8_STA
#undef PG8_STB
#undef PG8_LDA
#undef PG8_LDB
#undef PG8_MMA
#undef PG8_LD8
#undef PG8_HALF
#undef PG8_WAIT_V
#undef PG8_WAIT_SEAM
#undef PG8_WAIT_L
#undef PG8_BAR
#undef PG8_SCHED
}
}

struct Frame {
    LAS unsigned char* lds;
    volatile LAS unsigned* MISC;
    gu32* ctl;
    int wave, G;
    unsigned char* ws;
};
struct Args { const float* in[15]; float* out; unsigned char* ws; };
#define KARG ((const __attribute__((address_space(4))) Args*)__builtin_amdgcn_kernarg_segment_ptr())
#define FIN(i) (KARG->in[i])
#define FOUT (KARG->out)

struct ProbDense {
    const char* A; const char* Bt; int lda, ldb, Kb, nM, nN, G, c, wave;
    __device__ __forceinline__ bool next(int i, pg8::Unit& u) const { u.e = 0; return pg8::order_next(i, G, c, nM, nN, u.pm, u.pn); }
    __device__ __forceinline__ void desc(const pg8::Unit& u, pg8::UD& d) const { d.a = pg8::uni_ptr(A + (size_t)u.pm * 256 * lda); d.b0 = pg8::uni_ptr(Bt + (size_t)u.pn * 256 * ldb); d.b1 = d.b0 + (size_t)128 * ldb; }
    __device__ __forceinline__ void desc_va(int, const pg8::Unit&, unsigned (&va)[4]) const {
#pragma unroll
        for (int i = 0; i < 2; ++i) { int R, C; pg8::stage_rc((wave * 64 + lane_id()) * 16 + i * 8192, R, C); va[i] = (unsigned)(R * lda + C * 2); va[2 + i] = va[i] + (unsigned)(128 * lda); }
    }
};
struct ProbPool {
    const char* A; const char* Bt; int ldb, Kb, G, c, wave;
    __device__ __forceinline__ bool next(int i, pg8::Unit& u) const { u.e = 0; return pg8::order_next(i, G, c, M / 256, 4, u.pm, u.pn); }
    __device__ __forceinline__ void desc(const pg8::Unit& u, pg8::UD& d) const { d.a = pg8::uni_ptr(A + (size_t)u.pm * 256 * D * 2 + (size_t)u.pn * 256 * 2); d.b0 = pg8::uni_ptr(Bt + (size_t)u.pn * 65536 * 2); d.b1 = d.b0 + (size_t)128 * 256 * 2; }
    __device__ __forceinline__ void desc_va(int, const pg8::Unit&, unsigned (&va)[4]) const {
#pragma unroll
        for (int i = 0; i < 2; ++i) { int R, C; pg8::stage_rc((wave * 64 + lane_id()) * 16 + i * 8192, R, C); va[i] = (unsigned)(R * D * 2 + C * 2); va[2 + i] = va[i] + (unsigned)(128 * D * 2); }
    }
};
struct ProbMoeUp {
    const char* A; const char* Bt; LAS unsigned char* lds; int ldb, Kb, nM, G, c, wave;
    __device__ __forceinline__ bool next(int i, pg8::Unit& u) const { if (!pg8::order_next(i, G, c, nM, 8, u.pm, u.pn)) return false; u.e = __builtin_amdgcn_readfirstlane((int)((const LAS unsigned char*)(lds + TAB_TEXP))[u.pm]); return true; }
    __device__ __forceinline__ void desc(const pg8::Unit& u, pg8::UD& d) const { d.a = pg8::uni_ptr(A); d.b0 = pg8::uni_ptr(Bt + ((size_t)u.e * 2048 + (size_t)u.pn * 256) * ldb); d.b1 = d.b0 + (size_t)128 * ldb; }
    __device__ __forceinline__ void desc_va(int ord, const pg8::Unit&, unsigned (&va)[4]) const {
        const LAS unsigned* rt = (const LAS unsigned*)(lds + TAB_ROW) + ord * 256;
#pragma unroll
        for (int i = 0; i < 2; ++i) { int R, C; pg8::stage_rc((wave * 64 + lane_id()) * 16 + i * 8192, R, C); va[i] = rt[R] + (unsigned)(C * 2); va[2 + i] = rt[128 + R] + (unsigned)(C * 2); }
    }
};
struct ProbMoeDown {
    const char* A; const char* Bt; LAS unsigned char* lds; int ldb, Kb, nM, G, c, wave;
    __device__ __forceinline__ bool next(int i, pg8::Unit& u) const { if (!pg8::order_next(i, G, c, nM, 4, u.pm, u.pn)) return false; u.e = __builtin_amdgcn_readfirstlane((int)((const LAS unsigned char*)(lds + TAB_TEXP))[u.pm]); return true; }
    __device__ __forceinline__ void desc(const pg8::Unit& u, pg8::UD& d) const { d.a = pg8::uni_ptr(A + (size_t)u.pm * 256 * ldb); d.b0 = pg8::uni_ptr(Bt + ((size_t)u.e * 1024 + (size_t)u.pn * 256) * ldb); d.b1 = d.b0 + (size_t)128 * ldb; }
    __device__ __forceinline__ void desc_va(int, const pg8::Unit&, unsigned (&va)[4]) const {
#pragma unroll
        for (int i = 0; i < 2; ++i) { int R, C; pg8::stage_rc((wave * 64 + lane_id()) * 16 + i * 8192, R, C); va[i] = (unsigned)(R * ldb + C * 2); va[2 + i] = va[i] + (unsigned)(128 * ldb); }
    }
};

struct EpiPool {
    static constexpr bool PERM = false; static constexpr int NST = 32, NPRE = 0;
    const float* x; float* X1; const float* scale;
    __device__ __forceinline__ void prefetch(const pg8::Unit&, LAS unsigned char*, int) const {}

    __device__ __forceinline__ void operator()(const f32x4 (&acc)[2][2][4][2], const pg8::Unit& u, int wr, int wc, int fr, int fq, LAS unsigned char* bl) const {
        const int row0 = u.pm * 256 + wr * 64 + fr, col0 = u.pn * 256 + wc * 32 + 4 * fq;
        f32x4 sv[2][2];
#pragma unroll
        for (int bj = 0; bj < 2; ++bj)
#pragma unroll
            for (int n = 0; n < 2; ++n) sv[bj][n] = *(const f32x4*)(scale + col0 + bj * 128 + n * 16);
#pragma unroll
        for (int ai = 0; ai < 2; ++ai)
#pragma unroll
            for (int m = 0; m < 4; ++m) { const size_t off = (size_t)(row0 + ai * 128 + m * 16) * D + col0;
#pragma unroll
                for (int bj = 0; bj < 2; ++bj)
#pragma unroll
                    for (int n = 0; n < 2; ++n) { const f32x4 xv = *(const f32x4*)(x + off + bj * 128 + n * 16); xs_st4(X1, off + bj * 128 + n * 16, xv + acc[ai][bj][m][n] * sv[bj][n]); }
                if (m & 1) asm volatile("" ::: "memory"); }
    }
};
struct EpiRes {
    static constexpr bool PERM = false; static constexpr int NST = 32, NPRE = 0;
    const float* Xi; float* Xo;
    __device__ __forceinline__ void prefetch(const pg8::Unit&, LAS unsigned char*, int) const {}

    __device__ __forceinline__ void operator()(const f32x4 (&acc)[2][2][4][2], const pg8::Unit& u, int wr, int wc, int fr, int fq, LAS unsigned char* bl) const {
        const int row0 = u.pm * 256 + wr * 64 + fr, col0 = u.pn * 256 + wc * 32 + 4 * fq;
#pragma unroll
        for (int ai = 0; ai < 2; ++ai)
#pragma unroll
            for (int m = 0; m < 4; ++m) { const size_t off = (size_t)(row0 + ai * 128 + m * 16) * D + col0;
#pragma unroll
                for (int bj = 0; bj < 2; ++bj)
#pragma unroll
                    for (int n = 0; n < 2; ++n) { const f32x4 xv = xs_ld4(Xi, off + bj * 128 + n * 16); xs_st4(Xo, off + bj * 128 + n * 16, xv + acc[ai][bj][m][n]); }
                if (m & 1) asm volatile("" ::: "memory"); }
    }
};
struct EpiQKV {
    static constexpr bool PERM = true; static constexpr int NST = 16, NPRE = 0;
    bf16* QKV; const LAS float* gl;
    __device__ __forceinline__ void prefetch(const pg8::Unit&, LAS unsigned char*, int) const {}

    __device__ __forceinline__ void operator()(const f32x4 (&acc)[2][2][4][2], const pg8::Unit& u, int wr, int wc, int fr, int fq, LAS unsigned char* bl) const {
        const int seg = u.pn >> 2, head = (u.pn & 3) * 4 + wc;
        f32x4 gv[2][2];
#pragma unroll
        for (int bj = 0; bj < 2; ++bj)
#pragma unroll
            for (int n = 0; n < 2; ++n) {
                if (seg == 2) gv[bj][n] = (f32x4){1.f, 1.f, 1.f, 1.f};
                else { const LAS float* g = gl + seg * 64 + bj * 32 + 8 * fq + 4 * n; gv[bj][n] = *(const LAS f32x4*)g; if (seg == 0) gv[bj][n] = gv[bj][n] * C2; } }
        bf16* base = QKV + (size_t)seg * M * D;
#pragma unroll
        for (int ai = 0; ai < 2; ++ai)
#pragma unroll
            for (int m = 0; m < 4; ++m) {
                const int t = u.pm * 256 + ai * 128 + wr * 64 + m * 16 + fr, b = t >> 11, s = t & (SEQ - 1);
                float rstd = 1.f;
                if (seg < 2) { float ss = 0.f;
#pragma unroll
                    for (int bj = 0; bj < 2; ++bj)
#pragma unroll
                        for (int n = 0; n < 2; ++n) { const f32x4 v = acc[ai][bj][m][n]; ss += (v[0] * v[0] + v[1] * v[1]) + (v[2] * v[2] + v[3] * v[3]); }
                    ss += __shfl_xor(ss, 16); ss += __shfl_xor(ss, 32);
                    rstd = 1.0f / sqrtf(ss * (1.0f / 64.0f) + RMS_EPS); }
                bf16* rowp = base + ((size_t)(b * NH + head) * SEQ + s) * HD + 8 * fq;
#pragma unroll
                for (int bj = 0; bj < 2; ++bj) { const f32x4 v0 = acc[ai][bj][m][0] * rstd * gv[bj][0], v1 = acc[ai][bj][m][1] * rstd * gv[bj][1];
                    u32x4 w; w.x = cvtpk(v0[0], v0[1]); w.y = cvtpk(v0[2], v0[3]); w.z = cvtpk(v1[0], v1[1]); w.w = cvtpk(v1[2], v1[3]);
                    *(u32x4*)(rowp + bj * 32) = w; }
            }
    }
};
template <bool OUT8> struct EpiGateUp {
    static constexpr bool PERM = true; static constexpr int NST = 8, NPRE = 1;
    bf16* ACT; const float* bias;
    __device__ __forceinline__ void prefetch(const pg8::Unit& u, LAS unsigned char* bl, int lane) const {
        pg8::glds_sv(pg8::uni_ptr((const char*)(bias + (size_t)u.e * 2048 + u.pn * 128)), (unsigned)((lane & 31) * 16 + (lane >> 5) * 4096), (unsigned)__builtin_amdgcn_readfirstlane((int)(unsigned)(uintptr_t)bl)); }
    __device__ __forceinline__ void operator()(const f32x4 (&acc)[2][2][4][2], const pg8::Unit& u, int wr, int wc, int fr, int fq, LAS unsigned char* bl) const {
        { const int le = lane_id(); fr = le & 15; fq = le >> 4; }
        const int lc = u.pn * 128 + wc * 32 + 8 * fq;
        const LAS float* bg = (const LAS float*)bl + wc * 32 + 8 * fq;
        f32x4 bv[2][2];
#pragma unroll
        for (int bj = 0; bj < 2; ++bj)
#pragma unroll
            for (int n = 0; n < 2; ++n) bv[bj][n] = *(const LAS f32x4*)(bg + bj * 128 + 4 * n) + (bj ? 1.0f : 0.0f);
#pragma unroll
        for (int ai = 0; ai < 2; ++ai)
#pragma unroll
            for (int m = 0; m < 4; ++m) {
                const size_t eoff = (size_t)(u.pm * 256 + ai * 128 + wr * 64 + m * 16 + fr) * FF + lc;
                float o[8];
                constexpr float OS = OUT8 ? S8_ACT : 1.0f, IOS = 1.0f / OS;
#pragma unroll
                for (int n = 0; n < 2; ++n) { const f32x4 g4 = acc[ai][0][m][n] + bv[0][n], u4 = acc[ai][1][m][n] + bv[1][n];
#pragma unroll
                    for (int i = 0; i < 4; ++i) { const float g = fminf(g4[i], SW_LIMIT), up1 = __builtin_amdgcn_fmed3f(u4[i], 1.0f - SW_LIMIT, 1.0f + SW_LIMIT);
                        const float sg = __builtin_amdgcn_rcpf(__builtin_fmaf(__builtin_amdgcn_exp2f(g * (-SW_ALPHA * 1.4426950408889634f)), IOS, IOS));
                        o[n * 4 + i] = up1 * (g * sg); } }
                if constexpr (OUT8) { u32x2 w; w.x = cvtfp8x4(o[0], o[1], o[2], o[3]); w.y = cvtfp8x4(o[4], o[5], o[6], o[7]);
                    *(u32x2*)((unsigned char*)ACT + eoff) = w; }
                else { u32x4 w; w.x = cvtpk(o[0], o[1]); w.y = cvtpk(o[2], o[3]); w.z = cvtpk(o[4], o[5]); w.w = cvtpk(o[6], o[7]);
                    *(u32x4*)(ACT + eoff) = w; }
            }
    }
};
template <bool OUT8> struct EpiDown {
    static constexpr bool PERM = true; static constexpr int NST = 16, NPRE = 1;
    bf16* OUTS; const float* bias;
    __device__ __forceinline__ void prefetch(const pg8::Unit& u, LAS unsigned char* bl, int lane) const {
        pg8::glds_sv(pg8::uni_ptr((const char*)(bias + (size_t)u.e * 1024 + u.pn * 256)), (unsigned)(lane * 16), (unsigned)__builtin_amdgcn_readfirstlane((int)(unsigned)(uintptr_t)bl)); }
    __device__ __forceinline__ void operator()(const f32x4 (&acc)[2][2][4][2], const pg8::Unit& u, int wr, int wc, int fr, int fq, LAS unsigned char* bl) const {
        const int col0 = u.pn * 256 + wc * 32 + 8 * fq;
        const LAS float* bd = (const LAS float*)bl + wc * 32 + 8 * fq;
        f32x4 bv[2][2];
#pragma unroll
        for (int bj = 0; bj < 2; ++bj)
#pragma unroll
            for (int n = 0; n < 2; ++n) bv[bj][n] = *(const LAS f32x4*)(bd + bj * 128 + 4 * n);
#pragma unroll
        for (int ai = 0; ai < 2; ++ai)
#pragma unroll
            for (int m = 0; m < 4; ++m) { bf16* rowp = OUTS + (size_t)(u.pm * 256 + ai * 128 + wr * 64 + m * 16 + fr) * D + col0;
#pragma unroll
                for (int bj = 0; bj < 2; ++bj) { const f32x4 v0 = acc[ai][bj][m][0] + bv[bj][0], v1 = acc[ai][bj][m][1] + bv[bj][1];
                    if constexpr (OUT8) { u32x2 w;
#define O8C(x) __builtin_amdgcn_fmed3f((x) * S8_OUT, -448.0f, 448.0f)
                        w.x = cvtfp8x4(O8C(v0[0]), O8C(v0[1]), O8C(v0[2]), O8C(v0[3])); w.y = cvtfp8x4(O8C(v1[0]), O8C(v1[1]), O8C(v1[2]), O8C(v1[3]));
#undef O8C
                        *(u32x2*)((unsigned char*)OUTS + (size_t)(u.pm * 256 + ai * 128 + wr * 64 + m * 16 + fr) * D + col0 + bj * 128) = w; }
                    else { u32x4 w; w.x = cvtpk(v0[0], v0[1]); w.y = cvtpk(v0[2], v0[3]); w.z = cvtpk(v1[0], v1[1]); w.w = cvtpk(v1[2], v1[3]);
                        *(u32x4*)(rowp + bj * 128) = w; } } }
    }
};

constexpr int CV_POOL = 4 * 2 * 4, CV_QKV = 8 * 48, CV_WO = 8 * 16, CV_GU1 = 32 * 8 * 32  , CV_DN1 = 32 * 8 * 16  ;
constexpr int CV_SMALL = CV_POOL + CV_QKV + CV_WO, CV_END = CV_SMALL + 2 * (CV_GU1 + CV_DN1);
struct CvtItem { const float* src; unsigned char* dst; int N, dpitch, fp8, hs; };
__device__ __forceinline__ CvtItem cvt_decode(Frame& F, int it) {
    CvtItem c; int r = it; c.fp8 = 0; c.hs = 32;
    if (r < CV_POOL) { const int g = r >> 3, q = r & 7, kb = q >> 2, nb = q & 3; c.N = 256; c.dpitch = 512;
        c.src = FIN(2) + (size_t)g * 65536 + (size_t)(kb * 128) * 256 + nb * 64; c.dst = F.ws + WS_POOLW + ((size_t)g * 65536 + (size_t)(nb * 64) * 256 + kb * 128) * 2; return c; }
    r -= CV_POOL;
    if (r < CV_QKV) { const int kb = r / 48, nb = r % 48, n0 = nb * 64, pn = n0 >> 8, w = (n0 & 255) >> 6; c.N = 3 * D; c.dpitch = 2 * D; c.hs = 128;
        c.src = FIN(4) + (size_t)(kb * 128) * (3 * D) + n0; c.dst = F.ws + WS_WQKV + ((size_t)(256 * pn + 32 * w) * D + kb * 128) * 2; return c; }
    r -= CV_QKV;
    if (r < CV_WO) { const int kb = r >> 4, nb = r & 15; c.N = D; c.dpitch = 2 * D;
        c.src = FIN(7) + (size_t)(kb * 128) * D + nb * 64; c.dst = F.ws + WS_WO + ((size_t)(nb * 64) * D + kb * 128) * 2; return c; }
    r -= CV_WO;
    int layer = 0;
    if (r >= CV_GU1 + CV_DN1) { r -= CV_GU1 + CV_DN1; layer = 1; }
    if (r < CV_GU1) { const int mat = layer * NE + (r >> 8), q = r & 255, kb = q >> 5, nb = q & 31; c.N = 2 * FF; c.fp8 = (layer == 1 || FP8_U0); c.dpitch = c.fp8 ? D : 2 * D;
        c.src = FIN(11) + (size_t)mat * D * 2 * FF + (size_t)(kb * 128) * (2 * FF) + nb * 64;
        const int n0 = nb * 64, cg = n0 & (FF - 1), drow = (cg >> 7) * 256 + (n0 >= FF ? 128 : 0) + (cg & 127);
        c.dst = c.fp8 ? F.ws + WS_WGU8 + (size_t)(1 - layer) * 64 * MiB + (size_t)(mat - layer * NE) * 2 * FF * D + (size_t)drow * D + kb * 128 : F.ws + WS_WGU + ((size_t)mat * 2 * FF * D + (size_t)drow * D + kb * 128) * 2; return c; }
    r -= CV_GU1;
    { const int mat = layer * NE + (r >> 7), q = r & 127, kb = q >> 4, nb = q & 15; c.N = D; c.fp8 = (layer == 1 || FP8_D0); c.dpitch = c.fp8 ? FF : 2 * FF;
        c.src = FIN(13) + (size_t)mat * FF * D + (size_t)(kb * 128) * D + nb * 64;
        c.dst = c.fp8 ? F.ws + WS_WDN8 + (size_t)(1 - layer) * 32 * MiB + (size_t)(mat - layer * NE) * D * FF + (size_t)(nb * 64) * FF + kb * 128 : F.ws + WS_WDN + ((size_t)mat * D * FF + (size_t)(nb * 64) * FF + kb * 128) * 2; return c; }
}
__device__ __forceinline__ void cvt_load(const CvtItem& c, int half, f32x4 (&v)[16], int lane) {
    const float* p = c.src + (size_t)(64 * half + (lane >> 4)) * c.N + 4 * (lane & 15);
#pragma unroll
    for (int i = 0; i < 16; ++i) v[i] = __builtin_nontemporal_load((const f32x4*)(p + (size_t)(4 * i) * c.N));
}
__device__ __forceinline__ s16x4 cvt_tr(LAS const unsigned char* p) { return __builtin_bit_cast(s16x4, __builtin_amdgcn_ds_read_tr16_b64_v4i16((LAS v4i16_t*)p)); }
constexpr int CVP = 136;
__device__ __forceinline__ void cvt_to_lds(const f32x4 (&v)[16], int half, LAS unsigned char* scr, int lane) {
    LAS unsigned char* wp = scr + (64 * half + (lane >> 4)) * CVP + (lane & 15) * 8;
#pragma unroll
    for (int i = 0; i < 16; ++i) { u32x2 w; w.x = cvtpk(v[i][0], v[i][1]); w.y = cvtpk(v[i][2], v[i][3]); *(LAS u32x2*)(wp + 4 * i * CVP) = w; }
}
__device__ __forceinline__ void cvt_emit(const CvtItem& c, LAS unsigned char* scr, int lane) {
    LDS_WAIT(); asm volatile("" ::: "memory");
    const int g = lane >> 4, i16 = lane & 15, r = i16 >> 2, cc = i16 & 3;
    if (c.fp8) {
#pragma unroll
        for (int nb = 0; nb < 4; ++nb)
#pragma unroll
            for (int ps = 0; ps < 2; ++ps) { const int kc = 4 * ps + g; LAS const unsigned char* rp = scr + (16 * kc + r) * CVP + cc * 8 + nb * 32;
                u32x4 o;
#pragma unroll
                for (int h = 0; h < 4; ++h) { const u32x2 t = __builtin_bit_cast(u32x2, cvt_tr(rp + (4 * h) * CVP));
                    const unsigned a = t.x + 0x03000300u, b = t.y + 0x03000300u;
                    o[h] = cvtfp8x4(__uint_as_float(a << 16), __uint_as_float(a & 0xffff0000u), __uint_as_float(b << 16), __uint_as_float(b & 0xffff0000u)); }
                const int n = 16 * nb + i16;
                *(u32x4*)(c.dst + (size_t)((n >> 5) * c.hs + (n & 31)) * c.dpitch + 16 * kc) = o; }
    } else {
#pragma unroll
        for (int nb = 0; nb < 4; ++nb)
#pragma unroll
            for (int ps = 0; ps < 4; ++ps) { const int kc = 4 * ps + g; LAS const unsigned char* rp = scr + (8 * kc + r) * CVP + cc * 8 + nb * 32;
                const u32x2 t0 = __builtin_bit_cast(u32x2, cvt_tr(rp)), t1 = __builtin_bit_cast(u32x2, cvt_tr(rp + 4 * CVP));
                const int n = 16 * nb + i16;
                *(u32x4*)(c.dst + (size_t)((n >> 5) * c.hs + (n & 31)) * c.dpitch + 16 * kc) = (u32x4){t0.x, t0.y, t1.x, t1.y}; }
    }
    LDS_WAIT(); asm volatile("" ::: "memory");
}
__device__ __forceinline__ void phase_convert(Frame& F, int item_lo, int item_hi, int bidx, int nblk) {
    const int lane = lane_id();
    LAS unsigned char* scr = F.lds + (F.wave < 7 ? F.wave * 17408 : 133120);
    const int gw = bidx * NWAVES + F.wave, NGW = nblk * NWAVES;
    int it = item_lo + gw; if (it >= item_hi) return;
    CvtItem c = cvt_decode(F, it); f32x4 va[16], vb[16]; cvt_load(c, 0, va, lane); cvt_load(c, 1, vb, lane);
    for (;;) {
        cvt_to_lds(va, 0, scr, lane); cvt_to_lds(vb, 1, scr, lane);
        const int itn = it + NGW; const bool more = itn < item_hi;
        CvtItem cn = c;
        if (more) { cn = cvt_decode(F, itn); cvt_load(cn, 0, va, lane); cvt_load(cn, 1, vb, lane); }
        cvt_emit(c, scr, lane);
        if (!more) break;
        c = cn; it = itn;
    }
}
__device__ __forceinline__ void phase_pooled(Frame& F, int bidx, int nblk) {
    const int lane = lane_id(), tid = F.wave * 64 + lane; (void)tid;
    LAS float* H = (LAS float*)F.lds;
    LAS float* RS = (LAS float*)(F.lds + 81920);
    bf16* P = (bf16*)(F.ws + WS_POOLED);
    for (int tile = bidx; tile < M / 64; tile += nblk) {
        const int t0 = tile * 64, s0 = t0 & (SEQ - 1);
        for (int i = F.wave; i < 79; i += NWAVES) {
            const int s = s0 - 15 + i; float r = 0.f;
            if (s >= 0) { const f32x4* xr = (const f32x4*)(FIN(0) + (size_t)(t0 - 15 + i) * D) + lane; float ss = 0.f;
#pragma unroll
                for (int j = 0; j < 4; ++j) { const f32x4 v = xr[64 * j]; ss += (v[0] * v[0] + v[1] * v[1]) + (v[2] * v[2] + v[3] * v[3]); }
                ss = wave_sum(ss); r = 1.0f / sqrtf(ss * (1.0f / D) + RMS_EPS); }
            if (lane == 0) RS[i] = r;
        }
        __syncthreads();
        for (int g = 0; g < 4; ++g) {
            const f32x4 gn = *((const f32x4*)(FIN(1) + g * 256) + lane);
            for (int i = F.wave; i < 79; i += NWAVES) {
                const int s = s0 - 15 + i; f32x4 v = (f32x4){0.f, 0.f, 0.f, 0.f};
                if (s >= 0) { v = *((const f32x4*)(FIN(0) + (size_t)(t0 - 15 + i) * D + g * 256) + lane); v = v * RS[i] * gn; }
                *((LAS f32x4*)(H + i * 256) + lane) = v;
            }
            __syncthreads();
            const int w = 2 << g, cp = tid & 127, rq = tid >> 7, i0 = 15 + rq * 16;
            const LAS f32x2* H2p = (const LAS f32x2*)H + cp;
            f32x2 S = (f32x2){0.f, 0.f};
            for (int j = i0 - w + 1; j <= i0; ++j) S += H2p[j * 128];
            for (int r = 0; r < 16; ++r) {
                const int i = i0 + r;
                if (r > 0) S += H2p[i * 128] - H2p[(i - w) * 128];
                const int s = s0 + rq * 16 + r; const int cnt = (s + 1 < w) ? (s + 1) : w;
                const f32x2 h = H2p[i * 128]; const float inv = 1.0f / (float)cnt;
                const f32x2 pv = S * inv - h;
                *(unsigned*)(P + (size_t)(t0 + rq * 16 + r) * D + g * 256 + 2 * cp) = cvtpk(pv[0], pv[1]);
            }
            __syncthreads();
        }
    }
}

__device__ __forceinline__ void moe_tables(Frame& F, int layer) {
    const int lane = lane_id(), tid = F.wave * 64 + lane; (void)tid;
    LAS int* ecnt = (LAS int*)(F.lds + TAB_ECNT); LAS int* tbase = (LAS int*)(F.lds + TAB_TBASE); LAS unsigned char* texp = (LAS unsigned char*)(F.lds + TAB_TEXP);
    if (tid < NE) ecnt[tid] = (int)__hip_atomic_load(F.ctl + CW_ECNT + layer * 2048 + tid * 64, RLX_AGENT);
    __syncthreads();
    if (tid == 0) { int a = 0; for (int e = 0; e < NE; ++e) { tbase[e] = a; a += (ecnt[e] + 255) >> 8; } tbase[NE] = a; }
    __syncthreads();
    if (tid < MT_MAX) { int e = 0; for (int q = 1; q < NE; ++q) if (tid >= tbase[q]) e = q; texp[tid] = (unsigned char)e; }
    __syncthreads();
}
template <bool H8>
__device__ __forceinline__ void phase_router(Frame& F, const float* src, const float* gain, bf16* dstH, int layer, int bidx, int nblk) {
    const int cl = layer;
    const int lane = lane_id(), tid = F.wave * 64 + lane;
    f32x4 gn[4];
#pragma unroll
    for (int j = 0; j < 4; ++j) gn[j] = *((const f32x4*)gain + lane + 64 * j);
    for (int tile = bidx; tile < M / 64; tile += nblk) {
        f32x4 v[8][4];
#pragma unroll
        for (int rr = 0; rr < 8; ++rr) {
            const int t = tile * 64 + F.wave * 8 + rr;
#pragma unroll
            for (int j = 0; j < 4; ++j) v[rr][j] = xs_ld4(src, (size_t)t * D + 4 * lane + 256 * j);
            {
                float ss = 0.f;
#pragma unroll
                for (int j = 0; j < 4; ++j) ss += (v[rr][j][0] * v[rr][j][0] + v[rr][j][1] * v[rr][j][1]) + (v[rr][j][2] * v[rr][j][2] + v[rr][j][3] * v[rr][j][3]);
                ss = wave_sum(ss); const float rstd = 1.0f / sqrtf(ss * (1.0f / D) + RMS_EPS);
                if constexpr (H8) { unsigned* ho = (unsigned*)((unsigned char*)dstH + (size_t)t * D) + lane;
#pragma unroll
                    for (int j = 0; j < 4; ++j) { v[rr][j] = v[rr][j] * rstd * gn[j]; ho[64 * j] = cvtfp8x4(v[rr][j][0] * S8_H, v[rr][j][1] * S8_H, v[rr][j][2] * S8_H, v[rr][j][3] * S8_H); } }
                else { u32x2* ho = (u32x2*)(dstH + (size_t)t * D) + lane;
#pragma unroll
                    for (int j = 0; j < 4; ++j) { v[rr][j] = v[rr][j] * rstd * gn[j]; u32x2 o; o.x = cvtpk(v[rr][j][0], v[rr][j][1]); o.y = cvtpk(v[rr][j][2], v[rr][j][3]); ho[64 * j] = o; } }
            }
        }
        {
            LAS float* HT = (LAS float*)F.lds;
            LAS float* WC = (LAS float*)(F.lds + 66560);
            LAS float* PART = (LAS float*)F.lds;
            LAS float* LG = (LAS float*)(F.lds + 66560);
            LAS int* lcnt = (LAS int*)(F.lds + 99328);
            LAS int* gbase = (LAS int*)(F.lds + 99328 + 128);
            const float* RW = FIN(9) + (size_t)layer * D * NE; const float* RB = FIN(10) + layer * NE;
            const int th = F.wave & 1, kq = F.wave >> 1, r32 = lane & 31, hi = lane >> 5;
            f32x16 acc = {};
            for (int j = 0; j < 4; ++j) {
                __syncthreads();
#pragma unroll
                for (int rr = 0; rr < 8; ++rr)
#pragma unroll
                    for (int i = 0; i < 4; ++i) HT[(4 * lane + i) * 65 + F.wave * 8 + rr] = v[rr][j][i];
                { const f32x4* wsrc = (const f32x4*)(RW + (size_t)j * 256 * NE); LAS f32x4* wdst = (LAS f32x4*)WC;
#pragma unroll
                    for (int q = 0; q < 4; ++q) wdst[tid + 512 * q] = wsrc[tid + 512 * q]; }
                __syncthreads();
                const LAS float* ap = HT + (kq * 64 + hi) * 65 + th * 32 + r32; const LAS float* bp = WC + (kq * 64 + hi) * 32 + r32;
#pragma unroll 8
                for (int s = 0; s < 32; ++s) acc = __builtin_amdgcn_mfma_f32_32x32x2f32(ap[s * 2 * 65], bp[s * 2 * 32], acc, 0, 0, 0);
            }
            __syncthreads();
#pragma unroll
            for (int r = 0; r < 16; ++r) { const int tok = th * 32 + (r & 3) + 8 * (r >> 2) + 4 * hi; PART[(kq * 64 + tok) * 33 + r32] = acc[r]; }
            if (tid < NE) lcnt[tid] = 0;
            __syncthreads();
            for (int q = tid; q < 64 * NE; q += 512) { const int tok = q >> 5, e = q & 31;
                LG[tok * 33 + e] = ((PART[tok * 33 + e] + PART[(64 + tok) * 33 + e]) + (PART[(128 + tok) * 33 + e] + PART[(192 + tok) * 33 + e])) + RB[e]; }
            __syncthreads();
            int te[4], lp[4]; float tw[4];
            if (F.wave == 0) {
                const int tok = lane; unsigned used = 0u; float tv[4];
#pragma unroll
                for (int k = 0; k < 4; ++k) { float best = -INFINITY; int bi = 0;
                    for (int e = 0; e < NE; ++e) { const float xv = LG[tok * 33 + e]; if (!((used >> e) & 1u) && xv > best) { best = xv; bi = e; } }
                    used |= 1u << bi; tv[k] = best; te[k] = bi; }
                float sum = 0.f;
#pragma unroll
                for (int k = 0; k < 4; ++k) { tw[k] = __expf(tv[k] - tv[0]); sum += tw[k]; }
                const float inv = 1.0f / sum;
#pragma unroll
                for (int k = 0; k < 4; ++k) { tw[k] *= inv; lp[k] = atomicAdd((int*)(lcnt + te[k]), 1); }
            }
            __syncthreads();
            if (tid < NE) { const int c = lcnt[tid]; gbase[tid] = c > 0 ? (int)__hip_atomic_fetch_add(F.ctl + CW_ECNT + cl * 2048 + tid * 64, (unsigned)c, RLX_AGENT) : 0; }
            __syncthreads();
            if (F.wave == 0) {
                const int t = tile * 64 + lane;
                int* list = (int*)(F.ws + WS_LIST); int* tope_w = (int*)(F.ws + WS_TOPE); int* topp_w = (int*)(F.ws + WS_TOPP); float* topw_w = (float*)(F.ws + WS_TOPW);
#pragma unroll
                for (int k = 0; k < 4; ++k) { const int pos = gbase[te[k]] + lp[k]; list[te[k] * M + pos] = t; tope_w[t * 4 + k] = te[k]; topp_w[t * 4 + k] = pos; topw_w[t * 4 + k] = tw[k]; }
            }
            __syncthreads();
        }
    }
}

template <bool NORM, bool O8, bool DSTF32  >
__device__ __forceinline__ void phase_combine(Frame& F, const float* src, float* dstX, const float* gain, bf16* dstH, int layer) {
    const int lane = lane_id();
    moe_tables(F, layer);
    const LAS int* tbase = (const LAS int*)(F.lds + TAB_TBASE);
    const int* tope = (const int*)(F.ws + WS_TOPE); const int* topp = (const int*)(F.ws + WS_TOPP); const float* topw = (const float*)(F.ws + WS_TOPW);
    const unsigned char* OUTS = F.ws + WS_OUTS;
    constexpr int ORB = O8 ? D : 2 * D;
    f32x4 gn[4];
    if (NORM) {
#pragma unroll
        for (int q = 0; q < 4; ++q) gn[q] = *(const f32x4*)(gain + 8 * lane + 512 * (q >> 1) + 4 * (q & 1)); }
    for (int tile = blockIdx.x; tile < M / 64; tile += F.G) {
        const int t0 = tile * 64 + F.wave * 8;
        int e_l = 0, p_l = 0; float w_l = 0.f;
        if (lane < 32) { e_l = tope[t0 * 4 + lane]; p_l = topp[t0 * 4 + lane]; w_l = topw[t0 * 4 + lane]; }
        const int slot_l = tbase[e_l] * 256 + p_l;
        if (O8) w_l *= (1.0f / S8_OUT);
#pragma unroll
        for (int b = 0; b < 2; ++b) {
            f32x4 x[4][4];
#pragma unroll
            for (int r = 0; r < 4; ++r) { const size_t ro = (size_t)(t0 + 4 * b + r) * D + 8 * lane; x[r][0] = xs_ld4(src, ro); x[r][1] = xs_ld4(src, ro + 4); x[r][2] = xs_ld4(src, ro + 512); x[r][3] = xs_ld4(src, ro + 516); }
            u32x4 o[4][4][O8 ? 1 : 2];
#pragma unroll
            for (int r = 0; r < 4; ++r)
#pragma unroll
                for (int k = 0; k < 4; ++k) { const int slot = __builtin_amdgcn_readlane(slot_l, (4 * b + r) * 4 + k); const unsigned char* ob = OUTS + (size_t)slot * ORB;
                    if constexpr (O8) { const u32x2 lo = *(const u32x2*)(ob + 8 * lane), hi = *(const u32x2*)(ob + 512 + 8 * lane); o[r][k][0] = (u32x4){lo.x, lo.y, hi.x, hi.y}; }
                    else { o[r][k][0] = *(const u32x4*)(ob + 16 * lane); o[r][k][1] = *(const u32x4*)(ob + 1024 + 16 * lane); } }
#pragma unroll
            for (int r = 0; r < 4; ++r) {
#pragma unroll
                for (int k = 0; k < 4; ++k) { const float wk = __uint_as_float((unsigned)__builtin_amdgcn_readlane((int)__float_as_uint(w_l), (4 * b + r) * 4 + k));
                    if constexpr (O8) {
#pragma unroll
                        for (int q = 0; q < 4; ++q) { const f32x2 a = __builtin_amdgcn_cvt_pk_f32_fp8((int)o[r][k][0][q], false), c = __builtin_amdgcn_cvt_pk_f32_fp8((int)o[r][k][0][q], true);
                            x[r][q] += (f32x4){a[0], a[1], c[0], c[1]} * wk; } }
                    else {
#pragma unroll
                        for (int j = 0; j < 2; ++j) { const u32x4 v = o[r][k][j];
                            x[r][2 * j] += (f32x4){bf_lo(v.x), bf_hi(v.x), bf_lo(v.y), bf_hi(v.y)} * wk; x[r][2 * j + 1] += (f32x4){bf_lo(v.z), bf_hi(v.z), bf_lo(v.w), bf_hi(v.w)} * wk; } } }
                const int t = t0 + 4 * b + r;
                if constexpr (DSTF32) { f32x4* xo = (f32x4*)(dstX + (size_t)t * D + 8 * lane); xo[0] = x[r][0]; xo[1] = x[r][1]; xo[128] = x[r][2]; xo[129] = x[r][3]; }
                else { const size_t ro = (size_t)t * D + 8 * lane; xs_st4(dstX, ro, x[r][0]); xs_st4(dstX, ro + 4, x[r][1]); xs_st4(dstX, ro + 512, x[r][2]); xs_st4(dstX, ro + 516, x[r][3]); }
                if (NORM) {
                    float ss = 0.f;
#pragma unroll
                    for (int q = 0; q < 4; ++q) ss += (x[r][q][0] * x[r][q][0] + x[r][q][1] * x[r][q][1]) + (x[r][q][2] * x[r][q][2] + x[r][q][3] * x[r][q][3]);
                    ss = wave_sum(ss); const float rstd = 1.0f / sqrtf(ss * (1.0f / D) + RMS_EPS);
#pragma unroll
                    for (int j = 0; j < 2; ++j) { const f32x4 a = x[r][2 * j] * rstd * gn[2 * j], c = x[r][2 * j + 1] * rstd * gn[2 * j + 1];
                        *(u32x4*)(dstH + (size_t)t * D + 8 * lane + 512 * j) = (u32x4){cvtpk(a[0], a[1]), cvtpk(a[2], a[3]), cvtpk(c[0], c[1]), cvtpk(c[2], c[3])}; }
                }
            }
        }
    }
}

template <bool FP8, bool OUT8>
__device__ __forceinline__ void phase_moe_up(Frame& F, int layer, int G = 0  ) {
    if (G == 0) G = F.G;
    const int lane = lane_id(), tid = F.wave * 64 + lane; (void)tid;
    moe_tables(F, layer);
    const LAS int* ecnt = (const LAS int*)(F.lds + TAB_ECNT); const LAS int* tbase = (const LAS int*)(F.lds + TAB_TBASE);
    const int rowb = FP8 ? D : 2 * D;
    ProbMoeUp S{(const char*)(F.ws + WS_H2), FP8 ? (const char*)(F.ws + WS_WGU8) + (size_t)(1 - layer) * 64 * MiB : (const char*)(F.ws + WS_WGU) + (size_t)layer * NE * 2048 * 1024 * 2, F.lds, rowb, rowb, __builtin_amdgcn_readfirstlane(tbase[NE]), G, (int)blockIdx.x, F.wave};
    {
        const int* list = (const int*)(F.ws + WS_LIST); LAS unsigned* rt = (LAS unsigned*)(F.lds + TAB_ROW);
        pg8::Unit u;
#pragma nounroll
        for (int ord = 0; ord < MAXU && S.next(ord, u); ++ord) {
            if (tid < 256) { const int p = (u.pm - tbase[u.e]) * 256 + tid; const int tok = (p < ecnt[u.e]) ? list[u.e * M + p] : 0; rt[ord * 256 + tid] = (unsigned)tok * (unsigned)rowb; }
        }
        __syncthreads();
    }
    EpiGateUp<OUT8> E{(bf16*)(F.ws + WS_ACT), FIN(12) + (size_t)layer * NE * 2048};
    pg8::gemm_phase<ProbMoeUp, EpiGateUp<OUT8>, FP8, E8_UP>(F.lds, S, E);
}
template <bool FP8, bool OUT8>
__device__ __forceinline__ void phase_moe_down(Frame& F, int layer, int G = 0) {
    if (G == 0) G = F.G;
    moe_tables(F, layer);
    const LAS int* tbase = (const LAS int*)(F.lds + TAB_TBASE);
    const int rowb = FP8 ? FF : 2 * FF;
    ProbMoeDown S{(const char*)(F.ws + WS_ACT), FP8 ? (const char*)(F.ws + WS_WDN8) + (size_t)(1 - layer) * 32 * MiB : (const char*)(F.ws + WS_WDN) + (size_t)layer * NE * 1024 * 1024 * 2, F.lds, rowb, rowb, __builtin_amdgcn_readfirstlane(tbase[NE]), G, (int)blockIdx.x, F.wave};
    EpiDown<OUT8> E{(bf16*)(F.ws + WS_OUTS), FIN(14) + (size_t)layer * NE * 1024};
    pg8::gemm_phase<ProbMoeDown, EpiDown<OUT8>, FP8, E8_DOWN>(F.lds, S, E);
}

__device__ __forceinline__ int crow(int r, int hi) { return (r & 3) + 8 * (r >> 2) + 4 * hi; }
typedef LAS const char* lds_cptr;
__device__ __forceinline__ s16x4 vtr(lds_cptr p) { return __builtin_bit_cast(s16x4, __builtin_amdgcn_ds_read_tr16_b64_v4i16((LAS v4i16_t*)p)); }
__device__ __forceinline__ void attn_pair(Frame& F, int bh, int qbA, int qbB) {
    const int lane = lane_id(), r32 = lane & 31, hi = lane >> 5, wid = F.wave, sub = wid >> 2, ws = wid & 3, tids = ws * 64 + lane;
    const bf16* Qh = (const bf16*)(F.ws + WS_Q) + (size_t)bh * SEQ * HD; const bf16* Kh = (const bf16*)(F.ws + WS_K) + (size_t)bh * SEQ * HD; const bf16* Vh = (const bf16*)(F.ws + WS_V) + (size_t)bh * SEQ * HD;
    const int q0 = (sub ? qbB : qbA) * 128, qw = q0 + 32 * ws, qpos = qw + r32, jd = qw >> 6, jtop = (q0 >> 6) + 1;
    LAS unsigned char* KB = F.lds + sub * 32768; LAS unsigned char* VB = KB + 16384; LAS unsigned char* OST = F.lds + 65536 + wid * 4096;
    const bf16* ksrc[2]; const bf16* vsrc[2];
#pragma unroll
    for (int i = 0; i < 2; ++i) { const int p = tids + 256 * i, wv = p >> 6, l = p & 63;
        ksrc[i] = Kh + (size_t)l * HD + wv * 8; vsrc[i] = Vh + (size_t)(16 * (wv & 3) + (l >> 2)) * HD + (wv >> 2) * 32 + (l & 3) * 8; }
    bf16x8 qr[4];
#pragma unroll
    for (int d0 = 0; d0 < 4; ++d0) qr[d0] = *(const bf16x8*)(Qh + (size_t)qpos * HD + d0 * 16 + hi * 8);
    f32x16 o0 = {}, o1 = {};
    float C = 0.f;
    int cur = 0;
    bool done = false;
    LAS int* flags = (LAS int*)(F.lds + 65536 + 32768);
    {
#pragma unroll
      for (int i = 0; i < 2; ++i) { const u32x4 kk = *(const u32x4*)(ksrc[i] + (size_t)jtop * 64 * HD), vv = *(const u32x4*)(vsrc[i] + (size_t)jtop * 64 * HD);
          *(LAS u32x4*)(KB + (tids + 256 * i) * 16) = kk; *(LAS u32x4*)(VB + (tids + 256 * i) * 16) = vv; } }
    u32x4 kA[2], vA[2], kB[2], vB[2];
    if (jtop > 0) {
#pragma unroll
        for (int i = 0; i < 2; ++i) { kA[i] = *(const u32x4*)(ksrc[i] + (size_t)(jtop - 1) * 64 * HD); vA[i] = *(const u32x4*)(vsrc[i] + (size_t)(jtop - 1) * 64 * HD); } }
    __syncthreads();
    bool brk = false;
#define ATT_STEP(KL, VL, KS, VS) do { const int j = jtop - st; \
        if (j > 1) { _Pragma("unroll") for (int i = 0; i < 2; ++i) { KL[i] = *(const u32x4*)(ksrc[i] + (size_t)(j - 2) * 64 * HD); VL[i] = *(const u32x4*)(vsrc[i] + (size_t)(j - 2) * 64 * HD); } } \
        att_compute(j); \
        if (j > 0) { _Pragma("unroll") for (int i = 0; i < 2; ++i) { *(LAS u32x4*)(KB + (cur ^ 1) * 8192 + (tids + 256 * i) * 16) = KS[i]; *(LAS u32x4*)(VB + (cur ^ 1) * 8192 + (tids + 256 * i) * 16) = VS[i]; } } \
        if (lane == 0) flags[(st & 1) * 8 + wid] = (done || j <= 0) ? 1 : 0; \
        __syncthreads(); \
        brk = __all(flags[(st & 1) * 8 + (lane & 7)] != 0); cur ^= 1; ++st; } while (0)
    auto att_compute = [&](const int j) __attribute__((always_inline)) {
        if (j >= 0 && j <= jd && !done) {
            const lds_cptr kb = (lds_cptr)(KB + cur * 8192) + hi * 1024 + r32 * 16;
            f32x16 p0 = {}, p1 = {};
#pragma unroll
            for (int d0 = 0; d0 < 4; ++d0) { const bf16x8 b0 = *(const LAS bf16x8*)(kb + d0 * 2048), b1 = *(const LAS bf16x8*)(kb + d0 * 2048 + 512);
                p0 = __builtin_amdgcn_mfma_f32_32x32x16_bf16(b0, qr[d0], p0, 0, 0, 0); p1 = __builtin_amdgcn_mfma_f32_32x32x16_bf16(b1, qr[d0], p1, 0, 0, 0); }
            float L0[16], L1[16];
#pragma unroll
            for (int r = 0; r < 16; ++r) { L0[r] = __builtin_amdgcn_logf(1.0f + __builtin_amdgcn_exp2f(p0[r])); L1[r] = __builtin_amdgcn_logf(1.0f + __builtin_amdgcn_exp2f(p1[r])); }
            if (j == jd) {
                const int kb0 = 64 * j + 4 * hi;
#pragma unroll
                for (int r = 0; r < 16; ++r) { const int kv = kb0 + (r & 3) + 8 * (r >> 2);
                    if (kv >= qpos) { L0[r] = 0.f; p0[r] = -INFINITY; } if (kv + 32 >= qpos) { L1[r] = 0.f; p1[r] = -INFINITY; } }
            }
            float tg[8];
#pragma unroll
            for (int g = 0; g < 4; ++g) {
                L0[4 * g + 2] += L0[4 * g + 3]; L0[4 * g + 1] += L0[4 * g + 2]; L0[4 * g] += L0[4 * g + 1]; tg[g] = L0[4 * g];
                L1[4 * g + 2] += L1[4 * g + 3]; L1[4 * g + 1] += L1[4 * g + 2]; L1[4 * g] += L1[4 * g + 1]; tg[4 + g] = L1[4 * g]; }
            float off[8]; float R = C;
#pragma unroll
            for (int g = 7; g >= 0; --g) {
                const auto rr = __builtin_amdgcn_permlane32_swap(__float_as_uint(tg[g]), __float_as_uint(tg[g]), false, false);
                const float tlo = __uint_as_float(rr[0]), thi = __uint_as_float(rr[1]);
                off[g] = R + (hi ? 0.f : thi);
                R += tlo + thi; }
            C = R;
#pragma unroll
            for (int g = 0; g < 4; ++g)
#pragma unroll
                for (int i = 0; i < 4; ++i) { p0[4 * g + i] = __builtin_amdgcn_exp2f(p0[4 * g + i] - (L0[4 * g + i] + off[g])); p1[4 * g + i] = __builtin_amdgcn_exp2f(p1[4 * g + i] - (L1[4 * g + i] + off[4 + g])); }
            u32x4 pw0, pw1, pw2, pw3;
            pw0 = (u32x4){cvtpk(p0[0], p0[1]), cvtpk(p0[2], p0[3]), cvtpk(p0[4], p0[5]), cvtpk(p0[6], p0[7])};
            pw1 = (u32x4){cvtpk(p0[8], p0[9]), cvtpk(p0[10], p0[11]), cvtpk(p0[12], p0[13]), cvtpk(p0[14], p0[15])};
            pw2 = (u32x4){cvtpk(p1[0], p1[1]), cvtpk(p1[2], p1[3]), cvtpk(p1[4], p1[5]), cvtpk(p1[6], p1[7])};
            pw3 = (u32x4){cvtpk(p1[8], p1[9]), cvtpk(p1[10], p1[11]), cvtpk(p1[12], p1[13]), cvtpk(p1[14], p1[15])};
            const lds_cptr vp = (lds_cptr)(VB + cur * 8192) + ((lane >> 4) & 1) * 32 + (lane & 3) * 8 + (4 * hi + ((lane & 15) >> 2)) * 64;
#define PVSTEP(OACC, D0, KS, PW) do { const s16x4 lo_ = vtr(vp + (D0) * 4096 + (KS) * 1024), hi_ = vtr(vp + (D0) * 4096 + (KS) * 1024 + 512); \
                const bf16x8 vf_ = (bf16x8){lo_[0], lo_[1], lo_[2], lo_[3], hi_[0], hi_[1], hi_[2], hi_[3]}; \
                OACC = __builtin_amdgcn_mfma_f32_32x32x16_bf16(__builtin_bit_cast(bf16x8, PW), vf_, OACC, 0, 0, 0); } while (0)
            PVSTEP(o0, 0, 0, pw0); PVSTEP(o1, 1, 0, pw0); PVSTEP(o0, 0, 1, pw1); PVSTEP(o1, 1, 1, pw1);
            PVSTEP(o0, 0, 2, pw2); PVSTEP(o1, 1, 2, pw2); PVSTEP(o0, 0, 3, pw3); PVSTEP(o1, 1, 3, pw3);
#undef PVSTEP
            done = __all(C > 150.0f);
        }
    };
    for (int st = 0; ; ) {
        ATT_STEP(kB, vB, kA, vA); if (brk) break;
        ATT_STEP(kA, vA, kB, vB); if (brk) break;
    }
#undef ATT_STEP
    { LAS bf16* stg = (LAS bf16*)OST;
#pragma unroll
      for (int r = 0; r < 16; ++r) { const int orow = crow(r, hi); stg[orow * 64 + r32] = (bf16)(cvtpk(o0[r], 0.f) & 0xffffu); stg[orow * 64 + 32 + r32] = (bf16)(cvtpk(o1[r], 0.f) & 0xffffu); }
      LDS_WAIT(); asm volatile("" ::: "memory");
      const int b = bh >> 4, h = bh & 15;
      bf16* Ow = (bf16*)(F.ws + WS_O) + ((size_t)b * SEQ + qw) * D + h * HD;
#pragma unroll
      for (int i = 0; i < 4; ++i) { const int row = i * 8 + (lane >> 3), ch = lane & 7; const u32x4 vv = *(const LAS u32x4*)(stg + row * 64 + ch * 8); *(u32x4*)(Ow + (size_t)row * D + ch * 8) = vv; } }
    __syncthreads();
}
__device__ __forceinline__ void phase_attn(Frame& F) {
    for (int v = blockIdx.x; v < BATCH * NH * 2; v += F.G) {
        const int bh = v >> 1, odd = v & 1;
        for (int i = 0; i < 4; ++i) { const int qa = 8 * odd + 2 * i; attn_pair(F, bh, qa, qa + 1); }
    }
}

__global__ void __launch_bounds__(NWAVES * 64, 2) fwd_kernel(Args args) {
    extern __shared__ __attribute__((aligned(16))) unsigned char lds[];
    Frame F;
    F.lds = (LAS unsigned char*)lds; F.MISC = (volatile LAS unsigned*)(F.lds + MISC_OFF);
    F.wave = __builtin_amdgcn_readfirstlane((int)threadIdx.x >> 6); F.G = gridDim.x;
    F.ws = args.ws; F.ctl = (gu32*)(args.ws + WS_CTL);
    for (int u = (int)threadIdx.x; u < (LDS_BYTES - LDSCTL_OFF) / 4; u += NWAVES * 64) ((LAS unsigned*)(F.lds + LDSCTL_OFF))[u] = 0u;
    __syncthreads();
    const XcdBarrier bar = xcd_barrier_post((unsigned*)(F.ctl + CW_BAR), F.MISC + 8, gridDim.x);
#define TP_PUT(i) do { if (threadIdx.x == 0) { const unsigned long long t_ = __builtin_amdgcn_s_memrealtime(); F.MISC[16 + 2 * (i)] = (unsigned)t_; F.MISC[17 + 2 * (i)] = (unsigned)(t_ >> 32); } } while (0)
#define SEAM(k) do { xcd_barrier(bar); if (MK_TPROBE == ((k) == 0 ? 3 : (k) + 1)) TP_PUT(0); if (MK_TPROBE == (k)) TP_PUT(1); } while (0)
    if (MK_TPROBE == 0) TP_PUT(0);
    float* X1 = (float*)(F.ws + WS_X1); float* X2 = (float*)(F.ws + WS_X2); float* X3 = (float*)(F.ws + WS_X3);

    const bool tuned = (F.G == 256);
    const int nfront = tuned ? NFRONT : F.G, cv3 = tuned ? CV3 : 0, cv9 = tuned ? CV9 : 0;
    {
        const int bx = (int)blockIdx.x;
        if (bx < nfront) {
            const XcdBarrier fbar = xcd_barrier_post((unsigned*)(F.ctl + CW_BAR2), F.MISC + 10, (unsigned)nfront);
            phase_convert(F, 0, CV_SMALL, bx, nfront); __syncthreads();
            phase_pooled(F, bx, nfront);
            xcd_barrier(fbar);
            { ProbPool S{(const char*)(F.ws + WS_POOLED), (const char*)(F.ws + WS_POOLW), 512, 512, nfront, bx, F.wave}; EpiPool E{FIN(0), X1, FIN(3)};
              pg8::gemm_phase<ProbPool, EpiPool>(F.lds, S, E); }
            xcd_barrier(fbar);
            phase_router<FP8_U0>(F, X1, FIN(8), (bf16*)(F.ws + WS_H2), 0, bx, nfront);
            if (nfront == F.G) phase_convert(F, CV_SMALL, CV_END, bx, F.G);
        } else {
            phase_convert(F, CV_SMALL, CV_END - cv9 - cv3, bx - nfront, F.G - nfront);
        }
    }
    SEAM(0);
    { const int bx = (int)blockIdx.x;
        if (cv3 > 0 && bx >= G3) phase_convert(F, CV_END - cv9 - cv3, CV_END - cv9, bx - G3, F.G - G3);
        else phase_moe_up<FP8_U0, FP8_D0>(F, 0, cv3 > 0 ? G3 : 0); }
    SEAM(3);
    phase_moe_down<FP8_D0, OUT8_L0>(F, 0);
    SEAM(4);
    phase_combine<true, OUT8_L0, false>(F, X1, X2, FIN(1) + D, (bf16*)(F.ws + WS_HQ), 0);
    SEAM(5);
    { ProbDense S{(const char*)(F.ws + WS_HQ), (const char*)(F.ws + WS_WQKV), 2 * D, 2 * D, 2 * D, M / 256, 12, F.G, (int)blockIdx.x, F.wave}; { const int l_ = lane_id(); if (F.wave == 0) { ((LAS float*)(F.lds + BIAS_OFF))[l_] = FIN(5)[l_]; ((LAS float*)(F.lds + BIAS_OFF))[64 + l_] = FIN(6)[l_]; } __syncthreads(); }
        EpiQKV E{(bf16*)(F.ws + WS_Q), (const LAS float*)(F.lds + BIAS_OFF)};
        pg8::gemm_phase<ProbDense, EpiQKV>(F.lds, S, E); }
    SEAM(6);
    phase_attn(F);
    SEAM(7);
    { ProbDense S{(const char*)(F.ws + WS_O), (const char*)(F.ws + WS_WO), 2 * D, 2 * D, 2 * D, M / 256, 4, F.G, (int)blockIdx.x, F.wave}; EpiRes E{X2, X3};
        pg8::gemm_phase<ProbDense, EpiRes>(F.lds, S, E); }
    SEAM(8);
    {
        const int bx = (int)blockIdx.x;
        if (cv9 == 0) phase_router<true>(F, X3, FIN(8) + D, (bf16*)(F.ws + WS_H2), 1, bx, F.G);
        else if (bx < NR9) phase_router<true>(F, X3, FIN(8) + D, (bf16*)(F.ws + WS_H2), 1, bx, NR9);
        else phase_convert(F, CV_END - cv9, CV_END, bx - NR9, F.G - NR9);
    }
    SEAM(9);
    phase_moe_up<true, true>(F, 1);
    SEAM(10);
    phase_moe_down<true, true>(F, 1);
    SEAM(11);
    phase_combine<false, true, true>(F, X3, FOUT, nullptr, nullptr, 1);
    if (MK_TPROBE >= 0) { if (MK_TPROBE == 12) TP_PUT(1);
        if (blockIdx.x == 0 && threadIdx.x == 0) { const unsigned long long tp0 = ((unsigned long long)F.MISC[17] << 32) | F.MISC[16], tp1 = ((unsigned long long)F.MISC[19] << 32) | F.MISC[18];
            const unsigned long long dt = (tp1 - tp0) * 4, ts = __builtin_amdgcn_s_memrealtime();
            while (__builtin_amdgcn_s_memrealtime() - ts < dt) __builtin_amdgcn_s_sleep(8); } }
#undef SEAM
}

extern "C" void kernel_launch(void* const* d_in, const int* in_sizes, int n_in, void* d_out, int out_size, void* d_ws, size_t ws_size, hipStream_t stream) {
    static int grid = 0;
    if (grid == 0) {
        if (n_in != 15 || in_sizes[0] != M * D || out_size != M * D || ws_size < WS_END) { fprintf(stderr, "kernel_launch: unexpected shapes (n_in %d, in0 %d, out %d, ws %zu, need %zu)\n", n_in, n_in > 0 ? in_sizes[0] : -1, out_size, ws_size, (size_t)WS_END); grid = -1; return; }
        int dev = 0, cus = 0, per_cu = 0;
        if (hipGetDevice(&dev) != hipSuccess || hipDeviceGetAttribute(&cus, hipDeviceAttributeMultiprocessorCount, dev) != hipSuccess) { grid = -1; return; }
        if (hipFuncSetAttribute((const void*)fwd_kernel, hipFuncAttributeMaxDynamicSharedMemorySize, LDS_BYTES) != hipSuccess) { fprintf(stderr, "kernel_launch: hipFuncSetAttribute failed\n"); grid = -1; return; }
        if (hipOccupancyMaxActiveBlocksPerMultiprocessor(&per_cu, (const void*)fwd_kernel, NWAVES * 64, LDS_BYTES) != hipSuccess || per_cu < 1) fprintf(stderr, "kernel_launch: occupancy query says %d\n", per_cu);
        (void)hipGetLastError();
        grid = cus;
    }
    if (grid < 0) return;
    (void)hipMemsetAsync((char*)d_ws + WS_CTL, 0, CTL_ZERO_BYTES, stream);
    Args a{};
    for (int i = 0; i < 15; ++i) a.in[i] = (const float*)d_in[i];
    a.out = (float*)d_out; a.ws = (unsigned char*)d_ws;
    hipLaunchKernelGGL(fwd_kernel, dim3(grid), dim3(NWAVES * 64), LDS_BYTES, stream, a);
    const hipError_t le = hipPeekAtLastError();
    if (le != hipSuccess) fprintf(stderr, "kernel_launch: launch failed: %s\n", hipGetErrorName(le));
}
```

```cpp
#include <hip/hip_runtime.h>
#include <cstdio>
#include <cstdint>

#define GAS __attribute__((address_space(1)))
#define LAS __attribute__((address_space(3)))
typedef unsigned short bf16;
typedef unsigned u32x4 __attribute__((ext_vector_type(4)));
typedef unsigned u32x2 __attribute__((ext_vector_type(2)));
typedef float f32x4 __attribute__((ext_vector_type(4)));
typedef float f32x2 __attribute__((ext_vector_type(2)));
typedef float f32x16 __attribute__((ext_vector_type(16)));
typedef short bf16x8 __attribute__((ext_vector_type(8)));
typedef short s16x4 __attribute__((ext_vector_type(4)));
typedef short v4i16_t __attribute__((ext_vector_type(4)));
typedef __bf16 bf16x2_t __attribute__((ext_vector_type(2)));
typedef int i32x8 __attribute__((ext_vector_type(8)));
typedef int i32x4 __attribute__((ext_vector_type(4)));
typedef GAS unsigned gu32;

constexpr int BATCH = 8, SEQ = 2048, D = 1024, M = BATCH * SEQ, NH = 16, HD = 64, NE = 32, TOPK = 4, FF = 1024;
#ifndef MK_QKV8
#define MK_QKV8 1
#endif
constexpr bool QKV8 = MK_QKV8 != 0;
constexpr float RMS_EPS = 1e-6f, SW_LIMIT = 7.0f, SW_ALPHA = 1.702f;
constexpr int MT_MAX = M * TOPK / 256 + NE;
constexpr int NSLOT = MT_MAX * 256;
constexpr float C2 = 0.125f * 1.4426950408889634f;
constexpr float S8_W = 64.0f, S8_H = 8.0f, S8_ACT = 4.0f, S8_OUT = 16.0f;
constexpr int E8_UP = 127 - 9, E8_DOWN = 127 - 8;

constexpr size_t MiB = 1u << 20;
constexpr size_t WS_CTL = 0, CTL_ZERO_BYTES = 128 * 1024;
constexpr size_t WS_POOLW = 1 * MiB;
constexpr size_t WS_WQKV = 2 * MiB;
constexpr size_t WS_WO = 8 * MiB;
constexpr size_t WS_TOPE = 10 * MiB, WS_TOPP = WS_TOPE + 256 * 1024, WS_TOPW = WS_TOPP + 256 * 1024;
constexpr size_t WS_LIST = 12 * MiB;
constexpr size_t WS_WGU = 16 * MiB;
constexpr size_t WS_WDN = 272 * MiB;
constexpr size_t WS_WGU8 = WS_WGU + 128 * MiB;
constexpr size_t WS_WDN8 = WS_WDN + 64 * MiB;
constexpr size_t WS_X1 = 400 * MiB, WS_X2 = 464 * MiB, WS_X3 = 528 * MiB;
constexpr size_t WS_POOLED = 592 * MiB, WS_H2 = 624 * MiB, WS_HQ = 656 * MiB, WS_Q = 688 * MiB, WS_K = 720 * MiB, WS_V = 752 * MiB, WS_O = 784 * MiB;
constexpr size_t WS_ACT = 816 * MiB, WS_OUTS = 960 * MiB;
constexpr size_t WS_END = 1104 * MiB;
static_assert(WS_ACT + (size_t)NSLOT * 1024 * 2 <= WS_OUTS && WS_OUTS + (size_t)NSLOT * 1024 * 2 <= WS_END, "ws map");
constexpr int CW_TMO = 0, CW_CODE = 1;
constexpr int CW_BAR = 4096;
constexpr int CW_BAR2 = 8192;
constexpr int CW_ECNT = 16384;

constexpr int RING_BYTES = 131072;
constexpr int LDSCTL_OFF = RING_BYTES, MISC_OFF = LDSCTL_OFF + 320;
constexpr int TAB_OFF = 131584;
constexpr int TAB_ECNT = TAB_OFF, TAB_TBASE = TAB_OFF + 128, TAB_TEXP = TAB_OFF + 384, TAB_ROW = TAB_OFF + 1024;
constexpr int MAXU = 12;
constexpr int BIAS_OFF = TAB_ROW + MAXU * 1024;
constexpr int LDS_BYTES = 163840;
static_assert(BIAS_OFF % 16 == 0 && BIAS_OFF + 2 * 8 * 1024 <= LDS_BYTES, "LDS map");

constexpr int NWAVES = 8;
#ifndef MK_NFRONT
#define MK_NFRONT 136
#endif
constexpr int NFRONT = MK_NFRONT;
#ifndef MK_CV9
#define MK_CV9 3560
#endif
#ifndef MK_NR9
#define MK_NR9 128
#endif
constexpr int CV9 = MK_CV9, NR9 = MK_NR9;
#ifndef MK_CV3
#define MK_CV3 1000
#endif
#ifndef MK_G4
#define MK_G4 240
#endif
#ifndef MK_G10
#define MK_G10 248
#endif
constexpr int CV3 = MK_CV3, G3 = 248, G4 = MK_G4, G10 = MK_G10;
#ifndef MK_H4
#define MK_H4 2560
#endif
#ifndef MK_H10
#define MK_H10 2048
#endif
#ifndef MK_G6
#define MK_G6 192
#endif
#ifndef MK_H6
#define MK_H6 3104
#endif
constexpr int H4 = MK_H4, H10 = MK_H10, G6 = MK_G6, H6 = MK_H6;
constexpr int CW_QUEUE = 12288;

#ifndef MK_TPROBE
#define MK_TPROBE -1
#endif
#ifndef MK_X16
#define MK_X16 1
#endif
constexpr bool X16 = MK_X16;
#ifndef MK_OUT8_L0
#define MK_OUT8_L0 1
#endif
constexpr bool OUT8_L0 = MK_OUT8_L0;
#ifndef MK_FP8_L0
#define MK_FP8_L0 3
#endif
constexpr bool FP8_U0 = (MK_FP8_L0 & 1) != 0, FP8_D0 = (MK_FP8_L0 & 2) != 0;

#define RLX_AGENT __ATOMIC_RELAXED, __HIP_MEMORY_SCOPE_AGENT
#define LDS_WAIT() asm volatile("s_waitcnt lgkmcnt(0)" ::: "memory")
#define VM_WAIT() asm volatile("s_waitcnt vmcnt(0)" ::: "memory")
__device__ __forceinline__ unsigned cvtpk(float lo, float hi) { f32x2 v = {lo, hi}; bf16x2_t b = __builtin_convertvector(v, bf16x2_t); return __builtin_bit_cast(unsigned, b); }
__device__ __forceinline__ unsigned cvtfp8x4(float a, float b, float c, float d) { int w = __builtin_amdgcn_cvt_pk_fp8_f32(a, b, 0, false); w = __builtin_amdgcn_cvt_pk_fp8_f32(c, d, w, true); return (unsigned)w; }
__device__ __forceinline__ f32x4 xs_ld4(const void* base, size_t off) {
    if constexpr (X16) { const u32x2 v = *(const u32x2*)((const bf16*)base + off); return (f32x4){__uint_as_float(v.x << 16), __uint_as_float(v.x & 0xffff0000u), __uint_as_float(v.y << 16), __uint_as_float(v.y & 0xffff0000u)}; }
    else return *(const f32x4*)((const float*)base + off);
}
__device__ __forceinline__ void xs_st4(void* base, size_t off, f32x4 v) {
    if constexpr (X16) { u32x2 w; w.x = cvtpk(v[0], v[1]); w.y = cvtpk(v[2], v[3]); *(u32x2*)((bf16*)base + off) = w; }
    else *(f32x4*)((float*)base + off) = v;
}
__device__ __forceinline__ float bf_lo(unsigned u) { return __uint_as_float(u << 16); }
__device__ __forceinline__ float bf_hi(unsigned u) { return __uint_as_float(u & 0xffff0000u); }
__device__ __forceinline__ int lane_id() { int r; asm volatile("v_mbcnt_lo_u32_b32 %0, -1, 0\n\tv_mbcnt_hi_u32_b32 %0, -1, %0" : "=v"(r)); return r; }
__device__ __forceinline__ float wave_sum(float v) {
#pragma unroll
    for (int o = 1; o < 64; o <<= 1) v += __shfl_xor(v, o);
    return v;
}

#define XB_TMO      128
#define XB_XCNT(j)  (256  + 64 * (j))
#define XB_XSUB(j)  (1280 + 64 * (j))
#define XB_XGEN(j)  (2304 + 64 * (j))
#define XB_TOP      3328
#define XB_TOPGEN   3392
#define XCD_BAR_WORDS 3456
#define XB_SPIN_CAP (1u << 18)
__device__ __forceinline__ unsigned xb_ld(unsigned* p)              { return __hip_atomic_load(p, __ATOMIC_RELAXED, __HIP_MEMORY_SCOPE_AGENT); }
__device__ __forceinline__ unsigned xb_add(unsigned* p, unsigned v) { return __hip_atomic_fetch_add(p, v, __ATOMIC_RELAXED, __HIP_MEMORY_SCOPE_AGENT); }
__device__ __forceinline__ unsigned xb_xcc_id() { return (unsigned)__builtin_amdgcn_s_getreg((3 << 11) | 20) & 0xFu; }
#define XB_SPIN(cond, bar) do { unsigned _sp = 0; while (cond) { __builtin_amdgcn_s_sleep(1); \
    if ((++_sp & 255u) == 0u) { if (xb_ld(&(bar)[XB_TMO])) break; if (_sp > XB_SPIN_CAP) { atomicAdd(&(bar)[XB_TMO], 1u); break; } } } } while (0)
struct XcdBarrier { unsigned* bar; unsigned x; volatile LAS unsigned* st; unsigned G; };
__device__ __forceinline__ XcdBarrier xcd_barrier_post(unsigned* bar, volatile LAS unsigned* st, unsigned G) {
    XcdBarrier b; b.bar = bar; b.x = xb_xcc_id(); b.st = st; b.G = G;
    if (threadIdx.x == 0) (void)xb_add(&bar[XB_XCNT(b.x)], 1u);
    return b;
}
__device__ __forceinline__ void xcd_barrier_complete(unsigned* bar, unsigned x, unsigned& nloc, unsigned& nx, const unsigned G) {
    unsigned sum, cnt, mine, sp = 0u;
    for (;;) {
        sum = 0u; cnt = 0u; mine = 0u;
#pragma unroll
        for (unsigned j = 0; j < 16; ++j) { const unsigned c = xb_ld(&bar[XB_XCNT(j)]); sum += c; cnt += (c > 0u) ? 1u : 0u; mine = (j == x) ? c : mine; }
        if (sum == G) break;
        __builtin_amdgcn_s_sleep(1);
        if ((++sp & 255u) == 0u) { if (xb_ld(&bar[XB_TMO])) break; if (sp > XB_SPIN_CAP) { atomicAdd(&bar[XB_TMO], 1u); break; } }
    }
    nloc = mine > 0u ? mine : 1u; nx = cnt > 0u ? cnt : 1u;
}
__device__ __forceinline__ void xcd_barrier(const XcdBarrier& b) {
    asm volatile("s_waitcnt vmcnt(0)" ::: "memory");
    __syncthreads();
    if (threadIdx.x == 0) {
        unsigned* bar = b.bar;
        __builtin_amdgcn_s_waitcnt(0);
        unsigned nloc = b.st[0], nx = b.st[1];
        if (nloc == 0u) { xcd_barrier_complete(bar, b.x, nloc, nx, b.G); b.st[0] = nloc; b.st[1] = nx; }
        const unsigned old = xb_add(&bar[XB_XSUB(b.x)], 1u);
        const unsigned gen = old / nloc;
        if (old + 1u == (gen + 1u) * nloc) {
            __builtin_amdgcn_fence(__ATOMIC_RELEASE, "agent");
            asm volatile("s_waitcnt vmcnt(0)" ::: "memory");
            const unsigned og = xb_add(&bar[XB_TOP], 1u);
            const unsigned tg = og / nx;
            if (og + 1u == (tg + 1u) * nx) xb_add(&bar[XB_TOPGEN], 1u);
            else XB_SPIN(xb_ld(&bar[XB_TOPGEN]) == tg, bar);
            __builtin_amdgcn_fence(__ATOMIC_ACQUIRE, "agent");
            xb_add(&bar[XB_XGEN(b.x)], 1u);
            asm volatile("s_waitcnt vmcnt(0)" ::: "memory");
        } else {
            XB_SPIN(xb_ld(&bar[XB_XGEN(b.x)]) == gen, bar);
            __builtin_amdgcn_fence(__ATOMIC_ACQUIRE, "agent");
            asm volatile("s_waitcnt vmcnt(0)" ::: "memory");
        }
    }
    __syncthreads();
}

namespace pg8 {
constexpr int BM = 256, BK = 64, HALF = 128, HTB = HALF * BK * 2, STAGE_BYTES = 8 * HTB, NXCD = 8, WGM = 8;
__host__ __device__ __forceinline__ int lds_byte(int r, int c) { const int st = (r >> 4) * 2 + (c >> 5), rr = r & 15, cc = c & 31, ob = rr * 64 + cc * 2; return st * 1024 + (ob ^ (((ob >> 9) & 1) << 5)); }
__host__ __device__ __forceinline__ void stage_rc(int b, int& R, int& C) { const int st = b / 1024, sb = b % 1024, swz = sb ^ (((sb >> 9) & 1) << 5); R = (st >> 1) * 16 + swz / 64; C = (st & 1) * 32 + (swz % 64) / 2; }
__host__ __device__ __forceinline__ int perm32(int rho) { const int n = rho >> 4, i = rho & 15; return 8 * (i >> 2) + 4 * n + (i & 3); }

struct Unit { int pm, pn, e; };
__device__ __forceinline__ void glds_sv(const char* base, unsigned voff, unsigned lds_dst) {
    unsigned keep;
    asm volatile("s_mov_b32 %0, m0\n\ts_mov_b32 m0, %3\n\ts_nop 0\n\tglobal_load_lds_dwordx4 %1, %2\n\ts_mov_b32 m0, %0" : "=&s"(keep) : "v"(voff), "s"(base), "s"(lds_dst) : "memory");
}
__device__ __forceinline__ const char* uni_ptr(const char* p) { const unsigned long long u = (unsigned long long)p; const unsigned lo = __builtin_amdgcn_readfirstlane((unsigned)u), hi = __builtin_amdgcn_readfirstlane((unsigned)(u >> 32)); return (const char*)(((unsigned long long)hi << 32) | lo); }
struct UD { const char* a; const char* b0; const char* b1; };

__device__ __forceinline__ bool order_next(int i, int G, int c, int nM, int nN, int& pm, int& pn) {
    const int L = i * G + c; const int nwg = nM * nN; if (L >= nwg) return false;
    int wgid = L; { const int q = nwg / NXCD, r = nwg % NXCD, xcd = wgid % NXCD, off = wgid / NXCD; wgid = (xcd < r ? xcd * (q + 1) : r * (q + 1) + (xcd - r) * q) + off; }
    const int nig = WGM * nN, gid = wgid / nig, fm = gid * WGM, gsz = (nM - fm) < WGM ? (nM - fm) : WGM;
    pm = fm + ((wgid % nig) % gsz); pn = (wgid % nig) / gsz; return true;
}

template <class Prob, class Epi, bool FP8 = false, int E8 = 127>
__device__ __forceinline__ void gemm_phase(LAS unsigned char* lds, const Prob& S, const Epi& E) {
    const int wid = S.wave, lane = lane_id(), tid = wid * 64 + lane, wr = wid >> 2, wc = wid & 3, fr = lane & 15, fq = lane >> 4;
    const int nt = S.Kb / 128;
    unsigned voffB[2];
#pragma unroll
    for (int i = 0; i < 2; ++i) { int R, C; stage_rc(tid * 16 + i * 8192, R, C); const int Rb = Epi::PERM ? ((R & ~31) + perm32(R & 31)) : R; voffB[i] = (unsigned)(Rb * S.ldb + C * 2); }
    const size_t kstep = (size_t)(BK * 2);
    const unsigned ldsb = (unsigned)__builtin_amdgcn_readfirstlane((int)(unsigned)(uintptr_t)lds + wid * 1024);
    const int aoff = lds_byte(wr * 64 + fr, fq * 8), boff = lds_byte(wc * 32 + fr, fq * 8);
#define PG8_SA(b, h) (((b) * 2 + (h)) * HTB)
#define PG8_SB(b, h) ((4 + (b) * 2 + (h)) * HTB)
#define PG8_STA(bufoff, gbase, va, h) do { _Pragma("unroll") for (int _i = 0; _i < 2; ++_i) glds_sv((const char*)(gbase), (va)[(h) * 2 + _i], ldsb + (unsigned)((bufoff) + _i * 8192)); } while (0)
#define PG8_STB(bufoff, gbase) do { _Pragma("unroll") for (int _i = 0; _i < 2; ++_i) glds_sv((const char*)(gbase), voffB[_i], ldsb + (unsigned)((bufoff) + _i * 8192)); } while (0)
#define PG8_LD8(p) __builtin_shufflevector(*(const LAS i32x4*)(p), *(const LAS i32x4*)((p) + 1024), 0, 1, 2, 3, 4, 5, 6, 7)
#define PG8_LDA(dst, b, h) do { _Pragma("unroll") for (int m = 0; m < 4; ++m) dst[m] = PG8_LD8(lds + PG8_SA(b, h) + aoff + m * 2048); } while (0)
#define PG8_LDB(dst, b, h) do { _Pragma("unroll") for (int n = 0; n < 2; ++n) dst[n] = PG8_LD8(lds + PG8_SB(b, h) + boff + n * 2048); } while (0)
#define PG8_HALF(x, k) __builtin_bit_cast(bf16x8, __builtin_shufflevector(x, x, 4 * (k), 4 * (k) + 1, 4 * (k) + 2, 4 * (k) + 3))
#define PG8_MMA(ai, bj, At, Bt) do { __builtin_amdgcn_s_setprio(1); _Pragma("unroll") for (int m = 0; m < 4; ++m) _Pragma("unroll") for (int n = 0; n < 2; ++n) { \
        if constexpr (FP8) acc[ai][bj][m][n] = __builtin_amdgcn_mfma_scale_f32_16x16x128_f8f6f4(Bt[n], At[m], acc[ai][bj][m][n], 0, 0, 0, E8, 0, E8 == 0 ? 0 : 127);   \
        else { acc[ai][bj][m][n] = __builtin_amdgcn_mfma_f32_16x16x32_bf16(PG8_HALF(Bt[n], 0), PG8_HALF(At[m], 0), acc[ai][bj][m][n], 0, 0, 0); \
               acc[ai][bj][m][n] = __builtin_amdgcn_mfma_f32_16x16x32_bf16(PG8_HALF(Bt[n], 1), PG8_HALF(At[m], 1), acc[ai][bj][m][n], 0, 0, 0); } } \
        __builtin_amdgcn_s_setprio(0); \
        if constexpr (FP8) asm volatile("" : "+v"(acc[ai][bj][0][0]), "+v"(acc[ai][bj][0][1]), "+v"(acc[ai][bj][1][0]), "+v"(acc[ai][bj][1][1]), "+v"(acc[ai][bj][2][0]), "+v"(acc[ai][bj][2][1]), "+v"(acc[ai][bj][3][0]), "+v"(acc[ai][bj][3][1])); \
        } while (0)
#define PG8_WAIT_V(n) asm volatile("s_waitcnt vmcnt(" #n ")" ::: "memory")
#define PG8_WAIT_SEAM(flag) asm volatile("s_cmp_lg_u32 %0, 0\n\ts_cbranch_scc1 1f\n\ts_waitcnt vmcnt(8)\n\ts_branch 2f\n1:\n\ts_waitcnt vmcnt(%1)\n2:" :: "s"(flag), "n"(RELAX) : "memory", "scc")
#define PG8_WAIT_L(n) asm volatile("s_waitcnt lgkmcnt(" #n ")" ::: "memory")
#define PG8_BAR __builtin_amdgcn_s_barrier()
#define PG8_SCHED __builtin_amdgcn_sched_barrier(0)
    Unit cur, nxt; UD cd, nd; unsigned cva[4]; int ui = 0;
    if (!S.next(0, cur)) return;
    S.desc(cur, cd); S.desc_va(0, cur, cva);
    constexpr int RELAX = 8 + Epi::NPRE + Epi::NST; static_assert(RELAX <= 63, "vmcnt is 6 bits");
    E.prefetch(cur, lds + BIAS_OFF + wid * 1024, lane);
    f32x4 acc[2][2][4][2];
    i32x8 At[4], B0[2], B1[2];
    PG8_STB(PG8_SB(0, 0), cd.b0); PG8_STB(PG8_SB(0, 1), cd.b1); PG8_STA(PG8_SA(0, 0), cd.a, cva, 0); PG8_STA(PG8_SA(0, 1), cd.a, cva, 1);
    if (wr == 1) PG8_BAR;
    PG8_WAIT_V(2); PG8_BAR;
    PG8_STB(PG8_SB(1, 0), cd.b0 + kstep); PG8_STA(PG8_SA(1, 0), cd.a + kstep, cva, 0); PG8_STB(PG8_SB(1, 1), cd.b1 + kstep); PG8_STA(PG8_SA(1, 1), cd.a + kstep, cva, 1);
    PG8_WAIT_V(8); PG8_BAR;
    E.init(acc, lds + BIAS_OFF + wid * 1024, wc);
    for (;;) {
        const bool has_next = S.next(ui + 1, nxt);
        if (has_next) S.desc(nxt, nd); else nd = cd;
#pragma clang loop unroll(disable)
        for (int t = 0; t < nt; t += 2) {
            const bool last = (t == nt - 2); const int seam = __builtin_amdgcn_readfirstlane((t == 0 && ui > 0) ? 1 : 0);
            const char* a2 = last ? nd.a : cd.a + (size_t)(t + 2) * kstep;
            const char* b20 = last ? nd.b0 : cd.b0 + (size_t)(t + 2) * kstep; const char* b21 = last ? nd.b1 : cd.b1 + (size_t)(t + 2) * kstep;
            const char* a3 = a2 + kstep; const char* b30 = b20 + kstep; const char* b31 = b21 + kstep;
            PG8_LDB(B0, 0, 0); PG8_LDB(B1, 0, 1); PG8_SCHED; PG8_LDA(At, 0, 0);
            PG8_WAIT_SEAM(seam);
            PG8_WAIT_L(0); PG8_BAR; PG8_MMA(0, 0, At, B0); PG8_MMA(0, 1, At, B1); PG8_BAR; PG8_SCHED;
            if (last && has_next) S.desc_va(ui + 1, nxt, cva);
            PG8_LDA(At, 0, 1); PG8_STB(PG8_SB(0, 0), b20); PG8_STB(PG8_SB(0, 1), b21); PG8_STA(PG8_SA(0, 0), a2, cva, 0);
            PG8_WAIT_SEAM(seam);
            PG8_WAIT_L(0); PG8_BAR; PG8_MMA(1, 0, At, B0); PG8_MMA(1, 1, At, B1); PG8_BAR; PG8_SCHED;
            PG8_LDB(B0, 1, 0); PG8_LDB(B1, 1, 1); PG8_SCHED; PG8_LDA(At, 1, 0); PG8_STA(PG8_SA(0, 1), a2, cva, 1);
            PG8_WAIT_SEAM(seam);
            PG8_WAIT_L(0); PG8_BAR; PG8_MMA(0, 0, At, B0); PG8_MMA(0, 1, At, B1); PG8_BAR; PG8_SCHED;
            PG8_LDA(At, 1, 1); PG8_STB(PG8_SB(1, 0), b30); PG8_STB(PG8_SB(1, 1), b31); PG8_STA(PG8_SA(1, 0), a3, cva, 0);
            PG8_WAIT_V(8); PG8_WAIT_L(0); PG8_BAR; PG8_MMA(1, 0, At, B0); PG8_MMA(1, 1, At, B1); PG8_BAR; PG8_SCHED;
            PG8_STA(PG8_SA(1, 1), a3, cva, 1);
        }
        if (has_next) E.prefetch(nxt, lds + BIAS_OFF + (((ui + 1) & 1) * 8 + wid) * 1024, lane);
        if (wr == 0) PG8_BAR;
        E(acc, cur, wr, wc, fr, fq, lds + BIAS_OFF + ((ui & 1) * 8 + wid) * 1024);
        if (!has_next) break;
        if constexpr (Epi::NPRE > 0) asm volatile("s_waitcnt vmcnt(%0)" :: "n"(Epi::NST) : "memory");
        E.init(acc, lds + BIAS_OFF + (((ui + 1) & 1) * 8 + wid) * 1024, wc);
        cur = nxt; cd = nd;
        ++ui;
        if (wr == 1) PG8_BAR;
    }
    PG8_WAIT_V(0);
    PG8_BAR;
#undef PG8_SA
#undef PG8_SB
#undef PG8_STA
#undef PG8_STB
#undef PG8_LDA
#undef PG8_LDB
#undef PG8_MMA
#undef PG8_LD8
#undef PG8_HALF
#undef PG8_WAIT_V
#undef PG8_WAIT_SEAM
#undef PG8_WAIT_L
#undef PG8_BAR
#undef PG8_SCHED
}
}

struct Frame {
    LAS unsigned char* lds;
    volatile LAS unsigned* MISC;
    gu32* ctl;
    int wave, G;
    unsigned char* ws;
};
struct Args { const float* in[15]; float* out; unsigned char* ws; };
#define KARG ((const __attribute__((address_space(4))) Args*)__builtin_amdgcn_kernarg_segment_ptr())
#define FIN(i) (KARG->in[i])
#define FOUT (KARG->out)

struct ProbDense {
    const char* A; const char* Bt; int lda, ldb, Kb, nM, nN, G, c, wave;
    __device__ __forceinline__ bool next(int i, pg8::Unit& u) const { u.e = 0; return pg8::order_next(i, G, c, nM, nN, u.pm, u.pn); }
    __device__ __forceinline__ void desc(const pg8::Unit& u, pg8::UD& d) const { d.a = pg8::uni_ptr(A + (size_t)u.pm * 256 * lda); d.b0 = pg8::uni_ptr(Bt + (size_t)u.pn * 256 * ldb); d.b1 = d.b0 + (size_t)128 * ldb; }
    __device__ __forceinline__ void desc_va(int, const pg8::Unit&, unsigned (&va)[4]) const {
#pragma unroll
        for (int i = 0; i < 2; ++i) { int R, C; pg8::stage_rc((wave * 64 + lane_id()) * 16 + i * 8192, R, C); va[i] = (unsigned)(R * lda + C * 2); va[2 + i] = va[i] + (unsigned)(128 * lda); }
    }
};
struct ProbPool {
    const char* A; const char* Bt; int ldb, Kb, G, c, wave;
    __device__ __forceinline__ bool next(int i, pg8::Unit& u) const { u.e = 0; return pg8::order_next(i, G, c, M / 256, 4, u.pm, u.pn); }
    __device__ __forceinline__ void desc(const pg8::Unit& u, pg8::UD& d) const { d.a = pg8::uni_ptr(A + (size_t)u.pm * 256 * D * 2 + (size_t)u.pn * 256 * 2); d.b0 = pg8::uni_ptr(Bt + (size_t)u.pn * 65536 * 2); d.b1 = d.b0 + (size_t)128 * 256 * 2; }
    __device__ __forceinline__ void desc_va(int, const pg8::Unit&, unsigned (&va)[4]) const {
#pragma unroll
        for (int i = 0; i < 2; ++i) { int R, C; pg8::stage_rc((wave * 64 + lane_id()) * 16 + i * 8192, R, C); va[i] = (unsigned)(R * D * 2 + C * 2); va[2 + i] = va[i] + (unsigned)(128 * D * 2); }
    }
};
struct ProbMoeUp {
    const char* A; const char* Bt; LAS unsigned char* lds; int ldb, Kb, nM, G, c, wave;
    __device__ __forceinline__ bool next(int i, pg8::Unit& u) const { if (!pg8::order_next(i, G, c, nM, 8, u.pm, u.pn)) return false; u.e = __builtin_amdgcn_readfirstlane((int)((const LAS unsigned char*)(lds + TAB_TEXP))[u.pm]); return true; }
    __device__ __forceinline__ void desc(const pg8::Unit& u, pg8::UD& d) const { d.a = pg8::uni_ptr(A); d.b0 = pg8::uni_ptr(Bt + ((size_t)u.e * 2048 + (size_t)u.pn * 256) * ldb); d.b1 = d.b0 + (size_t)128 * ldb; }
    __device__ __forceinline__ void desc_va(int ord, const pg8::Unit&, unsigned (&va)[4]) const {
        const LAS unsigned* rt = (const LAS unsigned*)(lds + TAB_ROW) + ord * 256;
#pragma unroll
        for (int i = 0; i < 2; ++i) { int R, C; pg8::stage_rc((wave * 64 + lane_id()) * 16 + i * 8192, R, C); va[i] = rt[R] + (unsigned)(C * 2); va[2 + i] = rt[128 + R] + (unsigned)(C * 2); }
    }
};
struct ProbMoeDown {
    const char* A; const char* Bt; LAS unsigned char* lds; int ldb, Kb, nM, G, c, wave;
    __device__ __forceinline__ bool next(int i, pg8::Unit& u) const { if (!pg8::order_next(i, G, c, nM, 4, u.pm, u.pn)) return false; u.e = __builtin_amdgcn_readfirstlane((int)((const LAS unsigned char*)(lds + TAB_TEXP))[u.pm]); return true; }
    __device__ __forceinline__ void desc(const pg8::Unit& u, pg8::UD& d) const { d.a = pg8::uni_ptr(A + (size_t)u.pm * 256 * ldb); d.b0 = pg8::uni_ptr(Bt + ((size_t)u.e * 1024 + (size_t)u.pn * 256) * ldb); d.b1 = d.b0 + (size_t)128 * ldb; }
    __device__ __forceinline__ void desc_va(int, const pg8::Unit&, unsigned (&va)[4]) const {
#pragma unroll
        for (int i = 0; i < 2; ++i) { int R, C; pg8::stage_rc((wave * 64 + lane_id()) * 16 + i * 8192, R, C); va[i] = (unsigned)(R * ldb + C * 2); va[2 + i] = va[i] + (unsigned)(128 * ldb); }
    }
};

struct EpiPool {
    static constexpr bool PERM = false; static constexpr int NST = 32, NPRE = 0;
    const float* x; float* X1; const float* scale;
    __device__ __forceinline__ void prefetch(const pg8::Unit&, LAS unsigned char*, int) const {}
    __device__ __forceinline__ void init(f32x4 (&acc)[2][2][4][2], LAS unsigned char*, int) const {
#pragma unroll
        for (int a = 0; a < 2; ++a)
#pragma unroll
            for (int b = 0; b < 2; ++b)
#pragma unroll
                for (int m = 0; m < 4; ++m)
#pragma unroll
                    for (int n = 0; n < 2; ++n) acc[a][b][m][n] = (f32x4){0.f, 0.f, 0.f, 0.f}; }

    __device__ __forceinline__ void operator()(const f32x4 (&acc)[2][2][4][2], const pg8::Unit& u, int wr, int wc, int fr, int fq, LAS unsigned char* bl) const {
        const int row0 = u.pm * 256 + wr * 64 + fr, col0 = u.pn * 256 + wc * 32 + 4 * fq;
        f32x4 sv[2][2];
#pragma unroll
        for (int bj = 0; bj < 2; ++bj)
#pragma unroll
            for (int n = 0; n < 2; ++n) sv[bj][n] = *(const f32x4*)(scale + col0 + bj * 128 + n * 16);
#pragma unroll
        for (int ai = 0; ai < 2; ++ai)
#pragma unroll
            for (int m = 0; m < 4; ++m) { const size_t off = (size_t)(row0 + ai * 128 + m * 16) * D + col0;
#pragma unroll
                for (int bj = 0; bj < 2; ++bj)
#pragma unroll
                    for (int n = 0; n < 2; ++n) { const f32x4 xv = *(const f32x4*)(x + off + bj * 128 + n * 16); xs_st4(X1, off + bj * 128 + n * 16, xv + acc[ai][bj][m][n] * sv[bj][n]); }
                if (m & 1) asm volatile("" ::: "memory"); }
    }
};
struct EpiRes {
    static constexpr bool PERM = false; static constexpr int NST = 32, NPRE = 0;
    const float* Xi; float* Xo;
    __device__ __forceinline__ void prefetch(const pg8::Unit&, LAS unsigned char*, int) const {}
    __device__ __forceinline__ void init(f32x4 (&acc)[2][2][4][2], LAS unsigned char*, int) const {
#pragma unroll
        for (int a = 0; a < 2; ++a)
#pragma unroll
            for (int b = 0; b < 2; ++b)
#pragma unroll
                for (int m = 0; m < 4; ++m)
#pragma unroll
                    for (int n = 0; n < 2; ++n) acc[a][b][m][n] = (f32x4){0.f, 0.f, 0.f, 0.f}; }

    __device__ __forceinline__ void operator()(const f32x4 (&acc)[2][2][4][2], const pg8::Unit& u, int wr, int wc, int fr, int fq, LAS unsigned char* bl) const {
        const int row0 = u.pm * 256 + wr * 64 + fr, col0 = u.pn * 256 + wc * 32 + 4 * fq;
#pragma unroll
        for (int ai = 0; ai < 2; ++ai)
#pragma unroll
            for (int m = 0; m < 4; ++m) { const size_t off = (size_t)(row0 + ai * 128 + m * 16) * D + col0;
#pragma unroll
                for (int bj = 0; bj < 2; ++bj)
#pragma unroll
                    for (int n = 0; n < 2; ++n) { const f32x4 xv = xs_ld4(Xi, off + bj * 128 + n * 16); xs_st4(Xo, off + bj * 128 + n * 16, xv + acc[ai][bj][m][n]); }
                if (m & 1) asm volatile("" ::: "memory"); }
    }
};
template <int LASC = 0  > struct EpiQKV {
    static constexpr bool PERM = true; static constexpr int NST = 16, NPRE = 0;
    bf16* QKV; const LAS float* gl;
    __device__ __forceinline__ void prefetch(const pg8::Unit&, LAS unsigned char*, int) const {}
    __device__ __forceinline__ void init(f32x4 (&acc)[2][2][4][2], LAS unsigned char*, int) const {
#pragma unroll
        for (int a = 0; a < 2; ++a)
#pragma unroll
            for (int b = 0; b < 2; ++b)
#pragma unroll
                for (int m = 0; m < 4; ++m)
#pragma unroll
                    for (int n = 0; n < 2; ++n) acc[a][b][m][n] = (f32x4){0.f, 0.f, 0.f, 0.f}; }

    __device__ __forceinline__ void operator()(const f32x4 (&acc)[2][2][4][2], const pg8::Unit& u, int wr, int wc, int fr, int fq, LAS unsigned char* bl) const {
        const int seg = u.pn >> 2, head = (u.pn & 3) * 4 + wc;
        f32x4 gv[2][2];
#pragma unroll
        for (int bj = 0; bj < 2; ++bj)
#pragma unroll
            for (int n = 0; n < 2; ++n) {
                if (seg == 2) gv[bj][n] = (f32x4){1.f, 1.f, 1.f, 1.f} * (1.0f / (float)(1 << LASC));
                else { const LAS float* g = gl + seg * 64 + bj * 32 + 8 * fq + 4 * n; gv[bj][n] = *(const LAS f32x4*)g; if (seg == 0) gv[bj][n] = gv[bj][n] * C2; } }
        bf16* base = QKV + (size_t)seg * M * D;
#pragma unroll
        for (int ai = 0; ai < 2; ++ai)
#pragma unroll
            for (int m = 0; m < 4; ++m) {
                const int t = u.pm * 256 + ai * 128 + wr * 64 + m * 16 + fr, b = t >> 11, s = t & (SEQ - 1);
                float rstd = 1.f;
                if (seg < 2) { float ss = 0.f;
#pragma unroll
                    for (int bj = 0; bj < 2; ++bj)
#pragma unroll
                        for (int n = 0; n < 2; ++n) { const f32x4 v = acc[ai][bj][m][n]; ss += (v[0] * v[0] + v[1] * v[1]) + (v[2] * v[2] + v[3] * v[3]); }
                    ss += __shfl_xor(ss, 16); ss += __shfl_xor(ss, 32);
                    rstd = 1.0f / sqrtf(ss * (1.0f / 64.0f) + RMS_EPS * (float)(1 << LASC) * (float)(1 << LASC)); }
                bf16* rowp = base + ((size_t)(b * NH + head) * SEQ + s) * HD + 8 * fq;
#pragma unroll
                for (int bj = 0; bj < 2; ++bj) { const f32x4 v0 = acc[ai][bj][m][0] * rstd * gv[bj][0], v1 = acc[ai][bj][m][1] * rstd * gv[bj][1];
                    u32x4 w; w.x = cvtpk(v0[0], v0[1]); w.y = cvtpk(v0[2], v0[3]); w.z = cvtpk(v1[0], v1[1]); w.w = cvtpk(v1[2], v1[3]);
                    *(u32x4*)(rowp + bj * 32) = w; }
            }
    }
};
template <bool OUT8, int LASC = 0  > struct EpiGateUp {
    static constexpr bool PERM = true; static constexpr int NST = 8, NPRE = 1;
    bf16* ACT; const float* bias;
    __device__ __forceinline__ void prefetch(const pg8::Unit& u, LAS unsigned char* bl, int lane) const {
        pg8::glds_sv(pg8::uni_ptr((const char*)(bias + (size_t)u.e * 2048 + u.pn * 128)), (unsigned)((lane & 31) * 16 + (lane >> 5) * 4096), (unsigned)__builtin_amdgcn_readfirstlane((int)(unsigned)(uintptr_t)bl)); }
    __device__ __forceinline__ void init(f32x4 (&acc)[2][2][4][2], LAS unsigned char* bl, int wc) const {
        const int fq = lane_id() >> 4; const LAS float* bg = (const LAS float*)bl + wc * 32 + 8 * fq;
#pragma unroll
        for (int bj = 0; bj < 2; ++bj)
#pragma unroll
            for (int n = 0; n < 2; ++n) { const f32x4 b = (*(const LAS f32x4*)(bg + bj * 128 + 4 * n) + (bj ? 1.0f : 0.0f)) * (float)(1 << LASC);
#pragma unroll
                for (int ai = 0; ai < 2; ++ai)
#pragma unroll
                    for (int m = 0; m < 4; ++m) acc[ai][bj][m][n] = b; } }
    __device__ __forceinline__ void operator()(const f32x4 (&acc)[2][2][4][2], const pg8::Unit& u, int wr, int wc, int fr, int fq, LAS unsigned char* bl) const {
        { const int le = lane_id(); fr = le & 15; fq = le >> 4; }
        const int lc = u.pn * 128 + wc * 32 + 8 * fq;
#pragma unroll
        for (int ai = 0; ai < 2; ++ai)
#pragma unroll
            for (int m = 0; m < 4; ++m) {
                const size_t eoff = (size_t)(u.pm * 256 + ai * 128 + wr * 64 + m * 16 + fr) * FF + lc;
                float o[8];
                constexpr float ASC = (float)(1 << LASC), OS = OUT8 ? S8_ACT : 1.0f, IOS = ASC * ASC / OS;
#pragma unroll
                for (int n = 0; n < 2; ++n) { const f32x4 g4 = acc[ai][0][m][n], u4 = acc[ai][1][m][n];
#pragma unroll
                    for (int i = 0; i < 4; ++i) { const float g = fminf(g4[i], SW_LIMIT * ASC), up1 = __builtin_amdgcn_fmed3f(u4[i], (1.0f - SW_LIMIT) * ASC, (1.0f + SW_LIMIT) * ASC);
                        const float sg = __builtin_amdgcn_rcpf(__builtin_fmaf(__builtin_amdgcn_exp2f(g * (-SW_ALPHA * 1.4426950408889634f / ASC)), IOS, IOS));
                        o[n * 4 + i] = up1 * (g * sg); } }
                if constexpr (OUT8) { u32x2 w; w.x = cvtfp8x4(o[0], o[1], o[2], o[3]); w.y = cvtfp8x4(o[4], o[5], o[6], o[7]);
                    *(u32x2*)((unsigned char*)ACT + eoff) = w; }
                else { u32x4 w; w.x = cvtpk(o[0], o[1]); w.y = cvtpk(o[2], o[3]); w.z = cvtpk(o[4], o[5]); w.w = cvtpk(o[6], o[7]);
                    *(u32x4*)(ACT + eoff) = w; }
            }
    }
};
template <bool OUT8, bool PRE = false  > struct EpiDown {
    static constexpr bool PERM = true; static constexpr int NST = 16, NPRE = 1;
    bf16* OUTS; const float* bias;
    __device__ __forceinline__ void prefetch(const pg8::Unit& u, LAS unsigned char* bl, int lane) const {
        pg8::glds_sv(pg8::uni_ptr((const char*)(bias + (size_t)u.e * 1024 + u.pn * 256)), (unsigned)(lane * 16), (unsigned)__builtin_amdgcn_readfirstlane((int)(unsigned)(uintptr_t)bl)); }
    __device__ __forceinline__ void init(f32x4 (&acc)[2][2][4][2], LAS unsigned char* bl, int wc) const {
        const int fq = lane_id() >> 4; const LAS float* bd = (const LAS float*)bl + wc * 32 + 8 * fq;
#pragma unroll
        for (int bj = 0; bj < 2; ++bj)
#pragma unroll
            for (int n = 0; n < 2; ++n) { const f32x4 b = *(const LAS f32x4*)(bd + bj * 128 + 4 * n) * (PRE ? S8_OUT : 1.0f);
#pragma unroll
                for (int ai = 0; ai < 2; ++ai)
#pragma unroll
                    for (int m = 0; m < 4; ++m) acc[ai][bj][m][n] = b; } }
    __device__ __forceinline__ void operator()(const f32x4 (&acc)[2][2][4][2], const pg8::Unit& u, int wr, int wc, int fr, int fq, LAS unsigned char* bl) const {
        const int col0 = u.pn * 256 + wc * 32 + 8 * fq;
#pragma unroll
        for (int ai = 0; ai < 2; ++ai)
#pragma unroll
            for (int m = 0; m < 4; ++m) { bf16* rowp = OUTS + (size_t)(u.pm * 256 + ai * 128 + wr * 64 + m * 16 + fr) * D + col0;
#pragma unroll
                for (int bj = 0; bj < 2; ++bj) { const f32x4 v0 = acc[ai][bj][m][0], v1 = acc[ai][bj][m][1];
                    if constexpr (OUT8) { u32x2 w;
#define O8C(x) __builtin_amdgcn_fmed3f(PRE ? (x) : (x) * S8_OUT, -448.0f, 448.0f)
                        w.x = cvtfp8x4(O8C(v0[0]), O8C(v0[1]), O8C(v0[2]), O8C(v0[3])); w.y = cvtfp8x4(O8C(v1[0]), O8C(v1[1]), O8C(v1[2]), O8C(v1[3]));
#undef O8C
                        *(u32x2*)((unsigned char*)OUTS + (size_t)(u.pm * 256 + ai * 128 + wr * 64 + m * 16 + fr) * D + col0 + bj * 128) = w; }
                    else { u32x4 w; w.x = cvtpk(v0[0], v0[1]); w.y = cvtpk(v0[2], v0[3]); w.z = cvtpk(v1[0], v1[1]); w.w = cvtpk(v1[2], v1[3]);
                        *(u32x4*)(rowp + bj * 128) = w; } } }
    }
};

constexpr int CV_POOL = 4 * 2 * 4, CV_QKV = 8 * 48, CV_WO = 8 * 16, CV_GU1 = 32 * 8 * 32  , CV_DN1 = 32 * 8 * 16  ;
constexpr int CV_SMALL = CV_POOL + CV_QKV + CV_WO, CV_END = CV_SMALL + 2 * (CV_GU1 + CV_DN1);
static_assert(H6 % 8 == 0 && H4 % 8 == 0 && H10 % 8 == 0 && CV3 % 8 == 0 && CV9 % 8 == 0 && CV_SMALL % 8 == 0 && CV_END % 8 == 0 && H10 <= CV_DN1 && CV_END - H10 - CV9 - H6 - H4 - CV3 >= CV_SMALL + CV_GU1 + CV_DN1, "hosted item ranges: chunks of 8; phase 10 may only host layer-1 down items; the front must cover layer 0");
struct CvtItem { const float* src; unsigned char* dst; int N, dpitch, fp8, hs; };
__device__ __forceinline__ CvtItem cvt_decode(Frame& F, int it) {
    CvtItem c; int r = it; c.fp8 = 0; c.hs = 32;
    if (r < CV_POOL) { const int g = r >> 3, q = r & 7, kb = q >> 2, nb = q & 3; c.N = 256; c.dpitch = 512;
        c.src = FIN(2) + (size_t)g * 65536 + (size_t)(kb * 128) * 256 + nb * 64; c.dst = F.ws + WS_POOLW + ((size_t)g * 65536 + (size_t)(nb * 64) * 256 + kb * 128) * 2; return c; }
    r -= CV_POOL;
    if (r < CV_QKV) { const int kb = r / 48, nb = r % 48, n0 = nb * 64, pn = n0 >> 8, w = (n0 & 255) >> 6; c.N = 3 * D; c.dpitch = QKV8 ? D : 2 * D; c.hs = 128; c.fp8 = QKV8;
        c.src = FIN(4) + (size_t)(kb * 128) * (3 * D) + n0; c.dst = F.ws + WS_WQKV + ((size_t)(256 * pn + 32 * w) * D + kb * 128) * (QKV8 ? 1 : 2); return c; }
    r -= CV_QKV;
    if (r < CV_WO) { const int kb = r >> 4, nb = r & 15; c.N = D; c.dpitch = 2 * D;
        c.src = FIN(7) + (size_t)(kb * 128) * D + nb * 64; c.dst = F.ws + WS_WO + ((size_t)(nb * 64) * D + kb * 128) * 2; return c; }
    r -= CV_WO;
    int layer = 0;
    if (r >= CV_GU1 + CV_DN1) { r -= CV_GU1 + CV_DN1; layer = 1; }
    if (r < CV_GU1) { const int mat = layer * NE + (r >> 8), q = r & 255, kb = q >> 5, nb = q & 31; c.N = 2 * FF; c.fp8 = (layer == 1 || FP8_U0); c.dpitch = c.fp8 ? D : 2 * D;
        c.src = FIN(11) + (size_t)mat * D * 2 * FF + (size_t)(kb * 128) * (2 * FF) + nb * 64;
        const int n0 = nb * 64, cg = n0 & (FF - 1), drow = (cg >> 7) * 256 + (n0 >= FF ? 128 : 0) + (cg & 127);
        c.dst = c.fp8 ? F.ws + WS_WGU8 + (size_t)(1 - layer) * 64 * MiB + (size_t)(mat - layer * NE) * 2 * FF * D + (size_t)drow * D + kb * 128 : F.ws + WS_WGU + ((size_t)mat * 2 * FF * D + (size_t)drow * D + kb * 128) * 2; return c; }
    r -= CV_GU1;
    { const int mat = layer * NE + (r >> 7), q = r & 127, kb = q >> 4, nb = q & 15; c.N = D; c.fp8 = (layer == 1 || FP8_D0); c.dpitch = c.fp8 ? FF : 2 * FF;
        c.src = FIN(13) + (size_t)mat * FF * D + (size_t)(kb * 128) * D + nb * 64;
        c.dst = c.fp8 ? F.ws + WS_WDN8 + (size_t)(1 - layer) * 32 * MiB + (size_t)(mat - layer * NE) * D * FF + (size_t)(nb * 64) * FF + kb * 128 : F.ws + WS_WDN + ((size_t)mat * D * FF + (size_t)(nb * 64) * FF + kb * 128) * 2; return c; }
}
__device__ __forceinline__ void cvt_load(const CvtItem& c, int half, f32x4 (&v)[16], int lane) {
    const float* p = c.src + (size_t)(64 * half + (lane >> 4)) * c.N + 4 * (lane & 15);
#pragma unroll
    for (int i = 0; i < 16; ++i) v[i] = __builtin_nontemporal_load((const f32x4*)(p + (size_t)(4 * i) * c.N));
}
__device__ __forceinline__ s16x4 cvt_tr(LAS const unsigned char* p) { return __builtin_bit_cast(s16x4, __builtin_amdgcn_ds_read_tr16_b64_v4i16((LAS v4i16_t*)p)); }
constexpr int CVP = 136;
__device__ __forceinline__ void cvt_to_lds(const f32x4 (&v)[16], int half, LAS unsigned char* scr, int lane) {
    LAS unsigned char* wp = scr + (64 * half + (lane >> 4)) * CVP + (lane & 15) * 8;
#pragma unroll
    for (int i = 0; i < 16; ++i) { u32x2 w; w.x = cvtpk(v[i][0], v[i][1]); w.y = cvtpk(v[i][2], v[i][3]); *(LAS u32x2*)(wp + 4 * i * CVP) = w; }
}
__device__ __forceinline__ void cvt_emit(const CvtItem& c, LAS unsigned char* scr, int lane) {
    LDS_WAIT(); asm volatile("" ::: "memory");
    const int g = lane >> 4, i16 = lane & 15, r = i16 >> 2, cc = i16 & 3;
    if (c.fp8) {
#pragma unroll
        for (int nb = 0; nb < 4; ++nb)
#pragma unroll
            for (int ps = 0; ps < 2; ++ps) { const int kc = 4 * ps + g; LAS const unsigned char* rp = scr + (16 * kc + r) * CVP + cc * 8 + nb * 32;
                u32x4 o;
#pragma unroll
                for (int h = 0; h < 4; ++h) { const u32x2 t = __builtin_bit_cast(u32x2, cvt_tr(rp + (4 * h) * CVP));
                    const unsigned a = t.x + 0x03000300u, b = t.y + 0x03000300u;
                    o[h] = cvtfp8x4(__uint_as_float(a << 16), __uint_as_float(a & 0xffff0000u), __uint_as_float(b << 16), __uint_as_float(b & 0xffff0000u)); }
                const int n = 16 * nb + i16;
                *(u32x4*)(c.dst + (size_t)((n >> 5) * c.hs + (n & 31)) * c.dpitch + 16 * kc) = o; }
    } else {
#pragma unroll
        for (int nb = 0; nb < 4; ++nb)
#pragma unroll
            for (int ps = 0; ps < 4; ++ps) { const int kc = 4 * ps + g; LAS const unsigned char* rp = scr + (8 * kc + r) * CVP + cc * 8 + nb * 32;
                const u32x2 t0 = __builtin_bit_cast(u32x2, cvt_tr(rp)), t1 = __builtin_bit_cast(u32x2, cvt_tr(rp + 4 * CVP));
                const int n = 16 * nb + i16;
                *(u32x4*)(c.dst + (size_t)((n >> 5) * c.hs + (n & 31)) * c.dpitch + 16 * kc) = (u32x4){t0.x, t0.y, t1.x, t1.y}; }
    }
    LDS_WAIT(); asm volatile("" ::: "memory");
}
__device__ __forceinline__ void phase_convert(Frame& F, int item_lo, int item_hi, int bidx, int nblk) {
    const int lane = lane_id();
    LAS unsigned char* scr = F.lds + (F.wave < 7 ? F.wave * 17408 : 133120);
    const int gw = bidx * NWAVES + F.wave, NGW = nblk * NWAVES;
    int it = item_lo + gw; if (it >= item_hi) return;
    CvtItem c = cvt_decode(F, it); f32x4 va[16], vb[16]; cvt_load(c, 0, va, lane); cvt_load(c, 1, vb, lane);
    for (;;) {
        cvt_to_lds(va, 0, scr, lane); cvt_to_lds(vb, 1, scr, lane);
        const int itn = it + NGW; const bool more = itn < item_hi;
        CvtItem cn = c;
        if (more) { cn = cvt_decode(F, itn); cvt_load(cn, 0, va, lane); cvt_load(cn, 1, vb, lane); }
        cvt_emit(c, scr, lane);
        if (!more) break;
        c = cn; it = itn;
    }
}
__device__ __forceinline__ void convert_queue(Frame& F, int item_lo, int item_hi, gu32* ctr) {
    const int lane = lane_id();
    LAS unsigned char* scr = F.lds + (F.wave < 7 ? F.wave * 17408 : 133120);
    volatile LAS unsigned* slot = F.MISC + 12;
    const bool t0 = (threadIdx.x == 0);
    __syncthreads();
    if (t0) slot[0] = xb_add((unsigned*)ctr, 1u);
    __syncthreads();
    int base = item_lo + 8 * (int)slot[0]; if (base >= item_hi) return;
    unsigned nxt = 0; if (t0) nxt = xb_add((unsigned*)ctr, 1u);
    CvtItem c = cvt_decode(F, base + F.wave); f32x4 va[16], vb[16]; cvt_load(c, 0, va, lane); cvt_load(c, 1, vb, lane);
    for (int k = 1;; ++k) {
        cvt_to_lds(va, 0, scr, lane); cvt_to_lds(vb, 1, scr, lane);
        if (t0) slot[k & 1] = nxt;
        __syncthreads();
        base = item_lo + 8 * (int)slot[k & 1]; const bool more = base < item_hi;
        CvtItem cn = c;
        if (more) { if (t0) nxt = xb_add((unsigned*)ctr, 1u); cn = cvt_decode(F, base + F.wave); cvt_load(cn, 0, va, lane); cvt_load(cn, 1, vb, lane); }
        cvt_emit(c, scr, lane);
        if (!more) break;
        c = cn;
    }
}
__device__ __forceinline__ float dpp_sum64(float v) {
    v += __builtin_bit_cast(float, __builtin_amdgcn_update_dpp(0, __builtin_bit_cast(int, v), 0xB1, 0xf, 0xf, true));
    v += __builtin_bit_cast(float, __builtin_amdgcn_update_dpp(0, __builtin_bit_cast(int, v), 0x4E, 0xf, 0xf, true));
    v += __builtin_bit_cast(float, __builtin_amdgcn_update_dpp(0, __builtin_bit_cast(int, v), 0x141, 0xf, 0xf, true));
    v += __builtin_bit_cast(float, __builtin_amdgcn_update_dpp(0, __builtin_bit_cast(int, v), 0x140, 0xf, 0xf, true));
    v += __builtin_bit_cast(float, __builtin_amdgcn_ds_swizzle(__builtin_bit_cast(int, v), 0x401F));
    const auto sw = __builtin_amdgcn_permlane32_swap(__float_as_uint(v), __float_as_uint(v), false, false);
    return __uint_as_float(sw[0]) + __uint_as_float(sw[1]);
}
__device__ __forceinline__ void phase_pooled(Frame& F, int bidx, int nblk) {
    const int lane = lane_id(), tid = F.wave * 64 + lane;
    LAS float* H = (LAS float*)F.lds;
    bf16* P = (bf16*)(F.ws + WS_POOLED);
    for (int tile = bidx; tile < M / 64; tile += nblk) {
        const int t0 = tile * 64, s0 = t0 & (SEQ - 1);
        f32x4 v[10][4]; float rs[10];
#pragma unroll
        for (int j = 0; j < 10; ++j) {
            const int i = F.wave + 8 * j, ic = (i < 79 && s0 - 15 + i >= 0) ? i : 15;
            const f32x4* xr = (const f32x4*)(FIN(0) + (size_t)(t0 - 15 + ic) * D) + lane;
#pragma unroll
            for (int q = 0; q < 4; ++q) v[j][q] = xr[64 * q];
        }
#pragma unroll
        for (int j = 0; j < 10; ++j) { const int i = F.wave + 8 * j; float ss = 0.f;
#pragma unroll
            for (int q = 0; q < 4; ++q) ss += (v[j][q][0] * v[j][q][0] + v[j][q][1] * v[j][q][1]) + (v[j][q][2] * v[j][q][2] + v[j][q][3] * v[j][q][3]);
            ss = dpp_sum64(ss); rs[j] = (i < 79 && s0 - 15 + i >= 0) ? 1.0f / sqrtf(ss * (1.0f / D) + RMS_EPS) : 0.f; }
#pragma unroll
        for (int g = 0; g < 4; ++g) {
            const f32x4 gn = *((const f32x4*)(FIN(1) + g * 256) + lane);
#pragma unroll
            for (int j = 0; j < 10; ++j) { const int i = F.wave + 8 * j; if (i < 79) *((LAS f32x4*)(H + i * 256) + lane) = v[j][g] * rs[j] * gn; }
            __syncthreads();
            const int w = 2 << g, cp = tid & 127, rq = tid >> 7, i0 = 15 + rq * 16;
            const LAS f32x2* H2p = (const LAS f32x2*)H + cp;
            f32x2 S = (f32x2){0.f, 0.f};
            for (int j = i0 - w + 1; j <= i0; ++j) S += H2p[j * 128];
            for (int r = 0; r < 16; ++r) {
                const int i = i0 + r;
                if (r > 0) S += H2p[i * 128] - H2p[(i - w) * 128];
                const int s = s0 + rq * 16 + r; const int cnt = (s + 1 < w) ? (s + 1) : w;
                const f32x2 h = H2p[i * 128]; const float inv = 1.0f / (float)cnt;
                const f32x2 pv = S * inv - h;
                *(unsigned*)(P + (size_t)(t0 + rq * 16 + r) * D + g * 256 + 2 * cp) = cvtpk(pv[0], pv[1]);
            }
            __syncthreads();
        }
    }
}

__device__ __forceinline__ void moe_tables(Frame& F, int layer) {
    const int lane = lane_id();
    LAS int* ecnt = (LAS int*)(F.lds + TAB_ECNT); LAS int* tbase = (LAS int*)(F.lds + TAB_TBASE); LAS unsigned char* texp = (LAS unsigned char*)(F.lds + TAB_TEXP);
    if (F.wave == 0) {
        const int e = lane & 31;
        const int c = (int)__hip_atomic_load(F.ctl + CW_ECNT + layer * 2048 + e * 64, RLX_AGENT);
        const int nt = (c + 255) >> 8;
        int inc = nt;
#pragma unroll
        for (int o = 1; o < 32; o <<= 1) { const int v = __shfl_up(inc, o, 32); if (e >= o) inc += v; }
        const int exc = inc - nt;
        if (lane < 32) { ecnt[e] = c; tbase[e] = exc; if (e == 31) tbase[NE] = inc;
            for (int i = 0; i < nt; ++i) texp[exc + i] = (unsigned char)e;
            if (e == 31) for (int t = inc; t < MT_MAX; ++t) texp[t] = (unsigned char)31; }
    }
    __syncthreads();
}
__device__ __forceinline__ float rt_dpp_max(float v) {
    v = fmaxf(v, __builtin_bit_cast(float, __builtin_amdgcn_update_dpp(0, __builtin_bit_cast(int, v), 0xB1, 0xf, 0xf, true)));
    v = fmaxf(v, __builtin_bit_cast(float, __builtin_amdgcn_update_dpp(0, __builtin_bit_cast(int, v), 0x4E, 0xf, 0xf, true)));
    v = fmaxf(v, __builtin_bit_cast(float, __builtin_amdgcn_update_dpp(0, __builtin_bit_cast(int, v), 0x141, 0xf, 0xf, true)));
    v = fmaxf(v, __builtin_bit_cast(float, __builtin_amdgcn_update_dpp(0, __builtin_bit_cast(int, v), 0x140, 0xf, 0xf, true)));
    v = fmaxf(v, __builtin_bit_cast(float, __builtin_amdgcn_ds_swizzle(__builtin_bit_cast(int, v), 0x401F)));
    return v;
}
__device__ __forceinline__ void rt_load(u32x4 (&x)[8], const unsigned char* base  , unsigned off) {
#pragma unroll
    for (int g = 0; g < 4; ++g) { x[2 * g] = *(const u32x4*)(base + (off + 64u * g)); x[2 * g + 1] = *(const u32x4*)(base + (off + 64u * g + 16u)); }
}
template <bool H8>
__device__ __forceinline__ void phase_router(Frame& F, const float* src, const float* gain, bf16* dstH, int layer, int bidx, int nblk) {
    static_assert(X16, "the router reads a bf16 residual stream");
    constexpr int RB = 8;
    const int lane = lane_id(), tid = F.wave * 64 + lane, r32 = lane & 31, hi = lane >> 5;
    LAS float* PART = (LAS float*)F.lds;
    LAS float* SSP = (LAS float*)(F.lds + 34816);
    LAS float* LG = (LAS float*)(F.lds + 36864);
    LAS float* GT = (LAS float*)(F.lds + 45056);
    LAS int* lcnt = (LAS int*)(F.lds + 49152);
    LAS int* gbase = (LAS int*)(F.lds + 49280);
    LAS int* rec_ep = (LAS int*)(F.lds + 53248);
    LAS float* rec_w = (LAS float*)(F.lds + 53248 + RB * 512);
    const float* RW = FIN(9) + (size_t)layer * D * NE; const float* RBI = FIN(10) + layer * NE;
    const unsigned char* xbase = (const unsigned char*)src; const unsigned xo = (unsigned)((128 * F.wave + 16 * hi) * 2 + r32 * 2 * D);
    u32x4 xr[8];
    int tile = bidx, nb = 0, bt0 = bidx;
    __syncthreads();
    const f32x2 gl = *((const f32x2*)gain + tid);
    bf16x8 BH[8], BL[8];
    LAS u32x4* BRT = (LAS u32x4*)(F.lds + 65536) + F.wave * 64 + lane;
    const unsigned rwo = (unsigned)(((128 * F.wave + 16 * hi) * NE + r32) * 4);
    float wv[8][8]; f32x4 gv[8][2];
#pragma unroll
    for (int q = 0; q < 8; ++q) {
        const int kb = 128 * F.wave + 32 * (q >> 1) + 16 * hi + 8 * (q & 1);
        const unsigned wo = rwo + (unsigned)((32 * (q >> 1) + 8 * (q & 1)) * NE * 4);
        gv[q][0] = *(const f32x4*)(gain + kb); gv[q][1] = *(const f32x4*)(gain + kb + 4);
#pragma unroll
        for (int i = 0; i < 8; ++i) wv[q][i] = *(const float*)((const char*)RW + (wo + (unsigned)(i * NE * 4)));
    }
    if (tile < M / 32) rt_load(xr, xbase, xo + (unsigned)tile * (unsigned)(32 * 2 * D));
    *((LAS f32x2*)GT + tid) = gl;
    if (tid < NE) lcnt[tid] = 0;
#pragma unroll
    for (int q = 0; q < 8; ++q) {
        u32x4 h4, l4, r4;
#pragma unroll
        for (int j = 0; j < 4; ++j) {
            const float w0 = wv[q][2 * j] * (j < 2 ? gv[q][0][2 * j] : gv[q][1][2 * j - 4]), w1 = wv[q][2 * j + 1] * (j < 2 ? gv[q][0][2 * j + 1] : gv[q][1][2 * j - 3]);
            const unsigned H = cvtpk(w0, w1); const float a0 = w0 - bf_lo(H), a1 = w1 - bf_hi(H);
            const unsigned L = cvtpk(a0, a1); const float b0 = a0 - bf_lo(L), b1 = a1 - bf_hi(L);
            h4[j] = H; l4[j] = L; r4[j] = cvtpk(b0, b1);
        }
        BH[q] = __builtin_bit_cast(bf16x8, h4); BL[q] = __builtin_bit_cast(bf16x8, l4); BRT[q * 512] = r4;
    }
    const int ntile = M / 32;
    int* list = (int*)(F.ws + WS_LIST); int* tope_w = (int*)(F.ws + WS_TOPE); int* topp_w = (int*)(F.ws + WS_TOPP); float* topw_w = (float*)(F.ws + WS_TOPW);
    __syncthreads();
    for (; tile < ntile; tile += nblk) {
        const int t = tile * 32 + r32;
        float ss = 0.f;
#pragma unroll
        for (int q = 0; q < 8; ++q)
#pragma unroll
            for (int j = 0; j < 4; ++j) { const float a = bf_lo(xr[q][j]), b = bf_hi(xr[q][j]); ss += a * a + b * b; }
        { const auto sw = __builtin_amdgcn_permlane32_swap(__float_as_uint(ss), __float_as_uint(ss), false, false); ss = __uint_as_float(sw[0]) + __uint_as_float(sw[1]); }
        if (hi == 0) SSP[F.wave * 32 + r32] = ss;
        f32x16 acc = {};
#pragma unroll
        for (int q = 0; q < 8; ++q) { const bf16x8 xa = __builtin_bit_cast(bf16x8, xr[q]);
            acc = __builtin_amdgcn_mfma_f32_32x32x16_bf16(xa, BH[q], acc, 0, 0, 0);
            acc = __builtin_amdgcn_mfma_f32_32x32x16_bf16(xa, BL[q], acc, 0, 0, 0);
            acc = __builtin_amdgcn_mfma_f32_32x32x16_bf16(xa, __builtin_bit_cast(bf16x8, BRT[q * 512]), acc, 0, 0, 0); }
#pragma unroll
        for (int r = 0; r < 16; ++r) { const int tok = (r & 3) + 8 * (r >> 2) + 4 * hi; PART[(F.wave * 32 + tok) * 33 + r32] = acc[r]; }
        __syncthreads();
        {
            const int tok = tid >> 4, e0 = (tid & 15) * 2; float s0 = 0.f, s1 = 0.f, st = 0.f;
#pragma unroll
            for (int w = 0; w < 8; ++w) { s0 += PART[(w * 32 + tok) * 33 + e0]; s1 += PART[(w * 32 + tok) * 33 + e0 + 1]; st += SSP[w * 32 + tok]; }
            const float rs = 1.0f / sqrtf(st * (1.0f / D) + RMS_EPS);
            LG[tok * 33 + e0] = s0 * rs + RBI[e0]; LG[tok * 33 + e0 + 1] = s1 * rs + RBI[e0 + 1];
        }
        {
            float st = 0.f;
#pragma unroll
            for (int w = 0; w < 8; ++w) st += SSP[w * 32 + r32];
            const float rstd = 1.0f / sqrtf(st * (1.0f / D) + RMS_EPS);
#pragma unroll
            for (int g = 0; g < 4; ++g) { const int k0 = 128 * F.wave + 32 * g + 16 * hi;
                float hv[16];
#pragma unroll
                for (int c = 0; c < 4; ++c) { const f32x4 gq = *(const LAS f32x4*)(GT + k0 + 4 * c); const u32x4& xx = xr[2 * g + (c >> 1)]; const unsigned u0 = xx[2 * (c & 1)], u1 = xx[2 * (c & 1) + 1];
                    hv[4 * c] = bf_lo(u0) * rstd * gq[0]; hv[4 * c + 1] = bf_hi(u0) * rstd * gq[1]; hv[4 * c + 2] = bf_lo(u1) * rstd * gq[2]; hv[4 * c + 3] = bf_hi(u1) * rstd * gq[3]; }
                if constexpr (H8) { u32x4 o;
#pragma unroll
                    for (int c = 0; c < 4; ++c) o[c] = cvtfp8x4(hv[4 * c] * S8_H, hv[4 * c + 1] * S8_H, hv[4 * c + 2] * S8_H, hv[4 * c + 3] * S8_H);
                    *(u32x4*)((unsigned char*)dstH + (unsigned)(t * D + k0)) = o; }
                else { u32x4 o0, o1;
#pragma unroll
                    for (int c = 0; c < 4; ++c) { o0[c] = cvtpk(hv[2 * c], hv[2 * c + 1]); o1[c] = cvtpk(hv[8 + 2 * c], hv[8 + 2 * c + 1]); }
                    *(u32x4*)((unsigned char*)dstH + (unsigned)(t * D + k0) * 2u) = o0; *(u32x4*)((unsigned char*)dstH + ((unsigned)(t * D + k0) * 2u + 16u)) = o1; }
            }
        }
        if (tile + nblk < ntile) rt_load(xr, xbase, xo + (unsigned)(tile + nblk) * (unsigned)(32 * 2 * D));
        __syncthreads();
#pragma unroll
        for (int rd = 0; rd < 2; ++rd) {
            const int tok = 4 * F.wave + 2 * rd + hi;
            float v = LG[tok * 33 + r32]; float tv[4]; int te[4];
#pragma unroll
            for (int k = 0; k < 4; ++k) {
                const float m = rt_dpp_max(v);
                const unsigned long long bal = __builtin_amdgcn_ballot_w64(v == m);
                const unsigned hb = hi ? (unsigned)(bal >> 32) : (unsigned)bal;
                const int e = __ffs(hb) - 1;
                tv[k] = m; te[k] = e; if (r32 == e) v = -INFINITY;
            }
            float tw[4], sum = 0.f;
#pragma unroll
            for (int k = 0; k < 4; ++k) { tw[k] = __expf(tv[k] - tv[0]); sum += tw[k]; }
            const float inv = 1.0f / sum;
            if (r32 < 4) { const int e = r32 == 0 ? te[0] : r32 == 1 ? te[1] : r32 == 2 ? te[2] : te[3]; const float w = (r32 == 0 ? tw[0] : r32 == 1 ? tw[1] : r32 == 2 ? tw[2] : tw[3]) * inv;
                const int lp = atomicAdd((int*)(lcnt + e), 1); const int ix = (nb * 32 + tok) * 4 + r32; rec_ep[ix] = e | (lp << 8); rec_w[ix] = w; }
        }
        ++nb;
        if (nb == RB || tile + nblk >= ntile) {
            __syncthreads();
            if (tid < NE) { const int c = lcnt[tid]; gbase[tid] = c > 0 ? (int)__hip_atomic_fetch_add(F.ctl + CW_ECNT + layer * 2048 + tid * 64, (unsigned)c, RLX_AGENT) : 0; lcnt[tid] = 0; }
            __syncthreads();
            for (int ix = tid; ix < nb * 128; ix += NWAVES * 64) { const int tl = ix >> 2, k = ix & 3, tt = (bt0 + (tl >> 5) * nblk) * 32 + (tl & 31);
                const int ep = rec_ep[ix], e = ep & 255, pos = gbase[e] + (ep >> 8);
                list[e * M + pos] = tt; tope_w[tt * 4 + k] = e; topp_w[tt * 4 + k] = pos; topw_w[tt * 4 + k] = rec_w[ix]; }
            nb = 0; bt0 = tile + nblk;
        }
    }
    __syncthreads();
}

template <bool NORM, bool O8, bool DSTF32  >
__device__ __forceinline__ void phase_combine(Frame& F, const float* src, float* dstX, const float* gain, bf16* dstH, int layer) {
    const int lane = lane_id();
    moe_tables(F, layer);
    const LAS int* tbase = (const LAS int*)(F.lds + TAB_TBASE);
    const int* tope = (const int*)(F.ws + WS_TOPE); const int* topp = (const int*)(F.ws + WS_TOPP); const float* topw = (const float*)(F.ws + WS_TOPW);
    const unsigned char* OUTS = F.ws + WS_OUTS;
    constexpr int ORB = O8 ? D : 2 * D;
    f32x4 gn[4];
    if (NORM) {
#pragma unroll
        for (int q = 0; q < 4; ++q) gn[q] = *(const f32x4*)(gain + 8 * lane + 512 * (q >> 1) + 4 * (q & 1)); }
    for (int tile = blockIdx.x; tile < M / 64; tile += F.G) {
        const int t0 = tile * 64 + F.wave * 8;
        int e_l = 0, p_l = 0; float w_l = 0.f;
        if (lane < 32) { e_l = tope[t0 * 4 + lane]; p_l = topp[t0 * 4 + lane]; w_l = topw[t0 * 4 + lane]; }
        const int slot_l = tbase[e_l] * 256 + p_l;
        if (O8) w_l *= (1.0f / S8_OUT);
#pragma unroll
        for (int b = 0; b < 2; ++b) {
            f32x4 x[4][4];
#pragma unroll
            for (int r = 0; r < 4; ++r) { const size_t ro = (size_t)(t0 + 4 * b + r) * D + 8 * lane; x[r][0] = xs_ld4(src, ro); x[r][1] = xs_ld4(src, ro + 4); x[r][2] = xs_ld4(src, ro + 512); x[r][3] = xs_ld4(src, ro + 516); }
            u32x4 o[4][4][O8 ? 1 : 2];
#pragma unroll
            for (int r = 0; r < 4; ++r)
#pragma unroll
                for (int k = 0; k < 4; ++k) { const int slot = __builtin_amdgcn_readlane(slot_l, (4 * b + r) * 4 + k); const unsigned char* ob = OUTS + (size_t)slot * ORB;
                    if constexpr (O8) { const u32x2 lo = *(const u32x2*)(ob + 8 * lane), hi = *(const u32x2*)(ob + 512 + 8 * lane); o[r][k][0] = (u32x4){lo.x, lo.y, hi.x, hi.y}; }
                    else { o[r][k][0] = *(const u32x4*)(ob + 16 * lane); o[r][k][1] = *(const u32x4*)(ob + 1024 + 16 * lane); } }
#pragma unroll
            for (int r = 0; r < 4; ++r) {
#pragma unroll
                for (int k = 0; k < 4; ++k) { const float wk = __uint_as_float((unsigned)__builtin_amdgcn_readlane((int)__float_as_uint(w_l), (4 * b + r) * 4 + k));
                    if constexpr (O8) {
#pragma unroll
                        for (int q = 0; q < 4; ++q) { const f32x2 a = __builtin_amdgcn_cvt_pk_f32_fp8((int)o[r][k][0][q], false), c = __builtin_amdgcn_cvt_pk_f32_fp8((int)o[r][k][0][q], true);
                            x[r][q] += (f32x4){a[0], a[1], c[0], c[1]} * wk; } }
                    else {
#pragma unroll
                        for (int j = 0; j < 2; ++j) { const u32x4 v = o[r][k][j];
                            x[r][2 * j] += (f32x4){bf_lo(v.x), bf_hi(v.x), bf_lo(v.y), bf_hi(v.y)} * wk; x[r][2 * j + 1] += (f32x4){bf_lo(v.z), bf_hi(v.z), bf_lo(v.w), bf_hi(v.w)} * wk; } } }
                const int t = t0 + 4 * b + r;
                if constexpr (DSTF32) { f32x4* xo = (f32x4*)(dstX + (size_t)t * D + 8 * lane); xo[0] = x[r][0]; xo[1] = x[r][1]; xo[128] = x[r][2]; xo[129] = x[r][3]; }
                else { const size_t ro = (size_t)t * D + 8 * lane; xs_st4(dstX, ro, x[r][0]); xs_st4(dstX, ro + 4, x[r][1]); xs_st4(dstX, ro + 512, x[r][2]); xs_st4(dstX, ro + 516, x[r][3]); }
                if (NORM) {
                    float ss = 0.f;
#pragma unroll
                    for (int q = 0; q < 4; ++q) ss += (x[r][q][0] * x[r][q][0] + x[r][q][1] * x[r][q][1]) + (x[r][q][2] * x[r][q][2] + x[r][q][3] * x[r][q][3]);
                    ss = wave_sum(ss); const float rstd = 1.0f / sqrtf(ss * (1.0f / D) + RMS_EPS);
#pragma unroll
                    for (int j = 0; j < 2; ++j) { const f32x4 a = x[r][2 * j] * rstd * gn[2 * j], c = x[r][2 * j + 1] * rstd * gn[2 * j + 1];
                        if constexpr (QKV8) *(u32x2*)((unsigned char*)dstH + (size_t)t * D + 8 * lane + 512 * j) = (u32x2){cvtfp8x4(a[0] * S8_H, a[1] * S8_H, a[2] * S8_H, a[3] * S8_H), cvtfp8x4(c[0] * S8_H, c[1] * S8_H, c[2] * S8_H, c[3] * S8_H)};
                        else *(u32x4*)(dstH + (size_t)t * D + 8 * lane + 512 * j) = (u32x4){cvtpk(a[0], a[1]), cvtpk(a[2], a[3]), cvtpk(c[0], c[1]), cvtpk(c[2], c[3])}; }
                }
            }
        }
    }
}

template <bool FP8, bool OUT8>
__device__ __forceinline__ void phase_moe_up(Frame& F, int layer, int G = 0  ) {
    if (G == 0) G = F.G;
    const int lane = lane_id(), tid = F.wave * 64 + lane; (void)tid;
    moe_tables(F, layer);
    const LAS int* ecnt = (const LAS int*)(F.lds + TAB_ECNT); const LAS int* tbase = (const LAS int*)(F.lds + TAB_TBASE);
    const int rowb = FP8 ? D : 2 * D;
    ProbMoeUp S{(const char*)(F.ws + WS_H2), FP8 ? (const char*)(F.ws + WS_WGU8) + (size_t)(1 - layer) * 64 * MiB : (const char*)(F.ws + WS_WGU) + (size_t)layer * NE * 2048 * 1024 * 2, F.lds, rowb, rowb, __builtin_amdgcn_readfirstlane(tbase[NE]), G, (int)blockIdx.x, F.wave};
    {
        const int* list = (const int*)(F.ws + WS_LIST); LAS unsigned* rt = (LAS unsigned*)(F.lds + TAB_ROW);
        pg8::Unit u, u0;
#pragma nounroll
        for (int ord0 = 0; ord0 < MAXU && S.next(ord0, u0); ord0 += 2) {
            const int ord = ord0 + (F.wave >> 2), r = tid & 255;
            if (ord < MAXU && S.next(ord, u)) { const int p = (u.pm - tbase[u.e]) * 256 + r; const int tok = (p < ecnt[u.e]) ? list[u.e * M + p] : 0; rt[ord * 256 + r] = (unsigned)tok * (unsigned)rowb; }
        }
        __syncthreads();
    }
    EpiGateUp<OUT8, FP8 ? 9 : 0> E{(bf16*)(F.ws + WS_ACT), FIN(12) + (size_t)layer * NE * 2048};
    pg8::gemm_phase<ProbMoeUp, EpiGateUp<OUT8, FP8 ? 9 : 0>, FP8, 0>(F.lds, S, E);
}
template <bool FP8, bool OUT8>
__device__ __forceinline__ void phase_moe_down(Frame& F, int layer, int G = 0) {
    if (G == 0) G = F.G;
    moe_tables(F, layer);
    const LAS int* tbase = (const LAS int*)(F.lds + TAB_TBASE);
    const int rowb = FP8 ? FF : 2 * FF;
    ProbMoeDown S{(const char*)(F.ws + WS_ACT), FP8 ? (const char*)(F.ws + WS_WDN8) + (size_t)(1 - layer) * 32 * MiB : (const char*)(F.ws + WS_WDN) + (size_t)layer * NE * 1024 * 1024 * 2, F.lds, rowb, rowb, __builtin_amdgcn_readfirstlane(tbase[NE]), G, (int)blockIdx.x, F.wave};
    constexpr bool PRE = FP8 && OUT8;
    EpiDown<OUT8, PRE> E{(bf16*)(F.ws + WS_OUTS), FIN(14) + (size_t)layer * NE * 1024};
    pg8::gemm_phase<ProbMoeDown, EpiDown<OUT8, PRE>, FP8, E8_DOWN + (PRE ? 4 : 0)>(F.lds, S, E);
}

__device__ __forceinline__ int crow(int r, int hi) { return (r & 3) + 8 * (r >> 2) + 4 * hi; }
typedef LAS const char* lds_cptr;
__device__ __forceinline__ s16x4 vtr(lds_cptr p) { return __builtin_bit_cast(s16x4, __builtin_amdgcn_ds_read_tr16_b64_v4i16((LAS v4i16_t*)p)); }
#ifndef MK_ATT_CUT
#define MK_ATT_CUT 64.0f
#endif
constexpr float ATT_CUT = MK_ATT_CUT;
struct AttPre { bf16x8 q[4]; u32x4 k0[2], v0[2], k1[2], v1[2]; };
__device__ __forceinline__ void att_prefetch(Frame& F, int bh, int qbA, int qbB, AttPre& P) {
    const int lane = lane_id(), r32 = lane & 31, hi = lane >> 5, wid = F.wave, sub = wid >> 2, ws = wid & 3, tids = ws * 64 + lane;
    const bf16* Qh = (const bf16*)(F.ws + WS_Q) + (size_t)bh * SEQ * HD; const bf16* Kh = (const bf16*)(F.ws + WS_K) + (size_t)bh * SEQ * HD; const bf16* Vh = (const bf16*)(F.ws + WS_V) + (size_t)bh * SEQ * HD;
    const int q0 = (sub ? qbB : qbA) * 128, qpos = q0 + 32 * ws + r32, jtop = (q0 >> 6) + 1;
#pragma unroll
    for (int d0 = 0; d0 < 4; ++d0) P.q[d0] = *(const bf16x8*)(Qh + (size_t)qpos * HD + d0 * 16 + hi * 8);
#pragma unroll
    for (int i = 0; i < 2; ++i) { const int p = tids + 256 * i, wv = p >> 6, l = p & 63;
        const bf16* kp = Kh + (size_t)l * HD + wv * 8; const bf16* vp = Vh + (size_t)(16 * (wv & 3) + (l >> 2)) * HD + (wv >> 2) * 32 + (l & 3) * 8;
        P.k0[i] = *(const u32x4*)(kp + (size_t)jtop * 64 * HD); P.v0[i] = *(const u32x4*)(vp + (size_t)jtop * 64 * HD);
        P.k1[i] = *(const u32x4*)(kp + (size_t)(jtop - 1) * 64 * HD); P.v1[i] = *(const u32x4*)(vp + (size_t)(jtop - 1) * 64 * HD); }
}
__device__ __forceinline__ void attn_pair(Frame& F, int bh, int qbA, int qbB, const AttPre& P, int nA, int nB, AttPre& N) {
    const int lane = lane_id(), r32 = lane & 31, hi = lane >> 5, wid = F.wave, sub = wid >> 2, ws = wid & 3, tids = ws * 64 + lane;
    const bf16* Qh = (const bf16*)(F.ws + WS_Q) + (size_t)bh * SEQ * HD; const bf16* Kh = (const bf16*)(F.ws + WS_K) + (size_t)bh * SEQ * HD; const bf16* Vh = (const bf16*)(F.ws + WS_V) + (size_t)bh * SEQ * HD;
    const int q0 = (sub ? qbB : qbA) * 128, qw = q0 + 32 * ws, qpos = qw + r32, jd = qw >> 6, jtop = (q0 >> 6) + 1;
    LAS unsigned char* KB = F.lds + sub * 49152; LAS unsigned char* VB = KB + 24576; LAS unsigned char* OST = F.lds + 98304 + wid * 4096;
    const bf16* ksrc[2]; const bf16* vsrc[2];
#pragma unroll
    for (int i = 0; i < 2; ++i) { const int p = tids + 256 * i, wv = p >> 6, l = p & 63;
        ksrc[i] = Kh + (size_t)l * HD + wv * 8; vsrc[i] = Vh + (size_t)(16 * (wv & 3) + (l >> 2)) * HD + (wv >> 2) * 32 + (l & 3) * 8; }
    bf16x8 qr[4];
#pragma unroll
    for (int d0 = 0; d0 < 4; ++d0) qr[d0] = P.q[d0];
    f32x16 o0 = {}, o1 = {};
    float C = 0.f;
    const int up = ws >> 1;
    int bw = (jtop - 1 + up) % 3, bwr = (jtop + 1) % 3;
    bool done = false;
    LAS int* flags = (LAS int*)(F.MISC + 24);
    {
#pragma unroll
      for (int i = 0; i < 2; ++i) {
          *(LAS u32x4*)(KB + (jtop % 3) * 8192 + (tids + 256 * i) * 16) = P.k0[i]; *(LAS u32x4*)(VB + (jtop % 3) * 8192 + (tids + 256 * i) * 16) = P.v0[i];
          *(LAS u32x4*)(KB + ((jtop - 1) % 3) * 8192 + (tids + 256 * i) * 16) = P.k1[i]; *(LAS u32x4*)(VB + ((jtop - 1) % 3) * 8192 + (tids + 256 * i) * 16) = P.v1[i]; } }
    u32x4 kS[2], vS[2];
    __syncthreads();
    if (nA >= 0) att_prefetch(F, bh, nA, nB, N);
    bool brk = false;
#define ATT_STEP() do { const int lo = jtop - 1 - st, j = lo + up;       \
        if (lo > 0) { _Pragma("unroll") for (int i = 0; i < 2; ++i) { kS[i] = *(const u32x4*)(ksrc[i] + (size_t)(lo - 1) * 64 * HD); vS[i] = *(const u32x4*)(vsrc[i] + (size_t)(lo - 1) * 64 * HD); } } \
        att_compute(j); \
        if (lo > 0) { _Pragma("unroll") for (int i = 0; i < 2; ++i) { *(LAS u32x4*)(KB + bwr * 8192 + (tids + 256 * i) * 16) = kS[i]; *(LAS u32x4*)(VB + bwr * 8192 + (tids + 256 * i) * 16) = vS[i]; } } \
        if (lane == 0) flags[(st & 1) * 8 + wid] = (done || j <= 0) ? 1 : 0; \
        __syncthreads(); \
        brk = __all(flags[(st & 1) * 8 + (lane & 7)] != 0); bw = bw == 0 ? 2 : bw - 1; bwr = bwr == 0 ? 2 : bwr - 1; ++st; } while (0)
    auto att_compute = [&](const int j) __attribute__((always_inline)) {
        if (j >= 0 && j <= jd && !done) {
            const lds_cptr kb = (lds_cptr)(KB + bw * 8192) + hi * 1024 + r32 * 16;
            f32x16 p0 = {}, p1 = {};
#pragma unroll
            for (int d0 = 0; d0 < 4; ++d0) { const bf16x8 b0 = *(const LAS bf16x8*)(kb + d0 * 2048), b1 = *(const LAS bf16x8*)(kb + d0 * 2048 + 512);
                p0 = __builtin_amdgcn_mfma_f32_32x32x16_bf16(b0, qr[d0], p0, 0, 0, 0); p1 = __builtin_amdgcn_mfma_f32_32x32x16_bf16(b1, qr[d0], p1, 0, 0, 0); }
            float L0[16], L1[16];
#pragma unroll
            for (int r = 0; r < 16; ++r) { L0[r] = __builtin_amdgcn_logf(1.0f + __builtin_amdgcn_exp2f(p0[r])); L1[r] = __builtin_amdgcn_logf(1.0f + __builtin_amdgcn_exp2f(p1[r])); }
            if (j == jd) {
                const int kb0 = 64 * j + 4 * hi;
#pragma unroll
                for (int r = 0; r < 16; ++r) { const int kv = kb0 + (r & 3) + 8 * (r >> 2);
                    if (kv >= qpos) { L0[r] = 0.f; p0[r] = -INFINITY; } if (kv + 32 >= qpos) { L1[r] = 0.f; p1[r] = -INFINITY; } }
            }
            float tg[8];
#pragma unroll
            for (int g = 0; g < 4; ++g) {
                L0[4 * g + 2] += L0[4 * g + 3]; L0[4 * g + 1] += L0[4 * g + 2]; L0[4 * g] += L0[4 * g + 1]; tg[g] = L0[4 * g];
                L1[4 * g + 2] += L1[4 * g + 3]; L1[4 * g + 1] += L1[4 * g + 2]; L1[4 * g] += L1[4 * g + 1]; tg[4 + g] = L1[4 * g]; }
            float off[8]; float R = C;
#pragma unroll
            for (int g = 7; g >= 0; --g) {
                const auto rr = __builtin_amdgcn_permlane32_swap(__float_as_uint(tg[g]), __float_as_uint(tg[g]), false, false);
                const float tlo = __uint_as_float(rr[0]), thi = __uint_as_float(rr[1]);
                off[g] = R + (hi ? 0.f : thi);
                R += tlo + thi; }
            C = R;
#pragma unroll
            for (int g = 0; g < 4; ++g)
#pragma unroll
                for (int i = 0; i < 4; ++i) { p0[4 * g + i] = __builtin_amdgcn_exp2f(p0[4 * g + i] - (L0[4 * g + i] + off[g])); p1[4 * g + i] = __builtin_amdgcn_exp2f(p1[4 * g + i] - (L1[4 * g + i] + off[4 + g])); }
            u32x4 pw0, pw1, pw2, pw3;
            pw0 = (u32x4){cvtpk(p0[0], p0[1]), cvtpk(p0[2], p0[3]), cvtpk(p0[4], p0[5]), cvtpk(p0[6], p0[7])};
            pw1 = (u32x4){cvtpk(p0[8], p0[9]), cvtpk(p0[10], p0[11]), cvtpk(p0[12], p0[13]), cvtpk(p0[14], p0[15])};
            pw2 = (u32x4){cvtpk(p1[0], p1[1]), cvtpk(p1[2], p1[3]), cvtpk(p1[4], p1[5]), cvtpk(p1[6], p1[7])};
            pw3 = (u32x4){cvtpk(p1[8], p1[9]), cvtpk(p1[10], p1[11]), cvtpk(p1[12], p1[13]), cvtpk(p1[14], p1[15])};
            const lds_cptr vp = (lds_cptr)(VB + bw * 8192) + ((lane >> 4) & 1) * 32 + (lane & 3) * 8 + (4 * hi + ((lane & 15) >> 2)) * 64;
#define PVSTEP(OACC, D0, KS, PW) do { const s16x4 lo_ = vtr(vp + (D0) * 4096 + (KS) * 1024), hi_ = vtr(vp + (D0) * 4096 + (KS) * 1024 + 512); \
                const bf16x8 vf_ = (bf16x8){lo_[0], lo_[1], lo_[2], lo_[3], hi_[0], hi_[1], hi_[2], hi_[3]}; \
                OACC = __builtin_amdgcn_mfma_f32_32x32x16_bf16(__builtin_bit_cast(bf16x8, PW), vf_, OACC, 0, 0, 0); } while (0)
            PVSTEP(o0, 0, 0, pw0); PVSTEP(o1, 1, 0, pw0); PVSTEP(o0, 0, 1, pw1); PVSTEP(o1, 1, 1, pw1);
            PVSTEP(o0, 0, 2, pw2); PVSTEP(o1, 1, 2, pw2); PVSTEP(o0, 0, 3, pw3); PVSTEP(o1, 1, 3, pw3);
#undef PVSTEP
            done = __all(C > ATT_CUT);
        }
    };
    for (int st = 0; ; ) {
        ATT_STEP(); if (brk) break;
    }
#undef ATT_STEP
    { LAS bf16* stg = (LAS bf16*)OST;
#pragma unroll
      for (int r = 0; r < 16; ++r) { const int orow = crow(r, hi); stg[orow * 64 + r32] = (bf16)(cvtpk(o0[r], 0.f) & 0xffffu); stg[orow * 64 + 32 + r32] = (bf16)(cvtpk(o1[r], 0.f) & 0xffffu); }
      LDS_WAIT(); asm volatile("" ::: "memory");
      const int b = bh >> 4, h = bh & 15;
      bf16* Ow = (bf16*)(F.ws + WS_O) + ((size_t)b * SEQ + qw) * D + h * HD;
#pragma unroll
      for (int i = 0; i < 4; ++i) { const int row = i * 8 + (lane >> 3), ch = lane & 7; const u32x4 vv = *(const LAS u32x4*)(stg + row * 64 + ch * 8); *(u32x4*)(Ow + (size_t)row * D + ch * 8) = vv; } }
    __syncthreads();
}
__device__ __forceinline__ void phase_attn(Frame& F) {
    for (int v = blockIdx.x; v < BATCH * NH * 2; v += F.G) {
        const int bh = v >> 1, odd = v & 1;
        AttPre P0, P1; att_prefetch(F, bh, 8 * odd, 8 * odd + 1, P0);
#pragma unroll
        for (int i = 0; i < 4; ++i) { const int qa = 8 * odd + 2 * i;
            if ((i & 1) == 0) attn_pair(F, bh, qa, qa + 1, P0, i < 3 ? qa + 2 : -1, qa + 3, P1);
            else attn_pair(F, bh, qa, qa + 1, P1, i < 3 ? qa + 2 : -1, qa + 3, P0); }
    }
}

__global__ void __launch_bounds__(NWAVES * 64, 2) fwd_kernel(Args args) {
    extern __shared__ __attribute__((aligned(16))) unsigned char lds[];
    Frame F;
    F.lds = (LAS unsigned char*)lds; F.MISC = (volatile LAS unsigned*)(F.lds + MISC_OFF);
    F.wave = __builtin_amdgcn_readfirstlane((int)threadIdx.x >> 6); F.G = gridDim.x;
    F.ws = args.ws; F.ctl = (gu32*)(args.ws + WS_CTL);
    for (int u = (int)threadIdx.x; u < (LDS_BYTES - LDSCTL_OFF) / 4; u += NWAVES * 64) ((LAS unsigned*)(F.lds + LDSCTL_OFF))[u] = 0u;
    __syncthreads();
    const XcdBarrier bar = xcd_barrier_post((unsigned*)(F.ctl + CW_BAR), F.MISC + 8, gridDim.x);
#define TP_PUT(i) do { if (threadIdx.x == 0) { const unsigned long long t_ = __builtin_amdgcn_s_memrealtime(); F.MISC[16 + 2 * (i)] = (unsigned)t_; F.MISC[17 + 2 * (i)] = (unsigned)(t_ >> 32); } } while (0)
#define SEAM(k) do { xcd_barrier(bar); if (MK_TPROBE == ((k) == 0 ? 3 : (k) + 1)) TP_PUT(0); if (MK_TPROBE == (k)) TP_PUT(1); } while (0)
    if (MK_TPROBE == 0) TP_PUT(0);
    float* X1 = (float*)(F.ws + WS_X1); float* X2 = (float*)(F.ws + WS_X2); float* X3 = (float*)(F.ws + WS_X3);

    const bool tuned = (F.G == 256);
    const int nfront = tuned ? NFRONT : F.G, cv3 = tuned ? CV3 : 0, cv9 = tuned ? CV9 : 0, h4 = tuned ? H4 : 0, h10 = tuned ? H10 : 0, h6 = tuned ? H6 : 0;
    const int i10 = CV_END - h10, i9 = i10 - cv9, i6 = i9 - h6, i4 = i6 - h4, i3 = i4 - cv3;
    {
        const int bx = (int)blockIdx.x;
        if (bx < nfront) {
            const XcdBarrier fbar = xcd_barrier_post((unsigned*)(F.ctl + CW_BAR2), F.MISC + 10, (unsigned)nfront);
            phase_convert(F, 0, CV_SMALL, bx, nfront); __syncthreads();
            phase_pooled(F, bx, nfront);
            xcd_barrier(fbar);
            { ProbPool S{(const char*)(F.ws + WS_POOLED), (const char*)(F.ws + WS_POOLW), 512, 512, nfront, bx, F.wave}; EpiPool E{FIN(0), X1, FIN(3)};
              pg8::gemm_phase<ProbPool, EpiPool>(F.lds, S, E); }
            xcd_barrier(fbar);
            phase_router<FP8_U0>(F, X1, FIN(8), (bf16*)(F.ws + WS_H2), 0, bx, nfront);
            if (nfront == F.G) phase_convert(F, CV_SMALL, CV_END, bx, F.G);
            else convert_queue(F, CV_SMALL, i3, F.ctl + CW_QUEUE + 192);
        } else {
            convert_queue(F, CV_SMALL, i3, F.ctl + CW_QUEUE + 192);
        }
    }
    SEAM(0);
    { const int bx = (int)blockIdx.x;
        if (!(tuned && bx >= G3)) phase_moe_up<FP8_U0, FP8_D0>(F, 0, tuned ? G3 : 0);
        if (cv3 > 0) convert_queue(F, i3, i4, F.ctl + CW_QUEUE); }
    SEAM(3);
    if (!(tuned && (int)blockIdx.x >= G4)) phase_moe_down<FP8_D0, OUT8_L0>(F, 0, tuned ? G4 : 0);
    if (h4 > 0) convert_queue(F, i4, i6, F.ctl + CW_QUEUE + 64);
    SEAM(4);
    phase_combine<true, OUT8_L0, false>(F, X1, X2, FIN(1) + D, (bf16*)(F.ws + WS_HQ), 0);
    SEAM(5);
    if (!(h6 > 0 && (int)blockIdx.x >= G6)) { ProbDense S{(const char*)(F.ws + WS_HQ), (const char*)(F.ws + WS_WQKV), QKV8 ? D : 2 * D, QKV8 ? D : 2 * D, QKV8 ? D : 2 * D, M / 256, 12, h6 > 0 ? G6 : F.G, (int)blockIdx.x, F.wave}; { const int l_ = lane_id(); if (F.wave == 0) { ((LAS float*)(F.lds + BIAS_OFF))[l_] = FIN(5)[l_]; ((LAS float*)(F.lds + BIAS_OFF))[64 + l_] = FIN(6)[l_]; } __syncthreads(); }
        EpiQKV<QKV8 ? 9 : 0> E{(bf16*)(F.ws + WS_Q), (const LAS float*)(F.lds + BIAS_OFF)};
        pg8::gemm_phase<ProbDense, EpiQKV<QKV8 ? 9 : 0>, QKV8, 0>(F.lds, S, E); }
    if (h6 > 0) convert_queue(F, i6, i9, F.ctl + CW_QUEUE + 320);
    SEAM(6);
    phase_attn(F);
    SEAM(7);
    { ProbDense S{(const char*)(F.ws + WS_O), (const char*)(F.ws + WS_WO), 2 * D, 2 * D, 2 * D, M / 256, 4, F.G, (int)blockIdx.x, F.wave}; EpiRes E{X2, X3};
        pg8::gemm_phase<ProbDense, EpiRes>(F.lds, S, E); }
    SEAM(8);
    {
        const int bx = (int)blockIdx.x;
        if (cv9 == 0) phase_router<true>(F, X3, FIN(8) + D, (bf16*)(F.ws + WS_H2), 1, bx, F.G);
        else if (bx < NR9) phase_router<true>(F, X3, FIN(8) + D, (bf16*)(F.ws + WS_H2), 1, bx, NR9);
        else phase_convert(F, i9, i10, bx - NR9, F.G - NR9);
    }
    SEAM(9);
    if (!(tuned && (int)blockIdx.x >= G10)) phase_moe_up<true, true>(F, 1, tuned ? G10 : 0);
    if (h10 > 0) convert_queue(F, i10, CV_END, F.ctl + CW_QUEUE + 128);
    SEAM(10);
    phase_moe_down<true, true>(F, 1);
    SEAM(11);
    phase_combine<false, true, true>(F, X3, FOUT, nullptr, nullptr, 1);
    if (MK_TPROBE >= 0) { if (MK_TPROBE == 12) TP_PUT(1);
        if (blockIdx.x == 0 && threadIdx.x == 0) { const unsigned long long tp0 = ((unsigned long long)F.MISC[17] << 32) | F.MISC[16], tp1 = ((unsigned long long)F.MISC[19] << 32) | F.MISC[18];
            const unsigned long long dt = (tp1 - tp0) * 4, ts = __builtin_amdgcn_s_memrealtime();
            while (__builtin_amdgcn_s_memrealtime() - ts < dt) __builtin_amdgcn_s_sleep(8); } }
#undef SEAM
}

extern "C" void kernel_launch(void* const* d_in, const int* in_sizes, int n_in, void* d_out, int out_size, void* d_ws, size_t ws_size, hipStream_t stream) {
    static int grid = 0;
    if (grid == 0) {
        if (n_in != 15 || in_sizes[0] != M * D || out_size != M * D || ws_size < WS_END) { fprintf(stderr, "kernel_launch: unexpected shapes (n_in %d, in0 %d, out %d, ws %zu, need %zu)\n", n_in, n_in > 0 ? in_sizes[0] : -1, out_size, ws_size, (size_t)WS_END); grid = -1; return; }
        int dev = 0, cus = 0, per_cu = 0;
        if (hipGetDevice(&dev) != hipSuccess || hipDeviceGetAttribute(&cus, hipDeviceAttributeMultiprocessorCount, dev) != hipSuccess) { grid = -1; return; }
        if (hipFuncSetAttribute((const void*)fwd_kernel, hipFuncAttributeMaxDynamicSharedMemorySize, LDS_BYTES) != hipSuccess) { fprintf(stderr, "kernel_launch: hipFuncSetAttribute failed\n"); grid = -1; return; }
        if (hipOccupancyMaxActiveBlocksPerMultiprocessor(&per_cu, (const void*)fwd_kernel, NWAVES * 64, LDS_BYTES) != hipSuccess || per_cu < 1) fprintf(stderr, "kernel_launch: occupancy query says %d\n", per_cu);
        (void)hipGetLastError();
        grid = cus;
    }
    if (grid < 0) return;
    (void)hipMemsetAsync((char*)d_ws + WS_CTL, 0, CTL_ZERO_BYTES, stream);
    Args a{};
    for (int i = 0; i < 15; ++i) a.in[i] = (const float*)d_in[i];
    a.out = (float*)d_out; a.ws = (unsigned char*)d_ws;
    hipLaunchKernelGGL(fwd_kernel, dim3(grid), dim3(NWAVES * 64), LDS_BYTES, stream, a);
    const hipError_t le = hipPeekAtLastError();
    if (le != hipSuccess) fprintf(stderr, "kernel_launch: launch failed: %s\n", hipGetErrorName(le));
}
```
